# Optimizing an MI355X kernel written in HIP

```python
import math
import jax, jax.numpy as jnp
from jax import lax
import numpy as np

D_MODEL = 1024
BATCH = 8
SEQ = 4096
DEPTH = 2

GRID_W = 64
CTX_LEN = 256
N_MOD = 6
EPS = 1e-6

D_CONV = D_MODEL // 2
CONV_WIDTH = 31
D_POOL = D_MODEL // 2
POOL_WINDOWS = (2, 4, 8, 16)
POOL_GROUP = D_POOL // len(POOL_WINDOWS)
EVEN_IN = 2 * D_CONV + D_POOL
EVEN_MIX = D_CONV + D_POOL

MLA_HEADS = 4
Q_LORA = D_MODEL // 4
KV_LORA = D_MODEL // 8
QK_NOPE = 128
QK_ROPE = 64
V_HEAD = 128
DIFF_HEADS = 4
DIFF_QK = 64
DIFF_V = 128
DIFF_QK_COLS = DIFF_HEADS * 2 * DIFF_QK
Q_COLS = Q_LORA + DIFF_QK_COLS
KV_COLS = KV_LORA + QK_ROPE + DIFF_QK_COLS + DIFF_HEADS * DIFF_V
ODD_IN = Q_COLS + KV_COLS
ODD_MIX = MLA_HEADS * V_HEAD + DIFF_HEADS * DIFF_V
MLA_SCALE = (QK_NOPE + QK_ROPE) ** -0.5
DIFF_SCALE = DIFF_QK ** -0.5
ROPE_BASE = 10000.0
Q_BLOCK = 128

N_EXPERTS = 32
N_GROUPS = 8
EXPERTS_PER_GROUP = N_EXPERTS // N_GROUPS
TOP_K = 2
D_EXPERT = 256

N_EVEN = (DEPTH + 1) // 2
N_ODD = DEPTH // 2

kernel_name = "hybrid_conv_pool_mla_diffattn_moe_dit"


def rms_norm(x, g):
    xf = x.astype(jnp.float32)
    y = xf * lax.rsqrt(jnp.mean(xf * xf, axis=-1, keepdims=True) + EPS)
    return (y * g).astype(x.dtype)


def layer_norm(x, g, b):
    xf = x.astype(jnp.float32)
    mu = jnp.mean(xf, axis=-1, keepdims=True)
    xc = xf - mu
    y = xc * lax.rsqrt(jnp.mean(xc * xc, axis=-1, keepdims=True) + EPS)
    return (y * g + b).astype(x.dtype)


def modulate(h, shift, scale):
    return h * (1.0 + scale) + shift


def axial_rope_tables(rows, rot_dim):
    row = jnp.repeat(jnp.arange(rows, dtype=jnp.float32), GRID_W)
    col = jnp.tile(jnp.arange(GRID_W, dtype=jnp.float32), rows)
    axis_dim = rot_dim // 2
    inv_freq = ROPE_BASE ** (-jnp.arange(0, axis_dim, 2, dtype=jnp.float32) / axis_dim)
    ang = jnp.concatenate([row[:, None] * inv_freq, col[:, None] * inv_freq], axis=-1)
    return jnp.cos(ang), jnp.sin(ang)


def apply_rope(x, cos, sin):
    half = x.shape[-1] // 2
    shape = (1, x.shape[1]) + (1,) * (x.ndim - 3) + (half,)
    cs = cos.reshape(shape).astype(x.dtype)
    sn = sin.reshape(shape).astype(x.dtype)
    x1, x2 = x[..., :half], x[..., half:]
    return jnp.concatenate([x1 * cs - x2 * sn, x2 * cs + x1 * sn], axis=-1)


def attend(q, k, v, scale):
    b, lq, h, dk = q.shape
    nb = lq // Q_BLOCK
    qb = jnp.moveaxis(q.reshape(b, nb, Q_BLOCK, h, dk), 1, 0)

    def one_block(qi):
        s = jnp.einsum('bqhd,bkhd->bhqk', qi, k).astype(jnp.float32) * scale
        p = jax.nn.softmax(s, axis=-1).astype(v.dtype)
        return jnp.einsum('bhqk,bkhd->bqhd', p, v)

    out = lax.map(one_block, qb)
    return jnp.moveaxis(out, 0, 1).reshape(b, lq, h, v.shape[-1])


def conformer_conv(u, dw_w, dw_b, ln_g, ln_b):
    a, g = jnp.split(u, 2, axis=-1)
    y = a * jax.nn.sigmoid(g)
    y = lax.conv_general_dilated(
        y, dw_w[:, None, :], window_strides=(1,),
        padding=[(CONV_WIDTH // 2, CONV_WIDTH // 2)],
        dimension_numbers=('NWC', 'WIO', 'NWC'),
        feature_group_count=D_CONV) + dw_b
    return jax.nn.silu(layer_norm(y, ln_g, ln_b))


def centred_mean_minus_self(x, w):
    n = x.shape[1]
    xf = x.astype(jnp.float32)
    cs = jnp.concatenate([jnp.zeros_like(xf[:, :1]), jnp.cumsum(xf, axis=1)], axis=1)
    t = jnp.arange(n)
    lo = jnp.clip(t - w // 2, 0, n)
    hi = jnp.clip(t + w // 2, 0, n)
    cnt = (hi - lo).astype(jnp.float32)[None, :, None]
    return ((cs[:, hi] - cs[:, lo]) / cnt - xf).astype(x.dtype)


def pool_mix(u, pool_w, pool_scale):
    groups = [centred_mean_minus_self(u[..., g * POOL_GROUP:(g + 1) * POOL_GROUP], w)
              for g, w in enumerate(POOL_WINDOWS)]
    y = jnp.stack(groups, axis=2)
    y = jnp.einsum('blgc,gcd->blgd', y, pool_w).reshape(u.shape)
    return y * pool_scale


def even_mixer(h, w_in, dw_w, dw_b, ln_g, ln_b, pool_w, pool_scale, w_out):
    u = h @ w_in
    y_conv = conformer_conv(u[..., :2 * D_CONV], dw_w, dw_b, ln_g, ln_b)
    y_pool = pool_mix(u[..., 2 * D_CONV:], pool_w, pool_scale)
    return jnp.concatenate([y_conv, y_pool], axis=-1) @ w_out


def rope_tail(x, rope):
    return jnp.concatenate([x[..., :QK_NOPE], apply_rope(x[..., QK_NOPE:], *rope)], axis=-1)


def odd_queries(p_q, g_cq, w_uq, g_q_mla, g_q_diff, rope):
    b, l, _ = p_q.shape
    c_q = rms_norm(p_q[..., :Q_LORA], g_cq)
    q_m = rms_norm((c_q @ w_uq).reshape(b, l, MLA_HEADS, QK_NOPE + QK_ROPE), g_q_mla)
    q_d = rms_norm(p_q[..., Q_LORA:].reshape(b, l, DIFF_HEADS, 2, DIFF_QK), g_q_diff)
    if rope is not None:
        q_m = rope_tail(q_m, rope)
        q_d = apply_rope(q_d, *rope)
    return (q_m, q_d[..., 0, :], q_d[..., 1, :])


def odd_keys_values(p_kv, g_ckv, w_ukv, g_k_mla, g_k_diff, rope):
    b, l, _ = p_kv.shape
    c_kv = rms_norm(p_kv[..., :KV_LORA], g_ckv)
    k_rope = p_kv[..., KV_LORA:KV_LORA + QK_ROPE]
    off = KV_LORA + QK_ROPE
    k_d = p_kv[..., off:off + DIFF_QK_COLS].reshape(b, l, DIFF_HEADS, 2, DIFF_QK)
    v_d = p_kv[..., off + DIFF_QK_COLS:].reshape(b, l, DIFF_HEADS, DIFF_V)
    kv = (c_kv @ w_ukv).reshape(b, l, MLA_HEADS, QK_NOPE + V_HEAD)
    k_nope, v_m = kv[..., :QK_NOPE], kv[..., QK_NOPE:]
    k_m = jnp.concatenate(
        [k_nope, jnp.broadcast_to(k_rope[:, :, None, :], (b, l, MLA_HEADS, QK_ROPE))], axis=-1)
    k_m = rms_norm(k_m, g_k_mla)
    k_d = rms_norm(k_d, g_k_diff)
    if rope is not None:
        k_m = rope_tail(k_m, rope)
        k_d = apply_rope(k_d, *rope)
    return (k_m, v_m, k_d[..., 0, :], k_d[..., 1, :], v_d)


def odd_output(qs, kvs, lam, lam_init, g_sub, w_out):
    q_m, q1, q2 = qs
    k_m, v_m, k1, k2, v_d = kvs
    b, l = q_m.shape[:2]
    o_m = attend(q_m, k_m, v_m, MLA_SCALE)
    a1 = attend(q1, k1, v_d, DIFF_SCALE)
    a2 = attend(q2, k2, v_d, DIFF_SCALE)
    o_d = rms_norm(a1 - lam.astype(a1.dtype) * a2, g_sub) * (1.0 - lam_init)
    return jnp.concatenate([o_m.reshape(b, l, -1), o_d.reshape(b, l, -1)], axis=-1) @ w_out


def moe(h, router_w, router_b, w_gate, w_up, w_down):
    scores = jax.nn.sigmoid(jnp.einsum('bld,de->ble', h, router_w).astype(jnp.float32))
    biased = scores + router_b.astype(jnp.float32)
    grp = biased.reshape(biased.shape[:-1] + (N_GROUPS, EXPERTS_PER_GROUP))
    grp_score = lax.top_k(grp, TOP_K)[0].sum(-1)
    sel = jnp.argmax(grp_score, axis=-1)
    in_group = (jnp.arange(N_EXPERTS) // EXPERTS_PER_GROUP) == sel[..., None]
    _, idx = lax.top_k(jnp.where(in_group, biased, -jnp.inf), TOP_K)
    w = jnp.take_along_axis(scores, idx, axis=-1)
    w = w / jnp.sum(w, axis=-1, keepdims=True)
    combine = jnp.einsum('blk,blke->ble', w, jax.nn.one_hot(idx, N_EXPERTS, dtype=jnp.float32)).astype(h.dtype)
    y = jnp.zeros_like(h)
    for e in range(N_EXPERTS):
        he = jax.nn.silu(h @ w_gate[e]) * (h @ w_up[e])
        y = y + combine[..., e:e + 1] * (he @ w_down[e])
    return y


def setup_inputs(seed: int = 0) -> dict:
    key = jax.random.key(seed)
    keys = jax.random.split(key, 30)
    D = D_MODEL

    def nrm(n, shape, s):
        return s * jax.random.normal(keys[n], shape, jnp.float32)

    return {
        "x": nrm(0, (BATCH, SEQ, D), 1.0),
        "c": nrm(1, (BATCH, D), 1.0),
        "ctx": nrm(2, (BATCH, CTX_LEN, D), 1.0),
        "c_ctx": nrm(3, (D,), 1.0),
        "mod_w": nrm(4, (DEPTH, D, N_MOD * D), 0.5 * D ** -0.5),
        "mod_b": nrm(5, (DEPTH, N_MOD * D), 0.02),
        "norm_g": 1.0 + nrm(6, (DEPTH, 2, D), 0.1),
        "even_w_in": nrm(7, (N_EVEN, D, EVEN_IN), D ** -0.5),
        "conv_dw_w": nrm(8, (N_EVEN, CONV_WIDTH, D_CONV), CONV_WIDTH ** -0.5),
        "conv_dw_b": nrm(9, (N_EVEN, D_CONV), 0.02),
        "conv_ln_g": 1.0 + nrm(10, (N_EVEN, D_CONV), 0.1),
        "conv_ln_b": nrm(11, (N_EVEN, D_CONV), 0.02),
        "pool_w": nrm(12, (N_EVEN, len(POOL_WINDOWS), POOL_GROUP, POOL_GROUP), POOL_GROUP ** -0.5),
        "pool_scale": 1.0 + nrm(13, (N_EVEN, D_POOL), 0.1),
        "even_w_out": nrm(14, (N_EVEN, EVEN_MIX, D), EVEN_MIX ** -0.5),
        "odd_w_in": nrm(15, (N_ODD, D, ODD_IN), D ** -0.5),
        "mla_g_cq": 1.0 + nrm(16, (N_ODD, Q_LORA), 0.1),
        "mla_w_uq": nrm(17, (N_ODD, Q_LORA, MLA_HEADS * (QK_NOPE + QK_ROPE)), Q_LORA ** -0.5),
        "mla_g_ckv": 1.0 + nrm(18, (N_ODD, KV_LORA), 0.1),
        "mla_w_ukv": nrm(19, (N_ODD, KV_LORA, MLA_HEADS * (QK_NOPE + V_HEAD)), KV_LORA ** -0.5),
        "qk_g_mla": 1.0 + nrm(20, (N_ODD, 2, QK_NOPE + QK_ROPE), 0.1),
        "qk_g_diff": 1.0 + nrm(21, (N_ODD, 2, DIFF_QK), 0.1),
        "diff_lambda": nrm(22, (N_ODD, 4, DIFF_QK), 0.1),
        "diff_sub_g": 1.0 + nrm(23, (N_ODD, DIFF_V), 0.1),
        "odd_w_out": nrm(24, (N_ODD, ODD_MIX, D), ODD_MIX ** -0.5),
        "router_w": nrm(25, (D, N_EXPERTS), D ** -0.5),
        "router_b": nrm(26, (N_EXPERTS,), 0.01),
        "moe_w_gate": nrm(27, (DEPTH, N_EXPERTS, D, D_EXPERT), D ** -0.5),
        "moe_w_up": nrm(28, (DEPTH, N_EXPERTS, D, D_EXPERT), D ** -0.5),
        "moe_w_down": nrm(29, (DEPTH, N_EXPERTS, D_EXPERT, D), D_EXPERT ** -0.5),
    }


def reference(x, c, ctx, c_ctx, mod_w, mod_b, norm_g, even_w_in, conv_dw_w, conv_dw_b, conv_ln_g,
              conv_ln_b, pool_w, pool_scale, even_w_out, odd_w_in, mla_g_cq, mla_w_uq, mla_g_ckv,
              mla_w_ukv, qk_g_mla, qk_g_diff, diff_lambda, diff_sub_g, odd_w_out, router_w, router_b,
              moe_w_gate, moe_w_up, moe_w_down):
    b, n_lat, d = x.shape
    n_ctx = ctx.shape[1]
    rows = n_lat // GRID_W
    rope = axial_rope_tables(rows, QK_ROPE)
    c_act = jax.nn.silu(c)
    c_ctx_act = jax.nn.silu(c_ctx)
    xl, xc = x, ctx
    for i in range(DEPTH):
        ctx_out = i < DEPTH - 1
        j = i // 2
        mod_l = (c_act @ mod_w[i] + mod_b[i]).reshape(b, N_MOD, 1, d)
        mod_c = (c_ctx_act @ mod_w[i] + mod_b[i]).reshape(N_MOD, d)

        hl = modulate(rms_norm(xl, norm_g[i, 0]), mod_l[:, 0], mod_l[:, 1])
        if i % 2 == 0:
            ew = (even_w_in[j], conv_dw_w[j], conv_dw_b[j], conv_ln_g[j], conv_ln_b[j],
                  pool_w[j], pool_scale[j], even_w_out[j])
            yl = even_mixer(hl, *ew)
            if ctx_out:
                hc = modulate(rms_norm(xc, norm_g[i, 0]), mod_c[0], mod_c[1])
                yc = even_mixer(hc, *ew)
        else:
            hc = modulate(rms_norm(xc, norm_g[i, 0]), mod_c[0], mod_c[1])
            lam_init = 0.8 - 0.6 * math.exp(-0.3 * i)
            dl = diff_lambda[j].astype(jnp.float32)
            lam = jnp.exp(jnp.sum(dl[0] * dl[1])) - jnp.exp(jnp.sum(dl[2] * dl[3])) + lam_init
            qg = (mla_g_cq[j], mla_w_uq[j], qk_g_mla[j, 0], qk_g_diff[j, 0])
            kg = (mla_g_ckv[j], mla_w_ukv[j], qk_g_mla[j, 1], qk_g_diff[j, 1])
            og = (lam, lam_init, diff_sub_g[j], odd_w_out[j])
            w_in = odd_w_in[j]
            kv_c = odd_keys_values(hc @ w_in[:, Q_COLS:], *kg, None)
            p_l = hl @ w_in
            kv_l = odd_keys_values(p_l[..., Q_COLS:], *kg, rope)
            kv_all = tuple(jnp.concatenate([kc, kl], axis=1) for kc, kl in zip(kv_c, kv_l))
            yl = odd_output(odd_queries(p_l[..., :Q_COLS], *qg, rope), kv_all, *og)
            if ctx_out:
                yc = odd_output(odd_queries(hc @ w_in[:, :Q_COLS], *qg, None), kv_c, *og)
        xl = xl + mod_l[:, 2] * yl
        if ctx_out:
            xc = xc + mod_c[2] * yc

        h2l = modulate(rms_norm(xl, norm_g[i, 1]), mod_l[:, 3], mod_l[:, 4])
        if ctx_out:
            h2c = modulate(rms_norm(xc, norm_g[i, 1]), mod_c[3], mod_c[4])
            y2 = moe(jnp.concatenate([h2c, h2l], axis=1), router_w, router_b,
                     moe_w_gate[i], moe_w_up[i], moe_w_down[i])
            xc = xc + mod_c[5] * y2[:, :n_ctx]
            xl = xl + mod_l[:, 5] * y2[:, n_ctx:]
        else:
            xl = xl + mod_l[:, 5] * moe(h2l, router_w, router_b, moe_w_gate[i], moe_w_up[i], moe_w_down[i])
    return xl
```

```cpp
#include <hip/hip_runtime.h>
#include <cstdio>
#include <cstdint>

#ifndef MK_ONE_LAUNCH
#define MK_ONE_LAUNCH 1
#endif
#ifndef MK_LAST_PHASE
#define MK_LAST_PHASE 99
#endif

#define GAS __attribute__((address_space(1)))
#define LAS __attribute__((address_space(3)))
typedef unsigned short bf16_t;
typedef short bf16x8 __attribute__((ext_vector_type(8)));
typedef short s16x4 __attribute__((ext_vector_type(4)));
typedef float f32x4 __attribute__((ext_vector_type(4)));
typedef float f32x2 __attribute__((ext_vector_type(2)));
typedef float f32x16 __attribute__((ext_vector_type(16)));
typedef unsigned u32x4 __attribute__((ext_vector_type(4)));
typedef unsigned u32x2 __attribute__((ext_vector_type(2)));

constexpr int D = 1024, NB = 8, SEQ = 4096, CTXL = 256, TPB = SEQ + CTXL;
constexpr int NTOK = NB * TPB, NLAT = NB * SEQ, NCTX = NB * CTXL;
constexpr int NMOD = 6;
constexpr float EPS = 1e-6f;
constexpr int NEXP = 32, NBUCK = 48, DEXP = 256, LCAP = NTOK;
constexpr int PW = 2048;
constexpr int UW = 1536;
constexpr int PC_CQ = 0, PC_QD = 256, PC_CKV = 768, PC_KROPE = 896, PC_KD = 960, PC_VD = 1472;
constexpr float LAM_INIT = 0.35550906759096934f;
constexpr int MOE_MAXT = NTOK / 256 + NBUCK;

constexpr size_t MiB = 1u << 20;
constexpr size_t WS_CTL = 0, CTL_ZERO_BYTES = 1 * MiB;
constexpr size_t WS_MOD = 2 * MiB;
constexpr size_t WS_COS = 3 * MiB, WS_SIN = 3 * MiB + 512 * 1024;
constexpr size_t WS_XC = 4 * MiB;
constexpr size_t WS_LIST = 12 * MiB;
constexpr size_t WS_TW = 19 * MiB;
constexpr size_t WS_WIN0 = 20 * MiB, WS_WOUT0 = 23 * MiB, WS_WIN1 = 25 * MiB, WS_WUQ = 29 * MiB, WS_WUKV = 29 * MiB + 512 * 1024, WS_WOUT1 = 30 * MiB, WS_WPOOL = 32 * MiB;
constexpr size_t WS_WM1 = 33 * MiB;
constexpr size_t WS_WM2 = 97 * MiB;
constexpr size_t WS_H = 129 * MiB;
constexpr size_t WS_BIG = 197 * MiB;
constexpr size_t WS_YMIX = 333 * MiB;
constexpr size_t WS_QM = 401 * MiB;
constexpr size_t WS_KM = 449 * MiB;
constexpr size_t WS_END = 500 * MiB;
constexpr size_t WS_STASH = WS_WM1;
constexpr int CW_BAR = 4096;
constexpr int CW_CNT = 16384;

constexpr int LDS_BYTES = 155648;
constexpr int LDS_CTL = 153600;

__device__ __forceinline__ unsigned cvt_pk_bf16(float lo, float hi) { unsigned r; asm volatile("v_cvt_pk_bf16_f32 %0, %1, %2" : "=v"(r) : "v"(lo), "v"(hi)); return r; }
__device__ __forceinline__ float bf2f(unsigned short u) { return __uint_as_float((unsigned)u << 16); }
__device__ __forceinline__ float bflo(unsigned w) { return __uint_as_float(w << 16); }
__device__ __forceinline__ float bfhi(unsigned w) { return __uint_as_float(w & 0xffff0000u); }
__device__ __forceinline__ unsigned short f2bf(float f) { return (unsigned short)(cvt_pk_bf16(f, 0.f) & 0xffffu); }
__device__ __forceinline__ float wave_sum(float v) {
#pragma unroll
    for (int o = 1; o < 64; o <<= 1) v += __shfl_xor(v, o);
    return v;
}
__device__ __forceinline__ float sigmoidf_(float x) { return 1.f / (1.f + __expf(-x)); }
__device__ __forceinline__ float siluf_(float x) { return x / (1.f + __expf(-x)); }
__device__ __forceinline__ int crow(int r, int hi) { return (r & 3) + 8 * (r >> 2) + 4 * hi; }
#define LDS_WAIT() asm volatile("s_waitcnt lgkmcnt(0)" ::: "memory")
#define VM_WAIT() asm volatile("s_waitcnt vmcnt(0)" ::: "memory")

#define XB_TMO      128
#define XB_XCNT(j)  (256  + 64 * (j))
#define XB_XSUB(j)  (1280 + 64 * (j))
#define XB_XGEN(j)  (2304 + 64 * (j))
#define XB_TOP      3328
#define XB_TOPGEN   3392
#define XCD_BAR_WORDS 3456
#define XB_SPIN_CAP (1u << 18)
__device__ __forceinline__ unsigned xb_ld(unsigned* p)              { return __hip_atomic_load(p, __ATOMIC_RELAXED, __HIP_MEMORY_SCOPE_AGENT); }
__device__ __forceinline__ unsigned xb_add(unsigned* p, unsigned v) { return __hip_atomic_fetch_add(p, v, __ATOMIC_RELAXED, __HIP_MEMORY_SCOPE_AGENT); }
__device__ __forceinline__ unsigned xb_xcc_id() { return (unsigned)__builtin_amdgcn_s_getreg((3 << 11) | 20) & 0xFu; }
#define XB_SPIN(cond, bar) do { unsigned _sp = 0; while (cond) { __builtin_amdgcn_s_sleep(1); \
    if ((++_sp & 255u) == 0u) { if (xb_ld(&(bar)[XB_TMO])) break; if (_sp > XB_SPIN_CAP) { atomicAdd(&(bar)[XB_TMO], 1u); break; } } } } while (0)
struct XcdBarrier { unsigned* bar; unsigned x; volatile LAS unsigned* st; };
__device__ __forceinline__ XcdBarrier xcd_barrier_post(unsigned* bar, volatile LAS unsigned* st) {
    XcdBarrier b; b.bar = bar; b.x = xb_xcc_id(); b.st = st;
    if (threadIdx.x == 0) (void)xb_add(&bar[XB_XCNT(b.x)], 1u);
    return b;
}
__device__ __forceinline__ void xcd_barrier_complete(unsigned* bar, unsigned x, unsigned& nloc, unsigned& nx) {
    const unsigned G = gridDim.x * gridDim.y * gridDim.z;
    unsigned sum, cnt, mine, sp = 0u;
    for (;;) {
        sum = 0u; cnt = 0u; mine = 0u;
#pragma unroll
        for (unsigned j = 0; j < 16; ++j) { const unsigned c = xb_ld(&bar[XB_XCNT(j)]); sum += c; cnt += (c > 0u) ? 1u : 0u; mine = (j == x) ? c : mine; }
        if (sum == G) break;
        __builtin_amdgcn_s_sleep(1);
        if ((++sp & 255u) == 0u) { if (xb_ld(&bar[XB_TMO])) break; if (sp > XB_SPIN_CAP) { atomicAdd(&bar[XB_TMO], 1u); break; } }
    }
    nloc = mine > 0u ? mine : 1u; nx = cnt > 0u ? cnt : 1u;
}
__device__ __forceinline__ void xcd_barrier(const XcdBarrier& b) {
    asm volatile("s_waitcnt vmcnt(0)" ::: "memory");
    __syncthreads();
    if (threadIdx.x == 0) {
        unsigned* bar = b.bar;
        __builtin_amdgcn_s_waitcnt(0);
        unsigned nloc = b.st[0], nx = b.st[1];
        if (nloc == 0u) { xcd_barrier_complete(bar, b.x, nloc, nx); b.st[0] = nloc; b.st[1] = nx; }
        const unsigned old = xb_add(&bar[XB_XSUB(b.x)], 1u);
        const unsigned gen = old / nloc;
        if (old + 1u == (gen + 1u) * nloc) {
            __builtin_amdgcn_fence(__ATOMIC_RELEASE, "agent");
            asm volatile("s_waitcnt vmcnt(0)" ::: "memory");
            const unsigned og = xb_add(&bar[XB_TOP], 1u);
            const unsigned tg = og / nx;
            if (og + 1u == (tg + 1u) * nx) xb_add(&bar[XB_TOPGEN], 1u);
            else XB_SPIN(xb_ld(&bar[XB_TOPGEN]) == tg, bar);
            __builtin_amdgcn_fence(__ATOMIC_ACQUIRE, "agent");
            xb_add(&bar[XB_XGEN(b.x)], 1u);
            asm volatile("s_waitcnt vmcnt(0)" ::: "memory");
        } else {
            XB_SPIN(xb_ld(&bar[XB_XGEN(b.x)]) == gen, bar);
            __builtin_amdgcn_fence(__ATOMIC_ACQUIRE, "agent");
            asm volatile("s_waitcnt vmcnt(0)" ::: "memory");
        }
    }
    __syncthreads();
}

namespace pg8 {
constexpr int BM = 256, BK = 64, HALF = 128, HTB = HALF * BK * 2, STAGE_BYTES = 8 * HTB, NXCD = 8, WGM = 8;
__device__ __forceinline__ int lds_byte(int r, int c) { const int st = (r >> 4) * 2 + (c >> 5), rr = r & 15, cc = c & 31, ob = rr * 64 + cc * 2; return st * 1024 + (ob ^ (((ob >> 9) & 1) << 5)); }
__device__ __forceinline__ void stage_rc(int b, int& R, int& C) { const int st = b / 1024, sb = b % 1024, swz = sb ^ (((sb >> 9) & 1) << 5); R = (st >> 1) * 16 + swz / 64; C = (st & 1) * 32 + (swz % 64) / 2; }
__device__ __forceinline__ int perm32(int rho) { const int n = rho >> 4, i = rho & 15; return 8 * (i >> 2) + 4 * n + (i & 3); }

struct Unit {
    int pm, pn, po;
    const char* A;
    const char* B;
    const char* B2;
    const int* rows;
    int nvalid, aux;
};

template <class Epi, class Sched>
__device__ __forceinline__ void gemm_phase(LAS unsigned char* lds, int K, int lda, int ldb, int ksplit, const Sched& S, const Epi& E) {
    asm volatile("" : "+s"(K), "+s"(lda), "+s"(ldb), "+s"(ksplit));
    const int tid = threadIdx.x, wid = __builtin_amdgcn_readfirstlane(tid >> 6), lane = tid & 63, wr = wid >> 2, wc = wid & 3, fr = lane & 15, fq = lane >> 4;
    const int nt = K / BK;
    int sR[2], sC[2];
    unsigned voffB[2];
#pragma unroll
    for (int i = 0; i < 2; ++i) { int R, C; stage_rc(tid * 16 + i * 8192, R, C); sR[i] = R; sC[i] = C; const int Rb = (R & ~31) + perm32(R & 31); voffB[i] = (unsigned)(Rb * ldb + C) * 2u; }
    const size_t kstep = (size_t)(BK * 2);
    const size_t hstepB = (size_t)HALF * ldb * 2;
    const unsigned ldsw = (unsigned)wid * 1024u;
    const int aoff = lds_byte(wr * 64 + fr, fq * 8), boff = lds_byte(wc * 32 + fr, fq * 8);
#define PG8_SA(b, h) (((b) * 2 + (h)) * HTB)
#define PG8_SB(b, h) ((4 + (b) * 2 + (h)) * HTB)
#define PG8_STAGE(bufoff, gbase, voff) do { _Pragma("unroll") for (int _i = 0; _i < 2; ++_i) \
        __builtin_amdgcn_global_load_lds((const unsigned*)((const char*)(gbase) + (voff)[_i]), (LAS unsigned*)(lds + (bufoff) + ldsw + _i * 8192), 16, 0, 0); } while (0)
#define PG8_LDA(dst, b, h) do { _Pragma("unroll") for (int m = 0; m < 4; ++m) _Pragma("unroll") for (int k = 0; k < 2; ++k) dst[m][k] = *(const LAS bf16x8*)(lds + PG8_SA(b, h) + aoff + m * 2048 + k * 1024); } while (0)
#define PG8_LDB(dst, b, h) do { _Pragma("unroll") for (int n = 0; n < 2; ++n) _Pragma("unroll") for (int k = 0; k < 2; ++k) dst[n][k] = *(const LAS bf16x8*)(lds + PG8_SB(b, h) + boff + n * 2048 + k * 1024); } while (0)
#define PG8_MMA(ai, bj, At, Bt) do { __builtin_amdgcn_s_setprio(1); _Pragma("unroll") for (int m = 0; m < 4; ++m) _Pragma("unroll") for (int n = 0; n < 2; ++n) _Pragma("unroll") for (int k = 0; k < 2; ++k) \
        acc[ai][bj][m][n] = __builtin_amdgcn_mfma_f32_16x16x32_bf16(Bt[n][k], At[m][k], acc[ai][bj][m][n], 0, 0, 0); __builtin_amdgcn_s_setprio(0); } while (0)
#define PG8_WAIT_V(n) asm volatile("s_waitcnt vmcnt(" #n ")" ::: "memory")
#define PG8_WAIT_L(n) asm volatile("s_waitcnt lgkmcnt(" #n ")" ::: "memory")
#define PG8_BAR __builtin_amdgcn_s_barrier()
#define PG8_SCHED __builtin_amdgcn_sched_barrier(0)
#define PG8_BK(u, t) (((t) < ksplit ? (u).B : (u).B2) + (size_t)(t) * kstep)
#define PG8_VOFF(dst, u) do { _Pragma("unroll") for (int _h = 0; _h < 2; ++_h) _Pragma("unroll") for (int _i = 0; _i < 2; ++_i) { int _r = sR[_i] + HALF * _h; \
        if constexpr (Sched::GATHER) { const int _rr = _r < (u).nvalid ? _r : 0; _r = (u).rows[_rr]; } dst[_h][_i] = (unsigned)(_r * lda + sC[_i]) * 2u; } } while (0)
    Unit cur, nxt; int ui = 0;
    if (!S.next(0, cur)) return;
    f32x4 acc[2][2][4][2];
#pragma unroll
    for (int a = 0; a < 2; ++a)
#pragma unroll
        for (int b = 0; b < 2; ++b)
#pragma unroll
            for (int m = 0; m < 4; ++m)
#pragma unroll
                for (int n = 0; n < 2; ++n) acc[a][b][m][n] = (f32x4){0.f, 0.f, 0.f, 0.f};
    bf16x8 At[4][2], B0[2][2], B1[2][2];
    LAS unsigned* VO = (LAS unsigned*)(lds + STAGE_BYTES) + tid;
#define PG8_VO(slot, h, i) VO[(((slot) & 1) * 4 + (h) * 2 + (i)) * 512]
    unsigned vfix[2][2];
    {
        unsigned vc[2][2];
        PG8_VOFF(vc, cur);
#pragma unroll
        for (int h = 0; h < 2; ++h)
#pragma unroll
            for (int i = 0; i < 2; ++i) { vfix[h][i] = vc[h][i]; if constexpr (Sched::GATHER) PG8_VO(0, h, i) = vc[h][i]; }
        const char* cA0 = cur.A;
        const char* b0 = PG8_BK(cur, 0); const char* b1 = PG8_BK(cur, 1);
        PG8_STAGE(PG8_SB(0, 0), b0, voffB); PG8_STAGE(PG8_SB(0, 1), b0 + hstepB, voffB); PG8_STAGE(PG8_SA(0, 0), cA0, vc[0]); PG8_STAGE(PG8_SA(0, 1), cA0, vc[1]);
        if (wr == 1) PG8_BAR;
        PG8_WAIT_V(2); PG8_BAR;
        PG8_STAGE(PG8_SB(1, 0), b1, voffB); PG8_STAGE(PG8_SA(1, 0), cA0 + kstep, vc[0]); PG8_STAGE(PG8_SB(1, 1), b1 + hstepB, voffB);
        PG8_WAIT_V(6); PG8_BAR;
    }
    const char* cA = cur.A;
    for (;;) {
        const bool has_next = S.next(ui + 1, nxt);
        if (!has_next) nxt = cur;
        if constexpr (Sched::GATHER) { unsigned vn[2][2]; PG8_VOFF(vn, nxt);
#pragma unroll
            for (int h = 0; h < 2; ++h)
#pragma unroll
                for (int i = 0; i < 2; ++i) PG8_VO(ui + 1, h, i) = vn[h][i]; }
        const char* nA = nxt.A;
#pragma nounroll
        for (int t = 0; t < nt; t += 2) {
            const bool last = (t == nt - 2);
            const char* a1 = cA + (size_t)(t + 1) * kstep;
            const char* a2 = last ? nA : cA + (size_t)(t + 2) * kstep;
            const char* a3 = a2 + kstep;
            const char* b2 = last ? PG8_BK(nxt, 0) : PG8_BK(cur, t + 2);
            const char* b3 = last ? PG8_BK(nxt, 1) : PG8_BK(cur, t + 3);
            unsigned v1[2], v2[2][2];
            if constexpr (Sched::GATHER) { const int s2 = last ? ui + 1 : ui;
                v1[0] = PG8_VO(ui, 1, 0); v1[1] = PG8_VO(ui, 1, 1);
#pragma unroll
                for (int h = 0; h < 2; ++h)
#pragma unroll
                    for (int i = 0; i < 2; ++i) v2[h][i] = PG8_VO(s2, h, i);
            } else { v1[0] = vfix[1][0]; v1[1] = vfix[1][1];
#pragma unroll
                for (int h = 0; h < 2; ++h)
#pragma unroll
                    for (int i = 0; i < 2; ++i) v2[h][i] = vfix[h][i]; }
            PG8_LDB(B0, 0, 0); PG8_LDB(B1, 0, 1); PG8_SCHED; PG8_LDA(At, 0, 0); PG8_STAGE(PG8_SA(1, 1), a1, v1);
            PG8_WAIT_V(8); PG8_WAIT_L(0); PG8_BAR; PG8_MMA(0, 0, At, B0); PG8_MMA(0, 1, At, B1); PG8_BAR; PG8_SCHED;
            PG8_LDA(At, 0, 1); PG8_STAGE(PG8_SB(0, 0), b2, voffB); PG8_STAGE(PG8_SB(0, 1), b2 + hstepB, voffB); PG8_STAGE(PG8_SA(0, 0), a2, v2[0]);
            PG8_WAIT_V(8); PG8_WAIT_L(0); PG8_BAR; PG8_MMA(1, 0, At, B0); PG8_MMA(1, 1, At, B1); PG8_BAR; PG8_SCHED;
            PG8_LDB(B0, 1, 0); PG8_LDB(B1, 1, 1); PG8_SCHED; PG8_LDA(At, 1, 0); PG8_STAGE(PG8_SA(0, 1), a2, v2[1]);
            PG8_WAIT_V(8); PG8_WAIT_L(0); PG8_BAR; PG8_MMA(0, 0, At, B0); PG8_MMA(0, 1, At, B1); PG8_BAR; PG8_SCHED;
            PG8_LDA(At, 1, 1); PG8_STAGE(PG8_SB(1, 0), b3, voffB); PG8_STAGE(PG8_SB(1, 1), b3 + hstepB, voffB); PG8_STAGE(PG8_SA(1, 0), a3, v2[0]);
            PG8_WAIT_V(8); PG8_WAIT_L(0); PG8_BAR; PG8_MMA(1, 0, At, B0); PG8_MMA(1, 1, At, B1); PG8_BAR; PG8_SCHED;
        }
        if (wr == 0) PG8_BAR;
        E(acc, cur, wr, wc, fr, fq);
        if (!has_next) break;
#pragma unroll
        for (int a = 0; a < 2; ++a)
#pragma unroll
            for (int b = 0; b < 2; ++b)
#pragma unroll
                for (int m = 0; m < 4; ++m)
#pragma unroll
                    for (int n = 0; n < 2; ++n) acc[a][b][m][n] = (f32x4){0.f, 0.f, 0.f, 0.f};
        cur = nxt; cA = nA; ++ui;
        if (wr == 1) PG8_BAR;
    }
    PG8_WAIT_V(0);
    PG8_BAR;
#undef PG8_SA
#undef PG8_SB
#undef PG8_STAGE
#undef PG8_LDA
#undef PG8_LDB
#undef PG8_MMA
#undef PG8_WAIT_V
#undef PG8_WAIT_L
#undef PG8_BAR
#undef PG8_SCHED
#undef PG8_BK
#undef PG8_VOFF
#undef PG8_VO
}

struct PlainSched {
    static constexpr bool GATHER = false;
    int nM, nN, nwg, G, c; const char* A; const char* Bt; int lda, ldb, K; int rowmap;
    __device__ __forceinline__ void init(const void* A_, const void* Bt_, int M, int N, int K_, int lda_, int ldb_, int G_, int c_, int rowmap_) {
        A = (const char*)A_; Bt = (const char*)Bt_; nM = M / BM; nN = N / BM; nwg = nM * nN; G = G_; c = c_; lda = lda_; ldb = ldb_; K = K_; rowmap = rowmap_; }
    __device__ __forceinline__ bool next(int i, Unit& u) const {
        const int L = i * G + c; if (L >= nwg) return false;
        int wgid = L; { const int q = nwg / NXCD, r = nwg % NXCD, xcd = wgid % NXCD, off = wgid / NXCD; wgid = (xcd < r ? xcd * (q + 1) : r * (q + 1) + (xcd - r) * q) + off; }
        const int nig = WGM * nN, gid = wgid / nig, fm = gid * WGM, gsz = (nM - fm) < WGM ? (nM - fm) : WGM;
        const int pm = fm + ((wgid % nig) % gsz), pn = (wgid % nig) / gsz;
        u.po = pm; u.pn = pn; u.pm = rowmap ? (pm / 16) * 17 + 1 + (pm % 16) : pm;
        u.A = A + (size_t)u.pm * BM * lda * 2; u.B = Bt + (size_t)pn * BM * ldb * 2; u.B2 = u.B; u.rows = nullptr; u.nvalid = BM; u.aux = 0;
        return true;
    }
};

struct EpiStoreBf16 {
    bf16_t* O; int ldc;
    __device__ __forceinline__ void operator()(const f32x4 (&acc)[2][2][4][2], const Unit& u, int wr, int wc, int fr, int fq) const {
        bf16_t* base = O + (size_t)(u.po * BM + wr * 64 + fr) * ldc + u.pn * BM + wc * 32 + 8 * fq;
#pragma unroll
        for (int ai = 0; ai < 2; ++ai)
#pragma unroll
            for (int m = 0; m < 4; ++m) { bf16_t* rowp = base + (size_t)(ai * HALF + m * 16) * ldc;
#pragma unroll
                for (int bj = 0; bj < 2; ++bj) { const f32x4 v0 = acc[ai][bj][m][0], v1 = acc[ai][bj][m][1];
                    u32x4 w; w.x = cvt_pk_bf16(v0[0], v0[1]); w.y = cvt_pk_bf16(v0[2], v0[3]); w.z = cvt_pk_bf16(v1[0], v1[1]); w.w = cvt_pk_bf16(v1[2], v1[3]);
                    *(u32x4*)(rowp + bj * HALF) = w; } }
    }
};
struct EpiResid {
    const float* x; const float* ctx; float* out; float* xc; const float* modl; int mode;
    __device__ __forceinline__ void operator()(const f32x4 (&acc)[2][2][4][2], const Unit& u, int wr, int wc, int fr, int fq) const {
        const float* src; float* dst; int mrow;
        if (mode == 0) { const int b = u.po / 17, jt = u.po % 17;
            if (jt == 0) { src = ctx + (size_t)b * CTXL * D; dst = xc + (size_t)b * CTXL * D; mrow = 8; }
            else { src = x + ((size_t)b * SEQ + (jt - 1) * 256) * D; dst = out + ((size_t)b * SEQ + (jt - 1) * 256) * D; mrow = b; } }
        else { src = out + (size_t)u.po * BM * D; dst = out + (size_t)u.po * BM * D; mrow = u.po / 16; }
        const float* gate = modl + (size_t)mrow * (NMOD * D) + 2 * D;
        const int col0 = u.pn * BM + wc * 32 + 8 * fq;
        f32x4 gv[2][2];
#pragma unroll
        for (int bj = 0; bj < 2; ++bj)
#pragma unroll
            for (int n = 0; n < 2; ++n) gv[bj][n] = *(const f32x4*)(gate + col0 + bj * HALF + 4 * n);
#pragma unroll
        for (int ai = 0; ai < 2; ++ai)
#pragma unroll
            for (int m = 0; m < 4; ++m) { const size_t ro = (size_t)(ai * HALF + wr * 64 + m * 16 + fr) * D + col0;
#pragma unroll
                for (int bj = 0; bj < 2; ++bj)
#pragma unroll
                    for (int n = 0; n < 2; ++n) { const f32x4 s = *(const f32x4*)(src + ro + bj * HALF + 4 * n);
                        *(f32x4*)(dst + ro + bj * HALF + 4 * n) = s + gv[bj][n] * acc[ai][bj][m][n]; } }
    }
};
}

struct Args { const float* in[30]; float* out; unsigned char* ws; int ph_lo, ph_hi; };
struct Frame {
    LAS unsigned char* lds;
    int tid, lane, wave, G, bid;
    float* out; unsigned char* ws;
    unsigned* ctl;
};
#define WSP(T, off) ((T*)(F.ws + (off)))

__device__ __forceinline__ float* xl_row(const Frame& F, int ta) {
    const int b = ta / TPB, j = ta - b * TPB;
    return j < CTXL ? WSP(float, WS_XC) + (size_t)(b * CTXL + j) * D : F.out + ((size_t)b * SEQ + (j - CTXL)) * D;
}

__device__ __forceinline__ void transpose_tile(const float* src, int N, bf16_t* dst, int ldo, LAS float* scr, int lane) {
#pragma unroll 8
    for (int i = 0; i < 32; ++i) { const int kk = 2 * i + (lane >> 5); scr[kk * 33 + (lane & 31)] = src[(size_t)kk * N + (lane & 31)]; }
    LDS_WAIT(); asm volatile("" ::: "memory");
    const int c = lane & 7;
#pragma unroll
    for (int j = 0; j < 4; ++j) { const int n = (lane >> 3) + 8 * j; const LAS float* s = scr + (8 * c) * 33 + n;
        u32x4 o; o.x = cvt_pk_bf16(s[0 * 33], s[1 * 33]); o.y = cvt_pk_bf16(s[2 * 33], s[3 * 33]); o.z = cvt_pk_bf16(s[4 * 33], s[5 * 33]); o.w = cvt_pk_bf16(s[6 * 33], s[7 * 33]);
        *(u32x4*)(dst + (size_t)n * ldo + 8 * c) = o; }
    LDS_WAIT(); asm volatile("" ::: "memory");
}
__device__ __forceinline__ void tr_item(const float* W, int K, int N, bf16_t* WT, int item, LAS float* scr, int lane) {
    const int nblk = N / 32, kb = item / nblk, nb = item % nblk;
    transpose_tile(W + (size_t)(64 * kb) * N + 32 * nb, N, WT + (size_t)(32 * nb) * K + 64 * kb, K, scr, lane);
}

__device__ __forceinline__ void p0_prologue(Frame& F, const Args& A) {
    const int tid = F.tid, lane = F.lane, wave = F.wave;
    {
        LAS float* SC = (LAS float*)F.lds;
        LAS float* RED = (LAS float*)(F.lds + 40960);
        for (int i = tid; i < 9 * 1024; i += 512) { const int r = i >> 10, k = i & 1023; const float v = r < 8 ? A.in[1][r * 1024 + k] : A.in[3][k]; SC[i] = siluf_(v); }
        __syncthreads();
        float* MOD = WSP(float, WS_MOD);
        for (int u = F.bid; u < 2 * 192; u += F.G) {
            const int l = u / 192, cb = u % 192, col = cb * 32 + (lane & 31), kp = lane >> 5;
            const float* W = A.in[4] + (size_t)l * D * (NMOD * D) + col;
            float a[9];
#pragma unroll
            for (int r = 0; r < 9; ++r) a[r] = 0.f;
#pragma unroll 8
            for (int kk = 0; kk < 64; ++kk) { const int k = 128 * wave + 2 * kk + kp; const float w = W[(size_t)k * (NMOD * D)];
#pragma unroll
                for (int r = 0; r < 9; ++r) a[r] += SC[r * 1024 + k] * w; }
#pragma unroll
            for (int r = 0; r < 9; ++r) RED[((wave * 2 + kp) * 9 + r) * 32 + (lane & 31)] = a[r];
            __syncthreads();
            if (tid < 288) { const int r = tid >> 5, cc = tid & 31; float s = 0.f;
#pragma unroll
                for (int w = 0; w < 16; ++w) s += RED[(w * 9 + r) * 32 + cc];
                MOD[((size_t)l * 9 + r) * (NMOD * D) + cb * 32 + cc] = s + A.in[5][l * (NMOD * D) + cb * 32 + cc]; }
            __syncthreads();
        }
    }
    {
        const float invf[16] = {1.000000000e+00f, 5.623413324e-01f, 3.162277639e-01f, 1.778279394e-01f, 1.000000015e-01f, 5.623413250e-02f, 3.162277490e-02f, 1.778279431e-02f,
                                9.999999776e-03f, 5.623413250e-03f, 3.162277630e-03f, 1.778279431e-03f, 1.000000047e-03f, 5.623413017e-04f, 3.162277571e-04f, 1.778279402e-04f};
        float* COS = WSP(float, WS_COS); float* SIN = WSP(float, WS_SIN);
        for (int i = F.bid * 512 + tid; i < SEQ * 32; i += F.G * 512) {
            const int pos = i >> 5, j = i & 31, f = j & 15; const float p = (float)(j < 16 ? (pos >> 6) : (pos & 63));
            float fr = 1.f;
#pragma unroll
            for (int q = 0; q < 16; ++q) fr = (f == q) ? invf[q] : fr;
            const float angf = p * fr; const double x = (double)angf;
            const double n = __builtin_rint(x * 0.63661977236758134308);
            const double y = (x - n * 1.57079632679489655800e+00) - n * 6.12323399573676603587e-17;
            const double y2 = y * y;
            double sn = y * (1.0 + y2 * (-1.0 / 6 + y2 * (1.0 / 120 + y2 * (-1.0 / 5040 + y2 * (1.0 / 362880 + y2 * (-1.0 / 39916800 + y2 * (1.0 / 6227020800.0)))))));
            double cs = 1.0 + y2 * (-0.5 + y2 * (1.0 / 24 + y2 * (-1.0 / 720 + y2 * (1.0 / 40320 + y2 * (-1.0 / 3628800 + y2 * (1.0 / 479001600.0 + y2 * (-1.0 / 87178291200.0)))))));
            const int q4 = ((int)n) & 3;
            const double c = (q4 == 0) ? cs : (q4 == 1) ? -sn : (q4 == 2) ? -cs : sn;
            const double s = (q4 == 0) ? sn : (q4 == 1) ? cs : (q4 == 2) ? -sn : -cs;
            COS[i] = (float)c; SIN[i] = (float)s;
        }
    }
    {
        LAS float* scr = (LAS float*)(F.lds + wave * 16384);
        const int gw = F.bid * 8 + wave, NGW = F.G * 8;
        constexpr int I_IN0 = 16 * 48, I_OUT = 16 * 32, I_IN1 = 16 * 62, I_UQ = 4 * 24, I_UKV = 2 * 32, I_POOL = 4 * 8, I_MOE = 64 * 384;
        constexpr int NIT = I_IN0 + I_OUT + I_IN1 + I_UQ + I_UKV + I_OUT + I_POOL + I_MOE;
        for (int it = gw; it < NIT; it += NGW) {
            int r = it;
            if (r < I_IN0) { tr_item(A.in[7], D, 1536, WSP(bf16_t, WS_WIN0), r, scr, lane); continue; } r -= I_IN0;
            if (r < I_OUT) { tr_item(A.in[14], D, D, WSP(bf16_t, WS_WOUT0), r, scr, lane); continue; } r -= I_OUT;
            if (r < I_IN1) { tr_item(A.in[15], D, 1984, WSP(bf16_t, WS_WIN1), r, scr, lane); continue; } r -= I_IN1;
            if (r < I_UQ) { tr_item(A.in[17], 256, 768, WSP(bf16_t, WS_WUQ), r, scr, lane); continue; } r -= I_UQ;
            if (r < I_UKV) { tr_item(A.in[19], 128, 1024, WSP(bf16_t, WS_WUKV), r, scr, lane); continue; } r -= I_UKV;
            if (r < I_OUT) { tr_item(A.in[24], D, D, WSP(bf16_t, WS_WOUT1), r, scr, lane); continue; } r -= I_OUT;
            if (r < I_POOL) { const int g = r / 8; tr_item(A.in[12] + (size_t)g * 128 * 128, 128, 128, WSP(bf16_t, WS_WPOOL) + (size_t)g * 128 * 128, r % 8, scr, lane); continue; } r -= I_POOL;
            {
                const int le = r / 384, q = r % 384;
                bf16_t* W1 = WSP(bf16_t, WS_WM1) + (size_t)le * 512 * 1024; bf16_t* W2 = WSP(bf16_t, WS_WM2) + (size_t)le * 1024 * 256;
                if (q < 256) {
                    const int up = q >> 7, item = q & 127, kb = item / 8, nb = item % 8, n0 = 32 * nb;
                    const float* W = A.in[up ? 28 : 27] + (size_t)le * 1024 * 256;
                    const int drow = (n0 >> 7) * 256 + up * 128 + (n0 & 127);
                    transpose_tile(W + (size_t)(64 * kb) * 256 + n0, 256, W1 + (size_t)drow * 1024 + 64 * kb, 1024, scr, lane);
                } else {
                    tr_item(A.in[29] + (size_t)le * 256 * 1024, 256, 1024, W2, q - 256, scr, lane);
                }
            }
        }
        { u32x4* z = (u32x4*)(WSP(bf16_t, WS_WIN1) + (size_t)1984 * 1024); const u32x4 zero = {0u, 0u, 0u, 0u};
          for (int i = F.bid * 512 + tid; i < 64 * 1024 / 8; i += F.G * 512) z[i] = zero; }
    }
}

__device__ __forceinline__ void norm_mod_phase(Frame& F, const Args& A, int layer) {
    const int gw = F.bid * 8 + F.wave, NGW = F.G * 8, lane = F.lane;
    const float* g = A.in[6] + (size_t)(layer * 2 + 0) * D;
    const float* MODL = WSP(float, WS_MOD) + (size_t)layer * 9 * (NMOD * D);
    bf16_t* H = WSP(bf16_t, WS_H);
    for (int ta = gw; ta < NTOK; ta += NGW) {
        const int b = ta / TPB, j = ta - b * TPB;
        const float* src; int mrow;
        if (layer == 0) { src = j < CTXL ? A.in[2] + (size_t)(b * CTXL + j) * D : A.in[0] + ((size_t)b * SEQ + (j - CTXL)) * D; }
        else src = xl_row(F, ta);
        mrow = j < CTXL ? 8 : b;
        const f32x4* xr = (const f32x4*)src + lane;
        f32x4 v[4]; float s = 0.f;
#pragma unroll
        for (int q = 0; q < 4; ++q) { v[q] = xr[64 * q]; s += (v[q].x * v[q].x + v[q].y * v[q].y) + (v[q].z * v[q].z + v[q].w * v[q].w); }
        const float r = 1.f / sqrtf(wave_sum(s) * (1.f / D) + EPS);
        const float* sh = MODL + (size_t)mrow * (NMOD * D); const float* sc = sh + D;
        u32x2* o8 = (u32x2*)(H + (size_t)ta * D) + lane;
#pragma unroll
        for (int q = 0; q < 4; ++q) { const int col = 4 * lane + 256 * q;
            const f32x4 g4 = *(const f32x4*)(g + col), s4 = *(const f32x4*)(sc + col), h4 = *(const f32x4*)(sh + col);
            const f32x4 y = (v[q] * r) * g4 * (s4 + 1.f) + h4;
            u32x2 w; w.x = cvt_pk_bf16(y.x, y.y); w.y = cvt_pk_bf16(y.z, y.w); o8[64 * q] = w; }
    }
}

__device__ __forceinline__ void convpool_phase(Frame& F, const Args& A) {
    const int tid = F.tid, lane = F.lane, wave = F.wave, r32 = lane & 31, hi = lane >> 5;
    LAS float* CW = (LAS float*)F.lds;
    LAS bf16_t* GL = (LAS bf16_t*)(F.lds + 63488);
    LAS bf16_t* UP = GL;
    LAS bf16_t* PL = GL + 48 * 512;
    const bf16_t* U = WSP(bf16_t, WS_BIG); bf16_t* Y = WSP(bf16_t, WS_YMIX); const bf16_t* WP = WSP(bf16_t, WS_WPOOL);
    for (int i = tid; i < 31 * 512 / 4; i += 512) ((LAS f32x4*)CW)[i] = ((const f32x4*)A.in[8])[i];
    float dwb[8], lng[8], lnb[8];
#pragma unroll
    for (int j = 0; j < 8; ++j) { dwb[j] = A.in[9][8 * lane + j]; lng[j] = A.in[10][8 * lane + j]; lnb[j] = A.in[11][8 * lane + j]; }
    for (int u = F.bid; u < 1088; u += F.G) {
        int b, seg, n, tb;
        if (u < 1024) { b = u >> 7; seg = u & 127; n = SEQ; tb = b * TPB + CTXL; } else { const int uu = u - 1024; b = uu >> 3; seg = uu & 7; n = CTXL; tb = b * TPB; }
        const int t0 = seg * 32;
        __syncthreads();
        for (int ch = tid; ch < 62 * 64; ch += 512) { const int ri = ch >> 6, c8 = (ch & 63) * 8, pos = t0 + ri - 15;
            u32x4 o = {0u, 0u, 0u, 0u};
            if (pos >= 0 && pos < n) { const bf16_t* up = U + (size_t)(tb + pos) * UW + c8; const u32x4 a = *(const u32x4*)up, g = *(const u32x4*)(up + 512);
#pragma unroll
                for (int q = 0; q < 4; ++q) { const float a0 = bflo(a[q]), a1 = bfhi(a[q]), g0 = bflo(g[q]), g1 = bfhi(g[q]); o[q] = cvt_pk_bf16(a0 * sigmoidf_(g0), a1 * sigmoidf_(g1)); } }
            *(LAS u32x4*)(GL + ri * 512 + c8) = o; }
        __syncthreads();
        for (int q = 0; q < 4; ++q) { const int i = wave + 8 * q;
            float a[8];
#pragma unroll
            for (int j = 0; j < 8; ++j) a[j] = dwb[j];
#pragma unroll 4
            for (int k = 0; k < 31; ++k) { const u32x4 gv = *(const LAS u32x4*)(GL + (i + k) * 512 + 8 * lane); const f32x4 w0 = *(const LAS f32x4*)(CW + k * 512 + 8 * lane), w1 = *(const LAS f32x4*)(CW + k * 512 + 8 * lane + 4);
                a[0] += bflo(gv.x) * w0.x; a[1] += bfhi(gv.x) * w0.y; a[2] += bflo(gv.y) * w0.z; a[3] += bfhi(gv.y) * w0.w;
                a[4] += bflo(gv.z) * w1.x; a[5] += bfhi(gv.z) * w1.y; a[6] += bflo(gv.w) * w1.z; a[7] += bfhi(gv.w) * w1.w; }
            float s = 0.f;
#pragma unroll
            for (int j = 0; j < 8; ++j) s += a[j];
            const float mean = wave_sum(s) * (1.f / 512.f); float s2 = 0.f;
#pragma unroll
            for (int j = 0; j < 8; ++j) { a[j] -= mean; s2 += a[j] * a[j]; }
            const float rstd = 1.f / sqrtf(wave_sum(s2) * (1.f / 512.f) + EPS);
            float y[8];
#pragma unroll
            for (int j = 0; j < 8; ++j) y[j] = siluf_(a[j] * rstd * lng[j] + lnb[j]);
            u32x4 o; o.x = cvt_pk_bf16(y[0], y[1]); o.y = cvt_pk_bf16(y[2], y[3]); o.z = cvt_pk_bf16(y[4], y[5]); o.w = cvt_pk_bf16(y[6], y[7]);
            *(u32x4*)(Y + (size_t)(tb + t0 + i) * D + 8 * lane) = o; }
        __syncthreads();
        for (int ch = tid; ch < 48 * 64; ch += 512) { const int ri = ch >> 6, c8 = (ch & 63) * 8, pos = t0 + ri - 8;
            u32x4 o = {0u, 0u, 0u, 0u};
            if (pos >= 0 && pos < n) o = *(const u32x4*)(U + (size_t)(tb + pos) * UW + 1024 + c8);
            *(LAS u32x4*)(UP + ri * 512 + c8) = o; }
        __syncthreads();
        for (int e = tid; e < 32 * 64; e += 512) { const int i = e >> 6, c8 = (e & 63) * 8, gi = c8 >> 7, hw = 1 << gi, pos = t0 + i;
            const int lo = (pos - hw) > 0 ? (pos - hw) : 0, hh = (pos + hw) < n ? (pos + hw) : n;
            float s[8];
#pragma unroll
            for (int j = 0; j < 8; ++j) s[j] = 0.f;
            for (int p = lo; p < hh; ++p) { const u32x4 v = *(const LAS u32x4*)(UP + (p - t0 + 8) * 512 + c8);
                s[0] += bflo(v.x); s[1] += bfhi(v.x); s[2] += bflo(v.y); s[3] += bfhi(v.y); s[4] += bflo(v.z); s[5] += bfhi(v.z); s[6] += bflo(v.w); s[7] += bfhi(v.w); }
            const float ic = 1.f / (float)(hh - lo);
            const u32x4 v = *(const LAS u32x4*)(UP + (i + 8) * 512 + c8);
            u32x4 o; o.x = cvt_pk_bf16(s[0] * ic - bflo(v.x), s[1] * ic - bfhi(v.x)); o.y = cvt_pk_bf16(s[2] * ic - bflo(v.y), s[3] * ic - bfhi(v.y));
            o.z = cvt_pk_bf16(s[4] * ic - bflo(v.z), s[5] * ic - bfhi(v.z)); o.w = cvt_pk_bf16(s[6] * ic - bflo(v.w), s[7] * ic - bfhi(v.w));
            *(LAS u32x4*)(PL + i * 512 + c8) = o; }
        __syncthreads();
        {
            const int gi = wave >> 1, nh = wave & 1;
#pragma unroll
            for (int ntile = 0; ntile < 2; ++ntile) { const int n0 = nh * 64 + ntile * 32;
                f32x16 acc = {};
#pragma unroll
                for (int ks = 0; ks < 8; ++ks) { const bf16x8 a = *(const LAS bf16x8*)(PL + r32 * 512 + gi * 128 + ks * 16 + hi * 8);
                    const bf16x8 bb = *(const bf16x8*)(WP + ((size_t)(gi * 128 + n0 + r32)) * 128 + ks * 16 + hi * 8);
                    acc = __builtin_amdgcn_mfma_f32_32x32x16_bf16(a, bb, acc, 0, 0, 0); }
                const float psc = A.in[13][gi * 128 + n0 + r32];
#pragma unroll
                for (int r = 0; r < 16; ++r) Y[(size_t)(tb + t0 + crow(r, hi)) * D + 512 + gi * 128 + n0 + r32] = f2bf(acc[r] * psc); }
        }
    }
    __syncthreads();
}

__device__ __forceinline__ void router_phase(Frame& F, const Args& A, int layer) {
    const int tid = F.tid, lane = F.lane, wave = F.wave, r32 = lane & 31, hi = lane >> 5;
    LAS float* T = (LAS float*)F.lds;
    LAS float* LOG = (LAS float*)(F.lds + 133120);
    const float* g = A.in[6] + (size_t)(layer * 2 + 1) * D;
    const float* MODL = WSP(float, WS_MOD) + (size_t)layer * 9 * (NMOD * D);
    bf16_t* H = WSP(bf16_t, WS_H);
    unsigned* CNT = F.ctl + CW_CNT + layer * 64; int* LIST = WSP(int, WS_LIST); f32x2* TW = WSP(f32x2, WS_TW);
    float rwreg[64];
#pragma unroll
    for (int s = 0; s < 64; ++s) rwreg[s] = A.in[25][(size_t)(128 * wave + 2 * s + hi) * NEXP + r32];
    const int ngroups = layer == 0 ? NTOK / 32 : NLAT / 32;
    for (int grp = F.bid; grp < ngroups; grp += F.G) {
        const int ta0 = layer == 0 ? grp * 32 : (grp >> 7) * TPB + CTXL + (grp & 127) * 32;
        __syncthreads();
        for (int q = 0; q < 4; ++q) { const int ti = 4 * wave + q, ta = ta0 + ti, b = ta / TPB, j = ta - b * TPB, mrow = j < CTXL ? 8 : b;
            const f32x4* xr = (const f32x4*)xl_row(F, ta) + lane;
            f32x4 v[4]; float s = 0.f;
#pragma unroll
            for (int c = 0; c < 4; ++c) { v[c] = xr[64 * c]; s += (v[c].x * v[c].x + v[c].y * v[c].y) + (v[c].z * v[c].z + v[c].w * v[c].w); }
            const float r = 1.f / sqrtf(wave_sum(s) * (1.f / D) + EPS);
            const float* sh = MODL + (size_t)mrow * (NMOD * D) + 3 * D; const float* sc = sh + D;
            u32x2* o8 = (u32x2*)(H + (size_t)ta * D) + lane;
#pragma unroll
            for (int c = 0; c < 4; ++c) { const int col = 4 * lane + 256 * c;
                const f32x4 g4 = *(const f32x4*)(g + col), s4 = *(const f32x4*)(sc + col), h4 = *(const f32x4*)(sh + col);
                const f32x4 y = (v[c] * r) * g4 * (s4 + 1.f) + h4;
                u32x2 w; w.x = cvt_pk_bf16(y.x, y.y); w.y = cvt_pk_bf16(y.z, y.w); o8[64 * c] = w;
                LAS float* tp = T + ti * 1025 + col; tp[0] = y.x; tp[1] = y.y; tp[2] = y.z; tp[3] = y.w; } }
        __syncthreads();
        f32x16 acc = {};
#pragma unroll
        for (int s = 0; s < 64; ++s) { const float a = T[r32 * 1025 + 128 * wave + 2 * s + hi]; acc = __builtin_amdgcn_mfma_f32_32x32x2f32(a, rwreg[s], acc, 0, 0, 0); }
        __syncthreads();
        { LAS float* RED = T + wave * (32 * 33);
#pragma unroll
          for (int r = 0; r < 16; ++r) RED[crow(r, hi) * 33 + r32] = acc[r]; }
        __syncthreads();
        for (int e = tid; e < 1024; e += 512) { const int tk = e >> 5, ex = e & 31; float s = 0.f;
#pragma unroll
            for (int w = 0; w < 8; ++w) s += T[w * (32 * 33) + tk * 33 + ex];
            LOG[tk * 33 + ex] = s; }
        __syncthreads();
        if (tid < 32) { const int ta = ta0 + tid;
            float bestg = -1e30f, bs1 = 0.f, bs2 = 0.f; int bi1 = 0, bi2 = 1, bgrp = 0;
#pragma unroll
            for (int gq = 0; gq < 8; ++gq) { float sc[4], bb[4];
#pragma unroll
                for (int q = 0; q < 4; ++q) { sc[q] = sigmoidf_(LOG[tid * 33 + gq * 4 + q]); bb[q] = sc[q] + A.in[26][gq * 4 + q]; }
                int i1 = 0; float m1 = bb[0];
#pragma unroll
                for (int q = 1; q < 4; ++q) if (bb[q] > m1) { m1 = bb[q]; i1 = q; }
                int i2 = -1; float m2 = -1e30f;
#pragma unroll
                for (int q = 0; q < 4; ++q) if (q != i1 && bb[q] > m2) { m2 = bb[q]; i2 = q; }
                const float gs = m1 + m2;
                float s1 = sc[0], s2 = sc[0];
#pragma unroll
                for (int q = 1; q < 4; ++q) { s1 = (i1 == q) ? sc[q] : s1; s2 = (i2 == q) ? sc[q] : s2; }
                if (gs > bestg) { bestg = gs; bgrp = gq; bi1 = i1; bi2 = i2; bs1 = s1; bs2 = s2; } }
            const float inv = 1.f / (bs1 + bs2); const float w1 = bs1 * inv, w2 = bs2 * inv;
            const int lo = bi1 < bi2 ? bi1 : bi2, hh = bi1 < bi2 ? bi2 : bi1;
            const float wlo = bi1 < bi2 ? w1 : w2, whi = bi1 < bi2 ? w2 : w1;
            const int pair = (lo == 0) ? (hh - 1) : (lo == 1 ? (hh + 1) : 5);
            const int bucket = bgrp * 6 + pair;
            const unsigned pos = atomicAdd(&CNT[bucket], 1u);
            LIST[(size_t)bucket * LCAP + pos] = ta; TW[ta] = (f32x2){wlo, whi}; }
    }
    __syncthreads();
}

struct MoeSched {
    static constexpr bool GATHER_ = true;
    int G, c, ntiles, layer, stage; const unsigned* cnt; const int* list; const char* A; const char* W; LAS int* pre;
};
template <bool G1> struct MoeSchedT {
    static constexpr bool GATHER = G1;
    MoeSched m;
    __device__ __forceinline__ bool next(int i, pg8::Unit& u) const {
        const int L = i * m.G + m.c; if (L >= m.ntiles * 4) return false;
        const int tile = L >> 2, pn = L & 3;
        int bk = 0;
        for (int q = 1; q < NBUCK; ++q) bk = (m.pre[q] <= tile) ? q : bk;
        const int tin = tile - m.pre[bk], cntb = (int)m.cnt[bk];
        const int grp = bk / 6, pair = bk % 6;
        const int lo = pair < 3 ? 0 : (pair < 5 ? 1 : 2), hh = pair < 3 ? pair + 1 : (pair < 5 ? pair - 1 : 3);
        const int e1 = grp * 4 + lo, e2 = grp * 4 + hh;
        u.pm = tile; u.po = tile; u.pn = pn; u.rows = m.list + (size_t)bk * LCAP + tin * 256; u.nvalid = (cntb - tin * 256) < 256 ? (cntb - tin * 256) : 256; u.aux = pn >> 1;
        if (G1) {
            const int e = (pn < 2) ? e1 : e2;
            u.A = m.A; u.B = m.W + ((size_t)(m.layer * NEXP + e) * 512 + (pn & 1) * 256) * 1024 * 2; u.B2 = u.B;
        } else {
            u.A = m.A + (size_t)tile * 256 * 512 * 2;
            u.B = m.W + ((size_t)(m.layer * NEXP + e1) * 1024 + pn * 256) * 256 * 2;
            u.B2 = m.W + ((size_t)(m.layer * NEXP + e2) * 1024 + pn * 256) * 256 * 2 - (size_t)4 * 128;
        }
        return true;
    }
};
struct EpiMoe1 {
    bf16_t* HE; const f32x2* TW;
    __device__ __forceinline__ void operator()(const f32x4 (&acc)[2][2][4][2], const pg8::Unit& u, int wr, int wc, int fr, int fq) const {
        const int slot = u.aux;
#pragma unroll
        for (int ai = 0; ai < 2; ++ai)
#pragma unroll
            for (int m = 0; m < 4; ++m) { const int r = ai * 128 + wr * 64 + m * 16 + fr; const int tok = u.rows[r < u.nvalid ? r : 0]; const f32x2 tw = TW[tok]; const float w = slot ? tw.y : tw.x;
                float o[8];
#pragma unroll
                for (int n = 0; n < 2; ++n)
#pragma unroll
                    for (int q = 0; q < 4; ++q) { const float gt = acc[ai][0][m][n][q], up = acc[ai][1][m][n][q]; o[4 * n + q] = siluf_(gt) * up * w; }
                u32x4 wv; wv.x = cvt_pk_bf16(o[0], o[1]); wv.y = cvt_pk_bf16(o[2], o[3]); wv.z = cvt_pk_bf16(o[4], o[5]); wv.w = cvt_pk_bf16(o[6], o[7]);
                *(u32x4*)(HE + (size_t)(u.po * 256 + r) * 512 + slot * 256 + (u.pn & 1) * 128 + wc * 32 + 8 * fq) = wv; }
    }
};
struct EpiMoe2 {
    float* out; float* xc; const float* modl;
    __device__ __forceinline__ void operator()(const f32x4 (&acc)[2][2][4][2], const pg8::Unit& u, int wr, int wc, int fr, int fq) const {
        const int col0 = u.pn * 256 + wc * 32 + 8 * fq;
#pragma unroll
        for (int ai = 0; ai < 2; ++ai)
#pragma unroll
            for (int m = 0; m < 4; ++m) { const int r = ai * 128 + wr * 64 + m * 16 + fr;
                if (r < u.nvalid) { const int tok = u.rows[r]; const int b = tok / TPB, j = tok - b * TPB; const int mrow = j < CTXL ? 8 : b;
                    const float* gate = modl + (size_t)mrow * (NMOD * D) + 5 * D + col0;
                    float* dst = (j < CTXL ? xc + (size_t)(b * CTXL + j) * D : out + ((size_t)b * SEQ + (j - CTXL)) * D) + col0;
#pragma unroll
                    for (int bj = 0; bj < 2; ++bj)
#pragma unroll
                        for (int n = 0; n < 2; ++n) { const f32x4 gv = *(const f32x4*)(gate + bj * 128 + 4 * n); f32x4* dp = (f32x4*)(dst + bj * 128 + 4 * n); *dp = *dp + gv * acc[ai][bj][m][n]; } }
                asm volatile("" ::: "memory"); }
    }
};
__device__ __forceinline__ int moe_prefix(Frame& F, int layer, LAS int* pre) {
    __syncthreads();
    if (F.tid == 0) { int s = 0; const unsigned* cnt = F.ctl + CW_CNT + layer * 64; for (int q = 0; q < NBUCK; ++q) { pre[q] = s; s += ((int)cnt[q] + 255) >> 8; } pre[NBUCK] = s; }
    __syncthreads();
    return pre[NBUCK];
}

__device__ __forceinline__ void p9_phase(Frame& F, const Args& A) {
    const int gw = F.bid * 8 + F.wave, NGW = F.G * 8, l = F.lane;
    bf16_t* P = WSP(bf16_t, WS_BIG); const float* COS = WSP(float, WS_COS); const float* SIN = WSP(float, WS_SIN);
    const int kind = l < 8 ? 0 : l < 24 ? 1 : l < 28 ? 2 : l < 30 ? 5 : l < 46 ? 3 : 5;
    float gg[32];
    {
        const float* gp = nullptr;
        if (kind == 0) gp = A.in[16] + 32 * l; else if (kind == 1) gp = A.in[21] + 0 * 64 + (l & 1) * 32; else if (kind == 2) gp = A.in[18] + 32 * (l - 24); else if (kind == 3) gp = A.in[21] + 1 * 64 + (l & 1) * 32;
#pragma unroll
        for (int j = 0; j < 32; ++j) gg[j] = gp ? gp[j] : 1.f;
    }
    for (int ta = gw; ta < NTOK; ta += NGW) {
        const int b = ta / TPB, jj = ta - b * TPB; const bool lat = jj >= CTXL; const int pos = jj - CTXL;
        bf16_t* rowp = P + (size_t)ta * PW + 32 * l;
        u32x4 w[4];
#pragma unroll
        for (int q = 0; q < 4; ++q) w[q] = *(const u32x4*)(rowp + 8 * q);
        float v[32]; float ss = 0.f;
#pragma unroll
        for (int q = 0; q < 4; ++q)
#pragma unroll
            for (int c = 0; c < 4; ++c) { v[8 * q + 2 * c] = bflo(w[q][c]); v[8 * q + 2 * c + 1] = bfhi(w[q][c]); }
#pragma unroll
        for (int j = 0; j < 32; ++j) ss += v[j] * v[j];
        const float s1 = ss + __shfl_xor(ss, 1), s2 = s1 + __shfl_xor(s1, 2), s4 = s2 + __shfl_xor(s2, 4);
        const float tot = kind == 0 ? s4 : kind == 2 ? s2 : s1;
        const float nn = kind == 0 ? 256.f : kind == 2 ? 128.f : 64.f;
        const float r = 1.f / sqrtf(tot / nn + EPS);
        const bool act = (kind == 0 && lat) || (kind == 1 && lat) || kind == 2 || kind == 3;
#pragma unroll
        for (int j = 0; j < 32; ++j) v[j] = v[j] * r * gg[j];
        const bool rope = (kind == 1 || kind == 3) && lat;
        {
            const float* cp = COS + (size_t)(lat ? pos : 0) * 32; const float* sp = SIN + (size_t)(lat ? pos : 0) * 32;
#pragma unroll
            for (int j = 0; j < 32; ++j) { const float other = __shfl_xor(v[j], 1); const float cs = cp[j], sn = sp[j];
                const float rv = (l & 1) ? (v[j] * cs + other * sn) : (v[j] * cs - other * sn);
                v[j] = rope ? rv : v[j]; }
        }
        if (act) {
#pragma unroll
            for (int q = 0; q < 4; ++q) { u32x4 o; o.x = cvt_pk_bf16(v[8 * q], v[8 * q + 1]); o.y = cvt_pk_bf16(v[8 * q + 2], v[8 * q + 3]); o.z = cvt_pk_bf16(v[8 * q + 4], v[8 * q + 5]); o.w = cvt_pk_bf16(v[8 * q + 6], v[8 * q + 7]);
                *(u32x4*)(rowp + 8 * q) = o; }
        }
    }
}

__device__ __forceinline__ void p11_phase(Frame& F, const Args& A) {
    const int gw = F.bid * 8 + F.wave, NGW = F.G * 8, l = F.lane;
    const bf16_t* P = WSP(bf16_t, WS_BIG); bf16_t* QM = WSP(bf16_t, WS_QM); bf16_t* KM = WSP(bf16_t, WS_KM); const bf16_t* KV = WSP(bf16_t, WS_H);
    const float* COS = WSP(float, WS_COS); const float* SIN = WSP(float, WS_SIN);
    const float* gq = A.in[20]; const float* gk = A.in[20] + 192;
    const float gq0 = gq[l], gq1 = gq[64 + l], gq2 = gq[128 + l], gk0 = gk[l], gk1 = gk[64 + l], gk2 = gk[128 + l];
    for (int it = gw; it < NLAT * 4; it += NGW) { const int tl = it >> 2, h = it & 3, pos = tl & (SEQ - 1);
        bf16_t* q = QM + (size_t)tl * 768 + h * 192;
        float v0 = bf2f(q[l]), v1 = bf2f(q[64 + l]), v2 = bf2f(q[128 + l]);
        const float r = 1.f / sqrtf(wave_sum(v0 * v0 + v1 * v1 + v2 * v2) * (1.f / 192.f) + EPS);
        v0 *= r * gq0; v1 *= r * gq1; v2 *= r * gq2;
        const float other = __shfl_xor(v2, 32); const float cs = COS[pos * 32 + (l & 31)], sn = SIN[pos * 32 + (l & 31)];
        v2 = (l < 32) ? (v2 * cs - other * sn) : (v2 * cs + other * sn);
        q[l] = f2bf(v0); q[64 + l] = f2bf(v1); q[128 + l] = f2bf(v2); }
    for (int it = gw; it < NTOK * 4; it += NGW) { const int ta = it >> 2, h = it & 3, b = ta / TPB, jj = ta - b * TPB; const bool lat = jj >= CTXL; const int pos = lat ? jj - CTXL : 0;
        const bf16_t* kv = KV + (size_t)ta * 1024 + h * 256;
        float v0 = bf2f(kv[l]), v1 = bf2f(kv[64 + l]), v2 = bf2f(P[(size_t)ta * PW + PC_KROPE + l]);
        const float r = 1.f / sqrtf(wave_sum(v0 * v0 + v1 * v1 + v2 * v2) * (1.f / 192.f) + EPS);
        v0 *= r * gk0; v1 *= r * gk1; v2 *= r * gk2;
        const float other = __shfl_xor(v2, 32); const float cs = COS[pos * 32 + (l & 31)], sn = SIN[pos * 32 + (l & 31)];
        const float rv = (l < 32) ? (v2 * cs - other * sn) : (v2 * cs + other * sn);
        v2 = lat ? rv : v2;
        bf16_t* k = KM + (size_t)ta * 768 + h * 192;
        k[l] = f2bf(v0); k[64 + l] = f2bf(v1); k[128 + l] = f2bf(v2); }
}

#define SBAR() __builtin_amdgcn_sched_barrier(0)
__device__ __forceinline__ void partialSM(f32x16& p0, f32x16& p1, float& m_reg, float& mn, float& alpha, const float C, const float thr) {
    float pmax = p0[0];
#pragma unroll
    for (int r = 1; r < 16; ++r) pmax = fmaxf(pmax, p0[r]);
#pragma unroll
    for (int r = 0; r < 16; ++r) pmax = fmaxf(pmax, p1[r]);
    { auto rr = __builtin_amdgcn_permlane32_swap(__float_as_uint(pmax), __float_as_uint(pmax), false, false);
      pmax = fmaxf(__uint_as_float(rr[0]), __uint_as_float(rr[1])); }
    if (__builtin_expect(__all(pmax - m_reg <= thr), 1)) { mn = m_reg; alpha = 1.f; }
    else { mn = fmaxf(m_reg, pmax); alpha = __builtin_amdgcn_exp2f((m_reg - mn) * C); m_reg = mn; }
    const float mnC = -mn * C;
#pragma unroll
    for (int r = 0; r < 16; ++r) p0[r] = fmaf(p0[r], C, mnC);
#pragma unroll
    for (int r = 0; r < 16; ++r) p1[r] = fmaf(p1[r], C, mnC);
#pragma unroll
    for (int r = 0; r < 16; ++r) p0[r] = __builtin_amdgcn_exp2f(p0[r]);
}
__device__ __forceinline__ void finishSM(f32x16& p0, f32x16& p1, float alpha, float& l_reg, bf16x8& pa0, bf16x8& pa1, bf16x8& pa2, bf16x8& pa3) {
#pragma unroll
    for (int r = 0; r < 16; ++r) p1[r] = __builtin_amdgcn_exp2f(p1[r]);
    float ps = 0;
#pragma unroll
    for (int r = 0; r < 16; ++r) ps += p0[r];
#pragma unroll
    for (int r = 0; r < 16; ++r) ps += p1[r];
    { auto rr = __builtin_amdgcn_permlane32_swap(__float_as_uint(ps), __float_as_uint(ps), false, false);
      ps = __uint_as_float(rr[0]) + __uint_as_float(rr[1]); }
    l_reg = l_reg * alpha + ps;
#define PK4(P, BASE, OUT) do { unsigned a0 = cvt_pk_bf16(P[BASE + 0], P[BASE + 1]), a1 = cvt_pk_bf16(P[BASE + 2], P[BASE + 3]);   \
    unsigned b0 = cvt_pk_bf16(P[BASE + 4], P[BASE + 5]), b1 = cvt_pk_bf16(P[BASE + 6], P[BASE + 7]);                              \
    auto r0 = __builtin_amdgcn_permlane32_swap(a0, b0, false, false); auto r1 = __builtin_amdgcn_permlane32_swap(a1, b1, false, false); \
    u32x4 w = {r0[0], r1[0], r0[1], r1[1]}; OUT = *reinterpret_cast<bf16x8*>(&w); } while (0)
    PK4(p0, 0, pa0); PK4(p0, 8, pa1); PK4(p1, 0, pa2); PK4(p1, 8, pa3);
#undef PK4
}
__device__ __forceinline__ int v_st(int k, int c) { const int kk = (k & ~0xC) | ((k & 4) << 1) | ((k & 8) >> 1); return ((kk >> 3) * 4 + (c >> 5)) * 512 + ((kk & 7) * 32 + (c & 31)) * 2; }
__device__ __forceinline__ int v_rd_base(int lane) { return ((lane & 3) << 3) | (((lane >> 2) & 3) << 6) | (((lane >> 4) & 1) << 5) | (((lane >> 5) & 1) << 8); }
constexpr int v_rd_off(int d0, int ks, int half) { return d0 * 512 + ks * 4096 + half * 2048; }
template <int OFF> __device__ __forceinline__ s16x4 tr_read(int vb) {
    s16x4 r; asm volatile("ds_read_b64_tr_b16 %0, %1 offset:%2" : "=&v"(r) : "v"(vb), "i"(OFF) : "memory"); return r;
}
template <int D0> __device__ __forceinline__ void pv_one(f32x16& od, int vb, bf16x8 pa0, bf16x8 pa1, bf16x8 pa2, bf16x8 pa3) {
    const s16x4 l0 = tr_read<v_rd_off(D0, 0, 0)>(vb), h0 = tr_read<v_rd_off(D0, 0, 1)>(vb), l1 = tr_read<v_rd_off(D0, 1, 0)>(vb), h1 = tr_read<v_rd_off(D0, 1, 1)>(vb);
    const s16x4 l2 = tr_read<v_rd_off(D0, 2, 0)>(vb), h2 = tr_read<v_rd_off(D0, 2, 1)>(vb), l3 = tr_read<v_rd_off(D0, 3, 0)>(vb), h3 = tr_read<v_rd_off(D0, 3, 1)>(vb);
    asm volatile("s_waitcnt lgkmcnt(0)" ::: "memory"); SBAR();
#define PK(L, H) (bf16x8){L[0], L[1], L[2], L[3], H[0], H[1], H[2], H[3]}
    od = __builtin_amdgcn_mfma_f32_32x32x16_bf16(pa0, PK(l0, h0), od, 0, 0, 0);
    od = __builtin_amdgcn_mfma_f32_32x32x16_bf16(pa1, PK(l1, h1), od, 0, 0, 0);
    od = __builtin_amdgcn_mfma_f32_32x32x16_bf16(pa2, PK(l2, h2), od, 0, 0, 0);
    od = __builtin_amdgcn_mfma_f32_32x32x16_bf16(pa3, PK(l3, h3), od, 0, 0, 0);
#undef PK
}
__device__ __forceinline__ void pv_d0(f32x16* o, int vb, bf16x8 pa0, bf16x8 pa1, bf16x8 pa2, bf16x8 pa3) {
    pv_one<0>(o[0], vb, pa0, pa1, pa2, pa3); pv_one<1>(o[1], vb, pa0, pa1, pa2, pa3); pv_one<2>(o[2], vb, pa0, pa1, pa2, pa3); pv_one<3>(o[3], vb, pa0, pa1, pa2, pa3);
}

template <int DK, int LDQ, int LDK, int LDV, int SDEPTH, int NQL>
__device__ __forceinline__ void attn_body(const int tid, const bf16_t* __restrict__ Qb, const bf16_t* __restrict__ Kh, const bf16_t* __restrict__ Vh, const int seq, char* lds,
                                          const float C, const float thr, f32x16 (&o)[4], float& l_out) {
    constexpr int RB = DK * 2, SHM_V = 64 * 256, SHM_K = 64 * RB, CPR = DK / 8, NKC = CPR / 8, ND0 = DK / 16, NQR = ND0 - NQL, QTB = NQL * 32;
#define KSWZ(row, colB) ((row) * RB + ((colB) ^ (((row) & 7) << 4)))
    const int wid = tid >> 6, lane = tid & 63, r32 = lane & 31, hi = lane >> 5;
    char* V_lds = lds; char* K_lds = lds + 2 * SHM_V;
    float* ws = (float*)(lds + 2 * SHM_V + 2 * SHM_K) + wid * 64; float* al_l = ws + 32;
    char* Qt = lds + 2 * SHM_V + 2 * SHM_K + 2048 + wid * (32 * (QTB > 0 ? QTB : 1));
    float m_reg = -1e30f, l_reg = 0;
#pragma unroll
    for (int d = 0; d < 4; ++d) o[d] = f32x16{};
    bf16x8 qr[NQR];
    const bf16_t* Qw = Qb + (size_t)(wid * 32 + r32) * LDQ + hi * 8;
#pragma unroll
    for (int d0 = 0; d0 < NQR; ++d0) qr[d0] = *(const bf16x8*)(Qw + d0 * 16);
    if constexpr (NQL > 0) {
        constexpr int CH = QTB / 16;
#pragma unroll
        for (int i = 0; i < (32 * CH) / 64; ++i) { const int c = lane + 64 * i, row = c / CH, cc = c % CH;
            const bf16x8 v = *(const bf16x8*)(Qb + (size_t)(wid * 32 + row) * LDQ + NQR * 16 + cc * 8);
            *(bf16x8*)(Qt + row * QTB + ((cc * 16) ^ (((row) & (CH - 1) & 7) << 4))) = v; }
        asm volatile("s_waitcnt lgkmcnt(0)" ::: "memory");
    }
    const int sr = tid >> 4, sc = (tid & 15) * 8, vst0 = v_st(sr, sc), vst1 = v_st(32 + sr, sc);
    const int vb0 = (int)(uintptr_t)V_lds + v_rd_base(lane);
    int krow[NKC], kcc[NKC];
#pragma unroll
    for (int i = 0; i < NKC; ++i) { const int c = tid + 512 * i; krow[i] = c / CPR; kcc[i] = c % CPR; }
    struct { bf16x8 vs0, vs1, ks[NKC]; } sr_[SDEPTH];
    constexpr int SE = 0, SO = SDEPTH - 1;
#define SLOAD(i, k0) do { sr_[i].vs0 = *(const bf16x8*)(&Vh[(size_t)((k0) + sr) * LDV + sc]); sr_[i].vs1 = *(const bf16x8*)(&Vh[(size_t)((k0) + 32 + sr) * LDV + sc]); \
    _Pragma("unroll") for (int _q = 0; _q < NKC; ++_q) sr_[i].ks[_q] = *(const bf16x8*)(&Kh[(size_t)((k0) + krow[_q]) * LDK + kcc[_q] * 8]); } while (0)
#define SWRITE(b, i) do { *(bf16x8*)(V_lds + (b) * SHM_V + vst0) = sr_[i].vs0; *(bf16x8*)(V_lds + (b) * SHM_V + vst1) = sr_[i].vs1; \
    _Pragma("unroll") for (int _q = 0; _q < NKC; ++_q) *(bf16x8*)(K_lds + (b) * SHM_K + KSWZ(krow[_q], kcc[_q] * 16)) = sr_[i].ks[_q]; } while (0)
#define SWAIT() do { if constexpr (SDEPTH == 2) asm volatile("s_waitcnt vmcnt(%0)" :: "n"(2 + NKC) : "memory"); else asm volatile("s_waitcnt vmcnt(0)" ::: "memory"); } while (0)
#define RESC(a) do { if (__any((a) < 1.f)) { if (hi == 0) al_l[r32] = (a); asm volatile("s_waitcnt lgkmcnt(0)" ::: "memory"); \
    _Pragma("unroll") for (int d = 0; d < 4; ++d) _Pragma("unroll") for (int r = 0; r < 16; ++r) o[d][r] *= al_l[crow(r, hi)]; } } while (0)
#define QFRAG(d0) ((d0) < NQR ? qr[(d0) < NQR ? (d0) : 0] : *(const bf16x8*)(Qt + r32 * QTB + (((((d0) - NQR) * 2 + hi) * 16) ^ ((r32 & ((QTB / 16) - 1) & 7) << 4))))
#define QKT(P0, P1, KB) do { P0 = f32x16{}; P1 = f32x16{}; _Pragma("unroll") for (int d0 = 0; d0 < ND0; ++d0) { const int cb = (d0 * 16 + hi * 8) * 2; \
    const bf16x8 b0 = *(const bf16x8*)((KB) + KSWZ(r32, cb)); const bf16x8 b1 = *(const bf16x8*)((KB) + KSWZ(32 + r32, cb)); const bf16x8 qf = QFRAG(d0); \
    P0 = __builtin_amdgcn_mfma_f32_32x32x16_bf16(b0, qf, P0, 0, 0, 0); P1 = __builtin_amdgcn_mfma_f32_32x32x16_bf16(b1, qf, P1, 0, 0, 0); } } while (0)
    f32x16 pA0, pA1, pB0, pB1; float mnA, mnB, alA, alB; bf16x8 pa0, pa1, pa2, pa3; const int NT = seq / 64;
    SLOAD(SE, 0); asm volatile("s_waitcnt vmcnt(0)" ::: "memory"); SWRITE(0, SE); __syncthreads();
    QKT(pA0, pA1, K_lds); partialSM(pA0, pA1, m_reg, mnA, alA, C, thr);
    SLOAD(SO, 64); if constexpr (SDEPTH == 2) { if (2 < NT) SLOAD(SE, 128); }
    SWAIT(); SWRITE(1, SO); __syncthreads();
    for (int j = 1; j + 1 < NT; j += 2) {
        SBAR(); QKT(pB0, pB1, K_lds + SHM_K);
        finishSM(pA0, pA1, alA, l_reg, pa0, pa1, pa2, pa3); SBAR();
        SLOAD(SO, (j + SDEPTH) * 64); SBAR();
        pv_d0(o, vb0, pa0, pa1, pa2, pa3); partialSM(pB0, pB1, m_reg, mnB, alB, C, thr);
        __syncthreads(); SWAIT(); SWRITE(0, SE);
        RESC(alB); __syncthreads();
        SBAR(); QKT(pA0, pA1, K_lds);
        finishSM(pB0, pB1, alB, l_reg, pa0, pa1, pa2, pa3); SBAR();
        if (SDEPTH == 1 || j + 3 < NT) SLOAD(SE, (j + 1 + SDEPTH) * 64); SBAR();
        pv_d0(o, vb0 + SHM_V, pa0, pa1, pa2, pa3); partialSM(pA0, pA1, m_reg, mnA, alA, C, thr);
        __syncthreads(); SWAIT(); SWRITE(1, SO);
        RESC(alA); __syncthreads();
    }
    SBAR(); QKT(pB0, pB1, K_lds + SHM_K);
    finishSM(pA0, pA1, alA, l_reg, pa0, pa1, pa2, pa3); SBAR();
    pv_d0(o, vb0, pa0, pa1, pa2, pa3); partialSM(pB0, pB1, m_reg, mnB, alB, C, thr);
    __syncthreads(); RESC(alB);
    finishSM(pB0, pB1, alB, l_reg, pa0, pa1, pa2, pa3); SBAR();
    pv_d0(o, vb0 + SHM_V, pa0, pa1, pa2, pa3);
    l_out = l_reg;
#undef SLOAD
#undef SWRITE
#undef SWAIT
#undef RESC
#undef QKT
#undef QFRAG
#undef KSWZ
}

__device__ __forceinline__ void attn_phase(Frame& F, const Args& A) {
    char* lds = (char*)F.lds;
    const bf16_t* P = WSP(bf16_t, WS_BIG); const bf16_t* QM = WSP(bf16_t, WS_QM); const bf16_t* KM = WSP(bf16_t, WS_KM); const bf16_t* KV = WSP(bf16_t, WS_H);
    bf16_t* Y = WSP(bf16_t, WS_YMIX); float* ST = WSP(float, WS_STASH) + (size_t)F.bid * 256 * 128;
    float lam;
    { const int lane = F.lane; const float* dl = A.in[22]; const float a = dl[lane] * dl[64 + lane], b = dl[128 + lane] * dl[192 + lane]; lam = __expf(wave_sum(a)) - __expf(wave_sum(b)) + LAM_INIT; }
    constexpr float LOG2E = 1.4426950408889634f;
#ifndef ATT_KINDS
#define ATT_KINDS 3
#endif
    if (ATT_KINDS & 1)
    for (int u = F.bid; u < 512; u += F.G) {
        int tid = threadIdx.x; asm volatile("" : "+v"(tid));
        const int wid = tid >> 6, lane = tid & 63, r32 = lane & 31, hi = lane >> 5;
        const int bh = u >> 4, qb = u & 15, b = bh >> 2, h = bh & 3;
        f32x16 o[4]; float l_reg;
        __syncthreads();
        attn_body<192, 768, 768, 1024, 1, 8>(tid, QM + ((size_t)(b * SEQ + qb * 256)) * 768 + h * 192, KM + (size_t)(b * TPB) * 768 + h * 192, KV + (size_t)(b * TPB) * 1024 + h * 256 + 128,
                                       TPB, lds, 0.07216878364870322f * LOG2E, 8.f / 0.07216878364870322f, o, l_reg);
        float* li_l = (float*)(lds + 2 * 16384 + 2 * 64 * 384) + wid * 64;
        if (hi == 0) li_l[r32] = l_reg; LDS_WAIT();
        float rli[16];
#pragma unroll
        for (int r = 0; r < 16; ++r) rli[r] = __builtin_amdgcn_rcpf(li_l[crow(r, hi)]);
        bf16_t* Ow = Y + (size_t)(b * SEQ + qb * 256 + wid * 32) * D + h * 128;
#pragma unroll
        for (int r = 0; r < 16; ++r)
#pragma unroll
            for (int d0 = 0; d0 < 4; ++d0) Ow[(size_t)crow(r, hi) * D + d0 * 32 + r32] = f2bf(o[d0][r] * rli[r]);
    }
    if (ATT_KINDS & 2)
    for (int u = F.bid; u < 512; u += F.G) {
        int tid = threadIdx.x; asm volatile("" : "+v"(tid));
        const int wid = tid >> 6, lane = tid & 63, r32 = lane & 31, hi = lane >> 5;
        const int bh = u >> 4, qb = u & 15, b = bh >> 2, h = bh & 3;
        const bf16_t* Pb = P + (size_t)(b * TPB) * PW;
        float* Sw = ST + (size_t)(wid * 32) * 128;
        float* li_l = (float*)(lds + 2 * 16384 + 2 * 64 * 128) + wid * 64;
        {
            f32x16 o[4]; float l_reg;
            __syncthreads();
            attn_body<64, PW, PW, PW, 2, 0>(tid, Pb + (size_t)(CTXL + qb * 256) * PW + PC_QD + h * 128, Pb + PC_KD + h * 128, Pb + PC_VD + h * 128, TPB, lds, 0.125f * LOG2E, 8.f / 0.125f, o, l_reg);
            if (hi == 0) li_l[r32] = l_reg; LDS_WAIT();
            float rli[16];
#pragma unroll
            for (int r = 0; r < 16; ++r) rli[r] = __builtin_amdgcn_rcpf(li_l[crow(r, hi)]);
#pragma unroll
            for (int r = 0; r < 16; ++r)
#pragma unroll
                for (int d0 = 0; d0 < 4; ++d0) Sw[(size_t)crow(r, hi) * 128 + d0 * 32 + r32] = o[d0][r] * rli[r];
        }
        {
            f32x16 o[4]; float l_reg;
            __syncthreads();
            attn_body<64, PW, PW, PW, 2, 0>(tid, Pb + (size_t)(CTXL + qb * 256) * PW + PC_QD + h * 128 + 64, Pb + PC_KD + h * 128 + 64, Pb + PC_VD + h * 128, TPB, lds, 0.125f * LOG2E, 8.f / 0.125f, o, l_reg);
            if (hi == 0) li_l[r32] = l_reg; LDS_WAIT();
            float ss[16];
#pragma unroll
            for (int r = 0; r < 16; ++r) { const float rl = __builtin_amdgcn_rcpf(li_l[crow(r, hi)]); float s = 0.f;
#pragma unroll
                for (int d0 = 0; d0 < 4; ++d0) { const float a1 = Sw[(size_t)crow(r, hi) * 128 + d0 * 32 + r32]; const float v = a1 - lam * (o[d0][r] * rl); o[d0][r] = v; s += v * v; }
                ss[r] = s; }
#pragma unroll
            for (int r = 0; r < 16; ++r) {
#pragma unroll
                for (int sh = 1; sh < 32; sh <<= 1) ss[r] += __shfl_xor(ss[r], sh);
                ss[r] = (1.f / sqrtf(ss[r] * (1.f / 128.f) + EPS)) * (1.f - LAM_INIT); }
            bf16_t* Ow = Y + (size_t)(b * SEQ + qb * 256 + wid * 32) * D + 512 + h * 128;
#pragma unroll
            for (int d0 = 0; d0 < 4; ++d0) { const float gs = A.in[23][d0 * 32 + r32];
#pragma unroll
                for (int r = 0; r < 16; ++r) Ow[(size_t)crow(r, hi) * D + d0 * 32 + r32] = f2bf(o[d0][r] * ss[r] * gs); }
        }
    }
    __syncthreads();
}

constexpr int NPHASE = 18;

__global__ void __launch_bounds__(512, 2) fwd(Args args) {
    extern __shared__ __attribute__((aligned(16))) unsigned char lds_raw[];
    Frame F;
    F.lds = (LAS unsigned char*)lds_raw;
    F.tid = threadIdx.x; F.lane = F.tid & 63; F.wave = __builtin_amdgcn_readfirstlane(F.tid >> 6);
    F.G = gridDim.x; F.bid = blockIdx.x;
    F.out = args.out; F.ws = args.ws; F.ctl = (unsigned*)(args.ws + WS_CTL);
    volatile LAS unsigned* MISC = (volatile LAS unsigned*)(F.lds + LDS_CTL);
    LAS int* PRE = (LAS int*)(F.lds + LDS_CTL + 64);
    if (F.tid < 4) MISC[F.tid] = 0u;
    __syncthreads();
    XcdBarrier bar; bar.bar = F.ctl + CW_BAR; bar.x = 0; bar.st = nullptr;
#if MK_ONE_LAUNCH
    bar = xcd_barrier_post(F.ctl + CW_BAR, MISC);
#define GRID_BAR() xcd_barrier(bar)
#else
#define GRID_BAR() do {} while (0)
#endif
    const int lo = args.ph_lo, hi = args.ph_hi;
#ifndef PH_MASK
#define PH_MASK 0x3ffff
#endif
#define IN(k) (((PH_MASK >> (k)) & 1) && lo <= (k) && (k) < hi)
#define SEAM(k) do { if (IN((k) + 1)) GRID_BAR(); } while (0)

    if (IN(0)) { p0_prologue(F, args); SEAM(0); }
    if (IN(1)) { norm_mod_phase(F, args, 0); SEAM(1); }
    if (IN(2)) {
        pg8::PlainSched S; S.init(WSP(bf16_t, WS_H), WSP(bf16_t, WS_WIN0), NTOK, 1536, D, D, D, F.G, F.bid, 0);
        pg8::EpiStoreBf16 E{WSP(bf16_t, WS_BIG), UW};
        pg8::gemm_phase(F.lds, D, D, D, 1 << 30, S, E); SEAM(2);
    }
    if (IN(3)) { convpool_phase(F, args); SEAM(3); }
    if (IN(4)) {
        pg8::PlainSched S; S.init(WSP(bf16_t, WS_YMIX), WSP(bf16_t, WS_WOUT0), NTOK, D, D, D, D, F.G, F.bid, 0);
        pg8::EpiResid E{args.in[0], args.in[2], F.out, WSP(float, WS_XC), WSP(float, WS_MOD), 0};
        pg8::gemm_phase(F.lds, D, D, D, 1 << 30, S, E); SEAM(4);
    }
    if (IN(5)) { router_phase(F, args, 0); SEAM(5); }
    if (IN(6)) {
        const int nt = moe_prefix(F, 0, PRE);
        MoeSchedT<true> S; S.m = MoeSched{F.G, F.bid, nt, 0, 0, F.ctl + CW_CNT, WSP(int, WS_LIST), (const char*)WSP(bf16_t, WS_H), (const char*)WSP(bf16_t, WS_WM1), PRE};
        EpiMoe1 E{WSP(bf16_t, WS_BIG), WSP(f32x2, WS_TW)};
        pg8::gemm_phase(F.lds, D, D, D, 1 << 30, S, E); SEAM(6);
    }
    if (IN(7)) {
        const int nt = moe_prefix(F, 0, PRE);
        MoeSchedT<false> S; S.m = MoeSched{F.G, F.bid, nt, 0, 1, F.ctl + CW_CNT, WSP(int, WS_LIST), (const char*)WSP(bf16_t, WS_BIG), (const char*)WSP(bf16_t, WS_WM2), PRE};
        EpiMoe2 E{F.out, WSP(float, WS_XC), WSP(float, WS_MOD)};
        pg8::gemm_phase(F.lds, 512, 512, 256, 4, S, E); SEAM(7);
    }
    if (IN(8)) { norm_mod_phase(F, args, 1); SEAM(8); }
    if (IN(9)) {
        pg8::PlainSched S; S.init(WSP(bf16_t, WS_H), WSP(bf16_t, WS_WIN1), NTOK, PW, D, D, D, F.G, F.bid, 0);
        pg8::EpiStoreBf16 E{WSP(bf16_t, WS_BIG), PW};
        pg8::gemm_phase(F.lds, D, D, D, 1 << 30, S, E); SEAM(9);
    }
    if (IN(10)) { p9_phase(F, args); SEAM(10); }
    if (IN(11)) {
        { pg8::PlainSched S; S.init(WSP(bf16_t, WS_BIG) + PC_CQ, WSP(bf16_t, WS_WUQ), NLAT, 768, 256, PW, 256, F.G, F.bid, 1);
          pg8::EpiStoreBf16 E{WSP(bf16_t, WS_QM), 768};
          pg8::gemm_phase(F.lds, 256, PW, 256, 1 << 30, S, E); }
        { pg8::PlainSched S; S.init(WSP(bf16_t, WS_BIG) + PC_CKV, WSP(bf16_t, WS_WUKV), NTOK, 1024, 128, PW, 128, F.G, F.bid, 0);
          pg8::EpiStoreBf16 E{WSP(bf16_t, WS_H), 1024};
          pg8::gemm_phase(F.lds, 128, PW, 128, 1 << 30, S, E); }
        SEAM(11);
    }
    if (IN(12)) { p11_phase(F, args); SEAM(12); }
    if (IN(13)) { attn_phase(F, args); SEAM(13); }
    if (IN(14)) {
        pg8::PlainSched S; S.init(WSP(bf16_t, WS_YMIX), WSP(bf16_t, WS_WOUT1), NLAT, D, D, D, D, F.G, F.bid, 0);
        pg8::EpiResid E{args.in[0], args.in[2], F.out, WSP(float, WS_XC), WSP(float, WS_MOD) + (size_t)9 * NMOD * D, 1};
        pg8::gemm_phase(F.lds, D, D, D, 1 << 30, S, E); SEAM(14);
    }
    if (IN(15)) { router_phase(F, args, 1); SEAM(15); }
    if (IN(16)) {
        const int nt = moe_prefix(F, 1, PRE);
        MoeSchedT<true> S; S.m = MoeSched{F.G, F.bid, nt, 1, 0, F.ctl + CW_CNT + 64, WSP(int, WS_LIST), (const char*)WSP(bf16_t, WS_H), (const char*)WSP(bf16_t, WS_WM1), PRE};
        EpiMoe1 E{WSP(bf16_t, WS_BIG), WSP(f32x2, WS_TW)};
        pg8::gemm_phase(F.lds, D, D, D, 1 << 30, S, E); SEAM(16);
    }
    if (IN(17)) {
        const int nt = moe_prefix(F, 1, PRE);
        MoeSchedT<false> S; S.m = MoeSched{F.G, F.bid, nt, 1, 1, F.ctl + CW_CNT + 64, WSP(int, WS_LIST), (const char*)WSP(bf16_t, WS_BIG), (const char*)WSP(bf16_t, WS_WM2), PRE};
        EpiMoe2 E{F.out, WSP(float, WS_XC), WSP(float, WS_MOD) + (size_t)9 * NMOD * D};
        pg8::gemm_phase(F.lds, 512, 512, 256, 4, S, E);
    }
#undef IN
#undef SEAM
}

extern "C" void kernel_launch(void* const* d_in, const int* in_sizes, int n_in, void* d_out, int out_size, void* d_ws, size_t ws_size, hipStream_t stream) {
    static int grid = 0;
    if (grid == 0) {
        if (n_in != 30 || in_sizes[0] != NLAT * D || out_size != NLAT * D || ws_size < WS_END) { fprintf(stderr, "kernel_launch: unexpected shapes (n_in %d, in0 %d, out %d, ws %zu)\n", n_in, n_in > 0 ? in_sizes[0] : -1, out_size, ws_size); grid = -1; return; }
        int dev = 0, cus = 0, per_cu = 0;
        if (hipGetDevice(&dev) != hipSuccess || hipDeviceGetAttribute(&cus, hipDeviceAttributeMultiprocessorCount, dev) != hipSuccess) { grid = -1; return; }
        if (hipFuncSetAttribute((const void*)fwd, hipFuncAttributeMaxDynamicSharedMemorySize, LDS_BYTES) != hipSuccess) { fprintf(stderr, "kernel_launch: hipFuncSetAttribute failed\n"); grid = -1; return; }
        if (hipOccupancyMaxActiveBlocksPerMultiprocessor(&per_cu, (const void*)fwd, 512, LDS_BYTES) != hipSuccess || per_cu < 1) fprintf(stderr, "kernel_launch: occupancy query reports %d\n", per_cu);
        (void)hipGetLastError();
        grid = cus;
    }
    if (grid < 0) return;
    if (hipMemsetAsync((char*)d_ws + WS_CTL, 0, CTL_ZERO_BYTES, stream) != hipSuccess) return;
    Args a{};
    for (int i = 0; i < 30; ++i) a.in[i] = (const float*)d_in[i];
    a.out = (float*)d_out; a.ws = (unsigned char*)d_ws;
    const int last = MK_LAST_PHASE < NPHASE - 1 ? MK_LAST_PHASE : NPHASE - 1;
#if MK_ONE_LAUNCH
    a.ph_lo = 0; a.ph_hi = last + 1;
    hipLaunchKernelGGL(fwd, dim3(grid), dim3(512), LDS_BYTES, stream, a);
#else
    for (int p = 0; p <= last; ++p) { a.ph_lo = p; a.ph_hi = p + 1; hipLaunchKernelGGL(fwd, dim3(grid), dim3(512), LDS_BYTES, stream, a); }
#endif
    const hipError_t le = hipPeekAtLastError();
    if (le != hipSuccess) fprintf(stderr, "kernel_launch: launch failed: %s\n", hipGetErrorName(le));
}
```

```cpp
#include <hip/hip_runtime.h>
#include <cstdio>
#include <cstdint>

#ifndef MK_ONE_LAUNCH
#define MK_ONE_LAUNCH 1
#endif
#ifndef MK_LAST_PHASE
#define MK_LAST_PHASE 99
#endif

#ifndef PROBE_REP
#define PROBE_REP 0
#endif
#define PT_LO -1
#define PT_HI -1
#define PT_AMP 4
#define PT_PRE 0
#define PT_SUB 0

#define GAS __attribute__((address_space(1)))
#define LAS __attribute__((address_space(3)))
typedef unsigned short bf16_t;
typedef short bf16x8 __attribute__((ext_vector_type(8)));
typedef short s16x4 __attribute__((ext_vector_type(4)));
typedef float f32x4 __attribute__((ext_vector_type(4)));
typedef float f32x2 __attribute__((ext_vector_type(2)));
typedef float f32x16 __attribute__((ext_vector_type(16)));
typedef unsigned u32x4 __attribute__((ext_vector_type(4)));
typedef unsigned u32x2 __attribute__((ext_vector_type(2)));

constexpr int D = 1024, NB = 8, SEQ = 4096, CTXL = 256, TPB = SEQ + CTXL;
constexpr int NTOK = NB * TPB, NLAT = NB * SEQ, NCTX = NB * CTXL;
constexpr int NMOD = 6;
constexpr float EPS = 1e-6f;
constexpr int NEXP = 32, NBUCK = 48, DEXP = 256, LCAP = NTOK;
constexpr int PW = 2048;
constexpr int UW = 1536;
constexpr int PC_CQ = 0, PC_QD = 256, PC_CKV = 768, PC_KROPE = 896, PC_KD = 960, PC_VD = 1472;
constexpr float LAM_INIT = 0.35550906759096934f;
constexpr int MOE_MAXT = NTOK / 256 + NBUCK;

constexpr size_t MiB = 1u << 20;
constexpr size_t WS_CTL = 0, CTL_ZERO_BYTES = 1 * MiB;
constexpr size_t WS_MOD = 2 * MiB;
constexpr size_t WS_COS = 3 * MiB, WS_SIN = 3 * MiB + 512 * 1024;
constexpr size_t WS_XC = 4 * MiB;
constexpr size_t WS_LIST = 12 * MiB;
constexpr size_t WS_TW = 19 * MiB;
constexpr size_t WS_WIN0 = 20 * MiB, WS_WOUT0 = 23 * MiB, WS_WIN1 = 25 * MiB, WS_WUQ = 29 * MiB, WS_WUKV = 29 * MiB + 512 * 1024, WS_WOUT1 = 30 * MiB, WS_WPOOL = 32 * MiB;
constexpr size_t WS_WM1 = 33 * MiB;
constexpr size_t WS_WM2 = 97 * MiB;
constexpr size_t WS_H = 129 * MiB;
constexpr size_t WS_BIG = 197 * MiB;
constexpr size_t WS_YMIX = 333 * MiB;
constexpr size_t WS_QM = 401 * MiB;
constexpr size_t WS_KM = 449 * MiB;
constexpr size_t WS_END = 500 * MiB;
constexpr size_t WS_STASH = WS_WM1;
constexpr int CW_BAR = 4096;
constexpr int CW_CNT = 16384;

constexpr int LDS_BYTES = 155648;
constexpr int LDS_CTL = 153600;

__device__ __forceinline__ unsigned cvt_pk_bf16(float lo, float hi) { unsigned r; asm volatile("v_cvt_pk_bf16_f32 %0, %1, %2" : "=v"(r) : "v"(lo), "v"(hi)); return r; }
__device__ __forceinline__ float bf2f(unsigned short u) { return __uint_as_float((unsigned)u << 16); }
__device__ __forceinline__ float bflo(unsigned w) { return __uint_as_float(w << 16); }
__device__ __forceinline__ float bfhi(unsigned w) { return __uint_as_float(w & 0xffff0000u); }
__device__ __forceinline__ unsigned short f2bf(float f) { return (unsigned short)(cvt_pk_bf16(f, 0.f) & 0xffffu); }
__device__ __forceinline__ float wave_sum(float v) {
#pragma unroll
    for (int o = 1; o < 64; o <<= 1) v += __shfl_xor(v, o);
    return v;
}
__device__ __forceinline__ float sigmoidf_(float x) { return 1.f / (1.f + __expf(-x)); }
__device__ __forceinline__ float siluf_(float x) { return x / (1.f + __expf(-x)); }
__device__ __forceinline__ int crow(int r, int hi) { return (r & 3) + 8 * (r >> 2) + 4 * hi; }
#define LDS_WAIT() asm volatile("s_waitcnt lgkmcnt(0)" ::: "memory")
#define VM_WAIT() asm volatile("s_waitcnt vmcnt(0)" ::: "memory")

#define XB_TMO      128
#define XB_XCNT(j)  (256  + 64 * (j))
#define XB_XSUB(j)  (1280 + 64 * (j))
#define XB_XGEN(j)  (2304 + 64 * (j))
#define XB_TOP      3328
#define XB_TOPGEN   3392
#define XCD_BAR_WORDS 3456
#define XB_SPIN_CAP (1u << 18)
__device__ __forceinline__ unsigned xb_ld(unsigned* p)              { return __hip_atomic_load(p, __ATOMIC_RELAXED, __HIP_MEMORY_SCOPE_AGENT); }
__device__ __forceinline__ unsigned xb_add(unsigned* p, unsigned v) { return __hip_atomic_fetch_add(p, v, __ATOMIC_RELAXED, __HIP_MEMORY_SCOPE_AGENT); }
__device__ __forceinline__ unsigned xb_xcc_id() { return (unsigned)__builtin_amdgcn_s_getreg((3 << 11) | 20) & 0xFu; }
#define XB_SPIN(cond, bar) do { unsigned _sp = 0; while (cond) { __builtin_amdgcn_s_sleep(1); \
    if ((++_sp & 255u) == 0u) { if (xb_ld(&(bar)[XB_TMO])) break; if (_sp > XB_SPIN_CAP) { atomicAdd(&(bar)[XB_TMO], 1u); break; } } } } while (0)
struct XcdBarrier { unsigned* bar; unsigned x; volatile LAS unsigned* st; };
__device__ __forceinline__ XcdBarrier xcd_barrier_post(unsigned* bar, volatile LAS unsigned* st) {
    XcdBarrier b; b.bar = bar; b.x = xb_xcc_id(); b.st = st;
    if (threadIdx.x == 0) (void)xb_add(&bar[XB_XCNT(b.x)], 1u);
    return b;
}
__device__ __forceinline__ void xcd_barrier_complete(unsigned* bar, unsigned x, unsigned& nloc, unsigned& nx) {
    const unsigned G = gridDim.x * gridDim.y * gridDim.z;
    unsigned sum, cnt, mine, sp = 0u;
    for (;;) {
        sum = 0u; cnt = 0u; mine = 0u;
#pragma unroll
        for (unsigned j = 0; j < 16; ++j) { const unsigned c = xb_ld(&bar[XB_XCNT(j)]); sum += c; cnt += (c > 0u) ? 1u : 0u; mine = (j == x) ? c : mine; }
        if (sum == G) break;
        __builtin_amdgcn_s_sleep(1);
        if ((++sp & 255u) == 0u) { if (xb_ld(&bar[XB_TMO])) break; if (sp > XB_SPIN_CAP) { atomicAdd(&bar[XB_TMO], 1u); break; } }
    }
    nloc = mine > 0u ? mine : 1u; nx = cnt > 0u ? cnt : 1u;
}
__device__ __forceinline__ void xcd_barrier(const XcdBarrier& b) {
    asm volatile("s_waitcnt vmcnt(0)" ::: "memory");
    __syncthreads();
    if (threadIdx.x == 0) {
        unsigned* bar = b.bar;
        __builtin_amdgcn_s_waitcnt(0);
        unsigned nloc = b.st[0], nx = b.st[1];
        if (nloc == 0u) { xcd_barrier_complete(bar, b.x, nloc, nx); b.st[0] = nloc; b.st[1] = nx; }
        const unsigned old = xb_add(&bar[XB_XSUB(b.x)], 1u);
        const unsigned gen = old / nloc;
        if (old + 1u == (gen + 1u) * nloc) {
            __builtin_amdgcn_fence(__ATOMIC_RELEASE, "agent");
            asm volatile("s_waitcnt vmcnt(0)" ::: "memory");
            const unsigned og = xb_add(&bar[XB_TOP], 1u);
            const unsigned tg = og / nx;
            if (og + 1u == (tg + 1u) * nx) xb_add(&bar[XB_TOPGEN], 1u);
            else XB_SPIN(xb_ld(&bar[XB_TOPGEN]) == tg, bar);
            __builtin_amdgcn_fence(__ATOMIC_ACQUIRE, "agent");
            xb_add(&bar[XB_XGEN(b.x)], 1u);
            asm volatile("s_waitcnt vmcnt(0)" ::: "memory");
        } else {
            XB_SPIN(xb_ld(&bar[XB_XGEN(b.x)]) == gen, bar);
            __builtin_amdgcn_fence(__ATOMIC_ACQUIRE, "agent");
            asm volatile("s_waitcnt vmcnt(0)" ::: "memory");
        }
    }
    __syncthreads();
}

namespace pg8 {
constexpr int BM = 256, BK = 64, HALF = 128, HTB = HALF * BK * 2, STAGE_BYTES = 8 * HTB, NXCD = 8, WGM = 8;
__device__ __forceinline__ int lds_byte(int r, int c) { const int st = (r >> 4) * 2 + (c >> 5), rr = r & 15, cc = c & 31, ob = rr * 64 + cc * 2; return st * 1024 + (ob ^ (((ob >> 9) & 1) << 5)); }
__device__ __forceinline__ void stage_rc(int b, int& R, int& C) { const int st = b / 1024, sb = b % 1024, swz = sb ^ (((sb >> 9) & 1) << 5); R = (st >> 1) * 16 + swz / 64; C = (st & 1) * 32 + (swz % 64) / 2; }
__device__ __forceinline__ int perm32(int rho) { const int n = rho >> 4, i = rho & 15; return 8 * (i >> 2) + 4 * n + (i & 3); }

struct Unit {
    int pm, pn, po;
    const char* A;
    const char* B;
    const char* B2;
    const int* rows;
    int nvalid, aux;
};

template <class Epi, class Sched>
__device__ __forceinline__ void gemm_phase(LAS unsigned char* lds, int K, int lda, int ldb, int ksplit, const Sched& S, const Epi& E) {
    asm volatile("" : "+s"(K), "+s"(lda), "+s"(ldb), "+s"(ksplit));
    const int tid = threadIdx.x, wid = __builtin_amdgcn_readfirstlane(tid >> 6), lane = tid & 63, wr = wid >> 2, wc = wid & 3, fr = lane & 15, fq = lane >> 4;
    const int nt = K / BK;
    int sR[2], sC[2];
    unsigned voffB[2];
#pragma unroll
    for (int i = 0; i < 2; ++i) { int R, C; stage_rc(tid * 16 + i * 8192, R, C); sR[i] = R; sC[i] = C; const int Rb = (R & ~31) + perm32(R & 31); voffB[i] = (unsigned)(Rb * ldb + C) * 2u; }
    const size_t kstep = (size_t)(BK * 2);
    const size_t hstepB = (size_t)HALF * ldb * 2;
    const unsigned ldsw = (unsigned)wid * 1024u;
    const int aoff = lds_byte(wr * 64 + fr, fq * 8), boff = lds_byte(wc * 32 + fr, fq * 8);
#define PG8_SA(b, h) (((b) * 2 + (h)) * HTB)
#define PG8_SB(b, h) ((4 + (b) * 2 + (h)) * HTB)
#define PG8_STAGE(bufoff, gbase, voff) do { _Pragma("unroll") for (int _i = 0; _i < 2; ++_i) \
        __builtin_amdgcn_global_load_lds((const unsigned*)((const char*)(gbase) + (voff)[_i]), (LAS unsigned*)(lds + (bufoff) + ldsw + _i * 8192), 16, 0, 0); } while (0)
#define PG8_LDA(dst, b, h) do { _Pragma("unroll") for (int m = 0; m < 4; ++m) _Pragma("unroll") for (int k = 0; k < 2; ++k) dst[m][k] = *(const LAS bf16x8*)(lds + PG8_SA(b, h) + aoff + m * 2048 + k * 1024); } while (0)
#define PG8_LDB(dst, b, h) do { _Pragma("unroll") for (int n = 0; n < 2; ++n) _Pragma("unroll") for (int k = 0; k < 2; ++k) dst[n][k] = *(const LAS bf16x8*)(lds + PG8_SB(b, h) + boff + n * 2048 + k * 1024); } while (0)
#define PG8_MMA(ai, bj, At, Bt) do { __builtin_amdgcn_s_setprio(1); _Pragma("unroll") for (int m = 0; m < 4; ++m) _Pragma("unroll") for (int n = 0; n < 2; ++n) _Pragma("unroll") for (int k = 0; k < 2; ++k) \
        acc[ai][bj][m][n] = __builtin_amdgcn_mfma_f32_16x16x32_bf16(Bt[n][k], At[m][k], acc[ai][bj][m][n], 0, 0, 0); __builtin_amdgcn_s_setprio(0); } while (0)
#define PG8_WAIT_V(n) asm volatile("s_waitcnt vmcnt(" #n ")" ::: "memory")
#define PG8_WAIT_L(n) asm volatile("s_waitcnt lgkmcnt(" #n ")" ::: "memory")
#define PG8_BAR __builtin_amdgcn_s_barrier()
#define PG8_SCHED __builtin_amdgcn_sched_barrier(0)
#define PG8_BK(u, t) (((t) < ksplit ? (u).B : (u).B2) + (size_t)(t) * kstep)
#define PG8_VOFF(dst, u) do { _Pragma("unroll") for (int _h = 0; _h < 2; ++_h) _Pragma("unroll") for (int _i = 0; _i < 2; ++_i) { int _r = sR[_i] + HALF * _h; \
        if constexpr (Sched::GATHER) { const int _rr = _r < (u).nvalid ? _r : 0; _r = (u).rows[_rr]; } dst[_h][_i] = (unsigned)(_r * lda + sC[_i]) * 2u; } } while (0)
    Unit cur, nxt; int ui = 0;
    if (!S.next(0, cur)) return;
    f32x4 acc[2][2][4][2];
#pragma unroll
    for (int a = 0; a < 2; ++a)
#pragma unroll
        for (int b = 0; b < 2; ++b)
#pragma unroll
            for (int m = 0; m < 4; ++m)
#pragma unroll
                for (int n = 0; n < 2; ++n) acc[a][b][m][n] = (f32x4){0.f, 0.f, 0.f, 0.f};
    bf16x8 At[4][2], B0[2][2], B1[2][2];
    LAS unsigned* VO = (LAS unsigned*)(lds + STAGE_BYTES) + tid;
#define PG8_VO(slot, h, i) VO[(((slot) & 1) * 4 + (h) * 2 + (i)) * 512]
    unsigned vfix[2][2];
    {
        unsigned vc[2][2];
        PG8_VOFF(vc, cur);
#pragma unroll
        for (int h = 0; h < 2; ++h)
#pragma unroll
            for (int i = 0; i < 2; ++i) { vfix[h][i] = vc[h][i]; if constexpr (Sched::GATHER) PG8_VO(0, h, i) = vc[h][i]; }
        const char* cA0 = cur.A;
        const char* b0 = PG8_BK(cur, 0); const char* b1 = PG8_BK(cur, 1);
        PG8_STAGE(PG8_SB(0, 0), b0, voffB); PG8_STAGE(PG8_SB(0, 1), b0 + hstepB, voffB); PG8_STAGE(PG8_SA(0, 0), cA0, vc[0]); PG8_STAGE(PG8_SA(0, 1), cA0, vc[1]);
        if (wr == 1) PG8_BAR;
        PG8_WAIT_V(2); PG8_BAR;
        PG8_STAGE(PG8_SB(1, 0), b1, voffB); PG8_STAGE(PG8_SA(1, 0), cA0 + kstep, vc[0]); PG8_STAGE(PG8_SB(1, 1), b1 + hstepB, voffB);
        PG8_WAIT_V(6); PG8_BAR;
    }
    const char* cA = cur.A;
    for (;;) {
        const bool has_next = S.next(ui + 1, nxt);
        if (!has_next) nxt = cur;
        if constexpr (Sched::GATHER) { unsigned vn[2][2]; PG8_VOFF(vn, nxt);
#pragma unroll
            for (int h = 0; h < 2; ++h)
#pragma unroll
                for (int i = 0; i < 2; ++i) PG8_VO(ui + 1, h, i) = vn[h][i]; }
        const char* nA = nxt.A;
#pragma nounroll
        for (int t = 0; t < nt; t += 2) {
            const bool last = (t == nt - 2);
            const char* a1 = cA + (size_t)(t + 1) * kstep;
            const char* a2 = last ? nA : cA + (size_t)(t + 2) * kstep;
            const char* a3 = a2 + kstep;
            const char* b2 = last ? PG8_BK(nxt, 0) : PG8_BK(cur, t + 2);
            const char* b3 = last ? PG8_BK(nxt, 1) : PG8_BK(cur, t + 3);
            unsigned v1[2], v2[2][2];
            if constexpr (Sched::GATHER) { const int s2 = last ? ui + 1 : ui;
                v1[0] = PG8_VO(ui, 1, 0); v1[1] = PG8_VO(ui, 1, 1);
#pragma unroll
                for (int h = 0; h < 2; ++h)
#pragma unroll
                    for (int i = 0; i < 2; ++i) v2[h][i] = PG8_VO(s2, h, i);
            } else { v1[0] = vfix[1][0]; v1[1] = vfix[1][1];
#pragma unroll
                for (int h = 0; h < 2; ++h)
#pragma unroll
                    for (int i = 0; i < 2; ++i) v2[h][i] = vfix[h][i]; }
            PG8_LDB(B0, 0, 0); PG8_LDB(B1, 0, 1); PG8_SCHED; PG8_LDA(At, 0, 0); PG8_STAGE(PG8_SA(1, 1), a1, v1);
            PG8_WAIT_V(8); PG8_WAIT_L(0); PG8_BAR; PG8_MMA(0, 0, At, B0); PG8_MMA(0, 1, At, B1); PG8_BAR; PG8_SCHED;
            PG8_LDA(At, 0, 1); PG8_STAGE(PG8_SB(0, 0), b2, voffB); PG8_STAGE(PG8_SB(0, 1), b2 + hstepB, voffB); PG8_STAGE(PG8_SA(0, 0), a2, v2[0]);
            PG8_WAIT_V(8); PG8_WAIT_L(0); PG8_BAR; PG8_MMA(1, 0, At, B0); PG8_MMA(1, 1, At, B1); PG8_BAR; PG8_SCHED;
            PG8_LDB(B0, 1, 0); PG8_LDB(B1, 1, 1); PG8_SCHED; PG8_LDA(At, 1, 0); PG8_STAGE(PG8_SA(0, 1), a2, v2[1]);
            PG8_WAIT_V(8); PG8_WAIT_L(0); PG8_BAR; PG8_MMA(0, 0, At, B0); PG8_MMA(0, 1, At, B1); PG8_BAR; PG8_SCHED;
            PG8_LDA(At, 1, 1); PG8_STAGE(PG8_SB(1, 0), b3, voffB); PG8_STAGE(PG8_SB(1, 1), b3 + hstepB, voffB); PG8_STAGE(PG8_SA(1, 0), a3, v2[0]);
            PG8_WAIT_V(8); PG8_WAIT_L(0); PG8_BAR; PG8_MMA(1, 0, At, B0); PG8_MMA(1, 1, At, B1); PG8_BAR; PG8_SCHED;
        }
        if (wr == 0) PG8_BAR;
        E(acc, cur, wr, wc, fr, fq);
        if (!has_next) break;
#pragma unroll
        for (int a = 0; a < 2; ++a)
#pragma unroll
            for (int b = 0; b < 2; ++b)
#pragma unroll
                for (int m = 0; m < 4; ++m)
#pragma unroll
                    for (int n = 0; n < 2; ++n) acc[a][b][m][n] = (f32x4){0.f, 0.f, 0.f, 0.f};
        cur = nxt; cA = nA; ++ui;
        if (wr == 1) PG8_BAR;
    }
    PG8_WAIT_V(0);
    PG8_BAR;
#undef PG8_SA
#undef PG8_SB
#undef PG8_STAGE
#undef PG8_LDA
#undef PG8_LDB
#undef PG8_MMA
#undef PG8_WAIT_V
#undef PG8_WAIT_L
#undef PG8_BAR
#undef PG8_SCHED
#undef PG8_BK
#undef PG8_VOFF
#undef PG8_VO
}

struct PlainSched {
    static constexpr bool GATHER = false;
    int nM, nN, nwg, G, c; const char* A; const char* Bt; int lda, ldb, K; int rowmap;
    __device__ __forceinline__ void init(const void* A_, const void* Bt_, int M, int N, int K_, int lda_, int ldb_, int G_, int c_, int rowmap_) {
        A = (const char*)A_; Bt = (const char*)Bt_; nM = M / BM; nN = N / BM; nwg = nM * nN; G = G_; c = c_; lda = lda_; ldb = ldb_; K = K_; rowmap = rowmap_; }
    __device__ __forceinline__ bool next(int i, Unit& u) const {
        const int L = i * G + c; if (L >= nwg) return false;
        int wgid = L; { const int q = nwg / NXCD, r = nwg % NXCD, xcd = wgid % NXCD, off = wgid / NXCD; wgid = (xcd < r ? xcd * (q + 1) : r * (q + 1) + (xcd - r) * q) + off; }
        const int nig = WGM * nN, gid = wgid / nig, fm = gid * WGM, gsz = (nM - fm) < WGM ? (nM - fm) : WGM;
        const int pm = fm + ((wgid % nig) % gsz), pn = (wgid % nig) / gsz;
        u.po = pm; u.pn = pn; u.pm = rowmap ? (pm / 16) * 17 + 1 + (pm % 16) : pm;
        u.A = A + (size_t)u.pm * BM * lda * 2; u.B = Bt + (size_t)pn * BM * ldb * 2; u.B2 = u.B; u.rows = nullptr; u.nvalid = BM; u.aux = 0;
        return true;
    }
};

struct EpiStoreBf16 {
    bf16_t* O; int ldc;
    __device__ __forceinline__ void operator()(const f32x4 (&acc)[2][2][4][2], const Unit& u, int wr, int wc, int fr, int fq) const {
        bf16_t* base = O + (size_t)(u.po * BM + wr * 64 + fr) * ldc + u.pn * BM + wc * 32 + 8 * fq;
#pragma unroll
        for (int ai = 0; ai < 2; ++ai)
#pragma unroll
            for (int m = 0; m < 4; ++m) { bf16_t* rowp = base + (size_t)(ai * HALF + m * 16) * ldc;
#pragma unroll
                for (int bj = 0; bj < 2; ++bj) { const f32x4 v0 = acc[ai][bj][m][0], v1 = acc[ai][bj][m][1];
                    u32x4 w; w.x = cvt_pk_bf16(v0[0], v0[1]); w.y = cvt_pk_bf16(v0[2], v0[3]); w.z = cvt_pk_bf16(v1[0], v1[1]); w.w = cvt_pk_bf16(v1[2], v1[3]);
                    *(u32x4*)(rowp + bj * HALF) = w; } }
    }
};
struct EpiResid {
    const float* x; const float* ctx; float* out; float* xc; const float* modl; int mode;
    __device__ __forceinline__ void operator()(const f32x4 (&acc)[2][2][4][2], const Unit& u, int wr, int wc, int fr, int fq) const {
        const float* src; float* dst; int mrow;
        if (mode == 0) { const int b = u.po / 17, jt = u.po % 17;
            if (jt == 0) { src = ctx + (size_t)b * CTXL * D; dst = xc + (size_t)b * CTXL * D; mrow = 8; }
            else { src = x + ((size_t)b * SEQ + (jt - 1) * 256) * D; dst = out + ((size_t)b * SEQ + (jt - 1) * 256) * D; mrow = b; } }
        else { src = out + (size_t)u.po * BM * D; dst = out + (size_t)u.po * BM * D; mrow = u.po / 16; }
        const float* gate = modl + (size_t)mrow * (NMOD * D) + 2 * D;
        const int col0 = u.pn * BM + wc * 32 + 8 * fq;
        f32x4 gv[2][2];
#pragma unroll
        for (int bj = 0; bj < 2; ++bj)
#pragma unroll
            for (int n = 0; n < 2; ++n) gv[bj][n] = *(const f32x4*)(gate + col0 + bj * HALF + 4 * n);
#pragma unroll
        for (int ai = 0; ai < 2; ++ai)
#pragma unroll
        for (int mp = 0; mp < 2; ++mp) {
            f32x4 sv[2][2][2];
#pragma unroll
            for (int mm = 0; mm < 2; ++mm) { const size_t ro = (size_t)(ai * HALF + wr * 64 + (mp * 2 + mm) * 16 + fr) * D + col0;
#pragma unroll
                for (int bj = 0; bj < 2; ++bj)
#pragma unroll
                    for (int n = 0; n < 2; ++n) sv[mm][bj][n] = *(const f32x4*)(src + ro + bj * HALF + 4 * n); }
            __builtin_amdgcn_sched_barrier(0);
#pragma unroll
            for (int mm = 0; mm < 2; ++mm) { const int m = mp * 2 + mm; const size_t ro = (size_t)(ai * HALF + wr * 64 + m * 16 + fr) * D + col0;
#pragma unroll
                for (int bj = 0; bj < 2; ++bj)
#pragma unroll
                    for (int n = 0; n < 2; ++n) *(f32x4*)(dst + ro + bj * HALF + 4 * n) = sv[mm][bj][n] + gv[bj][n] * acc[ai][bj][m][n]; }
            __builtin_amdgcn_sched_barrier(0);
        }
    }
};
}

struct Args { const float* in[30]; float* out; unsigned char* ws; int ph_lo, ph_hi; };
struct Frame {
    LAS unsigned char* lds;
    int tid, lane, wave, G, bid;
    float* out; unsigned char* ws;
    unsigned* ctl;
};
#define WSP(T, off) ((T*)(F.ws + (off)))

__device__ __forceinline__ float* xl_row(const Frame& F, int ta) {
    const int b = ta / TPB, j = ta - b * TPB;
    return j < CTXL ? WSP(float, WS_XC) + (size_t)(b * CTXL + j) * D : F.out + ((size_t)b * SEQ + (j - CTXL)) * D;
}

struct TrItem { const float* src; bf16_t* dst; int N, ldo; };
__device__ __forceinline__ void tr_load(const TrItem& t, f32x4 (&v)[8], int lane) {
#pragma unroll
    for (int i = 0; i < 8; ++i) { const int kk = 8 * i + (lane >> 3); v[i] = *(const f32x4*)(t.src + (size_t)kk * t.N + 4 * (lane & 7)); }
}
__device__ __forceinline__ void tr_finish(const TrItem& t, const f32x4 (&v)[8], LAS float* scr, int lane) {
#pragma unroll
    for (int i = 0; i < 8; ++i) { const int kk = 8 * i + (lane >> 3); LAS float* p = scr + kk * 33 + 4 * (lane & 7); p[0] = v[i].x; p[1] = v[i].y; p[2] = v[i].z; p[3] = v[i].w; }
    LDS_WAIT(); asm volatile("" ::: "memory");
    const int c = lane & 7;
#pragma unroll
    for (int j = 0; j < 4; ++j) { const int n = (lane >> 3) + 8 * j; const LAS float* s = scr + (8 * c) * 33 + n;
        u32x4 o; o.x = cvt_pk_bf16(s[0 * 33], s[1 * 33]); o.y = cvt_pk_bf16(s[2 * 33], s[3 * 33]); o.z = cvt_pk_bf16(s[4 * 33], s[5 * 33]); o.w = cvt_pk_bf16(s[6 * 33], s[7 * 33]);
        *(u32x4*)(t.dst + (size_t)n * t.ldo + 8 * c) = o; }
    LDS_WAIT(); asm volatile("" ::: "memory");
}
__device__ __forceinline__ TrItem tr_generic(const float* W, int K, int N, bf16_t* WT, int item) {
    const int nblk = N / 32, kb = item / nblk, nb = item % nblk;
    return TrItem{W + (size_t)(64 * kb) * N + 32 * nb, WT + (size_t)(32 * nb) * K + 64 * kb, N, K};
}

__device__ __forceinline__ void p0_prologue(Frame& F, const Args& A, unsigned long long& pt1) {
    const int tid = F.tid, lane = F.lane, wave = F.wave;
    constexpr int NMODU = 48;
    if (F.bid < NMODU) {
        LAS float* SC = (LAS float*)F.lds;
        LAS float* RED = (LAS float*)(F.lds + 36864);
        for (int i = tid; i < 9 * 1024; i += 512) { const int r = i >> 10, k = i & 1023; const float v = r < 8 ? A.in[1][r * 1024 + k] : A.in[3][k]; SC[i] = siluf_(v); }
        __syncthreads();
        float* MOD = WSP(float, WS_MOD);
        for (int u = F.bid; u < NMODU; u += F.G) {
            const int l = u / 24, cb = u % 24;
            const float* W = A.in[4] + (size_t)l * D * (NMOD * D) + cb * 256 + 4 * lane;
            f32x4 a[9];
#pragma unroll
            for (int r = 0; r < 9; ++r) a[r] = (f32x4){0.f, 0.f, 0.f, 0.f};
#pragma unroll 1
            for (int kk0 = 0; kk0 < 128; kk0 += 16) { const int k0 = 128 * wave + kk0;
                f32x4 w[16];
#pragma unroll
                for (int i = 0; i < 16; ++i) w[i] = *(const f32x4*)(W + (size_t)(k0 + i) * (NMOD * D));
                __builtin_amdgcn_sched_barrier(0);
#pragma unroll
                for (int i = 0; i < 16; ++i)
#pragma unroll
                    for (int r = 0; r < 9; ++r) a[r] += w[i] * SC[r * 1024 + k0 + i]; }
#pragma unroll
            for (int r = 0; r < 9; ++r) *(LAS f32x4*)(RED + (wave * 9 + r) * 256 + 4 * lane) = a[r];
            __syncthreads();
            for (int o = tid; o < 9 * 256; o += 512) { const int r = o >> 8, cc = o & 255; float s = 0.f;
#pragma unroll
                for (int w = 0; w < 8; ++w) s += RED[(w * 9 + r) * 256 + cc];
                MOD[((size_t)l * 9 + r) * (NMOD * D) + cb * 256 + cc] = s + A.in[5][l * (NMOD * D) + cb * 256 + cc]; }
            __syncthreads();
        }
    }
    if (PT_SUB == 1) pt1 = __builtin_amdgcn_s_memrealtime();
    {
        const float invf[16] = {1.000000000e+00f, 5.623413324e-01f, 3.162277639e-01f, 1.778279394e-01f, 1.000000015e-01f, 5.623413250e-02f, 3.162277490e-02f, 1.778279431e-02f,
                                9.999999776e-03f, 5.623413250e-03f, 3.162277630e-03f, 1.778279431e-03f, 1.000000047e-03f, 5.623413017e-04f, 3.162277571e-04f, 1.778279402e-04f};
        float* COS = WSP(float, WS_COS); float* SIN = WSP(float, WS_SIN);
        for (int i = F.bid * 512 + tid; i < SEQ * 32; i += F.G * 512) {
            const int pos = i >> 5, j = i & 31, f = j & 15; const float p = (float)(j < 16 ? (pos >> 6) : (pos & 63));
            float fr = 1.f;
#pragma unroll
            for (int q = 0; q < 16; ++q) fr = (f == q) ? invf[q] : fr;
            const float angf = p * fr; const double x = (double)angf;
            const double n = __builtin_rint(x * 0.63661977236758134308);
            const double y = (x - n * 1.57079632679489655800e+00) - n * 6.12323399573676603587e-17;
            const double y2 = y * y;
            double sn = y * (1.0 + y2 * (-1.0 / 6 + y2 * (1.0 / 120 + y2 * (-1.0 / 5040 + y2 * (1.0 / 362880 + y2 * (-1.0 / 39916800 + y2 * (1.0 / 6227020800.0)))))));
            double cs = 1.0 + y2 * (-0.5 + y2 * (1.0 / 24 + y2 * (-1.0 / 720 + y2 * (1.0 / 40320 + y2 * (-1.0 / 3628800 + y2 * (1.0 / 479001600.0 + y2 * (-1.0 / 87178291200.0)))))));
            const int q4 = ((int)n) & 3;
            const double c = (q4 == 0) ? cs : (q4 == 1) ? -sn : (q4 == 2) ? -cs : sn;
            const double s = (q4 == 0) ? sn : (q4 == 1) ? cs : (q4 == 2) ? -sn : -cs;
            COS[i] = (float)c; SIN[i] = (float)s;
        }
    }
    if (PT_SUB == 2) pt1 = __builtin_amdgcn_s_memrealtime();
    {
        LAS float* scr = (LAS float*)(F.lds + wave * 16384);
        constexpr int I_IN0 = 16 * 48, I_OUT = 16 * 32, I_IN1 = 16 * 62, I_UQ = 4 * 24, I_UKV = 2 * 32, I_POOL = 4 * 8, I_MOE = 64 * 384;
        constexpr int NIT = I_IN0 + I_OUT + I_IN1 + I_UQ + I_UKV + I_OUT + I_POOL + I_MOE;
        int it0, it1, step;
        if (F.G == 256) {
            const int wv = F.bid * 8 + wave;
            it0 = F.bid < NMODU ? wv * 12 : NMODU * 8 * 12 + (wv - NMODU * 8) * 14; it1 = it0 + (F.bid < NMODU ? 12 : 14); if (it1 > NIT) it1 = NIT; step = 1;
            static_assert(NMODU * 8 * 12 + (256 - NMODU) * 8 * 14 >= NIT, "prologue item split");
        } else { it0 = F.bid * 8 + wave; it1 = NIT; step = F.G * 8; }
        unsigned char* ws_ = F.ws;
        auto item_of = [&](int it) -> TrItem {
            int r = it;
            if (r < I_IN0) return tr_generic(A.in[7], D, 1536, (bf16_t*)(ws_ + WS_WIN0), r); r -= I_IN0;
            if (r < I_OUT) return tr_generic(A.in[14], D, D, (bf16_t*)(ws_ + WS_WOUT0), r); r -= I_OUT;
            if (r < I_IN1) return tr_generic(A.in[15], D, 1984, (bf16_t*)(ws_ + WS_WIN1), r); r -= I_IN1;
            if (r < I_UQ) return tr_generic(A.in[17], 256, 768, (bf16_t*)(ws_ + WS_WUQ), r); r -= I_UQ;
            if (r < I_UKV) return tr_generic(A.in[19], 128, 1024, (bf16_t*)(ws_ + WS_WUKV), r); r -= I_UKV;
            if (r < I_OUT) return tr_generic(A.in[24], D, D, (bf16_t*)(ws_ + WS_WOUT1), r); r -= I_OUT;
            if (r < I_POOL) { const int g = r / 8; return tr_generic(A.in[12] + (size_t)g * 128 * 128, 128, 128, (bf16_t*)(ws_ + WS_WPOOL) + (size_t)g * 128 * 128, r % 8); } r -= I_POOL;
            const int le = r / 384, q = r % 384;
            bf16_t* W1 = (bf16_t*)(ws_ + WS_WM1) + (size_t)le * 512 * 1024; bf16_t* W2 = (bf16_t*)(ws_ + WS_WM2) + (size_t)le * 1024 * 256;
            if (q < 256) {
                const int up = q >> 7, item = q & 127, kb = item / 8, nb = item % 8, n0 = 32 * nb;
                const float* W = A.in[up ? 28 : 27] + (size_t)le * 1024 * 256;
                const int drow = (n0 >> 7) * 256 + up * 128 + (n0 & 127);
                return TrItem{W + (size_t)(64 * kb) * 256 + n0, W1 + (size_t)drow * 1024 + 64 * kb, 256, 1024};
            }
            return tr_generic(A.in[29] + (size_t)le * 256 * 1024, 256, 1024, W2, q - 256);
        };
        for (int it = it0; it < it1; it += 4 * step) {
            TrItem t0 = item_of(it), t1 = item_of(it + step < it1 ? it + step : it), t2 = item_of(it + 2 * step < it1 ? it + 2 * step : it), t3 = item_of(it + 3 * step < it1 ? it + 3 * step : it);
            f32x4 v0[8], v1[8], v2[8], v3[8];
            tr_load(t0, v0, lane); tr_load(t1, v1, lane); tr_load(t2, v2, lane); tr_load(t3, v3, lane);
            __builtin_amdgcn_sched_barrier(0);
            tr_finish(t0, v0, scr, lane);
            if (it + step < it1) tr_finish(t1, v1, scr, lane);
            if (it + 2 * step < it1) tr_finish(t2, v2, scr, lane);
            if (it + 3 * step < it1) tr_finish(t3, v3, scr, lane);
        }
        { u32x4* z = (u32x4*)(WSP(bf16_t, WS_WIN1) + (size_t)1984 * 1024); const u32x4 zero = {0u, 0u, 0u, 0u};
          for (int i = F.bid * 512 + tid; i < 64 * 1024 / 8; i += F.G * 512) z[i] = zero; }
    }
}

__device__ __forceinline__ void norm_mod_phase(Frame& F, const Args& A, int layer) {
    const int gw = F.bid * 8 + F.wave, NGW = F.G * 8, lane = F.lane;
    const float* g = A.in[6] + (size_t)(layer * 2 + 0) * D;
    const float* MODL = WSP(float, WS_MOD) + (size_t)layer * 9 * (NMOD * D);
    bf16_t* H = WSP(bf16_t, WS_H);
    for (int ta0 = gw; ta0 < NTOK; ta0 += 2 * NGW) {
        const int ta1 = ta0 + NGW; const bool has1 = ta1 < NTOK;
        f32x4 v[2][4];
#pragma unroll
        for (int e = 0; e < 2; ++e) { const int ta = e ? (has1 ? ta1 : ta0) : ta0; const int b = ta / TPB, j = ta - b * TPB;
            const float* src = layer == 0 ? (j < CTXL ? A.in[2] + (size_t)(b * CTXL + j) * D : A.in[0] + ((size_t)b * SEQ + (j - CTXL)) * D) : xl_row(F, ta);
            const f32x4* xr = (const f32x4*)src + lane;
#pragma unroll
            for (int q = 0; q < 4; ++q) v[e][q] = xr[64 * q]; }
        __builtin_amdgcn_sched_barrier(0);
#pragma unroll
        for (int e = 0; e < 2; ++e) { const int ta = e ? ta1 : ta0; if (e && !has1) break; const int b = ta / TPB, j = ta - b * TPB, mrow = j < CTXL ? 8 : b;
            float s = 0.f;
#pragma unroll
            for (int q = 0; q < 4; ++q) s += (v[e][q].x * v[e][q].x + v[e][q].y * v[e][q].y) + (v[e][q].z * v[e][q].z + v[e][q].w * v[e][q].w);
            const float r = 1.f / sqrtf(wave_sum(s) * (1.f / D) + EPS);
            const float* sh = MODL + (size_t)mrow * (NMOD * D); const float* sc = sh + D;
            u32x2* o8 = (u32x2*)(H + (size_t)ta * D) + lane;
#pragma unroll
            for (int q = 0; q < 4; ++q) { const int col = 4 * lane + 256 * q;
                const f32x4 g4 = *(const f32x4*)(g + col), s4 = *(const f32x4*)(sc + col), h4 = *(const f32x4*)(sh + col);
                const f32x4 y = (v[e][q] * r) * g4 * (s4 + 1.f) + h4;
                u32x2 w; w.x = cvt_pk_bf16(y.x, y.y); w.y = cvt_pk_bf16(y.z, y.w); o8[64 * q] = w; } }
    }
}

__device__ __forceinline__ void convpool_phase(Frame& F, const Args& A) {
    const int tid = F.tid, lane = F.lane, wave = F.wave, r32 = lane & 31, hi = lane >> 5;
    const bf16_t* __restrict__ U = WSP(bf16_t, WS_BIG); bf16_t* __restrict__ Y = WSP(bf16_t, WS_YMIX); const bf16_t* __restrict__ WP = WSP(bf16_t, WS_WPOOL);
    {
        LAS bf16_t* GL = (LAS bf16_t*)F.lds;
        LAS float* CV = (LAS float*)(F.lds + 63488);
        const int c0 = wave * 64 + lane;
        float w0[31];
#pragma unroll
        for (int k = 0; k < 31; ++k) w0[k] = A.in[8][k * 512 + c0];
        const float dwb = A.in[9][c0];
        for (int u = F.bid; u < 1280; u += F.G) {
            int b, n, tb, t0, TS;
            if (u < 1024) { b = u >> 7; n = SEQ; tb = b * TPB + CTXL; t0 = (u & 127) * 32; TS = 32; } else { const int uu = u - 1024; b = uu >> 5; n = CTXL; tb = b * TPB; t0 = (uu & 31) * 8; TS = 8; }
            __syncthreads();
            const int nG = (TS + 30) * 64;
#pragma unroll 1
            for (int base = 0; base < nG; base += 512 * 4) {
                u32x4 av[4], gv[4]; bool ok[4];
#pragma unroll
                for (int q = 0; q < 4; ++q) { const int ch = base + q * 512 + tid, ri = ch >> 6, c8 = (ch & 63) * 8, pos = t0 + ri - 15; ok[q] = (ch < nG) && pos >= 0 && pos < n;
                    const bf16_t* up = U + (size_t)(tb + (ok[q] ? pos : t0)) * UW + c8; av[q] = *(const u32x4*)up; gv[q] = *(const u32x4*)(up + 512); }
                __builtin_amdgcn_sched_barrier(0);
#pragma unroll
                for (int q = 0; q < 4; ++q) { const int ch = base + q * 512 + tid, ri = ch >> 6, c8 = (ch & 63) * 8;
                    u32x4 o;
#pragma unroll
                    for (int e = 0; e < 4; ++e) { const float a0 = bflo(av[q][e]), a1 = bfhi(av[q][e]), g0 = bflo(gv[q][e]), g1 = bfhi(gv[q][e]);
                        o[e] = cvt_pk_bf16(a0 * __builtin_amdgcn_rcpf(1.f + __expf(-g0)), a1 * __builtin_amdgcn_rcpf(1.f + __expf(-g1))); }
                    if (!ok[q]) o = (u32x4){0u, 0u, 0u, 0u};
                    if (ch < nG) *(LAS u32x4*)(GL + ri * 512 + c8) = o; }
            }
            __syncthreads();
#pragma unroll 1
            for (int i0 = 0; i0 < TS; i0 += 4) {
                float x0[4];
#pragma unroll
                for (int q = 0; q < 4; ++q) x0[q] = dwb;
#pragma unroll
                for (int r = 0; r < 34; ++r) { const float g0 = bf2f(*(const LAS unsigned short*)(GL + (i0 + r) * 512 + c0));
#pragma unroll
                    for (int q = 0; q < 4; ++q) { const int k = r - q; if (k >= 0 && k < 31) x0[q] += g0 * w0[k]; } }
#pragma unroll
                for (int q = 0; q < 4; ++q) CV[(i0 + q) * 512 + c0] = x0[q];
            }
            __syncthreads();
            for (int tk = wave; tk < TS; tk += 8) {
                const f32x4 v0 = *(const LAS f32x4*)(CV + tk * 512 + 8 * lane), v1 = *(const LAS f32x4*)(CV + tk * 512 + 8 * lane + 4);
                const float sm = wave_sum((v0.x + v0.y) + (v0.z + v0.w) + (v1.x + v1.y) + (v1.z + v1.w));
                const float mean = sm * (1.f / 512.f);
                const f32x4 d0 = v0 - mean, d1 = v1 - mean;
                const float s2 = wave_sum((d0.x * d0.x + d0.y * d0.y) + (d0.z * d0.z + d0.w * d0.w) + (d1.x * d1.x + d1.y * d1.y) + (d1.z * d1.z + d1.w * d1.w));
                const float rstd = 1.f / sqrtf(s2 * (1.f / 512.f) + EPS);
                const f32x4 g0 = *(const f32x4*)(A.in[10] + 8 * lane), g1 = *(const f32x4*)(A.in[10] + 8 * lane + 4), b0 = *(const f32x4*)(A.in[11] + 8 * lane), b1 = *(const f32x4*)(A.in[11] + 8 * lane + 4);
                const f32x4 y0 = d0 * rstd * g0 + b0, y1 = d1 * rstd * g1 + b1;
                u32x4 o; o.x = cvt_pk_bf16(siluf_(y0.x), siluf_(y0.y)); o.y = cvt_pk_bf16(siluf_(y0.z), siluf_(y0.w)); o.z = cvt_pk_bf16(siluf_(y1.x), siluf_(y1.y)); o.w = cvt_pk_bf16(siluf_(y1.z), siluf_(y1.w));
                *(u32x4*)(Y + (size_t)(tb + t0 + tk) * D + 8 * lane) = o;
            }
        }
    }
    {
        LAS bf16_t* UP = (LAS bf16_t*)F.lds;
        LAS bf16_t* PL = (LAS bf16_t*)(F.lds + 49152);
        for (int u = F.bid; u < 1280; u += F.G) {
            int b, n, tb, t0, TS;
            if (u < 1024) { b = u >> 7; n = SEQ; tb = b * TPB + CTXL; t0 = (u & 127) * 32; TS = 32; } else { const int uu = u - 1024; b = uu >> 5; n = CTXL; tb = b * TPB; t0 = (uu & 31) * 8; TS = 8; }
            __syncthreads();
            const int nU = (TS + 16) * 64;
#pragma unroll 1
            for (int base = 0; base < nU; base += 512 * 6) {
                u32x4 uv[6];
#pragma unroll
                for (int q = 0; q < 6; ++q) { const int ch = base + q * 512 + tid, ri = ch >> 6, c8 = (ch & 63) * 8, pos = t0 + ri - 8; const bool ok = (ch < nU) && pos >= 0 && pos < n;
                    uv[q] = *(const u32x4*)(U + (size_t)(tb + (ok ? pos : t0)) * UW + 1024 + c8); if (!ok) uv[q] = (u32x4){0u, 0u, 0u, 0u}; }
                __builtin_amdgcn_sched_barrier(0);
#pragma unroll
                for (int q = 0; q < 6; ++q) { const int ch = base + q * 512 + tid, ri = ch >> 6, c8 = (ch & 63) * 8; if (ch < nU) *(LAS u32x4*)(UP + ri * 512 + c8) = uv[q]; }
            }
            __syncthreads();
#pragma unroll 1
            for (int e = tid; e < 32 * 64; e += 512) { const int i = e >> 6, c8 = (e & 63) * 8, gi = c8 >> 7, hw = 1 << gi, pos = t0 + i;
                u32x4 o = {0u, 0u, 0u, 0u};
                if (i < TS) {
                    const int lo = (pos - hw) > 0 ? (pos - hw) : 0, hh = (pos + hw) < n ? (pos + hw) : n;
                    float s[8];
#pragma unroll
                    for (int j = 0; j < 8; ++j) s[j] = 0.f;
                    for (int p = lo; p < hh; ++p) { const u32x4 v = *(const LAS u32x4*)(UP + (p - t0 + 8) * 512 + c8);
                        s[0] += bflo(v.x); s[1] += bfhi(v.x); s[2] += bflo(v.y); s[3] += bfhi(v.y); s[4] += bflo(v.z); s[5] += bfhi(v.z); s[6] += bflo(v.w); s[7] += bfhi(v.w); }
                    const float ic = 1.f / (float)(hh - lo);
                    const u32x4 v = *(const LAS u32x4*)(UP + (i + 8) * 512 + c8);
                    o.x = cvt_pk_bf16(s[0] * ic - bflo(v.x), s[1] * ic - bfhi(v.x)); o.y = cvt_pk_bf16(s[2] * ic - bflo(v.y), s[3] * ic - bfhi(v.y));
                    o.z = cvt_pk_bf16(s[4] * ic - bflo(v.z), s[5] * ic - bfhi(v.z)); o.w = cvt_pk_bf16(s[6] * ic - bflo(v.w), s[7] * ic - bfhi(v.w)); }
                *(LAS u32x4*)(PL + i * 512 + c8) = o; }
            __syncthreads();
            {
                const int gi = wave >> 1, nh = wave & 1;
#pragma unroll
                for (int ntile = 0; ntile < 2; ++ntile) { const int n0 = nh * 64 + ntile * 32;
                    f32x16 acc = {};
#pragma unroll
                    for (int ks = 0; ks < 8; ++ks) { const bf16x8 a = *(const LAS bf16x8*)(PL + r32 * 512 + gi * 128 + ks * 16 + hi * 8);
                        const bf16x8 bb = *(const bf16x8*)(WP + ((size_t)(gi * 128 + n0 + r32)) * 128 + ks * 16 + hi * 8);
                        acc = __builtin_amdgcn_mfma_f32_32x32x16_bf16(a, bb, acc, 0, 0, 0); }
                    const float psc = A.in[13][gi * 128 + n0 + r32];
#pragma unroll
                    for (int r = 0; r < 16; ++r) { const int tk = crow(r, hi); if (tk < TS) Y[(size_t)(tb + t0 + tk) * D + 512 + gi * 128 + n0 + r32] = f2bf(acc[r] * psc); } }
            }
        }
    }
    __syncthreads();
}

__device__ __forceinline__ void router_phase(Frame& F, const Args& A, int layer) {
    const int tid = F.tid, lane = F.lane, wave = F.wave, r32 = lane & 31, hi = lane >> 5;
    LAS float* T = (LAS float*)F.lds;
    LAS float* LOG = (LAS float*)(F.lds + 133120);
    LAS float* BIA = (LAS float*)(F.lds + 133120 + 4224);
    const float rbias = A.in[26][tid & 31];
    const float* g = A.in[6] + (size_t)(layer * 2 + 1) * D;
    const float* MODL = WSP(float, WS_MOD) + (size_t)layer * 9 * (NMOD * D);
    bf16_t* H = WSP(bf16_t, WS_H);
    unsigned* CNT = F.ctl + CW_CNT + layer * 64; int* LIST = WSP(int, WS_LIST); f32x2* TW = WSP(f32x2, WS_TW);
    float rwreg[64];
#pragma unroll
    for (int s = 0; s < 64; ++s) rwreg[s] = A.in[25][(size_t)(128 * wave + 2 * s + hi) * NEXP + r32];
    const int ngroups = layer == 0 ? NTOK / 32 : NLAT / 32;
    for (int grp = F.bid; grp < ngroups; grp += F.G) {
        const int ta0 = layer == 0 ? grp * 32 : (grp >> 7) * TPB + CTXL + (grp & 127) * 32;
        __syncthreads();
        {
            f32x4 v[4][4];
#pragma unroll
            for (int q = 0; q < 4; ++q) { const f32x4* xr = (const f32x4*)xl_row(F, ta0 + 4 * wave + q) + lane;
#pragma unroll
                for (int c = 0; c < 4; ++c) v[q][c] = xr[64 * c]; }
            __builtin_amdgcn_sched_barrier(0);
#pragma unroll
            for (int q = 0; q < 4; ++q) { const int ti = 4 * wave + q, ta = ta0 + ti, b = ta / TPB, j = ta - b * TPB, mrow = j < CTXL ? 8 : b;
                float s = 0.f;
#pragma unroll
                for (int c = 0; c < 4; ++c) s += (v[q][c].x * v[q][c].x + v[q][c].y * v[q][c].y) + (v[q][c].z * v[q][c].z + v[q][c].w * v[q][c].w);
                const float r = 1.f / sqrtf(wave_sum(s) * (1.f / D) + EPS);
                const float* sh = MODL + (size_t)mrow * (NMOD * D) + 3 * D; const float* sc = sh + D;
                u32x2* o8 = (u32x2*)(H + (size_t)ta * D) + lane;
#pragma unroll
                for (int c = 0; c < 4; ++c) { const int col = 4 * lane + 256 * c;
                    const f32x4 g4 = *(const f32x4*)(g + col), s4 = *(const f32x4*)(sc + col), h4 = *(const f32x4*)(sh + col);
                    const f32x4 y = (v[q][c] * r) * g4 * (s4 + 1.f) + h4;
                    u32x2 w; w.x = cvt_pk_bf16(y.x, y.y); w.y = cvt_pk_bf16(y.z, y.w); o8[64 * c] = w;
                    LAS float* tp = T + ti * 1025 + col; tp[0] = y.x; tp[1] = y.y; tp[2] = y.z; tp[3] = y.w; } }
        }
        __syncthreads();
        f32x16 acc = {};
#pragma unroll
        for (int s = 0; s < 64; ++s) { const float a = T[r32 * 1025 + 128 * wave + 2 * s + hi]; acc = __builtin_amdgcn_mfma_f32_32x32x2f32(a, rwreg[s], acc, 0, 0, 0); }
        __syncthreads();
        { LAS float* RED = T + wave * (32 * 33);
#pragma unroll
          for (int r = 0; r < 16; ++r) RED[crow(r, hi) * 33 + r32] = acc[r]; }
        __syncthreads();
        for (int e = tid; e < 1024; e += 512) { const int tk = e >> 5, ex = e & 31; float s = 0.f;
#pragma unroll
            for (int w = 0; w < 8; ++w) s += T[w * (32 * 33) + tk * 33 + ex];
            const float sg = __builtin_amdgcn_rcpf(1.f + __expf(-s));
            LOG[tk * 33 + ex] = sg; BIA[tk * 33 + ex] = sg + rbias; }
        __syncthreads();
        if (tid < 32) { const int ta = ta0 + tid;
            float bestg = -1e30f, bs1 = 0.f, bs2 = 0.f; int bi1 = 0, bi2 = 1, bgrp = 0;
#pragma unroll
            for (int gq = 0; gq < 8; ++gq) { float sc[4], bb[4];
#pragma unroll
                for (int q = 0; q < 4; ++q) { sc[q] = LOG[tid * 33 + gq * 4 + q]; bb[q] = BIA[tid * 33 + gq * 4 + q]; }
                int i1 = 0; float m1 = bb[0];
#pragma unroll
                for (int q = 1; q < 4; ++q) if (bb[q] > m1) { m1 = bb[q]; i1 = q; }
                int i2 = -1; float m2 = -1e30f;
#pragma unroll
                for (int q = 0; q < 4; ++q) if (q != i1 && bb[q] > m2) { m2 = bb[q]; i2 = q; }
                const float gs = m1 + m2;
                float s1 = sc[0], s2 = sc[0];
#pragma unroll
                for (int q = 1; q < 4; ++q) { s1 = (i1 == q) ? sc[q] : s1; s2 = (i2 == q) ? sc[q] : s2; }
                if (gs > bestg) { bestg = gs; bgrp = gq; bi1 = i1; bi2 = i2; bs1 = s1; bs2 = s2; } }
            const float inv = 1.f / (bs1 + bs2); const float w1 = bs1 * inv, w2 = bs2 * inv;
            const int lo = bi1 < bi2 ? bi1 : bi2, hh = bi1 < bi2 ? bi2 : bi1;
            const float wlo = bi1 < bi2 ? w1 : w2, whi = bi1 < bi2 ? w2 : w1;
            const int pair = (lo == 0) ? (hh - 1) : (lo == 1 ? (hh + 1) : 5);
            const int bucket = bgrp * 6 + pair;
            const unsigned pos = atomicAdd(&CNT[bucket], 1u);
            LIST[(size_t)bucket * LCAP + pos] = ta; TW[ta] = (f32x2){wlo, whi}; }
    }
    __syncthreads();
}

struct MoeSched {
    static constexpr bool GATHER_ = true;
    int G, c, ntiles, layer, stage; const unsigned* cnt; const int* list; const char* A; const char* W; LAS int* pre;
};
template <bool G1> struct MoeSchedT {
    static constexpr bool GATHER = G1;
    MoeSched m;
    __device__ __forceinline__ bool next(int i, pg8::Unit& u) const {
        const int L = i * m.G + m.c; if (L >= m.ntiles * 4) return false;
        const int tile = L >> 2, pn = L & 3;
        int bk = 0;
        for (int q = 1; q < NBUCK; ++q) bk = (m.pre[q] <= tile) ? q : bk;
        const int tin = tile - m.pre[bk], cntb = (int)m.cnt[bk];
        const int grp = bk / 6, pair = bk % 6;
        const int lo = pair < 3 ? 0 : (pair < 5 ? 1 : 2), hh = pair < 3 ? pair + 1 : (pair < 5 ? pair - 1 : 3);
        const int e1 = grp * 4 + lo, e2 = grp * 4 + hh;
        u.pm = tile; u.po = tile; u.pn = pn; u.rows = m.list + (size_t)bk * LCAP + tin * 256; u.nvalid = (cntb - tin * 256) < 256 ? (cntb - tin * 256) : 256; u.aux = pn >> 1;
        if (G1) {
            const int e = (pn < 2) ? e1 : e2;
            u.A = m.A; u.B = m.W + ((size_t)(m.layer * NEXP + e) * 512 + (pn & 1) * 256) * 1024 * 2; u.B2 = u.B;
        } else {
            u.A = m.A + (size_t)tile * 256 * 512 * 2;
            u.B = m.W + ((size_t)(m.layer * NEXP + e1) * 1024 + pn * 256) * 256 * 2;
            u.B2 = m.W + ((size_t)(m.layer * NEXP + e2) * 1024 + pn * 256) * 256 * 2 - (size_t)4 * 128;
        }
        return true;
    }
};
struct EpiMoe1 {
    bf16_t* HE; const f32x2* TW;
    __device__ __forceinline__ void operator()(const f32x4 (&acc)[2][2][4][2], const pg8::Unit& u, int wr, int wc, int fr, int fq) const {
        const int slot = u.aux;
        int tok[8]; f32x2 tw[8];
#pragma unroll
        for (int q = 0; q < 8; ++q) { const int r = (q >> 2) * 128 + wr * 64 + (q & 3) * 16 + fr; tok[q] = u.rows[r < u.nvalid ? r : 0]; }
        __builtin_amdgcn_sched_barrier(0);
#pragma unroll
        for (int q = 0; q < 8; ++q) tw[q] = TW[tok[q]];
        __builtin_amdgcn_sched_barrier(0);
#pragma unroll
        for (int ai = 0; ai < 2; ++ai)
#pragma unroll
            for (int m = 0; m < 4; ++m) { const int r = ai * 128 + wr * 64 + m * 16 + fr; const float w = slot ? tw[ai * 4 + m].y : tw[ai * 4 + m].x;
                float o[8];
#pragma unroll
                for (int n = 0; n < 2; ++n)
#pragma unroll
                    for (int q = 0; q < 4; ++q) { const float gt = acc[ai][0][m][n][q], up = acc[ai][1][m][n][q]; o[4 * n + q] = gt * __builtin_amdgcn_rcpf(1.f + __expf(-gt)) * up * w; }
                u32x4 wv; wv.x = cvt_pk_bf16(o[0], o[1]); wv.y = cvt_pk_bf16(o[2], o[3]); wv.z = cvt_pk_bf16(o[4], o[5]); wv.w = cvt_pk_bf16(o[6], o[7]);
                *(u32x4*)(HE + (size_t)(u.po * 256 + r) * 512 + slot * 256 + (u.pn & 1) * 128 + wc * 32 + 8 * fq) = wv; }
    }
};
struct EpiMoe2 {
    float* out; float* xc; const float* modl;
    __device__ __forceinline__ void operator()(const f32x4 (&acc)[2][2][4][2], const pg8::Unit& u, int wr, int wc, int fr, int fq) const {
        const int col0 = u.pn * 256 + wc * 32 + 8 * fq;
        int tok[8];
#pragma unroll
        for (int q = 0; q < 8; ++q) { const int r = (q >> 2) * 128 + wr * 64 + (q & 3) * 16 + fr; tok[q] = u.rows[r < u.nvalid ? r : 0]; }
        __builtin_amdgcn_sched_barrier(0);
#pragma unroll
        for (int ai = 0; ai < 2; ++ai)
#pragma unroll
        for (int mp = 0; mp < 2; ++mp) {
            f32x4 sv[2][2][2]; float* dp[2]; const float* gp[2];
#pragma unroll
            for (int mm = 0; mm < 2; ++mm) { const int m = mp * 2 + mm; const int tk = tok[ai * 4 + m]; const int b = tk / TPB, j = tk - b * TPB; const int mrow = j < CTXL ? 8 : b;
                gp[mm] = modl + (size_t)mrow * (NMOD * D) + 5 * D + col0;
                dp[mm] = (j < CTXL ? xc + (size_t)(b * CTXL + j) * D : out + ((size_t)b * SEQ + (j - CTXL)) * D) + col0;
#pragma unroll
                for (int bj = 0; bj < 2; ++bj)
#pragma unroll
                    for (int n = 0; n < 2; ++n) sv[mm][bj][n] = *(const f32x4*)(dp[mm] + bj * 128 + 4 * n); }
            __builtin_amdgcn_sched_barrier(0);
#pragma unroll
            for (int mm = 0; mm < 2; ++mm) { const int m = mp * 2 + mm; const int r = ai * 128 + wr * 64 + m * 16 + fr;
                if (r < u.nvalid) {
#pragma unroll
                    for (int bj = 0; bj < 2; ++bj)
#pragma unroll
                        for (int n = 0; n < 2; ++n) { const f32x4 gvv = *(const f32x4*)(gp[mm] + bj * 128 + 4 * n); *(f32x4*)(dp[mm] + bj * 128 + 4 * n) = sv[mm][bj][n] + gvv * acc[ai][bj][m][n]; } } }
            __builtin_amdgcn_sched_barrier(0);
        }
    }
};
__device__ __forceinline__ int moe_prefix(Frame& F, int layer, LAS int* pre) {
    __syncthreads();
    if (F.tid == 0) { int s = 0; const unsigned* cnt = F.ctl + CW_CNT + layer * 64; for (int q = 0; q < NBUCK; ++q) { pre[q] = s; s += ((int)cnt[q] + 255) >> 8; } pre[NBUCK] = s; }
    __syncthreads();
    return pre[NBUCK];
}

__device__ __forceinline__ void p9_phase(Frame& F, const Args& A) {
    const int gw = F.bid * 8 + F.wave, NGW = F.G * 8, l = F.lane;
    bf16_t* P = WSP(bf16_t, WS_BIG); const float* COS = WSP(float, WS_COS); const float* SIN = WSP(float, WS_SIN);
    const int kind = l < 8 ? 0 : l < 24 ? 1 : l < 28 ? 2 : l < 30 ? 5 : l < 46 ? 3 : 5;
    float gg[32];
    {
        const float* gp = nullptr;
        if (kind == 0) gp = A.in[16] + 32 * l; else if (kind == 1) gp = A.in[21] + 0 * 64 + (l & 1) * 32; else if (kind == 2) gp = A.in[18] + 32 * (l - 24); else if (kind == 3) gp = A.in[21] + 1 * 64 + (l & 1) * 32;
#pragma unroll
        for (int j = 0; j < 32; ++j) gg[j] = gp ? gp[j] : 1.f;
    }
    for (int tb0 = gw; tb0 < NTOK; tb0 += 2 * NGW) {
        const int tb1 = tb0 + NGW; const bool has1 = tb1 < NTOK;
        u32x4 wq[2][4];
#pragma unroll
        for (int e = 0; e < 2; ++e) { const int ta = e ? (has1 ? tb1 : tb0) : tb0; const bf16_t* rp = P + (size_t)ta * PW + 32 * l;
#pragma unroll
            for (int q = 0; q < 4; ++q) wq[e][q] = *(const u32x4*)(rp + 8 * q); }
        __builtin_amdgcn_sched_barrier(0);
#pragma unroll
        for (int e = 0; e < 2; ++e) {
            const int ta = e ? tb1 : tb0; if (e && !has1) break;
            const int b = ta / TPB, jj = ta - b * TPB; const bool lat = jj >= CTXL; const int pos = jj - CTXL;
            bf16_t* rowp = P + (size_t)ta * PW + 32 * l;
            float v[32]; float ss = 0.f;
#pragma unroll
            for (int q = 0; q < 4; ++q)
#pragma unroll
                for (int c = 0; c < 4; ++c) { v[8 * q + 2 * c] = bflo(wq[e][q][c]); v[8 * q + 2 * c + 1] = bfhi(wq[e][q][c]); }
#pragma unroll
            for (int j = 0; j < 32; ++j) ss += v[j] * v[j];
            const float s1 = ss + __shfl_xor(ss, 1), s2 = s1 + __shfl_xor(s1, 2), s4 = s2 + __shfl_xor(s2, 4);
            const float tot = kind == 0 ? s4 : kind == 2 ? s2 : s1;
            const float nn = kind == 0 ? 256.f : kind == 2 ? 128.f : 64.f;
            const float r = 1.f / sqrtf(tot / nn + EPS);
            const bool act = (kind == 0 && lat) || (kind == 1 && lat) || kind == 2 || kind == 3;
#pragma unroll
            for (int j = 0; j < 32; ++j) v[j] = v[j] * r * gg[j];
            const bool rope = (kind == 1 || kind == 3) && lat;
            {
                const f32x4* cp = (const f32x4*)(COS + (size_t)(lat ? pos : 0) * 32); const f32x4* sp = (const f32x4*)(SIN + (size_t)(lat ? pos : 0) * 32);
#pragma unroll
                for (int j4 = 0; j4 < 8; ++j4) { const f32x4 cs4 = cp[j4], sn4 = sp[j4];
#pragma unroll
                    for (int c = 0; c < 4; ++c) { const int j = 4 * j4 + c; const float other = __shfl_xor(v[j], 1); const float cs = cs4[c], sn = sn4[c];
                        const float rv = (l & 1) ? (v[j] * cs + other * sn) : (v[j] * cs - other * sn);
                        v[j] = rope ? rv : v[j]; } }
            }
            if (act) {
#pragma unroll
                for (int q = 0; q < 4; ++q) { u32x4 o; o.x = cvt_pk_bf16(v[8 * q], v[8 * q + 1]); o.y = cvt_pk_bf16(v[8 * q + 2], v[8 * q + 3]); o.z = cvt_pk_bf16(v[8 * q + 4], v[8 * q + 5]); o.w = cvt_pk_bf16(v[8 * q + 6], v[8 * q + 7]);
                    *(u32x4*)(rowp + 8 * q) = o; }
            }
        }
    }
}

__device__ __forceinline__ void p11_phase(Frame& F, const Args& A) {
    const int gw = F.bid * 8 + F.wave, NGW = F.G * 8, l = F.lane, h = l >> 4, j = l & 15;
    const bf16_t* __restrict__ P = WSP(bf16_t, WS_BIG); bf16_t* __restrict__ QM = WSP(bf16_t, WS_QM); bf16_t* __restrict__ KM = WSP(bf16_t, WS_KM); const bf16_t* __restrict__ KV = WSP(bf16_t, WS_H);
    const float* __restrict__ COS = WSP(float, WS_COS); const float* __restrict__ SIN = WSP(float, WS_SIN);
#define P11_BODY(wa, wb, DST, GP, DOROPE, POS) do { \
        float v[12]; \
        _Pragma("unroll") for (int c = 0; c < 4; ++c) { v[2 * c] = bflo(wa[c]); v[2 * c + 1] = bfhi(wa[c]); } \
        v[8] = bflo(wb.x); v[9] = bfhi(wb.x); v[10] = bflo(wb.y); v[11] = bfhi(wb.y); \
        float ss = 0.f; \
        _Pragma("unroll") for (int c = 0; c < 12; ++c) ss += v[c] * v[c]; \
        ss += __shfl_xor(ss, 1); ss += __shfl_xor(ss, 2); ss += __shfl_xor(ss, 4); ss += __shfl_xor(ss, 8); \
        const float r = 1.f / sqrtf(ss * (1.f / 192.f) + EPS); \
        const f32x4 ga = *(const f32x4*)((GP) + 8 * j), gb = *(const f32x4*)((GP) + 8 * j + 4), gc = *(const f32x4*)((GP) + 128 + 4 * j); \
        v[0] *= r * ga.x; v[1] *= r * ga.y; v[2] *= r * ga.z; v[3] *= r * ga.w; v[4] *= r * gb.x; v[5] *= r * gb.y; v[6] *= r * gb.z; v[7] *= r * gb.w; \
        v[8] *= r * gc.x; v[9] *= r * gc.y; v[10] *= r * gc.z; v[11] *= r * gc.w; \
        const f32x4 cs = *(const f32x4*)(COS + (size_t)(POS) * 32 + 4 * (j & 7)), sn = *(const f32x4*)(SIN + (size_t)(POS) * 32 + 4 * (j & 7)); \
        _Pragma("unroll") for (int c = 0; c < 4; ++c) { const float other = __shfl_xor(v[8 + c], 8); const float rv = (j < 8) ? (v[8 + c] * cs[c] - other * sn[c]) : (v[8 + c] * cs[c] + other * sn[c]); v[8 + c] = (DOROPE) ? rv : v[8 + c]; } \
        u32x4 oa; oa.x = cvt_pk_bf16(v[0], v[1]); oa.y = cvt_pk_bf16(v[2], v[3]); oa.z = cvt_pk_bf16(v[4], v[5]); oa.w = cvt_pk_bf16(v[6], v[7]); \
        u32x2 ob; ob.x = cvt_pk_bf16(v[8], v[9]); ob.y = cvt_pk_bf16(v[10], v[11]); \
        *(u32x4*)((DST) + 8 * j) = oa; *(u32x2*)((DST) + 128 + 4 * j) = ob; } while (0)
    constexpr int NB4 = 4;
    for (int t0 = gw; t0 < NLAT; t0 += NB4 * NGW) {
        u32x4 wa[NB4]; u32x2 wb[NB4];
#pragma unroll
        for (int e = 0; e < NB4; ++e) { const int tl = (t0 + e * NGW) < NLAT ? (t0 + e * NGW) : t0; const bf16_t* q = QM + (size_t)tl * 768 + h * 192; wa[e] = *(const u32x4*)(q + 8 * j); wb[e] = *(const u32x2*)(q + 128 + 4 * j); }
        __builtin_amdgcn_sched_barrier(0);
#pragma unroll
        for (int e = 0; e < NB4; ++e) { const int tl = t0 + e * NGW; if (tl < NLAT) { bf16_t* q = QM + (size_t)tl * 768 + h * 192; const int pos = tl & (SEQ - 1);
            P11_BODY(wa[e], wb[e], q, A.in[20], true, pos); } }
    }
    for (int t0 = gw; t0 < NTOK; t0 += NB4 * NGW) {
        u32x4 wa[NB4]; u32x2 wb[NB4];
#pragma unroll
        for (int e = 0; e < NB4; ++e) { const int ta = (t0 + e * NGW) < NTOK ? (t0 + e * NGW) : t0; wa[e] = *(const u32x4*)(KV + (size_t)ta * 1024 + h * 256 + 8 * j); wb[e] = *(const u32x2*)(P + (size_t)ta * PW + PC_KROPE + 4 * j); }
        __builtin_amdgcn_sched_barrier(0);
#pragma unroll
        for (int e = 0; e < NB4; ++e) { const int ta = t0 + e * NGW; if (ta < NTOK) { const int b = ta / TPB, jj = ta - b * TPB; const bool lat = jj >= CTXL; const int pos = lat ? jj - CTXL : 0;
            bf16_t* k = KM + (size_t)ta * 768 + h * 192;
            P11_BODY(wa[e], wb[e], k, A.in[20] + 192, lat, pos); } }
    }
#undef P11_BODY
}

#define SBAR() __builtin_amdgcn_sched_barrier(0)
__device__ __forceinline__ void partialSM(f32x16& p0, f32x16& p1, float& m_reg, float& mn, float& alpha, const float C, const float thr) {
    float pmax = p0[0];
#pragma unroll
    for (int r = 1; r < 16; ++r) pmax = fmaxf(pmax, p0[r]);
#pragma unroll
    for (int r = 0; r < 16; ++r) pmax = fmaxf(pmax, p1[r]);
    { auto rr = __builtin_amdgcn_permlane32_swap(__float_as_uint(pmax), __float_as_uint(pmax), false, false);
      pmax = fmaxf(__uint_as_float(rr[0]), __uint_as_float(rr[1])); }
    if (__builtin_expect(__all(pmax - m_reg <= thr), 1)) { mn = m_reg; alpha = 1.f; }
    else { mn = fmaxf(m_reg, pmax); alpha = __builtin_amdgcn_exp2f((m_reg - mn) * C); m_reg = mn; }
    const float mnC = -mn * C;
#pragma unroll
    for (int r = 0; r < 16; ++r) p0[r] = fmaf(p0[r], C, mnC);
#pragma unroll
    for (int r = 0; r < 16; ++r) p1[r] = fmaf(p1[r], C, mnC);
#pragma unroll
    for (int r = 0; r < 16; ++r) p0[r] = __builtin_amdgcn_exp2f(p0[r]);
}
__device__ __forceinline__ void finishSM(f32x16& p0, f32x16& p1, float alpha, float& l_reg, bf16x8& pa0, bf16x8& pa1, bf16x8& pa2, bf16x8& pa3) {
#pragma unroll
    for (int r = 0; r < 16; ++r) p1[r] = __builtin_amdgcn_exp2f(p1[r]);
    float ps = 0;
#pragma unroll
    for (int r = 0; r < 16; ++r) ps += p0[r];
#pragma unroll
    for (int r = 0; r < 16; ++r) ps += p1[r];
    { auto rr = __builtin_amdgcn_permlane32_swap(__float_as_uint(ps), __float_as_uint(ps), false, false);
      ps = __uint_as_float(rr[0]) + __uint_as_float(rr[1]); }
    l_reg = l_reg * alpha + ps;
#define PK4(P, BASE, OUT) do { unsigned a0 = cvt_pk_bf16(P[BASE + 0], P[BASE + 1]), a1 = cvt_pk_bf16(P[BASE + 2], P[BASE + 3]);   \
    unsigned b0 = cvt_pk_bf16(P[BASE + 4], P[BASE + 5]), b1 = cvt_pk_bf16(P[BASE + 6], P[BASE + 7]);                              \
    auto r0 = __builtin_amdgcn_permlane32_swap(a0, b0, false, false); auto r1 = __builtin_amdgcn_permlane32_swap(a1, b1, false, false); \
    u32x4 w = {r0[0], r1[0], r0[1], r1[1]}; OUT = *reinterpret_cast<bf16x8*>(&w); } while (0)
    PK4(p0, 0, pa0); PK4(p0, 8, pa1); PK4(p1, 0, pa2); PK4(p1, 8, pa3);
#undef PK4
}
__device__ __forceinline__ int v_st(int k, int c) { const int kk = (k & ~0xC) | ((k & 4) << 1) | ((k & 8) >> 1); return ((kk >> 3) * 4 + (c >> 5)) * 512 + ((kk & 7) * 32 + (c & 31)) * 2; }
__device__ __forceinline__ int v_rd_base(int lane) { return ((lane & 3) << 3) | (((lane >> 2) & 3) << 6) | (((lane >> 4) & 1) << 5) | (((lane >> 5) & 1) << 8); }
constexpr int v_rd_off(int d0, int ks, int half) { return d0 * 512 + ks * 4096 + half * 2048; }
template <int OFF> __device__ __forceinline__ s16x4 tr_read(int vb) {
    s16x4 r; asm volatile("ds_read_b64_tr_b16 %0, %1 offset:%2" : "=&v"(r) : "v"(vb), "i"(OFF) : "memory"); return r;
}
template <int D0> __device__ __forceinline__ void pv_one(f32x16& od, int vb, bf16x8 pa0, bf16x8 pa1, bf16x8 pa2, bf16x8 pa3) {
    const s16x4 l0 = tr_read<v_rd_off(D0, 0, 0)>(vb), h0 = tr_read<v_rd_off(D0, 0, 1)>(vb), l1 = tr_read<v_rd_off(D0, 1, 0)>(vb), h1 = tr_read<v_rd_off(D0, 1, 1)>(vb);
    const s16x4 l2 = tr_read<v_rd_off(D0, 2, 0)>(vb), h2 = tr_read<v_rd_off(D0, 2, 1)>(vb), l3 = tr_read<v_rd_off(D0, 3, 0)>(vb), h3 = tr_read<v_rd_off(D0, 3, 1)>(vb);
    asm volatile("s_waitcnt lgkmcnt(0)" ::: "memory"); SBAR();
#define PK(L, H) (bf16x8){L[0], L[1], L[2], L[3], H[0], H[1], H[2], H[3]}
    od = __builtin_amdgcn_mfma_f32_32x32x16_bf16(pa0, PK(l0, h0), od, 0, 0, 0);
    od = __builtin_amdgcn_mfma_f32_32x32x16_bf16(pa1, PK(l1, h1), od, 0, 0, 0);
    od = __builtin_amdgcn_mfma_f32_32x32x16_bf16(pa2, PK(l2, h2), od, 0, 0, 0);
    od = __builtin_amdgcn_mfma_f32_32x32x16_bf16(pa3, PK(l3, h3), od, 0, 0, 0);
#undef PK
}
__device__ __forceinline__ void pv_d0(f32x16* o, int vb, bf16x8 pa0, bf16x8 pa1, bf16x8 pa2, bf16x8 pa3) {
    pv_one<0>(o[0], vb, pa0, pa1, pa2, pa3); pv_one<1>(o[1], vb, pa0, pa1, pa2, pa3); pv_one<2>(o[2], vb, pa0, pa1, pa2, pa3); pv_one<3>(o[3], vb, pa0, pa1, pa2, pa3);
}

template <int DK, int LDQ, int LDK, int LDV, int SDEPTH, int NQL>
__device__ __forceinline__ void attn_body(const int tid, const bf16_t* __restrict__ Qb, const bf16_t* __restrict__ Kh, const bf16_t* __restrict__ Vh, const int seq, char* lds,
                                          const float C, const float thr, f32x16 (&o)[4], float& l_out) {
    constexpr int RB = DK * 2, SHM_V = 64 * 256, SHM_K = 64 * RB, CPR = DK / 8, NKC = CPR / 8, ND0 = DK / 16, NQR = ND0 - NQL, QTB = NQL * 32;
#define KSWZ(row, colB) ((row) * RB + ((colB) ^ (((row) & 7) << 4)))
    const int wid = tid >> 6, lane = tid & 63, r32 = lane & 31, hi = lane >> 5;
    char* V_lds = lds; char* K_lds = lds + 2 * SHM_V;
    float* ws = (float*)(lds + 2 * SHM_V + 2 * SHM_K) + wid * 64; float* al_l = ws + 32;
    char* Qt = lds + 2 * SHM_V + 2 * SHM_K + 2048 + wid * (32 * (QTB > 0 ? QTB : 1));
    float m_reg = -1e30f, l_reg = 0;
#pragma unroll
    for (int d = 0; d < 4; ++d) o[d] = f32x16{};
    bf16x8 qr[NQR];
    const bf16_t* Qw = Qb + (size_t)(wid * 32 + r32) * LDQ + hi * 8;
#pragma unroll
    for (int d0 = 0; d0 < NQR; ++d0) qr[d0] = *(const bf16x8*)(Qw + d0 * 16);
    if constexpr (NQL > 0) {
        constexpr int CH = QTB / 16;
#pragma unroll
        for (int i = 0; i < (32 * CH) / 64; ++i) { const int c = lane + 64 * i, row = c / CH, cc = c % CH;
            const bf16x8 v = *(const bf16x8*)(Qb + (size_t)(wid * 32 + row) * LDQ + NQR * 16 + cc * 8);
            *(bf16x8*)(Qt + row * QTB + ((cc * 16) ^ (((row) & (CH - 1) & 7) << 4))) = v; }
        asm volatile("s_waitcnt lgkmcnt(0)" ::: "memory");
    }
    const int sr = tid >> 4, sc = (tid & 15) * 8, vst0 = v_st(sr, sc), vst1 = v_st(32 + sr, sc);
    const int vb0 = (int)(uintptr_t)V_lds + v_rd_base(lane);
    int krow[NKC], kcc[NKC];
#pragma unroll
    for (int i = 0; i < NKC; ++i) { const int c = tid + 512 * i; krow[i] = c / CPR; kcc[i] = c % CPR; }
    struct { bf16x8 vs0, vs1, ks[NKC]; } sr_[SDEPTH];
    constexpr int SE = 0, SO = SDEPTH - 1;
#define SLOAD(i, k0) do { sr_[i].vs0 = *(const bf16x8*)(&Vh[(size_t)((k0) + sr) * LDV + sc]); sr_[i].vs1 = *(const bf16x8*)(&Vh[(size_t)((k0) + 32 + sr) * LDV + sc]); \
    _Pragma("unroll") for (int _q = 0; _q < NKC; ++_q) sr_[i].ks[_q] = *(const bf16x8*)(&Kh[(size_t)((k0) + krow[_q]) * LDK + kcc[_q] * 8]); } while (0)
#define SWRITE(b, i) do { *(bf16x8*)(V_lds + (b) * SHM_V + vst0) = sr_[i].vs0; *(bf16x8*)(V_lds + (b) * SHM_V + vst1) = sr_[i].vs1; \
    _Pragma("unroll") for (int _q = 0; _q < NKC; ++_q) *(bf16x8*)(K_lds + (b) * SHM_K + KSWZ(krow[_q], kcc[_q] * 16)) = sr_[i].ks[_q]; } while (0)
#define SWAIT() do { if constexpr (SDEPTH == 2) asm volatile("s_waitcnt vmcnt(%0)" :: "n"(2 + NKC) : "memory"); else asm volatile("s_waitcnt vmcnt(0)" ::: "memory"); } while (0)
#define RESC(a) do { if (__any((a) < 1.f)) { if (hi == 0) al_l[r32] = (a); asm volatile("s_waitcnt lgkmcnt(0)" ::: "memory"); \
    _Pragma("unroll") for (int d = 0; d < 4; ++d) _Pragma("unroll") for (int r = 0; r < 16; ++r) o[d][r] *= al_l[crow(r, hi)]; } } while (0)
#define QFRAG(d0) ((d0) < NQR ? qr[(d0) < NQR ? (d0) : 0] : *(const bf16x8*)(Qt + r32 * QTB + (((((d0) - NQR) * 2 + hi) * 16) ^ ((r32 & ((QTB / 16) - 1) & 7) << 4))))
#define QKT(P0, P1, KB) do { P0 = f32x16{}; P1 = f32x16{}; _Pragma("unroll") for (int d0 = 0; d0 < ND0; ++d0) { const int cb = (d0 * 16 + hi * 8) * 2; \
    const bf16x8 b0 = *(const bf16x8*)((KB) + KSWZ(r32, cb)); const bf16x8 b1 = *(const bf16x8*)((KB) + KSWZ(32 + r32, cb)); const bf16x8 qf = QFRAG(d0); \
    P0 = __builtin_amdgcn_mfma_f32_32x32x16_bf16(b0, qf, P0, 0, 0, 0); P1 = __builtin_amdgcn_mfma_f32_32x32x16_bf16(b1, qf, P1, 0, 0, 0); } } while (0)
    f32x16 pA0, pA1, pB0, pB1; float mnA, mnB, alA, alB; bf16x8 pa0, pa1, pa2, pa3; const int NT = seq / 64;
    SLOAD(SE, 0); asm volatile("s_waitcnt vmcnt(0)" ::: "memory"); SWRITE(0, SE); __syncthreads();
    QKT(pA0, pA1, K_lds); partialSM(pA0, pA1, m_reg, mnA, alA, C, thr);
    SLOAD(SO, 64); if constexpr (SDEPTH == 2) { if (2 < NT) SLOAD(SE, 128); }
    SWAIT(); SWRITE(1, SO); __syncthreads();
    for (int j = 1; j + 1 < NT; j += 2) {
        SBAR(); QKT(pB0, pB1, K_lds + SHM_K);
        finishSM(pA0, pA1, alA, l_reg, pa0, pa1, pa2, pa3); SBAR();
        SLOAD(SO, (j + SDEPTH) * 64); SBAR();
        pv_d0(o, vb0, pa0, pa1, pa2, pa3); partialSM(pB0, pB1, m_reg, mnB, alB, C, thr);
        __syncthreads(); SWAIT(); SWRITE(0, SE);
        RESC(alB); __syncthreads();
        SBAR(); QKT(pA0, pA1, K_lds);
        finishSM(pB0, pB1, alB, l_reg, pa0, pa1, pa2, pa3); SBAR();
        if (SDEPTH == 1 || j + 3 < NT) SLOAD(SE, (j + 1 + SDEPTH) * 64); SBAR();
        pv_d0(o, vb0 + SHM_V, pa0, pa1, pa2, pa3); partialSM(pA0, pA1, m_reg, mnA, alA, C, thr);
        __syncthreads(); SWAIT(); SWRITE(1, SO);
        RESC(alA); __syncthreads();
    }
    SBAR(); QKT(pB0, pB1, K_lds + SHM_K);
    finishSM(pA0, pA1, alA, l_reg, pa0, pa1, pa2, pa3); SBAR();
    pv_d0(o, vb0, pa0, pa1, pa2, pa3); partialSM(pB0, pB1, m_reg, mnB, alB, C, thr);
    __syncthreads(); RESC(alB);
    finishSM(pB0, pB1, alB, l_reg, pa0, pa1, pa2, pa3); SBAR();
    pv_d0(o, vb0 + SHM_V, pa0, pa1, pa2, pa3);
    l_out = l_reg;
#undef SLOAD
#undef SWRITE
#undef SWAIT
#undef RESC
#undef QKT
#undef QFRAG
#undef KSWZ
}

__device__ __forceinline__ void attn_phase(Frame& F, const Args& A, unsigned long long& pt1) {
    char* lds = (char*)F.lds;
    const bf16_t* P = WSP(bf16_t, WS_BIG); const bf16_t* QM = WSP(bf16_t, WS_QM); const bf16_t* KM = WSP(bf16_t, WS_KM); const bf16_t* KV = WSP(bf16_t, WS_H);
    bf16_t* Y = WSP(bf16_t, WS_YMIX); float* ST = WSP(float, WS_STASH) + (size_t)F.bid * 256 * 128;
    float lam;
    { const int lane = F.lane; const float* dl = A.in[22]; const float a = dl[lane] * dl[64 + lane], b = dl[128 + lane] * dl[192 + lane]; lam = __expf(wave_sum(a)) - __expf(wave_sum(b)) + LAM_INIT; }
    constexpr float LOG2E = 1.4426950408889634f;
#ifndef ATT_KINDS
#define ATT_KINDS 3
#endif
    if (ATT_KINDS & 1)
    for (int u = F.bid; u < 512; u += F.G) {
        int tid = threadIdx.x; asm volatile("" : "+v"(tid));
        const int wid = tid >> 6, lane = tid & 63, r32 = lane & 31, hi = lane >> 5;
        const int bh = u >> 4, qb = u & 15, b = bh >> 2, h = bh & 3;
        f32x16 o[4]; float l_reg;
        __syncthreads();
        attn_body<192, 768, 768, 1024, 1, 8>(tid, QM + ((size_t)(b * SEQ + qb * 256)) * 768 + h * 192, KM + (size_t)(b * TPB) * 768 + h * 192, KV + (size_t)(b * TPB) * 1024 + h * 256 + 128,
                                       TPB, lds, 0.07216878364870322f * LOG2E, 8.f / 0.07216878364870322f, o, l_reg);
        float* li_l = (float*)(lds + 2 * 16384 + 2 * 64 * 384) + wid * 64;
        if (hi == 0) li_l[r32] = l_reg; LDS_WAIT();
        float rli[16];
#pragma unroll
        for (int r = 0; r < 16; ++r) rli[r] = __builtin_amdgcn_rcpf(li_l[crow(r, hi)]);
        bf16_t* Ow = Y + (size_t)(b * SEQ + qb * 256 + wid * 32) * D + h * 128;
#pragma unroll
        for (int r = 0; r < 16; ++r)
#pragma unroll
            for (int d0 = 0; d0 < 4; ++d0) Ow[(size_t)crow(r, hi) * D + d0 * 32 + r32] = f2bf(o[d0][r] * rli[r]);
    }
    if (PT_SUB == 3) pt1 = __builtin_amdgcn_s_memrealtime();
    if (ATT_KINDS & 2)
    for (int u = F.bid; u < 512; u += F.G) {
        int tid = threadIdx.x; asm volatile("" : "+v"(tid));
        const int wid = tid >> 6, lane = tid & 63, r32 = lane & 31, hi = lane >> 5;
        const int bh = u >> 4, qb = u & 15, b = bh >> 2, h = bh & 3;
        const bf16_t* Pb = P + (size_t)(b * TPB) * PW;
        float* Sw = ST + (size_t)(wid * 32) * 128;
        float* li_l = (float*)(lds + 2 * 16384 + 2 * 64 * 128) + wid * 64;
        {
            f32x16 o[4]; float l_reg;
            __syncthreads();
            attn_body<64, PW, PW, PW, 2, 0>(tid, Pb + (size_t)(CTXL + qb * 256) * PW + PC_QD + h * 128, Pb + PC_KD + h * 128, Pb + PC_VD + h * 128, TPB, lds, 0.125f * LOG2E, 8.f / 0.125f, o, l_reg);
            if (hi == 0) li_l[r32] = l_reg; LDS_WAIT();
            float rli[16];
#pragma unroll
            for (int r = 0; r < 16; ++r) rli[r] = __builtin_amdgcn_rcpf(li_l[crow(r, hi)]);
#pragma unroll
            for (int r = 0; r < 16; ++r)
#pragma unroll
                for (int d0 = 0; d0 < 4; ++d0) Sw[(size_t)crow(r, hi) * 128 + d0 * 32 + r32] = o[d0][r] * rli[r];
        }
        {
            f32x16 o[4]; float l_reg;
            __syncthreads();
            attn_body<64, PW, PW, PW, 2, 0>(tid, Pb + (size_t)(CTXL + qb * 256) * PW + PC_QD + h * 128 + 64, Pb + PC_KD + h * 128 + 64, Pb + PC_VD + h * 128, TPB, lds, 0.125f * LOG2E, 8.f / 0.125f, o, l_reg);
            if (hi == 0) li_l[r32] = l_reg; LDS_WAIT();
            float ss[16];
#pragma unroll
            for (int r = 0; r < 16; ++r) { const float rl = __builtin_amdgcn_rcpf(li_l[crow(r, hi)]); float s = 0.f;
#pragma unroll
                for (int d0 = 0; d0 < 4; ++d0) { const float a1 = Sw[(size_t)crow(r, hi) * 128 + d0 * 32 + r32]; const float v = a1 - lam * (o[d0][r] * rl); o[d0][r] = v; s += v * v; }
                ss[r] = s; }
#pragma unroll
            for (int r = 0; r < 16; ++r) {
#pragma unroll
                for (int sh = 1; sh < 32; sh <<= 1) ss[r] += __shfl_xor(ss[r], sh);
                ss[r] = (1.f / sqrtf(ss[r] * (1.f / 128.f) + EPS)) * (1.f - LAM_INIT); }
            bf16_t* Ow = Y + (size_t)(b * SEQ + qb * 256 + wid * 32) * D + 512 + h * 128;
#pragma unroll
            for (int d0 = 0; d0 < 4; ++d0) { const float gs = A.in[23][d0 * 32 + r32];
#pragma unroll
                for (int r = 0; r < 16; ++r) Ow[(size_t)crow(r, hi) * D + d0 * 32 + r32] = f2bf(o[d0][r] * ss[r] * gs); }
        }
    }
    __syncthreads();
}

constexpr int NPHASE = 18;

__global__ void __launch_bounds__(512, 2) fwd(Args args) {
    extern __shared__ __attribute__((aligned(16))) unsigned char lds_raw[];
    Frame F;
    F.lds = (LAS unsigned char*)lds_raw;
    F.tid = threadIdx.x; F.lane = F.tid & 63; F.wave = __builtin_amdgcn_readfirstlane(F.tid >> 6);
    F.G = gridDim.x; F.bid = blockIdx.x;
    F.out = args.out; F.ws = args.ws; F.ctl = (unsigned*)(args.ws + WS_CTL);
    volatile LAS unsigned* MISC = (volatile LAS unsigned*)(F.lds + LDS_CTL);
    LAS int* PRE = (LAS int*)(F.lds + LDS_CTL + 64);
    if (F.tid < 4) MISC[F.tid] = 0u;
    __syncthreads();
    XcdBarrier bar; bar.bar = F.ctl + CW_BAR; bar.x = 0; bar.st = nullptr;
#if MK_ONE_LAUNCH
    bar = xcd_barrier_post(F.ctl + CW_BAR, MISC);
#define GRID_BAR() xcd_barrier(bar)
#else
#define GRID_BAR() do {} while (0)
#endif
    const int lo = args.ph_lo, hi = args.ph_hi;
    unsigned long long pt0 = 0, pt1 = 0;
#ifndef PH_MASK
#define PH_MASK 0x3ffff
#endif
#define IN(k) (((PH_MASK >> (k)) & 1) && lo <= (k) && (k) < hi)
#define SEAM(k) do { if (IN((k) + 1)) GRID_BAR(); } while (0)
#define REP(k) for (int _rep = 0; _rep <= ((PROBE_REP >> (k)) & 1); ++_rep, (void)((_rep <= ((PROBE_REP >> (k)) & 1)) ? (GRID_BAR(), 0) : 0))

    if (IN(0)) { if (PT_LO == 0) pt0 = __builtin_amdgcn_s_memrealtime(); REP(0) { p0_prologue(F, args, pt1); } if (!PT_SUB && PT_PRE && PT_HI == 0) pt1 = __builtin_amdgcn_s_memrealtime(); SEAM(0); if (!PT_SUB && !PT_PRE && PT_HI == 0) pt1 = __builtin_amdgcn_s_memrealtime(); }
    if (IN(1)) { if (PT_LO == 1) pt0 = __builtin_amdgcn_s_memrealtime(); REP(1) { norm_mod_phase(F, args, 0); } if (PT_PRE && PT_HI == 1) pt1 = __builtin_amdgcn_s_memrealtime(); SEAM(1); if (!PT_PRE && PT_HI == 1) pt1 = __builtin_amdgcn_s_memrealtime(); }
    if (IN(2)) { if (PT_LO == 2) pt0 = __builtin_amdgcn_s_memrealtime(); REP(2) {
        pg8::PlainSched S; S.init(WSP(bf16_t, WS_H), WSP(bf16_t, WS_WIN0), NTOK, 1536, D, D, D, F.G, F.bid, 0);
        pg8::EpiStoreBf16 E{WSP(bf16_t, WS_BIG), UW};
        pg8::gemm_phase(F.lds, D, D, D, 1 << 30, S, E);
    } if (PT_PRE && PT_HI == 2) pt1 = __builtin_amdgcn_s_memrealtime(); SEAM(2); if (!PT_PRE && PT_HI == 2) pt1 = __builtin_amdgcn_s_memrealtime(); }
    if (IN(3)) { if (PT_LO == 3) pt0 = __builtin_amdgcn_s_memrealtime(); REP(3) { convpool_phase(F, args); } if (PT_PRE && PT_HI == 3) pt1 = __builtin_amdgcn_s_memrealtime(); SEAM(3); if (!PT_PRE && PT_HI == 3) pt1 = __builtin_amdgcn_s_memrealtime(); }
    if (IN(4)) { if (PT_LO == 4) pt0 = __builtin_amdgcn_s_memrealtime(); REP(4) {
        pg8::PlainSched S; S.init(WSP(bf16_t, WS_YMIX), WSP(bf16_t, WS_WOUT0), NTOK, D, D, D, D, F.G, F.bid, 0);
        pg8::EpiResid E{args.in[0], args.in[2], F.out, WSP(float, WS_XC), WSP(float, WS_MOD), 0};
        pg8::gemm_phase(F.lds, D, D, D, 1 << 30, S, E);
    } if (PT_PRE && PT_HI == 4) pt1 = __builtin_amdgcn_s_memrealtime(); SEAM(4); if (!PT_PRE && PT_HI == 4) pt1 = __builtin_amdgcn_s_memrealtime(); }
    if (IN(5)) { if (PT_LO == 5) pt0 = __builtin_amdgcn_s_memrealtime(); REP(5) { router_phase(F, args, 0); } if (PT_PRE && PT_HI == 5) pt1 = __builtin_amdgcn_s_memrealtime(); SEAM(5); if (!PT_PRE && PT_HI == 5) pt1 = __builtin_amdgcn_s_memrealtime(); }
    if (IN(6)) { if (PT_LO == 6) pt0 = __builtin_amdgcn_s_memrealtime(); REP(6) {
        const int nt = moe_prefix(F, 0, PRE);
        MoeSchedT<true> S; S.m = MoeSched{F.G, F.bid, nt, 0, 0, F.ctl + CW_CNT, WSP(int, WS_LIST), (const char*)WSP(bf16_t, WS_H), (const char*)WSP(bf16_t, WS_WM1), PRE};
        EpiMoe1 E{WSP(bf16_t, WS_BIG), WSP(f32x2, WS_TW)};
        pg8::gemm_phase(F.lds, D, D, D, 1 << 30, S, E);
    } if (PT_PRE && PT_HI == 6) pt1 = __builtin_amdgcn_s_memrealtime(); SEAM(6); if (!PT_PRE && PT_HI == 6) pt1 = __builtin_amdgcn_s_memrealtime(); }
    if (IN(7)) { if (PT_LO == 7) pt0 = __builtin_amdgcn_s_memrealtime(); REP(7) {
        const int nt = moe_prefix(F, 0, PRE);
        MoeSchedT<false> S; S.m = MoeSched{F.G, F.bid, nt, 0, 1, F.ctl + CW_CNT, WSP(int, WS_LIST), (const char*)WSP(bf16_t, WS_BIG), (const char*)WSP(bf16_t, WS_WM2), PRE};
        EpiMoe2 E{F.out, WSP(float, WS_XC), WSP(float, WS_MOD)};
        pg8::gemm_phase(F.lds, 512, 512, 256, 4, S, E);
    } if (PT_PRE && PT_HI == 7) pt1 = __builtin_amdgcn_s_memrealtime(); SEAM(7); if (!PT_PRE && PT_HI == 7) pt1 = __builtin_amdgcn_s_memrealtime(); }
    if (IN(8)) { if (PT_LO == 8) pt0 = __builtin_amdgcn_s_memrealtime(); REP(8) { norm_mod_phase(F, args, 1); } if (PT_PRE && PT_HI == 8) pt1 = __builtin_amdgcn_s_memrealtime(); SEAM(8); if (!PT_PRE && PT_HI == 8) pt1 = __builtin_amdgcn_s_memrealtime(); }
    if (IN(9)) { if (PT_LO == 9) pt0 = __builtin_amdgcn_s_memrealtime(); REP(9) {
        pg8::PlainSched S; S.init(WSP(bf16_t, WS_H), WSP(bf16_t, WS_WIN1), NTOK, PW, D, D, D, F.G, F.bid, 0);
        pg8::EpiStoreBf16 E{WSP(bf16_t, WS_BIG), PW};
        pg8::gemm_phase(F.lds, D, D, D, 1 << 30, S, E);
    } if (PT_PRE && PT_HI == 9) pt1 = __builtin_amdgcn_s_memrealtime(); SEAM(9); if (!PT_PRE && PT_HI == 9) pt1 = __builtin_amdgcn_s_memrealtime(); }
    if (IN(10)) { if (PT_LO == 10) pt0 = __builtin_amdgcn_s_memrealtime(); REP(10) { p9_phase(F, args); } if (PT_PRE && PT_HI == 10) pt1 = __builtin_amdgcn_s_memrealtime(); SEAM(10); if (!PT_PRE && PT_HI == 10) pt1 = __builtin_amdgcn_s_memrealtime(); }
    if (IN(11)) { if (PT_LO == 11) pt0 = __builtin_amdgcn_s_memrealtime(); REP(11) {
        { pg8::PlainSched S; S.init(WSP(bf16_t, WS_BIG) + PC_CQ, WSP(bf16_t, WS_WUQ), NLAT, 768, 256, PW, 256, F.G, F.bid, 1);
          pg8::EpiStoreBf16 E{WSP(bf16_t, WS_QM), 768};
          pg8::gemm_phase(F.lds, 256, PW, 256, 1 << 30, S, E); }
        { pg8::PlainSched S; S.init(WSP(bf16_t, WS_BIG) + PC_CKV, WSP(bf16_t, WS_WUKV), NTOK, 1024, 128, PW, 128, F.G, F.bid, 0);
          pg8::EpiStoreBf16 E{WSP(bf16_t, WS_H), 1024};
          pg8::gemm_phase(F.lds, 128, PW, 128, 1 << 30, S, E); }

    } if (PT_PRE && PT_HI == 11) pt1 = __builtin_amdgcn_s_memrealtime(); SEAM(11); if (!PT_PRE && PT_HI == 11) pt1 = __builtin_amdgcn_s_memrealtime(); }
    if (IN(12)) { if (PT_LO == 12) pt0 = __builtin_amdgcn_s_memrealtime(); REP(12) { p11_phase(F, args); } if (PT_PRE && PT_HI == 12) pt1 = __builtin_amdgcn_s_memrealtime(); SEAM(12); if (!PT_PRE && PT_HI == 12) pt1 = __builtin_amdgcn_s_memrealtime(); }
    if (IN(13)) { if (PT_LO == 13) pt0 = __builtin_amdgcn_s_memrealtime(); REP(13) { attn_phase(F, args, pt1); } if (!PT_SUB && PT_PRE && PT_HI == 13) pt1 = __builtin_amdgcn_s_memrealtime(); SEAM(13); if (!PT_SUB && !PT_PRE && PT_HI == 13) pt1 = __builtin_amdgcn_s_memrealtime(); }
    if (IN(14)) { if (PT_LO == 14) pt0 = __builtin_amdgcn_s_memrealtime(); REP(14) {
        pg8::PlainSched S; S.init(WSP(bf16_t, WS_YMIX), WSP(bf16_t, WS_WOUT1), NLAT, D, D, D, D, F.G, F.bid, 0);
        pg8::EpiResid E{args.in[0], args.in[2], F.out, WSP(float, WS_XC), WSP(float, WS_MOD) + (size_t)9 * NMOD * D, 1};
        pg8::gemm_phase(F.lds, D, D, D, 1 << 30, S, E);
    } if (PT_PRE && PT_HI == 14) pt1 = __builtin_amdgcn_s_memrealtime(); SEAM(14); if (!PT_PRE && PT_HI == 14) pt1 = __builtin_amdgcn_s_memrealtime(); }
    if (IN(15)) { if (PT_LO == 15) pt0 = __builtin_amdgcn_s_memrealtime(); REP(15) { router_phase(F, args, 1); } if (PT_PRE && PT_HI == 15) pt1 = __builtin_amdgcn_s_memrealtime(); SEAM(15); if (!PT_PRE && PT_HI == 15) pt1 = __builtin_amdgcn_s_memrealtime(); }
    if (IN(16)) { if (PT_LO == 16) pt0 = __builtin_amdgcn_s_memrealtime(); REP(16) {
        const int nt = moe_prefix(F, 1, PRE);
        MoeSchedT<true> S; S.m = MoeSched{F.G, F.bid, nt, 1, 0, F.ctl + CW_CNT + 64, WSP(int, WS_LIST), (const char*)WSP(bf16_t, WS_H), (const char*)WSP(bf16_t, WS_WM1), PRE};
        EpiMoe1 E{WSP(bf16_t, WS_BIG), WSP(f32x2, WS_TW)};
        pg8::gemm_phase(F.lds, D, D, D, 1 << 30, S, E);
    } if (PT_PRE && PT_HI == 16) pt1 = __builtin_amdgcn_s_memrealtime(); SEAM(16); if (!PT_PRE && PT_HI == 16) pt1 = __builtin_amdgcn_s_memrealtime(); }
    if (IN(17)) { if (PT_LO == 17) pt0 = __builtin_amdgcn_s_memrealtime(); REP(17) {
        const int nt = moe_prefix(F, 1, PRE);
        MoeSchedT<false> S; S.m = MoeSched{F.G, F.bid, nt, 1, 1, F.ctl + CW_CNT + 64, WSP(int, WS_LIST), (const char*)WSP(bf16_t, WS_BIG), (const char*)WSP(bf16_t, WS_WM2), PRE};
        EpiMoe2 E{F.out, WSP(float, WS_XC), WSP(float, WS_MOD) + (size_t)9 * NMOD * D};
        pg8::gemm_phase(F.lds, 512, 512, 256, 4, S, E);
    } if (PT_HI == 17) pt1 = __builtin_amdgcn_s_memrealtime(); }
    if (PT_LO >= 0 && F.bid == 0 && F.tid == 0) { const unsigned long long tend = __builtin_amdgcn_s_memrealtime() + (unsigned long long)PT_AMP * (pt1 - pt0);
        while (__builtin_amdgcn_s_memrealtime() < tend) __builtin_amdgcn_s_sleep(8); }
#undef IN
#undef SEAM
}

extern "C" void kernel_launch(void* const* d_in, const int* in_sizes, int n_in, void* d_out, int out_size, void* d_ws, size_t ws_size, hipStream_t stream) {
    static int grid = 0;
    if (grid == 0) {
        if (n_in != 30 || in_sizes[0] != NLAT * D || out_size != NLAT * D || ws_size < WS_END) { fprintf(stderr, "kernel_launch: unexpected shapes (n_in %d, in0 %d, out %d, ws %zu)\n", n_in, n_in > 0 ? in_sizes[0] : -1, out_size, ws_size); grid = -1; return; }
        int dev = 0, cus = 0, per_cu = 0;
        if (hipGetDevice(&dev) != hipSuccess || hipDeviceGetAttribute(&cus, hipDeviceAttributeMultiprocessorCount, dev) != hipSuccess) { grid = -1; return; }
        if (hipFuncSetAttribute((const void*)fwd, hipFuncAttributeMaxDynamicSharedMemorySize, LDS_BYTES) != hipSuccess) { fprintf(stderr, "kernel_launch: hipFuncSetAttribute failed\n"); grid = -1; return; }
        if (hipOccupancyMaxActiveBlocksPerMultiprocessor(&per_cu, (const void*)fwd, 512, LDS_BYTES) != hipSuccess || per_cu < 1) fprintf(stderr, "kernel_launch: occupancy query reports %d\n", per_cu);
        (void)hipGetLastError();
        grid = cus;
    }
    if (grid < 0) return;
    if (hipMemsetAsync((char*)d_ws + WS_CTL, 0, CTL_ZERO_BYTES, stream) != hipSuccess) return;
    Args a{};
    for (int i = 0; i < 30; ++i) a.in[i] = (const float*)d_in[i];
    a.out = (float*)d_out; a.ws = (unsigned char*)d_ws;
    const int last = MK_LAST_PHASE < NPHASE - 1 ? MK_LAST_PHASE : NPHASE - 1;
#if MK_ONE_LAUNCH
    a.ph_lo = 0; a.ph_hi = last + 1;
    hipLaunchKernelGGL(fwd, dim3(grid), dim3(512), LDS_BYTES, stream, a);
#else
    for (int p = 0; p <= last; ++p) { a.ph_lo = p; a.ph_hi = p + 1; hipLaunchKernelGGL(fwd, dim3(grid), dim3(512), LDS_BYTES, stream, a); }
#endif
    const hipError_t le = hipPeekAtLastError();
    if (le != hipSuccess) fprintf(stderr, "kernel_launch: launch failed: %s\n", hipGetErrorName(le));
}
```

```cpp
#include <hip/hip_runtime.h>
#include <cstdio>
#include <cstdint>

#ifndef MK_ONE_LAUNCH
#define MK_ONE_LAUNCH 1
#endif
#ifndef MK_LAST_PHASE
#define MK_LAST_PHASE 99
#endif

#ifndef PROBE_REP
#define PROBE_REP 0
#endif
#define PT_LO -1
#define PT_HI -1
#define PT_AMP 4
#define PT_PRE 0
#define PT_SUB 0

#define GAS __attribute__((address_space(1)))
#define LAS __attribute__((address_space(3)))
typedef unsigned short bf16_t;
typedef short bf16x8 __attribute__((ext_vector_type(8)));
typedef short s16x4 __attribute__((ext_vector_type(4)));
typedef float f32x4 __attribute__((ext_vector_type(4)));
typedef float f32x2 __attribute__((ext_vector_type(2)));
typedef float f32x16 __attribute__((ext_vector_type(16)));
typedef unsigned u32x4 __attribute__((ext_vector_type(4)));
typedef unsigned u32x2 __attribute__((ext_vector_type(2)));

constexpr int D = 1024, NB = 8, SEQ = 4096, CTXL = 256, TPB = SEQ + CTXL;
constexpr int NTOK = NB * TPB, NLAT = NB * SEQ, NCTX = NB * CTXL;
constexpr int NMOD = 6;
constexpr float EPS = 1e-6f;
constexpr int NEXP = 32, NBUCK = 48, DEXP = 256, LCAP = NTOK;
constexpr int PW = 2048;
constexpr int UW = 1536;
constexpr int PC_CQ = 0, PC_QD = 256, PC_CKV = 768, PC_KROPE = 896, PC_KD = 960, PC_VD = 1472;
constexpr float LAM_INIT = 0.35550906759096934f;
constexpr int MOE_MAXT = NTOK / 256 + NBUCK;

constexpr size_t MiB = 1u << 20;
constexpr size_t WS_CTL = 0, CTL_ZERO_BYTES = 3 * MiB;
constexpr size_t WS_MOD = 2 * MiB;
constexpr size_t WS_COS = 3 * MiB, WS_SIN = 3 * MiB + 512 * 1024;
constexpr size_t WS_XC = 4 * MiB;
constexpr size_t WS_LIST = 12 * MiB;
constexpr size_t WS_TW = 19 * MiB;
constexpr size_t WS_WIN0 = 20 * MiB, WS_WOUT0 = 23 * MiB, WS_WIN1 = 25 * MiB, WS_WUQ = 29 * MiB, WS_WUKV = 29 * MiB + 512 * 1024, WS_WOUT1 = 30 * MiB, WS_WPOOL = 32 * MiB;
constexpr size_t WS_WM1 = 33 * MiB;
constexpr size_t WS_WM2 = 97 * MiB;
constexpr size_t WS_H = 129 * MiB;
constexpr size_t WS_BIG = 197 * MiB;
constexpr size_t WS_YMIX = 333 * MiB;
constexpr size_t WS_QM = 401 * MiB;
constexpr size_t WS_KM = 449 * MiB;
constexpr size_t WS_END = 500 * MiB;
constexpr size_t WS_STASH = WS_WM1;
constexpr int CW_BAR = 4096;
constexpr int CW_CNT = 16384;

constexpr int LDS_BYTES = 155648;
constexpr int LDS_CTL = 153600;

__device__ __forceinline__ unsigned cvt_pk_bf16(float lo, float hi) { unsigned r; asm volatile("v_cvt_pk_bf16_f32 %0, %1, %2" : "=v"(r) : "v"(lo), "v"(hi)); return r; }
__device__ __forceinline__ float bf2f(unsigned short u) { return __uint_as_float((unsigned)u << 16); }
__device__ __forceinline__ float bflo(unsigned w) { return __uint_as_float(w << 16); }
__device__ __forceinline__ float bfhi(unsigned w) { return __uint_as_float(w & 0xffff0000u); }
__device__ __forceinline__ unsigned short f2bf(float f) { return (unsigned short)(cvt_pk_bf16(f, 0.f) & 0xffffu); }
__device__ __forceinline__ float wave_sum(float v) {
#pragma unroll
    for (int o = 1; o < 64; o <<= 1) v += __shfl_xor(v, o);
    return v;
}
__device__ __forceinline__ float sigmoidf_(float x) { return 1.f / (1.f + __expf(-x)); }
__device__ __forceinline__ float siluf_(float x) { return x / (1.f + __expf(-x)); }
__device__ __forceinline__ int crow(int r, int hi) { return (r & 3) + 8 * (r >> 2) + 4 * hi; }
#define LDS_WAIT() asm volatile("s_waitcnt lgkmcnt(0)" ::: "memory")
#define VM_WAIT() asm volatile("s_waitcnt vmcnt(0)" ::: "memory")

#define XB_TMO      128
#define XB_XCNT(j)  (256  + 64 * (j))
#define XB_XSUB(j)  (1280 + 64 * (j))
#define XB_XGEN(j)  (2304 + 64 * (j))
#define XB_TOP      3328
#define XB_TOPGEN   3392
#define XCD_BAR_WORDS 3456
#define XB_SPIN_CAP (1u << 18)
__device__ __forceinline__ unsigned xb_ld(unsigned* p)              { return __hip_atomic_load(p, __ATOMIC_RELAXED, __HIP_MEMORY_SCOPE_AGENT); }
__device__ __forceinline__ unsigned xb_add(unsigned* p, unsigned v) { return __hip_atomic_fetch_add(p, v, __ATOMIC_RELAXED, __HIP_MEMORY_SCOPE_AGENT); }
__device__ __forceinline__ unsigned xb_xcc_id() { return (unsigned)__builtin_amdgcn_s_getreg((3 << 11) | 20) & 0xFu; }
#define XB_SPIN(cond, bar) do { unsigned _sp = 0; while (cond) { __builtin_amdgcn_s_sleep(1); \
    if ((++_sp & 255u) == 0u) { if (xb_ld(&(bar)[XB_TMO])) break; if (_sp > XB_SPIN_CAP) { atomicAdd(&(bar)[XB_TMO], 1u); break; } } } } while (0)
struct XcdBarrier { unsigned* bar; unsigned x; volatile LAS unsigned* st; };
__device__ __forceinline__ XcdBarrier xcd_barrier_post(unsigned* bar, volatile LAS unsigned* st) {
    XcdBarrier b; b.bar = bar; b.x = xb_xcc_id(); b.st = st;
    if (threadIdx.x == 0) (void)xb_add(&bar[XB_XCNT(b.x)], 1u);
    return b;
}
__device__ __forceinline__ void xcd_barrier_complete(unsigned* bar, unsigned x, unsigned& nloc, unsigned& nx) {
    const unsigned G = gridDim.x * gridDim.y * gridDim.z;
    unsigned sum, cnt, mine, sp = 0u;
    for (;;) {
        sum = 0u; cnt = 0u; mine = 0u;
#pragma unroll
        for (unsigned j = 0; j < 16; ++j) { const unsigned c = xb_ld(&bar[XB_XCNT(j)]); sum += c; cnt += (c > 0u) ? 1u : 0u; mine = (j == x) ? c : mine; }
        if (sum == G) break;
        __builtin_amdgcn_s_sleep(1);
        if ((++sp & 255u) == 0u) { if (xb_ld(&bar[XB_TMO])) break; if (sp > XB_SPIN_CAP) { atomicAdd(&bar[XB_TMO], 1u); break; } }
    }
    nloc = mine > 0u ? mine : 1u; nx = cnt > 0u ? cnt : 1u;
}
__device__ __forceinline__ void xcd_barrier(const XcdBarrier& b) {
    asm volatile("s_waitcnt vmcnt(0)" ::: "memory");
    __syncthreads();
    if (threadIdx.x == 0) {
        unsigned* bar = b.bar;
        __builtin_amdgcn_s_waitcnt(0);
        unsigned nloc = b.st[0], nx = b.st[1];
        if (nloc == 0u) { xcd_barrier_complete(bar, b.x, nloc, nx); b.st[0] = nloc; b.st[1] = nx; }
        const unsigned old = xb_add(&bar[XB_XSUB(b.x)], 1u);
        const unsigned gen = old / nloc;
        if (old + 1u == (gen + 1u) * nloc) {
            __builtin_amdgcn_fence(__ATOMIC_RELEASE, "agent");
            asm volatile("s_waitcnt vmcnt(0)" ::: "memory");
            const unsigned og = xb_add(&bar[XB_TOP], 1u);
            const unsigned tg = og / nx;
            if (og + 1u == (tg + 1u) * nx) xb_add(&bar[XB_TOPGEN], 1u);
            else XB_SPIN(xb_ld(&bar[XB_TOPGEN]) == tg, bar);
            __builtin_amdgcn_fence(__ATOMIC_ACQUIRE, "agent");
            xb_add(&bar[XB_XGEN(b.x)], 1u);
            asm volatile("s_waitcnt vmcnt(0)" ::: "memory");
        } else {
            XB_SPIN(xb_ld(&bar[XB_XGEN(b.x)]) == gen, bar);
            __builtin_amdgcn_fence(__ATOMIC_ACQUIRE, "agent");
            asm volatile("s_waitcnt vmcnt(0)" ::: "memory");
        }
    }
    __syncthreads();
}

namespace pg8 {
constexpr int BM = 256, BK = 64, HALF = 128, HTB = HALF * BK * 2, STAGE_BYTES = 8 * HTB, NXCD = 8, WGM = 8;
__device__ __forceinline__ int lds_byte(int r, int c) { const int st = (r >> 4) * 2 + (c >> 5), rr = r & 15, cc = c & 31, ob = rr * 64 + cc * 2; return st * 1024 + (ob ^ (((ob >> 9) & 1) << 5)); }
__device__ __forceinline__ void stage_rc(int b, int& R, int& C) { const int st = b / 1024, sb = b % 1024, swz = sb ^ (((sb >> 9) & 1) << 5); R = (st >> 1) * 16 + swz / 64; C = (st & 1) * 32 + (swz % 64) / 2; }
__device__ __forceinline__ int perm32(int rho) { const int n = rho >> 4, i = rho & 15; return 8 * (i >> 2) + 4 * n + (i & 3); }

struct Unit {
    int pm, pn, po;
    const char* A;
    const char* B;
    const char* B2;
    const int* rows;
    int nvalid, aux;
};

template <class Epi, class Sched>
__device__ __forceinline__ void gemm_phase(LAS unsigned char* lds, int K, int lda, int ldb, int ksplit, const Sched& S, const Epi& E) {
    asm volatile("" : "+s"(K), "+s"(lda), "+s"(ldb), "+s"(ksplit));
    const int tid = threadIdx.x, wid = __builtin_amdgcn_readfirstlane(tid >> 6), lane = tid & 63, wr = wid >> 2, wc = wid & 3, fr = lane & 15, fq = lane >> 4;
    const int nt = K / BK;
    unsigned voffB[2];
#pragma unroll
    for (int i = 0; i < 2; ++i) { int R, C; stage_rc(tid * 16 + i * 8192, R, C); const int Rb = (R & ~31) + perm32(R & 31); voffB[i] = (unsigned)(Rb * ldb + C) * 2u; }
    const size_t kstep = (size_t)(BK * 2);
    const size_t hstepB = (size_t)HALF * ldb * 2;
    const unsigned ldsw = (unsigned)wid * 1024u;
    const int aoff = lds_byte(wr * 64 + fr, fq * 8), boff = lds_byte(wc * 32 + fr, fq * 8);
#define PG8_SA(b, h) (((b) * 2 + (h)) * HTB)
#define PG8_SB(b, h) ((4 + (b) * 2 + (h)) * HTB)
#define PG8_STAGE(bufoff, gbase, voff) do { _Pragma("unroll") for (int _i = 0; _i < 2; ++_i) \
        __builtin_amdgcn_global_load_lds((const unsigned*)((const char*)(gbase) + (voff)[_i]), (LAS unsigned*)(lds + (bufoff) + ldsw + _i * 8192), 16, 0, 0); } while (0)
#define PG8_LDA(dst, b, h) do { _Pragma("unroll") for (int m = 0; m < 4; ++m) _Pragma("unroll") for (int k = 0; k < 2; ++k) dst[m][k] = *(const LAS bf16x8*)(lds + PG8_SA(b, h) + aoff + m * 2048 + k * 1024); } while (0)
#define PG8_LDB(dst, b, h) do { _Pragma("unroll") for (int n = 0; n < 2; ++n) _Pragma("unroll") for (int k = 0; k < 2; ++k) dst[n][k] = *(const LAS bf16x8*)(lds + PG8_SB(b, h) + boff + n * 2048 + k * 1024); } while (0)
#define PG8_MMA(ai, bj, At, Bt) do { __builtin_amdgcn_s_setprio(1); _Pragma("unroll") for (int m = 0; m < 4; ++m) _Pragma("unroll") for (int n = 0; n < 2; ++n) _Pragma("unroll") for (int k = 0; k < 2; ++k) \
        acc[ai][bj][m][n] = __builtin_amdgcn_mfma_f32_16x16x32_bf16(Bt[n][k], At[m][k], acc[ai][bj][m][n], 0, 0, 0); __builtin_amdgcn_s_setprio(0); } while (0)
#define PG8_WAIT_V(n) asm volatile("s_waitcnt vmcnt(" #n ")" ::: "memory")
#define PG8_WAIT_L(n) asm volatile("s_waitcnt lgkmcnt(" #n ")" ::: "memory")
#define PG8_BAR __builtin_amdgcn_s_barrier()
#define PG8_SCHED __builtin_amdgcn_sched_barrier(0)
#define PG8_BK(u, t) (((t) < ksplit ? (u).B : (u).B2) + (size_t)(t) * kstep)
#define PG8_VOFF(dst, u) do { int _tl = tid; asm volatile("" : "+v"(_tl)); _Pragma("unroll") for (int _h = 0; _h < 2; ++_h) _Pragma("unroll") for (int _i = 0; _i < 2; ++_i) { int _R, _C; stage_rc(_tl * 16 + _i * 8192, _R, _C); int _r = _R + HALF * _h; \
        if constexpr (Sched::GATHER) { const int _rr = _r < (u).nvalid ? _r : 0; _r = (u).rows[_rr]; } dst[_h][_i] = (unsigned)(_r * lda + _C) * 2u; } } while (0)
    Unit cur, nxt; int ui = 0;
    if (!S.next(0, cur)) return;
    f32x4 acc[2][2][4][2];
#pragma unroll
    for (int a = 0; a < 2; ++a)
#pragma unroll
        for (int b = 0; b < 2; ++b)
#pragma unroll
            for (int m = 0; m < 4; ++m)
#pragma unroll
                for (int n = 0; n < 2; ++n) acc[a][b][m][n] = (f32x4){0.f, 0.f, 0.f, 0.f};
    bf16x8 At[4][2], B0[2][2], B1[2][2];
    LAS unsigned* VO = (LAS unsigned*)(lds + STAGE_BYTES) + tid;
#define PG8_VO(slot, h, i) VO[(((slot) & 1) * 4 + (h) * 2 + (i)) * 512]
    unsigned vfix[2][2];
    {
        unsigned vc[2][2];
        PG8_VOFF(vc, cur);
#pragma unroll
        for (int h = 0; h < 2; ++h)
#pragma unroll
            for (int i = 0; i < 2; ++i) { vfix[h][i] = vc[h][i]; if constexpr (Sched::GATHER) PG8_VO(0, h, i) = vc[h][i]; }
        const char* cA0 = cur.A;
        const char* b0 = PG8_BK(cur, 0); const char* b1 = PG8_BK(cur, 1);
        PG8_STAGE(PG8_SB(0, 0), b0, voffB); PG8_STAGE(PG8_SB(0, 1), b0 + hstepB, voffB); PG8_STAGE(PG8_SA(0, 0), cA0, vc[0]); PG8_STAGE(PG8_SA(0, 1), cA0, vc[1]);
        if (wr == 1) PG8_BAR;
        PG8_WAIT_V(2); PG8_BAR;
        PG8_STAGE(PG8_SB(1, 0), b1, voffB); PG8_STAGE(PG8_SA(1, 0), cA0 + kstep, vc[0]); PG8_STAGE(PG8_SB(1, 1), b1 + hstepB, voffB);
        PG8_WAIT_V(6); PG8_BAR;
    }
    const char* cA = cur.A;
    for (;;) {
        const bool has_next = S.next(ui + 1, nxt);
        if (!has_next) nxt = cur;
        if constexpr (Sched::GATHER) { unsigned vn[2][2]; PG8_VOFF(vn, nxt);
#pragma unroll
            for (int h = 0; h < 2; ++h)
#pragma unroll
                for (int i = 0; i < 2; ++i) PG8_VO(ui + 1, h, i) = vn[h][i]; }
        const char* nA = nxt.A;
#pragma nounroll
        for (int t = 0; t < nt; t += 2) {
            const bool last = (t == nt - 2);
            const char* a1 = cA + (size_t)(t + 1) * kstep;
            const char* a2 = last ? nA : cA + (size_t)(t + 2) * kstep;
            const char* a3 = a2 + kstep;
            const char* b2 = last ? PG8_BK(nxt, 0) : PG8_BK(cur, t + 2);
            const char* b3 = last ? PG8_BK(nxt, 1) : PG8_BK(cur, t + 3);
            unsigned v1[2], v2[2][2];
            if constexpr (Sched::GATHER) { const int s2 = last ? ui + 1 : ui;
                v1[0] = PG8_VO(ui, 1, 0); v1[1] = PG8_VO(ui, 1, 1);
#pragma unroll
                for (int h = 0; h < 2; ++h)
#pragma unroll
                    for (int i = 0; i < 2; ++i) v2[h][i] = PG8_VO(s2, h, i);
            } else { v1[0] = vfix[1][0]; v1[1] = vfix[1][1];
#pragma unroll
                for (int h = 0; h < 2; ++h)
#pragma unroll
                    for (int i = 0; i < 2; ++i) v2[h][i] = vfix[h][i]; }
            PG8_LDB(B0, 0, 0); PG8_LDB(B1, 0, 1); PG8_SCHED; PG8_LDA(At, 0, 0); PG8_STAGE(PG8_SA(1, 1), a1, v1);
            PG8_WAIT_V(8); PG8_WAIT_L(0); PG8_BAR; PG8_MMA(0, 0, At, B0); PG8_MMA(0, 1, At, B1); PG8_BAR; PG8_SCHED;
            PG8_LDA(At, 0, 1); PG8_STAGE(PG8_SB(0, 0), b2, voffB); PG8_STAGE(PG8_SB(0, 1), b2 + hstepB, voffB); PG8_STAGE(PG8_SA(0, 0), a2, v2[0]);
            PG8_WAIT_V(8); PG8_WAIT_L(0); PG8_BAR; PG8_MMA(1, 0, At, B0); PG8_MMA(1, 1, At, B1); PG8_BAR; PG8_SCHED;
            PG8_LDB(B0, 1, 0); PG8_LDB(B1, 1, 1); PG8_SCHED; PG8_LDA(At, 1, 0); PG8_STAGE(PG8_SA(0, 1), a2, v2[1]);
            PG8_WAIT_V(8); PG8_WAIT_L(0); PG8_BAR; PG8_MMA(0, 0, At, B0); PG8_MMA(0, 1, At, B1); PG8_BAR; PG8_SCHED;
            PG8_LDA(At, 1, 1); PG8_STAGE(PG8_SB(1, 0), b3, voffB); PG8_STAGE(PG8_SB(1, 1), b3 + hstepB, voffB); PG8_STAGE(PG8_SA(1, 0), a3, v2[0]);
            PG8_WAIT_V(8); PG8_WAIT_L(0); PG8_BAR; PG8_MMA(1, 0, At, B0); PG8_MMA(1, 1, At, B1); PG8_BAR; PG8_SCHED;
        }
        if (wr == 0) PG8_BAR;
        E(acc, cur, wr, wc, fr, fq);
        if (!has_next) break;
#pragma unroll
        for (int a = 0; a < 2; ++a)
#pragma unroll
            for (int b = 0; b < 2; ++b)
#pragma unroll
                for (int m = 0; m < 4; ++m)
#pragma unroll
                    for (int n = 0; n < 2; ++n) acc[a][b][m][n] = (f32x4){0.f, 0.f, 0.f, 0.f};
        cur = nxt; cA = nA; ++ui;
        if (wr == 1) PG8_BAR;
    }
    PG8_WAIT_V(0);
    PG8_BAR;
#undef PG8_SA
#undef PG8_SB
#undef PG8_STAGE
#undef PG8_LDA
#undef PG8_LDB
#undef PG8_MMA
#undef PG8_WAIT_V
#undef PG8_WAIT_L
#undef PG8_BAR
#undef PG8_SCHED
#undef PG8_BK
#undef PG8_VOFF
#undef PG8_VO
}

struct PlainSched {
    static constexpr bool GATHER = false;
    int nM, nN, nwg, G, c; const char* A; const char* Bt; int lda, ldb, K; int rowmap;
    __device__ __forceinline__ void init(const void* A_, const void* Bt_, int M, int N, int K_, int lda_, int ldb_, int G_, int c_, int rowmap_) {
        A = (const char*)A_; Bt = (const char*)Bt_; nM = M / BM; nN = N / BM; nwg = nM * nN; G = G_; c = c_; lda = lda_; ldb = ldb_; K = K_; rowmap = rowmap_; }
    __device__ __forceinline__ bool next(int i, Unit& u) const {
        const int L = i * G + c; if (L >= nwg) return false;
        int wgid = L; { const int q = nwg / NXCD, r = nwg % NXCD, xcd = wgid % NXCD, off = wgid / NXCD; wgid = (xcd < r ? xcd * (q + 1) : r * (q + 1) + (xcd - r) * q) + off; }
        const int nig = WGM * nN, gid = wgid / nig, fm = gid * WGM, gsz = (nM - fm) < WGM ? (nM - fm) : WGM;
        const int pm = fm + ((wgid % nig) % gsz), pn = (wgid % nig) / gsz;
        u.po = pm; u.pn = pn; u.pm = rowmap ? (pm / 16) * 17 + 1 + (pm % 16) : pm;
        u.A = A + (size_t)u.pm * BM * lda * 2; u.B = Bt + (size_t)pn * BM * ldb * 2; u.B2 = u.B; u.rows = nullptr; u.nvalid = BM; u.aux = 0;
        return true;
    }
};

struct EpiStoreBf16 {
    bf16_t* O; int ldc;
    __device__ __forceinline__ void operator()(const f32x4 (&acc)[2][2][4][2], const Unit& u, int wr, int wc, int fr, int fq) const {
        bf16_t* base = O + (size_t)(u.po * BM + wr * 64 + fr) * ldc + u.pn * BM + wc * 32 + 8 * fq;
#pragma unroll
        for (int ai = 0; ai < 2; ++ai)
#pragma unroll
            for (int m = 0; m < 4; ++m) { bf16_t* rowp = base + (size_t)(ai * HALF + m * 16) * ldc;
#pragma unroll
                for (int bj = 0; bj < 2; ++bj) { const f32x4 v0 = acc[ai][bj][m][0], v1 = acc[ai][bj][m][1];
                    u32x4 w; w.x = cvt_pk_bf16(v0[0], v0[1]); w.y = cvt_pk_bf16(v0[2], v0[3]); w.z = cvt_pk_bf16(v1[0], v1[1]); w.w = cvt_pk_bf16(v1[2], v1[3]);
                    *(u32x4*)(rowp + bj * HALF) = w; } }
    }
};
struct EpiResid {
    const float* x; const float* ctx; float* out; float* xc; const float* modl; int mode;
    __device__ __forceinline__ void operator()(const f32x4 (&acc)[2][2][4][2], const Unit& u, int wr, int wc, int fr, int fq) const {
        const float* src; float* dst; int mrow;
        if (mode == 0) { const int b = u.po / 17, jt = u.po % 17;
            if (jt == 0) { src = ctx + (size_t)b * CTXL * D; dst = xc + (size_t)b * CTXL * D; mrow = 8; }
            else { src = x + ((size_t)b * SEQ + (jt - 1) * 256) * D; dst = out + ((size_t)b * SEQ + (jt - 1) * 256) * D; mrow = b; } }
        else { src = out + (size_t)u.po * BM * D; dst = out + (size_t)u.po * BM * D; mrow = u.po / 16; }
        const float* gate = modl + (size_t)mrow * (NMOD * D) + 2 * D;
        const int col0 = u.pn * BM + wc * 32 + 8 * fq;
        f32x4 gv[2][2];
#pragma unroll
        for (int bj = 0; bj < 2; ++bj)
#pragma unroll
            for (int n = 0; n < 2; ++n) gv[bj][n] = *(const f32x4*)(gate + col0 + bj * HALF + 4 * n);
#pragma unroll
        for (int ai = 0; ai < 2; ++ai)
#pragma unroll
        for (int mp = 0; mp < 2; ++mp) {
            f32x4 sv[2][2][2];
#pragma unroll
            for (int mm = 0; mm < 2; ++mm) { const size_t ro = (size_t)(ai * HALF + wr * 64 + (mp * 2 + mm) * 16 + fr) * D + col0;
#pragma unroll
                for (int bj = 0; bj < 2; ++bj)
#pragma unroll
                    for (int n = 0; n < 2; ++n) sv[mm][bj][n] = *(const f32x4*)(src + ro + bj * HALF + 4 * n); }
            __builtin_amdgcn_sched_barrier(0);
#pragma unroll
            for (int mm = 0; mm < 2; ++mm) { const int m = mp * 2 + mm; const size_t ro = (size_t)(ai * HALF + wr * 64 + m * 16 + fr) * D + col0;
#pragma unroll
                for (int bj = 0; bj < 2; ++bj)
#pragma unroll
                    for (int n = 0; n < 2; ++n) *(f32x4*)(dst + ro + bj * HALF + 4 * n) = sv[mm][bj][n] + gv[bj][n] * acc[ai][bj][m][n]; }
            __builtin_amdgcn_sched_barrier(0);
        }
    }
};
}

struct Args { const float* in[30]; float* out; unsigned char* ws; int ph_lo, ph_hi; };
typedef const __attribute__((address_space(4))) Args& CArgsRef;
#define ARGP() (*({ const __attribute__((address_space(4))) Args* _p = (const __attribute__((address_space(4))) Args*)__builtin_amdgcn_kernarg_segment_ptr(); asm volatile("" : "+s"(_p)); _p; }))
struct Frame {
    LAS unsigned char* lds;
    int tid, lane, wave, G, bid;
    float* out; unsigned char* ws;
    unsigned* ctl;
};
#define WSP(T, off) ((T*)(F.ws + (off)))

__device__ __forceinline__ float* xl_row(const Frame& F, int ta) {
    const int b = ta / TPB, j = ta - b * TPB;
    return j < CTXL ? WSP(float, WS_XC) + (size_t)(b * CTXL + j) * D : F.out + ((size_t)b * SEQ + (j - CTXL)) * D;
}

struct TrItem { const float* src; bf16_t* dst; int N, ldo; };
__device__ __forceinline__ void tr_load(const TrItem& t, f32x4 (&v)[8], int lane) {
#pragma unroll
    for (int i = 0; i < 8; ++i) { const int kk = 8 * i + (lane >> 3); v[i] = *(const f32x4*)(t.src + (size_t)kk * t.N + 4 * (lane & 7)); }
}
__device__ __forceinline__ void tr_finish(const TrItem& t, const f32x4 (&v)[8], LAS float* scr, int lane) {
#pragma unroll
    for (int i = 0; i < 8; ++i) { const int kk = 8 * i + (lane >> 3); LAS float* p = scr + kk * 33 + 4 * (lane & 7); p[0] = v[i].x; p[1] = v[i].y; p[2] = v[i].z; p[3] = v[i].w; }
    LDS_WAIT(); asm volatile("" ::: "memory");
    const int c = lane & 7;
#pragma unroll
    for (int j = 0; j < 4; ++j) { const int n = (lane >> 3) + 8 * j; const LAS float* s = scr + (8 * c) * 33 + n;
        u32x4 o; o.x = cvt_pk_bf16(s[0 * 33], s[1 * 33]); o.y = cvt_pk_bf16(s[2 * 33], s[3 * 33]); o.z = cvt_pk_bf16(s[4 * 33], s[5 * 33]); o.w = cvt_pk_bf16(s[6 * 33], s[7 * 33]);
        *(u32x4*)(t.dst + (size_t)n * t.ldo + 8 * c) = o; }
    LDS_WAIT(); asm volatile("" ::: "memory");
}
__device__ __forceinline__ TrItem tr_generic(const float* W, int K, int N, bf16_t* WT, int item) {
    const int nblk = N / 32, kb = item / nblk, nb = item % nblk;
    return TrItem{W + (size_t)(64 * kb) * N + 32 * nb, WT + (size_t)(32 * nb) * K + 64 * kb, N, K};
}

__device__ __forceinline__ void p0_prologue(Frame& F, CArgsRef A, unsigned long long& pt1) {
    const int tid = F.tid, lane = F.lane, wave = F.wave;
    constexpr int NMODU = 96;
    if (F.bid < NMODU) {
        LAS float* SC = (LAS float*)F.lds;
        LAS float* RED = (LAS float*)(F.lds + 36864);
        {
            float cv[18];
#pragma unroll
            for (int q = 0; q < 18; ++q) { const int i = tid + 512 * q, r = i >> 10, k = i & 1023; cv[q] = r < 8 ? A.in[1][r * 1024 + k] : A.in[3][k]; }
            __builtin_amdgcn_sched_barrier(0);
#pragma unroll
            for (int q = 0; q < 18; ++q) SC[tid + 512 * q] = siluf_(cv[q]);
        }
        __syncthreads();
        float* MOD = WSP(float, WS_MOD);
        for (int u = F.bid; u < NMODU; u += F.G) {
            const int l = u / 48, cb = (u % 48) >> 1, kh = u & 1;
            const float* W = A.in[4] + (size_t)l * D * (NMOD * D) + cb * 256 + 4 * lane;
            f32x4 a[9];
#pragma unroll
            for (int r = 0; r < 9; ++r) a[r] = (f32x4){0.f, 0.f, 0.f, 0.f};
#pragma unroll 1
            for (int kk0 = 0; kk0 < 64; kk0 += 16) { const int k0 = kh * 512 + 64 * wave + kk0;
                f32x4 w[16];
#pragma unroll
                for (int i = 0; i < 16; ++i) w[i] = *(const f32x4*)(W + (size_t)(k0 + i) * (NMOD * D));
                __builtin_amdgcn_sched_barrier(0);
#pragma unroll
                for (int i = 0; i < 16; ++i)
#pragma unroll
                    for (int r = 0; r < 9; ++r) a[r] += w[i] * SC[r * 1024 + k0 + i]; }
#pragma unroll
            for (int r = 0; r < 9; ++r) *(LAS f32x4*)(RED + (wave * 9 + r) * 256 + 4 * lane) = a[r];
            __syncthreads();
            {
                float bs[5];
#pragma unroll
                for (int q = 0; q < 5; ++q) { const int o = tid + 512 * q; bs[q] = (kh == 0 && o < 9 * 256) ? A.in[5][l * (NMOD * D) + cb * 256 + (o & 255)] : 0.f; }
#pragma unroll
                for (int q = 0; q < 5; ++q) { const int o = tid + 512 * q; if (o < 9 * 256) { const int r = o >> 8, cc = o & 255; float sm = 0.f;
#pragma unroll
                    for (int w = 0; w < 8; ++w) sm += RED[(w * 9 + r) * 256 + cc];
                    atomicAdd(&MOD[((size_t)l * 9 + r) * (NMOD * D) + cb * 256 + cc], sm + bs[q]); } }
            }
            __syncthreads();
        }
    }
    if (PT_SUB == 1) pt1 = __builtin_amdgcn_s_memrealtime();
    {
        const float invf[16] = {1.000000000e+00f, 5.623413324e-01f, 3.162277639e-01f, 1.778279394e-01f, 1.000000015e-01f, 5.623413250e-02f, 3.162277490e-02f, 1.778279431e-02f,
                                9.999999776e-03f, 5.623413250e-03f, 3.162277630e-03f, 1.778279431e-03f, 1.000000047e-03f, 5.623413017e-04f, 3.162277571e-04f, 1.778279402e-04f};
        float* COS = WSP(float, WS_COS); float* SIN = WSP(float, WS_SIN);
        for (int i = F.bid * 512 + tid; i < SEQ * 32; i += F.G * 512) {
            const int pos = i >> 5, j = i & 31, f = j & 15; const float p = (float)(j < 16 ? (pos >> 6) : (pos & 63));
            float fr = 1.f;
#pragma unroll
            for (int q = 0; q < 16; ++q) fr = (f == q) ? invf[q] : fr;
            const float angf = p * fr; const double x = (double)angf;
            const double n = __builtin_rint(x * 0.63661977236758134308);
            const double y = (x - n * 1.57079632679489655800e+00) - n * 6.12323399573676603587e-17;
            const double y2 = y * y;
            double sn = y * (1.0 + y2 * (-1.0 / 6 + y2 * (1.0 / 120 + y2 * (-1.0 / 5040 + y2 * (1.0 / 362880 + y2 * (-1.0 / 39916800 + y2 * (1.0 / 6227020800.0)))))));
            double cs = 1.0 + y2 * (-0.5 + y2 * (1.0 / 24 + y2 * (-1.0 / 720 + y2 * (1.0 / 40320 + y2 * (-1.0 / 3628800 + y2 * (1.0 / 479001600.0 + y2 * (-1.0 / 87178291200.0)))))));
            const int q4 = ((int)n) & 3;
            const double c = (q4 == 0) ? cs : (q4 == 1) ? -sn : (q4 == 2) ? -cs : sn;
            const double s = (q4 == 0) ? sn : (q4 == 1) ? cs : (q4 == 2) ? -sn : -cs;
            COS[i] = (float)c; SIN[i] = (float)s;
        }
    }
    if (PT_SUB == 2) pt1 = __builtin_amdgcn_s_memrealtime();
    {
        LAS float* scr = (LAS float*)(F.lds + wave * 16384);
        constexpr int I_IN0 = 16 * 48, I_OUT = 16 * 32, I_IN1 = 16 * 62, I_UQ = 4 * 24, I_UKV = 2 * 32, I_POOL = 4 * 8, I_MOE = 64 * 384;
        constexpr int NIT = I_IN0 + I_OUT + I_IN1 + I_UQ + I_UKV + I_OUT + I_POOL + I_MOE;
        int it0, it1, step;
        if (F.G == 256) {
            const int wv = F.bid * 8 + wave;
            it0 = F.bid < NMODU ? wv * 12 : NMODU * 8 * 12 + (wv - NMODU * 8) * 15; it1 = it0 + (F.bid < NMODU ? 12 : 15); if (it1 > NIT) it1 = NIT; if (it0 > NIT) it0 = NIT; step = 1;
            static_assert(NMODU * 8 * 12 + (256 - NMODU) * 8 * 15 >= NIT, "prologue item split");
        } else { it0 = F.bid * 8 + wave; it1 = NIT; step = F.G * 8; }
        unsigned char* ws_ = F.ws;
        auto item_of = [&](int it) -> TrItem {
            int r = it;
            if (r < I_IN0) return tr_generic(A.in[7], D, 1536, (bf16_t*)(ws_ + WS_WIN0), r); r -= I_IN0;
            if (r < I_OUT) return tr_generic(A.in[14], D, D, (bf16_t*)(ws_ + WS_WOUT0), r); r -= I_OUT;
            if (r < I_IN1) return tr_generic(A.in[15], D, 1984, (bf16_t*)(ws_ + WS_WIN1), r); r -= I_IN1;
            if (r < I_UQ) return tr_generic(A.in[17], 256, 768, (bf16_t*)(ws_ + WS_WUQ), r); r -= I_UQ;
            if (r < I_UKV) return tr_generic(A.in[19], 128, 1024, (bf16_t*)(ws_ + WS_WUKV), r); r -= I_UKV;
            if (r < I_OUT) return tr_generic(A.in[24], D, D, (bf16_t*)(ws_ + WS_WOUT1), r); r -= I_OUT;
            if (r < I_POOL) { const int g = r / 8; return tr_generic(A.in[12] + (size_t)g * 128 * 128, 128, 128, (bf16_t*)(ws_ + WS_WPOOL) + (size_t)g * 128 * 128, r % 8); } r -= I_POOL;
            const int le = r / 384, q = r % 384;
            bf16_t* W1 = (bf16_t*)(ws_ + WS_WM1) + (size_t)le * 512 * 1024; bf16_t* W2 = (bf16_t*)(ws_ + WS_WM2) + (size_t)le * 1024 * 256;
            if (q < 256) {
                const int up = q >> 7, item = q & 127, kb = item / 8, nb = item % 8, n0 = 32 * nb;
                const float* W = A.in[up ? 28 : 27] + (size_t)le * 1024 * 256;
                const int drow = (n0 >> 7) * 256 + up * 128 + (n0 & 127);
                return TrItem{W + (size_t)(64 * kb) * 256 + n0, W1 + (size_t)drow * 1024 + 64 * kb, 256, 1024};
            }
            return tr_generic(A.in[29] + (size_t)le * 256 * 1024, 256, 1024, W2, q - 256);
        };
        for (int it = it0; it < it1; it += 4 * step) {
            TrItem t0 = item_of(it), t1 = item_of(it + step < it1 ? it + step : it), t2 = item_of(it + 2 * step < it1 ? it + 2 * step : it), t3 = item_of(it + 3 * step < it1 ? it + 3 * step : it);
            f32x4 v0[8], v1[8], v2[8], v3[8];
            tr_load(t0, v0, lane); tr_load(t1, v1, lane); tr_load(t2, v2, lane); tr_load(t3, v3, lane);
            __builtin_amdgcn_sched_barrier(0);
            tr_finish(t0, v0, scr, lane);
            if (it + step < it1) tr_finish(t1, v1, scr, lane);
            if (it + 2 * step < it1) tr_finish(t2, v2, scr, lane);
            if (it + 3 * step < it1) tr_finish(t3, v3, scr, lane);
        }
        { u32x4* z = (u32x4*)(WSP(bf16_t, WS_WIN1) + (size_t)1984 * 1024); const u32x4 zero = {0u, 0u, 0u, 0u};
          for (int i = F.bid * 512 + tid; i < 64 * 1024 / 8; i += F.G * 512) z[i] = zero; }
    }
}

__device__ __forceinline__ void norm_mod_phase(Frame& F, CArgsRef A, int layer) {
    const int gw = F.bid * 8 + F.wave, NGW = F.G * 8, lane = F.lane;
    const float* g = A.in[6] + (size_t)(layer * 2 + 0) * D;
    const float* MODL = WSP(float, WS_MOD) + (size_t)layer * 9 * (NMOD * D);
    bf16_t* H = WSP(bf16_t, WS_H);
    f32x4 gvec[4];
#pragma unroll
    for (int q = 0; q < 4; ++q) gvec[q] = *(const f32x4*)(g + 4 * lane + 256 * q);
    for (int ta0 = gw; ta0 < NTOK; ta0 += 2 * NGW) {
        const int ta1 = ta0 + NGW; const bool has1 = ta1 < NTOK;
        f32x4 v[2][4], s4[2][4], h4[2][4];
#pragma unroll
        for (int e = 0; e < 2; ++e) { const int ta = e ? (has1 ? ta1 : ta0) : ta0; const int b = ta / TPB, j = ta - b * TPB, mrow = j < CTXL ? 8 : b;
            const float* src = layer == 0 ? (j < CTXL ? A.in[2] + (size_t)(b * CTXL + j) * D : A.in[0] + ((size_t)b * SEQ + (j - CTXL)) * D) : xl_row(F, ta);
            const f32x4* xr = (const f32x4*)src + lane;
            const float* sh = MODL + (size_t)mrow * (NMOD * D); const float* sc = sh + D;
#pragma unroll
            for (int q = 0; q < 4; ++q) { v[e][q] = xr[64 * q]; s4[e][q] = *(const f32x4*)(sc + 4 * lane + 256 * q); h4[e][q] = *(const f32x4*)(sh + 4 * lane + 256 * q); } }
        __builtin_amdgcn_sched_barrier(0);
#pragma unroll
        for (int e = 0; e < 2; ++e) { const int ta = e ? ta1 : ta0; if (e && !has1) break;
            float s = 0.f;
#pragma unroll
            for (int q = 0; q < 4; ++q) s += (v[e][q].x * v[e][q].x + v[e][q].y * v[e][q].y) + (v[e][q].z * v[e][q].z + v[e][q].w * v[e][q].w);
            const float r = 1.f / sqrtf(wave_sum(s) * (1.f / D) + EPS);
            u32x2* o8 = (u32x2*)(H + (size_t)ta * D) + lane;
#pragma unroll
            for (int q = 0; q < 4; ++q) { const f32x4 y = (v[e][q] * r) * gvec[q] * (s4[e][q] + 1.f) + h4[e][q];
                u32x2 w; w.x = cvt_pk_bf16(y.x, y.y); w.y = cvt_pk_bf16(y.z, y.w); o8[64 * q] = w; } }
    }
}

__device__ __forceinline__ void convpool_phase(Frame& F, CArgsRef A, unsigned long long& pt1) {
    const int tid = F.tid, lane = F.lane, wave = F.wave, r32 = lane & 31, hi = lane >> 5;
    const bf16_t* __restrict__ U = WSP(bf16_t, WS_BIG); bf16_t* __restrict__ Y = WSP(bf16_t, WS_YMIX); const bf16_t* __restrict__ WP = WSP(bf16_t, WS_WPOOL);
    {
        LAS bf16_t* GL = (LAS bf16_t*)F.lds;
        LAS float* CV = (LAS float*)(F.lds + 63488);
        const int c0 = wave * 64 + lane;
        float w0[31];
#pragma unroll
        for (int k = 0; k < 31; ++k) w0[k] = A.in[8][k * 512 + c0];
        const float dwb = A.in[9][c0];
        const f32x4 lg0 = *(const f32x4*)(A.in[10] + 8 * lane), lg1 = *(const f32x4*)(A.in[10] + 8 * lane + 4), lb0 = *(const f32x4*)(A.in[11] + 8 * lane), lb1 = *(const f32x4*)(A.in[11] + 8 * lane + 4);
#define CP_UNIT(u_, b, n, tb, t0, TS) int b, n, tb, t0, TS; if ((u_) < 1024) { b = (u_) >> 7; n = SEQ; tb = b * TPB + CTXL; t0 = ((u_) & 127) * 32; TS = 32; } else { const int uu = (u_) - 1024; b = uu >> 5; n = CTXL; tb = b * TPB; t0 = (uu & 31) * 8; TS = 8; }
#define CPA_LOAD(u_) do { CP_UNIT(u_, b_, n_, tb_, t0_, TS_); const int nG_ = (TS_ + 30) * 64; (void)b_; \
            _Pragma("unroll") for (int q = 0; q < 8; ++q) { const int ch = q * 512 + tid, ri = ch >> 6, c8 = (ch & 63) * 8, pos = t0_ + ri - 15; const bool ok = (ch < nG_) && pos >= 0 && pos < n_; \
                const bf16_t* up = U + (size_t)(tb_ + (ok ? pos : t0_)) * UW + c8; av[q] = *(const u32x4*)up; gv[q] = *(const u32x4*)(up + 512); } } while (0)
        u32x4 av[8], gv[8];
        if (F.bid < 1280) CPA_LOAD(F.bid);
        for (int u = F.bid; u < 1280; u += F.G) {
            CP_UNIT(u, b, n, tb, t0, TS); (void)b;
            __syncthreads();
            const int nG = (TS + 30) * 64;
#pragma unroll
            for (int q = 0; q < 8; ++q) { const int ch = q * 512 + tid, ri = ch >> 6, c8 = (ch & 63) * 8, pos = t0 + ri - 15; const bool ok = pos >= 0 && pos < n;
                u32x4 o;
#pragma unroll
                for (int e = 0; e < 4; ++e) { const float a0 = bflo(av[q][e]), a1 = bfhi(av[q][e]), g0 = bflo(gv[q][e]), g1 = bfhi(gv[q][e]);
                    o[e] = cvt_pk_bf16(a0 * __builtin_amdgcn_rcpf(1.f + __expf(-g0)), a1 * __builtin_amdgcn_rcpf(1.f + __expf(-g1))); }
                if (!ok) o = (u32x4){0u, 0u, 0u, 0u};
                if (ch < nG) *(LAS u32x4*)(GL + ri * 512 + c8) = o; }
            __builtin_amdgcn_sched_barrier(0);
            if (u + F.G < 1280) CPA_LOAD(u + F.G);
            __builtin_amdgcn_sched_barrier(0);
            __syncthreads();
#pragma unroll 1
            for (int i0 = 0; i0 < TS; i0 += 4) {
                float x0[4];
#pragma unroll
                for (int q = 0; q < 4; ++q) x0[q] = dwb;
#pragma unroll
                for (int r = 0; r < 34; ++r) { const float g0 = bf2f(*(const LAS unsigned short*)(GL + (i0 + r) * 512 + c0));
#pragma unroll
                    for (int q = 0; q < 4; ++q) { const int k = r - q; if (k >= 0 && k < 31) x0[q] += g0 * w0[k]; } }
#pragma unroll
                for (int q = 0; q < 4; ++q) CV[(i0 + q) * 512 + c0] = x0[q];
            }
            __syncthreads();
            for (int tk = wave; tk < TS; tk += 8) {
                const f32x4 v0 = *(const LAS f32x4*)(CV + tk * 512 + 8 * lane), v1 = *(const LAS f32x4*)(CV + tk * 512 + 8 * lane + 4);
                const float sm = wave_sum((v0.x + v0.y) + (v0.z + v0.w) + (v1.x + v1.y) + (v1.z + v1.w));
                const float mean = sm * (1.f / 512.f);
                const f32x4 d0 = v0 - mean, d1 = v1 - mean;
                const float s2 = wave_sum((d0.x * d0.x + d0.y * d0.y) + (d0.z * d0.z + d0.w * d0.w) + (d1.x * d1.x + d1.y * d1.y) + (d1.z * d1.z + d1.w * d1.w));
                const float rstd = 1.f / sqrtf(s2 * (1.f / 512.f) + EPS);
                const f32x4 y0 = d0 * rstd * lg0 + lb0, y1 = d1 * rstd * lg1 + lb1;
                u32x4 o; o.x = cvt_pk_bf16(siluf_(y0.x), siluf_(y0.y)); o.y = cvt_pk_bf16(siluf_(y0.z), siluf_(y0.w)); o.z = cvt_pk_bf16(siluf_(y1.x), siluf_(y1.y)); o.w = cvt_pk_bf16(siluf_(y1.z), siluf_(y1.w));
                *(u32x4*)(Y + (size_t)(tb + t0 + tk) * D + 8 * lane) = o;
            }
        }
    }
    if (PT_SUB == 4) pt1 = __builtin_amdgcn_s_memrealtime();
    {
        LAS bf16_t* UP = (LAS bf16_t*)F.lds;
        LAS bf16_t* PL = (LAS bf16_t*)(F.lds + 49152);
        bf16x8 wfr[2][8]; float pscv[2];
#pragma unroll
        for (int ntile = 0; ntile < 2; ++ntile) { const int gi = wave >> 1, n0 = (wave & 1) * 64 + ntile * 32; pscv[ntile] = A.in[13][gi * 128 + n0 + r32];
#pragma unroll
            for (int ks = 0; ks < 8; ++ks) wfr[ntile][ks] = *(const bf16x8*)(WP + ((size_t)(gi * 128 + n0 + r32)) * 128 + ks * 16 + hi * 8); }
#define CPB_LOAD(u_) do { CP_UNIT(u_, b_, n_, tb_, t0_, TS_); const int nU_ = (TS_ + 16) * 64; (void)b_; \
            _Pragma("unroll") for (int q = 0; q < 6; ++q) { const int ch = q * 512 + tid, ri = ch >> 6, c8 = (ch & 63) * 8, pos = t0_ + ri - 8; const bool ok = (ch < nU_) && pos >= 0 && pos < n_; \
                uv[q] = *(const u32x4*)(U + (size_t)(tb_ + (ok ? pos : t0_)) * UW + 1024 + c8); if (!ok) uv[q] = (u32x4){0u, 0u, 0u, 0u}; } } while (0)
        u32x4 uv[6];
        if (F.bid < 1280) CPB_LOAD(F.bid);
        for (int u = F.bid; u < 1280; u += F.G) {
            CP_UNIT(u, b, n, tb, t0, TS); (void)b;
            __syncthreads();
            const int nU = (TS + 16) * 64;
#pragma unroll
            for (int q = 0; q < 6; ++q) { const int ch = q * 512 + tid, ri = ch >> 6, c8 = (ch & 63) * 8; if (ch < nU) *(LAS u32x4*)(UP + ri * 512 + c8) = uv[q]; }
            __builtin_amdgcn_sched_barrier(0);
            if (u + F.G < 1280) CPB_LOAD(u + F.G);
            __builtin_amdgcn_sched_barrier(0);
            __syncthreads();
#pragma unroll 1
            for (int e = tid; e < 32 * 64; e += 512) { const int i = e >> 6, c8 = (e & 63) * 8, gi = c8 >> 7, hw = 1 << gi, pos = t0 + i;
                u32x4 o = {0u, 0u, 0u, 0u};
                if (i < TS) {
                    const int lo = (pos - hw) > 0 ? (pos - hw) : 0, hh = (pos + hw) < n ? (pos + hw) : n;
                    float s[8];
#pragma unroll
                    for (int j = 0; j < 8; ++j) s[j] = 0.f;
                    for (int p = lo; p < hh; ++p) { const u32x4 v = *(const LAS u32x4*)(UP + (p - t0 + 8) * 512 + c8);
                        s[0] += bflo(v.x); s[1] += bfhi(v.x); s[2] += bflo(v.y); s[3] += bfhi(v.y); s[4] += bflo(v.z); s[5] += bfhi(v.z); s[6] += bflo(v.w); s[7] += bfhi(v.w); }
                    const float ic = 1.f / (float)(hh - lo);
                    const u32x4 v = *(const LAS u32x4*)(UP + (i + 8) * 512 + c8);
                    o.x = cvt_pk_bf16(s[0] * ic - bflo(v.x), s[1] * ic - bfhi(v.x)); o.y = cvt_pk_bf16(s[2] * ic - bflo(v.y), s[3] * ic - bfhi(v.y));
                    o.z = cvt_pk_bf16(s[4] * ic - bflo(v.z), s[5] * ic - bfhi(v.z)); o.w = cvt_pk_bf16(s[6] * ic - bflo(v.w), s[7] * ic - bfhi(v.w)); }
                *(LAS u32x4*)(PL + i * 512 + c8) = o; }
            __syncthreads();
            {
                const int gi = wave >> 1, nh = wave & 1;
#pragma unroll
                for (int ntile = 0; ntile < 2; ++ntile) { const int n0 = nh * 64 + ntile * 32;
                    f32x16 acc = {};
#pragma unroll
                    for (int ks = 0; ks < 8; ++ks) { const bf16x8 a = *(const LAS bf16x8*)(PL + r32 * 512 + gi * 128 + ks * 16 + hi * 8);
                        acc = __builtin_amdgcn_mfma_f32_32x32x16_bf16(a, wfr[ntile][ks], acc, 0, 0, 0); }
                    const float psc = pscv[ntile];
#pragma unroll
                    for (int r = 0; r < 16; ++r) { const int tk = crow(r, hi); if (tk < TS) Y[(size_t)(tb + t0 + tk) * D + 512 + gi * 128 + n0 + r32] = f2bf(acc[r] * psc); } }
            }
        }
    }
#undef CP_UNIT
#undef CPA_LOAD
#undef CPB_LOAD
    __syncthreads();
}

__device__ __forceinline__ void router_phase(Frame& F, CArgsRef A, int layer) {
    const int tid = F.tid, lane = F.lane, wave = F.wave, r32 = lane & 31, hi = lane >> 5;
    LAS float* T = (LAS float*)F.lds;
    LAS float* LOG = (LAS float*)(F.lds + 133120);
    LAS float* BIA = (LAS float*)(F.lds + 133120 + 4224);
    const float rbias = A.in[26][tid & 31];
    LAS float* VA = (LAS float*)(F.lds + 141568);
    LAS float* VB = VA + 1024;
    const float* g = A.in[6] + (size_t)(layer * 2 + 1) * D;
    const float* MODL = WSP(float, WS_MOD) + (size_t)layer * 9 * (NMOD * D);
    bf16_t* H = WSP(bf16_t, WS_H);
    unsigned* CNT = F.ctl + CW_CNT + layer * 64; int* LIST = WSP(int, WS_LIST); f32x2* TW = WSP(f32x2, WS_TW);
    float rwreg[64];
#pragma unroll
    for (int s = 0; s < 64; ++s) rwreg[s] = A.in[25][(size_t)(128 * wave + 2 * s + hi) * NEXP + r32];
    const int ngroups = layer == 0 ? NTOK / 32 : NLAT / 32;
    for (int grp = F.bid; grp < ngroups; grp += F.G) {
        const int ta0 = layer == 0 ? grp * 32 : (grp >> 7) * TPB + CTXL + (grp & 127) * 32;
        __syncthreads();
        {
            f32x4 v[4][4];
#pragma unroll
            for (int q = 0; q < 4; ++q) { const f32x4* xr = (const f32x4*)xl_row(F, ta0 + 4 * wave + q) + lane;
#pragma unroll
                for (int c = 0; c < 4; ++c) v[q][c] = xr[64 * c]; }
            {
                const int b0 = ta0 / TPB, j0 = ta0 - b0 * TPB, mrow = j0 < CTXL ? 8 : b0;
                const float* sh = MODL + (size_t)mrow * (NMOD * D) + 3 * D; const float* sc = sh + D;
                const f32x2 g2 = *(const f32x2*)(g + 2 * tid), s2 = *(const f32x2*)(sc + 2 * tid), h2 = *(const f32x2*)(sh + 2 * tid);
                __builtin_amdgcn_sched_barrier(0);
                *(LAS f32x2*)(VA + 2 * tid) = g2 * (s2 + 1.f); *(LAS f32x2*)(VB + 2 * tid) = h2;
            }
            float rr[4];
#pragma unroll
            for (int q = 0; q < 4; ++q) { float s = 0.f;
#pragma unroll
                for (int c = 0; c < 4; ++c) s += (v[q][c].x * v[q][c].x + v[q][c].y * v[q][c].y) + (v[q][c].z * v[q][c].z + v[q][c].w * v[q][c].w);
                rr[q] = 1.f / sqrtf(wave_sum(s) * (1.f / D) + EPS); }
            __syncthreads();
#pragma unroll
            for (int q = 0; q < 4; ++q) { const int ti = 4 * wave + q, ta = ta0 + ti;
                u32x2* o8 = (u32x2*)(H + (size_t)ta * D) + lane;
#pragma unroll
                for (int c = 0; c < 4; ++c) { const int col = 4 * lane + 256 * c;
                    const f32x4 a4 = *(const LAS f32x4*)(VA + col), b4 = *(const LAS f32x4*)(VB + col);
                    const f32x4 y = (v[q][c] * rr[q]) * a4 + b4;
                    u32x2 w; w.x = cvt_pk_bf16(y.x, y.y); w.y = cvt_pk_bf16(y.z, y.w); o8[64 * c] = w;
                    LAS float* tp = T + ti * 1025 + col; tp[0] = y.x; tp[1] = y.y; tp[2] = y.z; tp[3] = y.w; } }
        }
        __syncthreads();
        f32x16 acc = {};
#pragma unroll
        for (int s = 0; s < 64; ++s) { const float a = T[r32 * 1025 + 128 * wave + 2 * s + hi]; acc = __builtin_amdgcn_mfma_f32_32x32x2f32(a, rwreg[s], acc, 0, 0, 0); }
        __syncthreads();
        { LAS float* RED = T + wave * (32 * 33);
#pragma unroll
          for (int r = 0; r < 16; ++r) RED[crow(r, hi) * 33 + r32] = acc[r]; }
        __syncthreads();
        for (int e = tid; e < 1024; e += 512) { const int tk = e >> 5, ex = e & 31; float s = 0.f;
#pragma unroll
            for (int w = 0; w < 8; ++w) s += T[w * (32 * 33) + tk * 33 + ex];
            const float sg = __builtin_amdgcn_rcpf(1.f + __expf(-s));
            LOG[tk * 33 + ex] = sg; BIA[tk * 33 + ex] = sg + rbias; }
        __syncthreads();
        if (tid < 32) { const int ta = ta0 + tid;
            float bestg = -1e30f, bs1 = 0.f, bs2 = 0.f; int bi1 = 0, bi2 = 1, bgrp = 0;
#pragma unroll
            for (int gq = 0; gq < 8; ++gq) { float sc[4], bb[4];
#pragma unroll
                for (int q = 0; q < 4; ++q) { sc[q] = LOG[tid * 33 + gq * 4 + q]; bb[q] = BIA[tid * 33 + gq * 4 + q]; }
                int i1 = 0; float m1 = bb[0];
#pragma unroll
                for (int q = 1; q < 4; ++q) if (bb[q] > m1) { m1 = bb[q]; i1 = q; }
                int i2 = -1; float m2 = -1e30f;
#pragma unroll
                for (int q = 0; q < 4; ++q) if (q != i1 && bb[q] > m2) { m2 = bb[q]; i2 = q; }
                const float gs = m1 + m2;
                float s1 = sc[0], s2 = sc[0];
#pragma unroll
                for (int q = 1; q < 4; ++q) { s1 = (i1 == q) ? sc[q] : s1; s2 = (i2 == q) ? sc[q] : s2; }
                if (gs > bestg) { bestg = gs; bgrp = gq; bi1 = i1; bi2 = i2; bs1 = s1; bs2 = s2; } }
            const float inv = 1.f / (bs1 + bs2); const float w1 = bs1 * inv, w2 = bs2 * inv;
            const int lo = bi1 < bi2 ? bi1 : bi2, hh = bi1 < bi2 ? bi2 : bi1;
            const float wlo = bi1 < bi2 ? w1 : w2, whi = bi1 < bi2 ? w2 : w1;
            const int pair = (lo == 0) ? (hh - 1) : (lo == 1 ? (hh + 1) : 5);
            const int bucket = bgrp * 6 + pair;
            const unsigned pos = atomicAdd(&CNT[bucket], 1u);
            LIST[(size_t)bucket * LCAP + pos] = ta; TW[ta] = (f32x2){wlo, whi}; }
    }
    __syncthreads();
}

struct MoeSched {
    static constexpr bool GATHER_ = true;
    int G, c, ntiles, layer, stage; const unsigned* cnt; const int* list; const char* A; const char* W; LAS int* pre;
};
template <bool G1> struct MoeSchedT {
    static constexpr bool GATHER = G1;
    MoeSched m;
    __device__ __forceinline__ bool next(int i, pg8::Unit& u) const {
        const int L = i * m.G + m.c; if (L >= m.ntiles * 4) return false;
        const int tile = L >> 2, pn = L & 3;
        int bk = 0;
        for (int q = 1; q < NBUCK; ++q) bk = (m.pre[q] <= tile) ? q : bk;
        const int tin = tile - m.pre[bk], cntb = (int)m.cnt[bk];
        const int grp = bk / 6, pair = bk % 6;
        const int lo = pair < 3 ? 0 : (pair < 5 ? 1 : 2), hh = pair < 3 ? pair + 1 : (pair < 5 ? pair - 1 : 3);
        const int e1 = grp * 4 + lo, e2 = grp * 4 + hh;
        u.pm = tile; u.po = tile; u.pn = pn; u.rows = m.list + (size_t)bk * LCAP + tin * 256; u.nvalid = (cntb - tin * 256) < 256 ? (cntb - tin * 256) : 256; u.aux = pn >> 1;
        if (G1) {
            const int e = (pn < 2) ? e1 : e2;
            u.A = m.A; u.B = m.W + ((size_t)(m.layer * NEXP + e) * 512 + (pn & 1) * 256) * 1024 * 2; u.B2 = u.B;
        } else {
            u.A = m.A + (size_t)tile * 256 * 512 * 2;
            u.B = m.W + ((size_t)(m.layer * NEXP + e1) * 1024 + pn * 256) * 256 * 2;
            u.B2 = m.W + ((size_t)(m.layer * NEXP + e2) * 1024 + pn * 256) * 256 * 2 - (size_t)4 * 128;
        }
        return true;
    }
};
struct EpiMoe1 {
    bf16_t* HE; const f32x2* TW;
    __device__ __forceinline__ void operator()(const f32x4 (&acc)[2][2][4][2], const pg8::Unit& u, int wr, int wc, int fr, int fq) const {
        const int slot = u.aux;
        int tok[8]; f32x2 tw[8];
#pragma unroll
        for (int q = 0; q < 8; ++q) { const int r = (q >> 2) * 128 + wr * 64 + (q & 3) * 16 + fr; tok[q] = u.rows[r < u.nvalid ? r : 0]; }
        __builtin_amdgcn_sched_barrier(0);
#pragma unroll
        for (int q = 0; q < 8; ++q) tw[q] = TW[tok[q]];
        __builtin_amdgcn_sched_barrier(0);
#pragma unroll
        for (int ai = 0; ai < 2; ++ai)
#pragma unroll
            for (int m = 0; m < 4; ++m) { const int r = ai * 128 + wr * 64 + m * 16 + fr; const float w = slot ? tw[ai * 4 + m].y : tw[ai * 4 + m].x;
                float o[8];
#pragma unroll
                for (int n = 0; n < 2; ++n)
#pragma unroll
                    for (int q = 0; q < 4; ++q) { const float gt = acc[ai][0][m][n][q], up = acc[ai][1][m][n][q]; o[4 * n + q] = gt * __builtin_amdgcn_rcpf(1.f + __expf(-gt)) * up * w; }
                u32x4 wv; wv.x = cvt_pk_bf16(o[0], o[1]); wv.y = cvt_pk_bf16(o[2], o[3]); wv.z = cvt_pk_bf16(o[4], o[5]); wv.w = cvt_pk_bf16(o[6], o[7]);
                *(u32x4*)(HE + (size_t)(u.po * 256 + r) * 512 + slot * 256 + (u.pn & 1) * 128 + wc * 32 + 8 * fq) = wv; }
    }
};
struct EpiMoe2 {
    float* out; float* xc; const float* modl;
    __device__ __forceinline__ void operator()(const f32x4 (&acc)[2][2][4][2], const pg8::Unit& u, int wr, int wc, int fr, int fq) const {
        const int col0 = u.pn * 256 + wc * 32 + 8 * fq;
        int tok[8];
#pragma unroll
        for (int q = 0; q < 8; ++q) { const int r = (q >> 2) * 128 + wr * 64 + (q & 3) * 16 + fr; tok[q] = u.rows[r < u.nvalid ? r : 0]; }
        __builtin_amdgcn_sched_barrier(0);
#pragma unroll
        for (int ai = 0; ai < 2; ++ai)
#pragma unroll
        for (int mp = 0; mp < 2; ++mp) {
            f32x4 sv[2][2][2]; float* dp[2]; const float* gp[2];
#pragma unroll
            for (int mm = 0; mm < 2; ++mm) { const int m = mp * 2 + mm; const int tk = tok[ai * 4 + m]; const int b = tk / TPB, j = tk - b * TPB; const int mrow = j < CTXL ? 8 : b;
                gp[mm] = modl + (size_t)mrow * (NMOD * D) + 5 * D + col0;
                dp[mm] = (j < CTXL ? xc + (size_t)(b * CTXL + j) * D : out + ((size_t)b * SEQ + (j - CTXL)) * D) + col0;
#pragma unroll
                for (int bj = 0; bj < 2; ++bj)
#pragma unroll
                    for (int n = 0; n < 2; ++n) sv[mm][bj][n] = *(const f32x4*)(dp[mm] + bj * 128 + 4 * n); }
            __builtin_amdgcn_sched_barrier(0);
#pragma unroll
            for (int mm = 0; mm < 2; ++mm) { const int m = mp * 2 + mm; const int r = ai * 128 + wr * 64 + m * 16 + fr;
                if (r < u.nvalid) {
#pragma unroll
                    for (int bj = 0; bj < 2; ++bj)
#pragma unroll
                        for (int n = 0; n < 2; ++n) { const f32x4 gvv = *(const f32x4*)(gp[mm] + bj * 128 + 4 * n); *(f32x4*)(dp[mm] + bj * 128 + 4 * n) = sv[mm][bj][n] + gvv * acc[ai][bj][m][n]; } } }
            __builtin_amdgcn_sched_barrier(0);
        }
    }
};
__device__ __forceinline__ int moe_prefix(Frame& F, int layer, LAS int* pre) {
    __syncthreads();
    if (F.tid == 0) { int s = 0; const unsigned* cnt = F.ctl + CW_CNT + layer * 64; for (int q = 0; q < NBUCK; ++q) { pre[q] = s; s += ((int)cnt[q] + 255) >> 8; } pre[NBUCK] = s; }
    __syncthreads();
    return pre[NBUCK];
}

__device__ __forceinline__ void p9_phase(Frame& F, CArgsRef A) {
    const int gw = F.bid * 8 + F.wave, NGW = F.G * 8, l = F.lane;
    bf16_t* P = WSP(bf16_t, WS_BIG); const float* COS = WSP(float, WS_COS); const float* SIN = WSP(float, WS_SIN);
    const int kind = l < 8 ? 0 : l < 24 ? 1 : l < 28 ? 2 : l < 30 ? 5 : l < 46 ? 3 : 5;
    float gg[32];
    {
        const float* gp = nullptr;
        if (kind == 0) gp = A.in[16] + 32 * l; else if (kind == 1) gp = A.in[21] + 0 * 64 + (l & 1) * 32; else if (kind == 2) gp = A.in[18] + 32 * (l - 24); else if (kind == 3) gp = A.in[21] + 1 * 64 + (l & 1) * 32;
#pragma unroll
        for (int j = 0; j < 32; ++j) gg[j] = gp ? gp[j] : 1.f;
    }
    for (int tb0 = gw; tb0 < NTOK; tb0 += 2 * NGW) {
        const int tb1 = tb0 + NGW; const bool has1 = tb1 < NTOK;
        u32x4 wq[2][4]; f32x4 csv[2][8], snv[2][8];
#pragma unroll
        for (int e = 0; e < 2; ++e) { const int ta = e ? (has1 ? tb1 : tb0) : tb0; const bf16_t* rp = P + (size_t)ta * PW + 32 * l;
            const int b_ = ta / TPB, jj_ = ta - b_ * TPB; const int pos_ = jj_ >= CTXL ? jj_ - CTXL : 0;
            const f32x4* cp = (const f32x4*)(COS + (size_t)pos_ * 32); const f32x4* sp = (const f32x4*)(SIN + (size_t)pos_ * 32);
#pragma unroll
            for (int q = 0; q < 4; ++q) wq[e][q] = *(const u32x4*)(rp + 8 * q);
#pragma unroll
            for (int q = 0; q < 8; ++q) { csv[e][q] = cp[q]; snv[e][q] = sp[q]; } }
        __builtin_amdgcn_sched_barrier(0);
#pragma unroll
        for (int e = 0; e < 2; ++e) {
            const int ta = e ? tb1 : tb0; if (e && !has1) break;
            const int b = ta / TPB, jj = ta - b * TPB; const bool lat = jj >= CTXL; const int pos = jj - CTXL;
            bf16_t* rowp = P + (size_t)ta * PW + 32 * l;
            float v[32]; float ss = 0.f;
#pragma unroll
            for (int q = 0; q < 4; ++q)
#pragma unroll
                for (int c = 0; c < 4; ++c) { v[8 * q + 2 * c] = bflo(wq[e][q][c]); v[8 * q + 2 * c + 1] = bfhi(wq[e][q][c]); }
#pragma unroll
            for (int j = 0; j < 32; ++j) ss += v[j] * v[j];
            const float s1 = ss + __shfl_xor(ss, 1), s2 = s1 + __shfl_xor(s1, 2), s4 = s2 + __shfl_xor(s2, 4);
            const float tot = kind == 0 ? s4 : kind == 2 ? s2 : s1;
            const float nn = kind == 0 ? 256.f : kind == 2 ? 128.f : 64.f;
            const float r = 1.f / sqrtf(tot / nn + EPS);
            const bool act = (kind == 0 && lat) || (kind == 1 && lat) || kind == 2 || kind == 3;
#pragma unroll
            for (int j = 0; j < 32; ++j) v[j] = v[j] * r * gg[j];
            const bool rope = (kind == 1 || kind == 3) && lat;
            {
#pragma unroll
                for (int j4 = 0; j4 < 8; ++j4) { const f32x4 cs4 = csv[e][j4], sn4 = snv[e][j4];
#pragma unroll
                    for (int c = 0; c < 4; ++c) { const int j = 4 * j4 + c; const float other = __shfl_xor(v[j], 1); const float cs = cs4[c], sn = sn4[c];
                        const float rv = (l & 1) ? (v[j] * cs + other * sn) : (v[j] * cs - other * sn);
                        v[j] = rope ? rv : v[j]; } }
            }
            if (act) {
#pragma unroll
                for (int q = 0; q < 4; ++q) { u32x4 o; o.x = cvt_pk_bf16(v[8 * q], v[8 * q + 1]); o.y = cvt_pk_bf16(v[8 * q + 2], v[8 * q + 3]); o.z = cvt_pk_bf16(v[8 * q + 4], v[8 * q + 5]); o.w = cvt_pk_bf16(v[8 * q + 6], v[8 * q + 7]);
                    *(u32x4*)(rowp + 8 * q) = o; }
            }
        }
    }
}

__device__ __forceinline__ void p11_phase(Frame& F, CArgsRef A) {
    const int gw = F.bid * 8 + F.wave, NGW = F.G * 8, l = F.lane, h = l >> 4, j = l & 15;
    const bf16_t* __restrict__ P = WSP(bf16_t, WS_BIG); bf16_t* __restrict__ QM = WSP(bf16_t, WS_QM); bf16_t* __restrict__ KM = WSP(bf16_t, WS_KM); const bf16_t* __restrict__ KV = WSP(bf16_t, WS_H);
    const float* __restrict__ COS = WSP(float, WS_COS); const float* __restrict__ SIN = WSP(float, WS_SIN);
#define P11_BODY(wa, wb, DST, GP, DOROPE, CSV, SNV) do { \
        float v[12]; \
        _Pragma("unroll") for (int c = 0; c < 4; ++c) { v[2 * c] = bflo(wa[c]); v[2 * c + 1] = bfhi(wa[c]); } \
        v[8] = bflo(wb.x); v[9] = bfhi(wb.x); v[10] = bflo(wb.y); v[11] = bfhi(wb.y); \
        float ss = 0.f; \
        _Pragma("unroll") for (int c = 0; c < 12; ++c) ss += v[c] * v[c]; \
        ss += __shfl_xor(ss, 1); ss += __shfl_xor(ss, 2); ss += __shfl_xor(ss, 4); ss += __shfl_xor(ss, 8); \
        const float r = 1.f / sqrtf(ss * (1.f / 192.f) + EPS); \
        const f32x4 ga = GP##a, gb = GP##b, gc = GP##c; \
        v[0] *= r * ga.x; v[1] *= r * ga.y; v[2] *= r * ga.z; v[3] *= r * ga.w; v[4] *= r * gb.x; v[5] *= r * gb.y; v[6] *= r * gb.z; v[7] *= r * gb.w; \
        v[8] *= r * gc.x; v[9] *= r * gc.y; v[10] *= r * gc.z; v[11] *= r * gc.w; \
        const f32x4 cs = CSV, sn = SNV; \
        _Pragma("unroll") for (int c = 0; c < 4; ++c) { const float other = __shfl_xor(v[8 + c], 8); const float rv = (j < 8) ? (v[8 + c] * cs[c] - other * sn[c]) : (v[8 + c] * cs[c] + other * sn[c]); v[8 + c] = (DOROPE) ? rv : v[8 + c]; } \
        u32x4 oa; oa.x = cvt_pk_bf16(v[0], v[1]); oa.y = cvt_pk_bf16(v[2], v[3]); oa.z = cvt_pk_bf16(v[4], v[5]); oa.w = cvt_pk_bf16(v[6], v[7]); \
        u32x2 ob; ob.x = cvt_pk_bf16(v[8], v[9]); ob.y = cvt_pk_bf16(v[10], v[11]); \
        *(u32x4*)((DST) + 8 * j) = oa; *(u32x2*)((DST) + 128 + 4 * j) = ob; } while (0)
    const f32x4 gqa = *(const f32x4*)(A.in[20] + 8 * j), gqb = *(const f32x4*)(A.in[20] + 8 * j + 4), gqc = *(const f32x4*)(A.in[20] + 128 + 4 * j);
    const f32x4 gka = *(const f32x4*)(A.in[20] + 192 + 8 * j), gkb = *(const f32x4*)(A.in[20] + 192 + 8 * j + 4), gkc = *(const f32x4*)(A.in[20] + 192 + 128 + 4 * j);
    constexpr int NB4 = 4;
    for (int t0 = gw; t0 < NLAT; t0 += NB4 * NGW) {
        u32x4 wa[NB4]; u32x2 wb[NB4]; f32x4 cv[NB4], sv[NB4];
#pragma unroll
        for (int e = 0; e < NB4; ++e) { const int tl = (t0 + e * NGW) < NLAT ? (t0 + e * NGW) : t0; const bf16_t* q = QM + (size_t)tl * 768 + h * 192; wa[e] = *(const u32x4*)(q + 8 * j); wb[e] = *(const u32x2*)(q + 128 + 4 * j);
            const int pos = tl & (SEQ - 1); cv[e] = *(const f32x4*)(COS + (size_t)pos * 32 + 4 * (j & 7)); sv[e] = *(const f32x4*)(SIN + (size_t)pos * 32 + 4 * (j & 7)); }
        __builtin_amdgcn_sched_barrier(0);
#pragma unroll
        for (int e = 0; e < NB4; ++e) { const int tl = t0 + e * NGW; if (tl < NLAT) { bf16_t* q = QM + (size_t)tl * 768 + h * 192;
            P11_BODY(wa[e], wb[e], q, gq, true, cv[e], sv[e]); } }
    }
    for (int t0 = gw; t0 < NTOK; t0 += NB4 * NGW) {
        u32x4 wa[NB4]; u32x2 wb[NB4]; f32x4 cv[NB4], sv[NB4];
#pragma unroll
        for (int e = 0; e < NB4; ++e) { const int ta = (t0 + e * NGW) < NTOK ? (t0 + e * NGW) : t0; wa[e] = *(const u32x4*)(KV + (size_t)ta * 1024 + h * 256 + 8 * j); wb[e] = *(const u32x2*)(P + (size_t)ta * PW + PC_KROPE + 4 * j);
            const int b_ = ta / TPB, jj_ = ta - b_ * TPB; const int pos = jj_ >= CTXL ? jj_ - CTXL : 0; cv[e] = *(const f32x4*)(COS + (size_t)pos * 32 + 4 * (j & 7)); sv[e] = *(const f32x4*)(SIN + (size_t)pos * 32 + 4 * (j & 7)); }
        __builtin_amdgcn_sched_barrier(0);
#pragma unroll
        for (int e = 0; e < NB4; ++e) { const int ta = t0 + e * NGW; if (ta < NTOK) { const int b = ta / TPB, jj = ta - b * TPB; const bool lat = jj >= CTXL;
            bf16_t* k = KM + ((size_t)(b * 4 + h) * TPB + jj) * 192;
            P11_BODY(wa[e], wb[e], k, gk, lat, cv[e], sv[e]); } }
    }
#undef P11_BODY
}

#define SBAR() __builtin_amdgcn_sched_barrier(0)
__device__ __forceinline__ void partialSM(f32x16& p0, f32x16& p1, float& m_reg, float& mn, float& alpha, const float C, const float thr) {
    float pmax = p0[0];
#pragma unroll
    for (int r = 1; r < 16; ++r) pmax = fmaxf(pmax, p0[r]);
#pragma unroll
    for (int r = 0; r < 16; ++r) pmax = fmaxf(pmax, p1[r]);
    { auto rr = __builtin_amdgcn_permlane32_swap(__float_as_uint(pmax), __float_as_uint(pmax), false, false);
      pmax = fmaxf(__uint_as_float(rr[0]), __uint_as_float(rr[1])); }
    if (__builtin_expect(__all(pmax - m_reg <= thr), 1)) { mn = m_reg; alpha = 1.f; }
    else { mn = fmaxf(m_reg, pmax); alpha = __builtin_amdgcn_exp2f((m_reg - mn) * C); m_reg = mn; }
    const float mnC = -mn * C;
#pragma unroll
    for (int r = 0; r < 16; ++r) p0[r] = fmaf(p0[r], C, mnC);
#pragma unroll
    for (int r = 0; r < 16; ++r) p1[r] = fmaf(p1[r], C, mnC);
#pragma unroll
    for (int r = 0; r < 16; ++r) p0[r] = __builtin_amdgcn_exp2f(p0[r]);
}
__device__ __forceinline__ void finishSM(f32x16& p0, f32x16& p1, float alpha, float& l_reg, bf16x8& pa0, bf16x8& pa1, bf16x8& pa2, bf16x8& pa3) {
#pragma unroll
    for (int r = 0; r < 16; ++r) p1[r] = __builtin_amdgcn_exp2f(p1[r]);
    float ps = 0;
#pragma unroll
    for (int r = 0; r < 16; ++r) ps += p0[r];
#pragma unroll
    for (int r = 0; r < 16; ++r) ps += p1[r];
    { auto rr = __builtin_amdgcn_permlane32_swap(__float_as_uint(ps), __float_as_uint(ps), false, false);
      ps = __uint_as_float(rr[0]) + __uint_as_float(rr[1]); }
    l_reg = l_reg * alpha + ps;
#define PK4(P, BASE, OUT) do { unsigned a0 = cvt_pk_bf16(P[BASE + 0], P[BASE + 1]), a1 = cvt_pk_bf16(P[BASE + 2], P[BASE + 3]);   \
    unsigned b0 = cvt_pk_bf16(P[BASE + 4], P[BASE + 5]), b1 = cvt_pk_bf16(P[BASE + 6], P[BASE + 7]);                              \
    auto r0 = __builtin_amdgcn_permlane32_swap(a0, b0, false, false); auto r1 = __builtin_amdgcn_permlane32_swap(a1, b1, false, false); \
    u32x4 w = {r0[0], r1[0], r0[1], r1[1]}; OUT = *reinterpret_cast<bf16x8*>(&w); } while (0)
    PK4(p0, 0, pa0); PK4(p0, 8, pa1); PK4(p1, 0, pa2); PK4(p1, 8, pa3);
#undef PK4
}
__device__ __forceinline__ void partialSM_fs(f32x16& p0, f32x16& p1, const float C, const float nBC) {
#pragma unroll
    for (int r = 0; r < 16; ++r) p0[r] = fmaf(p0[r], C, nBC);
#pragma unroll
    for (int r = 0; r < 16; ++r) p1[r] = fmaf(p1[r], C, nBC);
#pragma unroll
    for (int r = 0; r < 16; ++r) p0[r] = __builtin_amdgcn_exp2f(p0[r]);
}
__device__ __forceinline__ void finishSM_fs(f32x16& p0, f32x16& p1, float& l_reg, bf16x8& pa0, bf16x8& pa1, bf16x8& pa2, bf16x8& pa3) {
#pragma unroll
    for (int r = 0; r < 16; ++r) p1[r] = __builtin_amdgcn_exp2f(p1[r]);
    float ps = 0;
#pragma unroll
    for (int r = 0; r < 16; ++r) ps += p0[r];
#pragma unroll
    for (int r = 0; r < 16; ++r) ps += p1[r];
    l_reg += ps;
#define PK4(P, BASE, OUT) do { unsigned a0 = cvt_pk_bf16(P[BASE + 0], P[BASE + 1]), a1 = cvt_pk_bf16(P[BASE + 2], P[BASE + 3]);   \
    unsigned b0 = cvt_pk_bf16(P[BASE + 4], P[BASE + 5]), b1 = cvt_pk_bf16(P[BASE + 6], P[BASE + 7]);                              \
    auto r0 = __builtin_amdgcn_permlane32_swap(a0, b0, false, false); auto r1 = __builtin_amdgcn_permlane32_swap(a1, b1, false, false); \
    u32x4 w = {r0[0], r1[0], r0[1], r1[1]}; OUT = *reinterpret_cast<bf16x8*>(&w); } while (0)
    PK4(p0, 0, pa0); PK4(p0, 8, pa1); PK4(p1, 0, pa2); PK4(p1, 8, pa3);
#undef PK4
}
__device__ __forceinline__ int v_st(int k, int c) { const int kk = (k & ~0xC) | ((k & 4) << 1) | ((k & 8) >> 1); return ((kk >> 3) * 4 + (c >> 5)) * 512 + ((kk & 7) * 32 + (c & 31)) * 2; }
__device__ __forceinline__ int v_rd_base(int lane) { return ((lane & 3) << 3) | (((lane >> 2) & 3) << 6) | (((lane >> 4) & 1) << 5) | (((lane >> 5) & 1) << 8); }
constexpr int v_rd_off(int d0, int ks, int half) { return d0 * 512 + ks * 4096 + half * 2048; }
template <int OFF> __device__ __forceinline__ s16x4 tr_read(int vb) {
    s16x4 r; asm volatile("ds_read_b64_tr_b16 %0, %1 offset:%2" : "=&v"(r) : "v"(vb), "i"(OFF) : "memory"); return r;
}
template <int D0> __device__ __forceinline__ void pv_one(f32x16& od, int vb, bf16x8 pa0, bf16x8 pa1, bf16x8 pa2, bf16x8 pa3) {
    const s16x4 l0 = tr_read<v_rd_off(D0, 0, 0)>(vb), h0 = tr_read<v_rd_off(D0, 0, 1)>(vb), l1 = tr_read<v_rd_off(D0, 1, 0)>(vb), h1 = tr_read<v_rd_off(D0, 1, 1)>(vb);
    const s16x4 l2 = tr_read<v_rd_off(D0, 2, 0)>(vb), h2 = tr_read<v_rd_off(D0, 2, 1)>(vb), l3 = tr_read<v_rd_off(D0, 3, 0)>(vb), h3 = tr_read<v_rd_off(D0, 3, 1)>(vb);
    asm volatile("s_waitcnt lgkmcnt(0)" ::: "memory"); SBAR();
#define PK(L, H) (bf16x8){L[0], L[1], L[2], L[3], H[0], H[1], H[2], H[3]}
    od = __builtin_amdgcn_mfma_f32_32x32x16_bf16(pa0, PK(l0, h0), od, 0, 0, 0);
    od = __builtin_amdgcn_mfma_f32_32x32x16_bf16(pa1, PK(l1, h1), od, 0, 0, 0);
    od = __builtin_amdgcn_mfma_f32_32x32x16_bf16(pa2, PK(l2, h2), od, 0, 0, 0);
    od = __builtin_amdgcn_mfma_f32_32x32x16_bf16(pa3, PK(l3, h3), od, 0, 0, 0);
#undef PK
}
__device__ __forceinline__ void pv_d0(f32x16* o, int vb, bf16x8 pa0, bf16x8 pa1, bf16x8 pa2, bf16x8 pa3) {
    pv_one<0>(o[0], vb, pa0, pa1, pa2, pa3); pv_one<1>(o[1], vb, pa0, pa1, pa2, pa3); pv_one<2>(o[2], vb, pa0, pa1, pa2, pa3); pv_one<3>(o[3], vb, pa0, pa1, pa2, pa3);
}

#define PV_READS(D0, L0, H0, L1, H1, L2, H2, L3, H3) do { L0 = tr_read<v_rd_off(D0, 0, 0)>(vb); H0 = tr_read<v_rd_off(D0, 0, 1)>(vb); L1 = tr_read<v_rd_off(D0, 1, 0)>(vb); H1 = tr_read<v_rd_off(D0, 1, 1)>(vb); \
    L2 = tr_read<v_rd_off(D0, 2, 0)>(vb); H2 = tr_read<v_rd_off(D0, 2, 1)>(vb); L3 = tr_read<v_rd_off(D0, 3, 0)>(vb); H3 = tr_read<v_rd_off(D0, 3, 1)>(vb); } while (0)
#define PV_PK(L, H) (bf16x8){L[0], L[1], L[2], L[3], H[0], H[1], H[2], H[3]}
#define PV_MMA(OD, L0, H0, L1, H1, L2, H2, L3, H3) do { OD = __builtin_amdgcn_mfma_f32_32x32x16_bf16(pa0, PV_PK(L0, H0), OD, 0, 0, 0); OD = __builtin_amdgcn_mfma_f32_32x32x16_bf16(pa1, PV_PK(L1, H1), OD, 0, 0, 0); \
    OD = __builtin_amdgcn_mfma_f32_32x32x16_bf16(pa2, PV_PK(L2, H2), OD, 0, 0, 0); OD = __builtin_amdgcn_mfma_f32_32x32x16_bf16(pa3, PV_PK(L3, H3), OD, 0, 0, 0); } while (0)
__device__ __forceinline__ void pv_d0_pipe(f32x16* o, int vb, bf16x8 pa0, bf16x8 pa1, bf16x8 pa2, bf16x8 pa3) {
    s16x4 a0, a1, a2, a3, a4, a5, a6, a7, b0, b1, b2, b3, b4, b5, b6, b7;
    PV_READS(0, a0, a1, a2, a3, a4, a5, a6, a7);
    PV_READS(1, b0, b1, b2, b3, b4, b5, b6, b7);
    asm volatile("s_waitcnt lgkmcnt(8)" ::: "memory"); SBAR();
    PV_MMA(o[0], a0, a1, a2, a3, a4, a5, a6, a7); SBAR();
    PV_READS(2, a0, a1, a2, a3, a4, a5, a6, a7);
    asm volatile("s_waitcnt lgkmcnt(8)" ::: "memory"); SBAR();
    PV_MMA(o[1], b0, b1, b2, b3, b4, b5, b6, b7); SBAR();
    PV_READS(3, b0, b1, b2, b3, b4, b5, b6, b7);
    asm volatile("s_waitcnt lgkmcnt(8)" ::: "memory"); SBAR();
    PV_MMA(o[2], a0, a1, a2, a3, a4, a5, a6, a7); SBAR();
    asm volatile("s_waitcnt lgkmcnt(0)" ::: "memory"); SBAR();
    PV_MMA(o[3], b0, b1, b2, b3, b4, b5, b6, b7);
}

template <int DK, int LDQ, int LDK, int LDV, int SDEPTH, int NQL, bool FS, bool PVP>
__device__ __forceinline__ void attn_body(const int tid, const bf16_t* __restrict__ Qb, const bf16_t* __restrict__ Kh, const bf16_t* __restrict__ Vh, const int seq, char* lds,
                                          const float C, const float thr, f32x16 (&o)[4], float& l_out) {
    constexpr int RB = DK * 2, SHM_V = 64 * 256, SHM_K = 64 * RB, CPR = DK / 8, NKC = CPR / 8, ND0 = DK / 16, NQR = ND0 - NQL, QTB = NQL * 32;
#define KSWZ(row, colB) ((row) * RB + ((colB) ^ ((((row) >> 1) & 7) << 4)))
    const int wid = tid >> 6, lane = tid & 63, r32 = lane & 31, hi = lane >> 5;
    char* V_lds = lds; char* K_lds = lds + 2 * SHM_V;
    float* ws = (float*)(lds + 2 * SHM_V + 2 * SHM_K) + wid * 64; float* al_l = ws + 32;
    char* Qt = lds + 2 * SHM_V + 2 * SHM_K + 2048 + wid * (32 * (QTB > 0 ? QTB : 1));
    float m_reg = -1e30f, l_reg = 0;
#pragma unroll
    for (int d = 0; d < 4; ++d) o[d] = f32x16{};
    bf16x8 qr[NQR];
    const bf16_t* Qw = Qb + (size_t)(wid * 32 + r32) * LDQ + hi * 8;
#pragma unroll
    for (int d0 = 0; d0 < NQR; ++d0) qr[d0] = *(const bf16x8*)(Qw + d0 * 16);
    if constexpr (NQL > 0) {
        constexpr int CH = QTB / 16;
#pragma unroll
        for (int i = 0; i < (32 * CH) / 64; ++i) { const int c = lane + 64 * i, row = c / CH, cc = c % CH;
            const bf16x8 v = *(const bf16x8*)(Qb + (size_t)(wid * 32 + row) * LDQ + NQR * 16 + cc * 8);
            *(bf16x8*)(Qt + row * QTB + ((cc * 16) ^ (((row) & (CH - 1)) << 4))) = v; }
        asm volatile("s_waitcnt lgkmcnt(0)" ::: "memory");
    }
    const int sr = tid >> 4, sc = (tid & 15) * 8, vst0 = v_st(sr, sc), vst1 = v_st(32 + sr, sc);
    const int vb0 = (int)(uintptr_t)V_lds + v_rd_base(lane);
    int krow[NKC], kcc[NKC];
#pragma unroll
    for (int i = 0; i < NKC; ++i) { const int c = tid + 512 * i; krow[i] = c / CPR; kcc[i] = c % CPR; }
    struct { bf16x8 vs0, vs1, ks[NKC]; } sr_[SDEPTH];
    constexpr int SE = 0, SO = SDEPTH - 1;
#define SLOAD(i, k0) do { sr_[i].vs0 = *(const bf16x8*)(&Vh[(size_t)((k0) + sr) * LDV + sc]); sr_[i].vs1 = *(const bf16x8*)(&Vh[(size_t)((k0) + 32 + sr) * LDV + sc]); \
    _Pragma("unroll") for (int _q = 0; _q < NKC; ++_q) sr_[i].ks[_q] = *(const bf16x8*)(&Kh[(size_t)((k0) + krow[_q]) * LDK + kcc[_q] * 8]); } while (0)
#define SWRITE(b, i) do { *(bf16x8*)(V_lds + (b) * SHM_V + vst0) = sr_[i].vs0; *(bf16x8*)(V_lds + (b) * SHM_V + vst1) = sr_[i].vs1; \
    _Pragma("unroll") for (int _q = 0; _q < NKC; ++_q) *(bf16x8*)(K_lds + (b) * SHM_K + KSWZ(krow[_q], kcc[_q] * 16)) = sr_[i].ks[_q]; } while (0)
#define SWAIT() do { if constexpr (SDEPTH == 2) asm volatile("s_waitcnt vmcnt(%0)" :: "n"(2 + NKC) : "memory"); else asm volatile("s_waitcnt vmcnt(0)" ::: "memory"); } while (0)
#define RESC(a) do { if (__any((a) < 1.f)) { if (hi == 0) al_l[r32] = (a); asm volatile("s_waitcnt lgkmcnt(0)" ::: "memory"); \
    _Pragma("unroll") for (int d = 0; d < 4; ++d) _Pragma("unroll") for (int r = 0; r < 16; ++r) o[d][r] *= al_l[crow(r, hi)]; } } while (0)
#define QFRAG(d0) ((d0) < NQR ? qr[(d0) < NQR ? (d0) : 0] : *(const bf16x8*)(Qt + r32 * QTB + (((((d0) - NQR) * 2 + hi) * 16) ^ ((r32 & ((QTB / 16) - 1)) << 4))))
#define QKT(P0, P1, KB) do { P0 = f32x16{}; P1 = f32x16{}; _Pragma("unroll") for (int d0 = 0; d0 < ND0; ++d0) { const int cb = (d0 * 16 + hi * 8) * 2; \
    const bf16x8 b0 = *(const bf16x8*)((KB) + KSWZ(r32, cb)); const bf16x8 b1 = *(const bf16x8*)((KB) + KSWZ(32 + r32, cb)); const bf16x8 qf = QFRAG(d0); \
    P0 = __builtin_amdgcn_mfma_f32_32x32x16_bf16(b0, qf, P0, 0, 0, 0); P1 = __builtin_amdgcn_mfma_f32_32x32x16_bf16(b1, qf, P1, 0, 0, 0); } } while (0)
    f32x16 pA0, pA1, pB0, pB1; float mnA, mnB, alA, alB; bf16x8 pa0, pa1, pa2, pa3; const int NT = seq / 64;
#define PVD(VB) do { if constexpr (PVP) pv_d0_pipe(o, VB, pa0, pa1, pa2, pa3); else pv_d0(o, VB, pa0, pa1, pa2, pa3); } while (0)
    const float nBC = -thr * C;
#define PSM(P0, P1, MN, AL) do { if constexpr (FS) partialSM_fs(P0, P1, C, nBC); else partialSM(P0, P1, m_reg, MN, AL, C, thr); } while (0)
#define FSM(P0, P1, AL) do { if constexpr (FS) finishSM_fs(P0, P1, l_reg, pa0, pa1, pa2, pa3); else finishSM(P0, P1, AL, l_reg, pa0, pa1, pa2, pa3); } while (0)
#define RSC(a) do { if constexpr (!FS) { RESC(a); } } while (0)
    SLOAD(SE, 0); asm volatile("s_waitcnt vmcnt(0)" ::: "memory"); SWRITE(0, SE); __syncthreads();
    QKT(pA0, pA1, K_lds); PSM(pA0, pA1, mnA, alA);
    SLOAD(SO, 64); if constexpr (SDEPTH == 2) { if (2 < NT) SLOAD(SE, 128); }
    SWAIT(); SWRITE(1, SO); __syncthreads();
    for (int j = 1; j + 1 < NT; j += 2) {
        SBAR(); QKT(pB0, pB1, K_lds + SHM_K);
        FSM(pA0, pA1, alA); SBAR();
        SLOAD(SO, (j + SDEPTH) * 64); SBAR();
        PVD(vb0); PSM(pB0, pB1, mnB, alB);
        __syncthreads(); SWAIT(); SWRITE(0, SE);
        RSC(alB); __syncthreads();
        SBAR(); QKT(pA0, pA1, K_lds);
        FSM(pB0, pB1, alB); SBAR();
        if (SDEPTH == 1 || j + 3 < NT) SLOAD(SE, (j + 1 + SDEPTH) * 64); SBAR();
        PVD(vb0 + SHM_V); PSM(pA0, pA1, mnA, alA);
        __syncthreads(); SWAIT(); SWRITE(1, SO);
        RSC(alA); __syncthreads();
    }
    SBAR(); QKT(pB0, pB1, K_lds + SHM_K);
    FSM(pA0, pA1, alA); SBAR();
    PVD(vb0); PSM(pB0, pB1, mnB, alB);
    __syncthreads(); RSC(alB);
    FSM(pB0, pB1, alB); SBAR();
    PVD(vb0 + SHM_V);
    if constexpr (FS) { auto rr = __builtin_amdgcn_permlane32_swap(__float_as_uint(l_reg), __float_as_uint(l_reg), false, false); l_reg = __uint_as_float(rr[0]) + __uint_as_float(rr[1]); }
#undef PSM
#undef PVD
#undef FSM
#undef RSC
    l_out = l_reg;
#undef SLOAD
#undef SWRITE
#undef SWAIT
#undef RESC
#undef QKT
#undef QFRAG
#undef KSWZ
}

__device__ __forceinline__ void attn_phase(Frame& F, CArgsRef A, unsigned long long& pt1) {
    char* lds = (char*)F.lds;
    const bf16_t* P = WSP(bf16_t, WS_BIG); const bf16_t* QM = WSP(bf16_t, WS_QM); const bf16_t* KM = WSP(bf16_t, WS_KM); const bf16_t* KV = WSP(bf16_t, WS_H);
    bf16_t* Y = WSP(bf16_t, WS_YMIX); float* ST = WSP(float, WS_STASH) + (size_t)F.bid * 256 * 128;
    float lam;
    { const int lane = F.lane; const float* dl = A.in[22]; const float a = dl[lane] * dl[64 + lane], b = dl[128 + lane] * dl[192 + lane]; lam = __expf(wave_sum(a)) - __expf(wave_sum(b)) + LAM_INIT; lam = __uint_as_float(__builtin_amdgcn_readfirstlane(__float_as_uint(lam))); }
    constexpr float LOG2E = 1.4426950408889634f;
#ifndef ATT_KINDS
#define ATT_KINDS 3
#endif
#ifndef ATT_PVP_MLA
#define ATT_PVP_MLA 1
#endif
#ifndef ATT_PVP_DIFF
#define ATT_PVP_DIFF 1
#endif
#ifndef ATT_FS
#define ATT_FS 1
#endif
    float bnd_mla, bnd_diff;
    { const int lane = F.lane; const float* gm = A.in[20]; const float* gd = A.in[21];
      float a = fmaxf(fmaxf(fabsf(gm[lane]), fabsf(gm[64 + lane])), fabsf(gm[128 + lane])), b = fmaxf(fmaxf(fabsf(gm[192 + lane]), fabsf(gm[256 + lane])), fabsf(gm[320 + lane]));
      float c = fabsf(gd[lane]), d = fabsf(gd[64 + lane]);
#pragma unroll
      for (int o = 1; o < 64; o <<= 1) { a = fmaxf(a, __shfl_xor(a, o)); b = fmaxf(b, __shfl_xor(b, o)); c = fmaxf(c, __shfl_xor(c, o)); d = fmaxf(d, __shfl_xor(d, o)); }
      bnd_mla = __uint_as_float(__builtin_amdgcn_readfirstlane(__float_as_uint(fminf(0.07216878364870322f * 192.f * a * b * 1.001f, 60.f))));
      bnd_diff = __uint_as_float(__builtin_amdgcn_readfirstlane(__float_as_uint(fminf(0.125f * 64.f * c * d * 1.001f, 60.f)))); }
    if (ATT_KINDS & 1)
    for (int u = F.bid, rnd = 0; u < 512; u += F.G, ++rnd) {
        int tid = threadIdx.x; asm volatile("" : "+v"(tid));
        const int wid = tid >> 6, lane = tid & 63, r32 = lane & 31, hi = lane >> 5;
        const int ux = (F.G == 256) ? ((((F.bid & 7) * 4 + rnd * 2 + ((F.bid >> 3) >> 4)) << 4) | ((F.bid >> 3) & 15)) : u;
        const int bh = ux >> 4, qb = ux & 15, b = bh >> 2, h = bh & 3;
        f32x16 o[4]; float l_reg;
        __syncthreads();
        attn_body<192, 768, 192, 1024, 1, 8, ATT_FS != 0, ATT_PVP_MLA != 0>(tid, QM + ((size_t)(b * SEQ + qb * 256)) * 768 + h * 192, KM + (size_t)(b * 4 + h) * TPB * 192, KV + (size_t)(b * TPB) * 1024 + h * 256 + 128,
                                       TPB, lds, 0.07216878364870322f * LOG2E, ATT_FS ? bnd_mla / 0.07216878364870322f : 8.f / 0.07216878364870322f, o, l_reg);
        float* li_l = (float*)(lds + 2 * 16384 + 2 * 64 * 384) + wid * 64;
        if (hi == 0) li_l[r32] = l_reg; LDS_WAIT();
        float rli[16];
#pragma unroll
        for (int r = 0; r < 16; ++r) rli[r] = __builtin_amdgcn_rcpf(li_l[crow(r, hi)]);
        bf16_t* Ow = Y + (size_t)(b * SEQ + qb * 256 + wid * 32) * D + h * 128;
#pragma unroll
        for (int r = 0; r < 16; ++r)
#pragma unroll
            for (int d0 = 0; d0 < 4; ++d0) Ow[(size_t)crow(r, hi) * D + d0 * 32 + r32] = f2bf(o[d0][r] * rli[r]);
    }
    if (PT_SUB == 3) pt1 = __builtin_amdgcn_s_memrealtime();
    if (ATT_KINDS & 2)
    for (int u = F.bid, rnd = 0; u < 512; u += F.G, ++rnd) {
        int tid = threadIdx.x; asm volatile("" : "+v"(tid));
        const int wid = tid >> 6, lane = tid & 63, r32 = lane & 31, hi = lane >> 5;
        const int ux = (F.G == 256) ? ((((F.bid & 7) * 4 + rnd * 2 + ((F.bid >> 3) >> 4)) << 4) | ((F.bid >> 3) & 15)) : u;
        const int bh = ux >> 4, qb = ux & 15, b = bh >> 2, h = bh & 3;
        const bf16_t* Pb = P + (size_t)(b * TPB) * PW;
        float* Sw = ST + (size_t)(wid * 32) * 128;
        float* li_l = (float*)(lds + 2 * 16384 + 2 * 64 * 128) + wid * 64;
        {
            f32x16 o[4]; float l_reg;
            __syncthreads();
            attn_body<64, PW, PW, PW, 1, 0, ATT_FS != 0, ATT_PVP_DIFF != 0>(tid, Pb + (size_t)(CTXL + qb * 256) * PW + PC_QD + h * 128, Pb + PC_KD + h * 128, Pb + PC_VD + h * 128, TPB, lds, 0.125f * LOG2E, ATT_FS ? bnd_diff / 0.125f : 8.f / 0.125f, o, l_reg);
            if (hi == 0) li_l[r32] = l_reg; LDS_WAIT();
            float rli[16];
#pragma unroll
            for (int r = 0; r < 16; ++r) rli[r] = __builtin_amdgcn_rcpf(li_l[crow(r, hi)]);
#pragma unroll
            for (int r = 0; r < 16; ++r)
#pragma unroll
                for (int d0 = 0; d0 < 4; ++d0) Sw[(size_t)crow(r, hi) * 128 + d0 * 32 + r32] = o[d0][r] * rli[r];
        }
        {
            f32x16 o[4]; float l_reg;
            __syncthreads();
            attn_body<64, PW, PW, PW, 1, 0, ATT_FS != 0, ATT_PVP_DIFF != 0>(tid, Pb + (size_t)(CTXL + qb * 256) * PW + PC_QD + h * 128 + 64, Pb + PC_KD + h * 128 + 64, Pb + PC_VD + h * 128, TPB, lds, 0.125f * LOG2E, ATT_FS ? bnd_diff / 0.125f : 8.f / 0.125f, o, l_reg);
            if (hi == 0) li_l[r32] = l_reg; LDS_WAIT();
            float ss[16];
#pragma unroll
            for (int r = 0; r < 16; ++r) { const float rl = __builtin_amdgcn_rcpf(li_l[crow(r, hi)]); float s = 0.f;
#pragma unroll
                for (int d0 = 0; d0 < 4; ++d0) { const float a1 = Sw[(size_t)crow(r, hi) * 128 + d0 * 32 + r32]; const float v = a1 - lam * (o[d0][r] * rl); o[d0][r] = v; s += v * v; }
                ss[r] = s; }
#pragma unroll
            for (int r = 0; r < 16; ++r) {
#pragma unroll
                for (int sh = 1; sh < 32; sh <<= 1) ss[r] += __shfl_xor(ss[r], sh);
                ss[r] = (1.f / sqrtf(ss[r] * (1.f / 128.f) + EPS)) * (1.f - LAM_INIT); }
            bf16_t* Ow = Y + (size_t)(b * SEQ + qb * 256 + wid * 32) * D + 512 + h * 128;
#pragma unroll
            for (int d0 = 0; d0 < 4; ++d0) { const float gs = A.in[23][d0 * 32 + r32];
#pragma unroll
                for (int r = 0; r < 16; ++r) Ow[(size_t)crow(r, hi) * D + d0 * 32 + r32] = f2bf(o[d0][r] * ss[r] * gs); }
        }
    }
    __syncthreads();
}

constexpr int NPHASE = 18;

__global__ void __launch_bounds__(512, 2) fwd(Args args) {
    extern __shared__ __attribute__((aligned(16))) unsigned char lds_raw[];
    Frame F;
    F.lds = (LAS unsigned char*)lds_raw;
    F.tid = threadIdx.x; F.lane = F.tid & 63; F.wave = __builtin_amdgcn_readfirstlane(F.tid >> 6);
    F.G = gridDim.x; F.bid = blockIdx.x;
    F.out = args.out; F.ws = args.ws; F.ctl = (unsigned*)(args.ws + WS_CTL);
    volatile LAS unsigned* MISC = (volatile LAS unsigned*)(F.lds + LDS_CTL);
    LAS int* PRE = (LAS int*)(F.lds + LDS_CTL + 64);
    if (F.tid < 4) MISC[F.tid] = 0u;
    __syncthreads();
    XcdBarrier bar; bar.bar = F.ctl + CW_BAR; bar.x = 0; bar.st = nullptr;
#if MK_ONE_LAUNCH
    bar = xcd_barrier_post(F.ctl + CW_BAR, MISC);
#define GRID_BAR() xcd_barrier(bar)
#else
#define GRID_BAR() do {} while (0)
#endif
    const int lo = args.ph_lo, hi = args.ph_hi;
    unsigned long long pt0 = 0, pt1 = 0;
#ifndef PH_MASK
#define PH_MASK 0x3ffff
#endif
#define IN(k) (((PH_MASK >> (k)) & 1) && lo <= (k) && (k) < hi)
#define SEAM(k) do { if (IN((k) + 1)) GRID_BAR(); } while (0)
#define REP(k) for (int _rep = 0; _rep <= ((PROBE_REP >> (k)) & 1); ++_rep, (void)((_rep <= ((PROBE_REP >> (k)) & 1)) ? (GRID_BAR(), 0) : 0))

    if (IN(0)) { if (PT_LO == 0) pt0 = __builtin_amdgcn_s_memrealtime(); REP(0) { p0_prologue(F, ARGP(), pt1); } if (!PT_SUB && PT_PRE && PT_HI == 0) pt1 = __builtin_amdgcn_s_memrealtime(); SEAM(0); if (!PT_SUB && !PT_PRE && PT_HI == 0) pt1 = __builtin_amdgcn_s_memrealtime(); }
    if (IN(1)) { if (PT_LO == 1) pt0 = __builtin_amdgcn_s_memrealtime(); REP(1) { norm_mod_phase(F, ARGP(), 0); } if (PT_PRE && PT_HI == 1) pt1 = __builtin_amdgcn_s_memrealtime(); SEAM(1); if (!PT_PRE && PT_HI == 1) pt1 = __builtin_amdgcn_s_memrealtime(); }
    if (IN(2)) { if (PT_LO == 2) pt0 = __builtin_amdgcn_s_memrealtime(); REP(2) {
        pg8::PlainSched S; S.init(WSP(bf16_t, WS_H), WSP(bf16_t, WS_WIN0), NTOK, 1536, D, D, D, F.G, F.bid, 0);
        pg8::EpiStoreBf16 E{WSP(bf16_t, WS_BIG), UW};
        pg8::gemm_phase(F.lds, D, D, D, 1 << 30, S, E);
    } if (PT_PRE && PT_HI == 2) pt1 = __builtin_amdgcn_s_memrealtime(); SEAM(2); if (!PT_PRE && PT_HI == 2) pt1 = __builtin_amdgcn_s_memrealtime(); }
    if (IN(3)) { if (PT_LO == 3) pt0 = __builtin_amdgcn_s_memrealtime(); REP(3) { convpool_phase(F, ARGP(), pt1); } if (!PT_SUB && PT_PRE && PT_HI == 3) pt1 = __builtin_amdgcn_s_memrealtime(); SEAM(3); if (!PT_SUB && !PT_PRE && PT_HI == 3) pt1 = __builtin_amdgcn_s_memrealtime(); }
    if (IN(4)) { if (PT_LO == 4) pt0 = __builtin_amdgcn_s_memrealtime(); REP(4) {
        pg8::PlainSched S; S.init(WSP(bf16_t, WS_YMIX), WSP(bf16_t, WS_WOUT0), NTOK, D, D, D, D, F.G, F.bid, 0);
        pg8::EpiResid E{ARGP().in[0], ARGP().in[2], F.out, WSP(float, WS_XC), WSP(float, WS_MOD), 0};
        pg8::gemm_phase(F.lds, D, D, D, 1 << 30, S, E);
    } if (PT_PRE && PT_HI == 4) pt1 = __builtin_amdgcn_s_memrealtime(); SEAM(4); if (!PT_PRE && PT_HI == 4) pt1 = __builtin_amdgcn_s_memrealtime(); }
    if (IN(5)) { if (PT_LO == 5) pt0 = __builtin_amdgcn_s_memrealtime(); REP(5) { router_phase(F, ARGP(), 0); } if (PT_PRE && PT_HI == 5) pt1 = __builtin_amdgcn_s_memrealtime(); SEAM(5); if (!PT_PRE && PT_HI == 5) pt1 = __builtin_amdgcn_s_memrealtime(); }
    if (IN(6)) { if (PT_LO == 6) pt0 = __builtin_amdgcn_s_memrealtime(); REP(6) {
        const int nt = moe_prefix(F, 0, PRE);
        MoeSchedT<true> S; S.m = MoeSched{F.G, F.bid, nt, 0, 0, F.ctl + CW_CNT, WSP(int, WS_LIST), (const char*)WSP(bf16_t, WS_H), (const char*)WSP(bf16_t, WS_WM1), PRE};
        EpiMoe1 E{WSP(bf16_t, WS_BIG), WSP(f32x2, WS_TW)};
        pg8::gemm_phase(F.lds, D, D, D, 1 << 30, S, E);
    } if (PT_PRE && PT_HI == 6) pt1 = __builtin_amdgcn_s_memrealtime(); SEAM(6); if (!PT_PRE && PT_HI == 6) pt1 = __builtin_amdgcn_s_memrealtime(); }
    if (IN(7)) { if (PT_LO == 7) pt0 = __builtin_amdgcn_s_memrealtime(); REP(7) {
        const int nt = moe_prefix(F, 0, PRE);
        MoeSchedT<false> S; S.m = MoeSched{F.G, F.bid, nt, 0, 1, F.ctl + CW_CNT, WSP(int, WS_LIST), (const char*)WSP(bf16_t, WS_BIG), (const char*)WSP(bf16_t, WS_WM2), PRE};
        EpiMoe2 E{F.out, WSP(float, WS_XC), WSP(float, WS_MOD)};
        pg8::gemm_phase(F.lds, 512, 512, 256, 4, S, E);
    } if (PT_PRE && PT_HI == 7) pt1 = __builtin_amdgcn_s_memrealtime(); SEAM(7); if (!PT_PRE && PT_HI == 7) pt1 = __builtin_amdgcn_s_memrealtime(); }
    if (IN(8)) { if (PT_LO == 8) pt0 = __builtin_amdgcn_s_memrealtime(); REP(8) { norm_mod_phase(F, ARGP(), 1); } if (PT_PRE && PT_HI == 8) pt1 = __builtin_amdgcn_s_memrealtime(); SEAM(8); if (!PT_PRE && PT_HI == 8) pt1 = __builtin_amdgcn_s_memrealtime(); }
    if (IN(9)) { if (PT_LO == 9) pt0 = __builtin_amdgcn_s_memrealtime(); REP(9) {
        pg8::PlainSched S; S.init(WSP(bf16_t, WS_H), WSP(bf16_t, WS_WIN1), NTOK, PW, D, D, D, F.G, F.bid, 0);
        pg8::EpiStoreBf16 E{WSP(bf16_t, WS_BIG), PW};
        pg8::gemm_phase(F.lds, D, D, D, 1 << 30, S, E);
    } if (PT_PRE && PT_HI == 9) pt1 = __builtin_amdgcn_s_memrealtime(); SEAM(9); if (!PT_PRE && PT_HI == 9) pt1 = __builtin_amdgcn_s_memrealtime(); }
    if (IN(10)) { if (PT_LO == 10) pt0 = __builtin_amdgcn_s_memrealtime(); REP(10) { p9_phase(F, ARGP()); } if (PT_PRE && PT_HI == 10) pt1 = __builtin_amdgcn_s_memrealtime(); SEAM(10); if (!PT_PRE && PT_HI == 10) pt1 = __builtin_amdgcn_s_memrealtime(); }
    if (IN(11)) { if (PT_LO == 11) pt0 = __builtin_amdgcn_s_memrealtime(); REP(11) {
        { pg8::PlainSched S; S.init(WSP(bf16_t, WS_BIG) + PC_CQ, WSP(bf16_t, WS_WUQ), NLAT, 768, 256, PW, 256, F.G, F.bid, 1);
          pg8::EpiStoreBf16 E{WSP(bf16_t, WS_QM), 768};
          pg8::gemm_phase(F.lds, 256, PW, 256, 1 << 30, S, E); }
        { pg8::PlainSched S; S.init(WSP(bf16_t, WS_BIG) + PC_CKV, WSP(bf16_t, WS_WUKV), NTOK, 1024, 128, PW, 128, F.G, F.bid, 0);
          pg8::EpiStoreBf16 E{WSP(bf16_t, WS_H), 1024};
          pg8::gemm_phase(F.lds, 128, PW, 128, 1 << 30, S, E); }

    } if (PT_PRE && PT_HI == 11) pt1 = __builtin_amdgcn_s_memrealtime(); SEAM(11); if (!PT_PRE && PT_HI == 11) pt1 = __builtin_amdgcn_s_memrealtime(); }
    if (IN(12)) { if (PT_LO == 12) pt0 = __builtin_amdgcn_s_memrealtime(); REP(12) { p11_phase(F, ARGP()); } if (PT_PRE && PT_HI == 12) pt1 = __builtin_amdgcn_s_memrealtime(); SEAM(12); if (!PT_PRE && PT_HI == 12) pt1 = __builtin_amdgcn_s_memrealtime(); }
    if (IN(13)) { if (PT_LO == 13) pt0 = __builtin_amdgcn_s_memrealtime(); REP(13) { attn_phase(F, ARGP(), pt1); } if (!PT_SUB && PT_PRE && PT_HI == 13) pt1 = __builtin_amdgcn_s_memrealtime(); SEAM(13); if (!PT_SUB && !PT_PRE && PT_HI == 13) pt1 = __builtin_amdgcn_s_memrealtime(); }
    if (IN(14)) { if (PT_LO == 14) pt0 = __builtin_amdgcn_s_memrealtime(); REP(14) {
        pg8::PlainSched S; S.init(WSP(bf16_t, WS_YMIX), WSP(bf16_t, WS_WOUT1), NLAT, D, D, D, D, F.G, F.bid, 0);
        pg8::EpiResid E{ARGP().in[0], ARGP().in[2], F.out, WSP(float, WS_XC), WSP(float, WS_MOD) + (size_t)9 * NMOD * D, 1};
        pg8::gemm_phase(F.lds, D, D, D, 1 << 30, S, E);
    } if (PT_PRE && PT_HI == 14) pt1 = __builtin_amdgcn_s_memrealtime(); SEAM(14); if (!PT_PRE && PT_HI == 14) pt1 = __builtin_amdgcn_s_memrealtime(); }
    if (IN(15)) { if (PT_LO == 15) pt0 = __builtin_amdgcn_s_memrealtime(); REP(15) { router_phase(F, ARGP(), 1); } if (PT_PRE && PT_HI == 15) pt1 = __builtin_amdgcn_s_memrealtime(); SEAM(15); if (!PT_PRE && PT_HI == 15) pt1 = __builtin_amdgcn_s_memrealtime(); }
    if (IN(16)) { if (PT_LO == 16) pt0 = __builtin_amdgcn_s_memrealtime(); REP(16) {
        const int nt = moe_prefix(F, 1, PRE);
        MoeSchedT<true> S; S.m = MoeSched{F.G, F.bid, nt, 1, 0, F.ctl + CW_CNT + 64, WSP(int, WS_LIST), (const char*)WSP(bf16_t, WS_H), (const char*)WSP(bf16_t, WS_WM1), PRE};
        EpiMoe1 E{WSP(bf16_t, WS_BIG), WSP(f32x2, WS_TW)};
        pg8::gemm_phase(F.lds, D, D, D, 1 << 30, S, E);
    } if (PT_PRE && PT_HI == 16) pt1 = __builtin_amdgcn_s_memrealtime(); SEAM(16); if (!PT_PRE && PT_HI == 16) pt1 = __builtin_amdgcn_s_memrealtime(); }
    if (IN(17)) { if (PT_LO == 17) pt0 = __builtin_amdgcn_s_memrealtime(); REP(17) {
        const int nt = moe_prefix(F, 1, PRE);
        MoeSchedT<false> S; S.m = MoeSched{F.G, F.bid, nt, 1, 1, F.ctl + CW_CNT + 64, WSP(int, WS_LIST), (const char*)WSP(bf16_t, WS_BIG), (const char*)WSP(bf16_t, WS_WM2), PRE};
        EpiMoe2 E{F.out, WSP(float, WS_XC), WSP(float, WS_MOD) + (size_t)9 * NMOD * D};
        pg8::gemm_phase(F.lds, 512, 512, 256, 4, S, E);
    } if (PT_HI == 17) pt1 = __builtin_amdgcn_s_memrealtime(); }
    if (PT_LO >= 0 && F.bid == 0 && F.tid == 0) { const unsigned long long tend = __builtin_amdgcn_s_memrealtime() + (unsigned long long)PT_AMP * (pt1 - pt0);
        while (__builtin_amdgcn_s_memrealtime() < tend) __builtin_amdgcn_s_sleep(8); }
#undef IN
#undef SEAM
}

extern "C" void kernel_launch(void* const* d_in, const int* in_sizes, int n_in, void* d_out, int out_size, void* d_ws, size_t ws_size, hipStream_t stream) {
    static int grid = 0;
    if (grid == 0) {
        if (n_in != 30 || in_sizes[0] != NLAT * D || out_size != NLAT * D || ws_size < WS_END) { fprintf(stderr, "kernel_launch: unexpected shapes (n_in %d, in0 %d, out %d, ws %zu)\n", n_in, n_in > 0 ? in_sizes[0] : -1, out_size, ws_size); grid = -1; return; }
        int dev = 0, cus = 0, per_cu = 0;
        if (hipGetDevice(&dev) != hipSuccess || hipDeviceGetAttribute(&cus, hipDeviceAttributeMultiprocessorCount, dev) != hipSuccess) { grid = -1; return; }
        if (hipFuncSetAttribute((const void*)fwd, hipFuncAttributeMaxDynamicSharedMemorySize, LDS_BYTES) != hipSuccess) { fprintf(stderr, "kernel_launch: hipFuncSetAttribute failed\n"); grid = -1; return; }
        if (hipOccupancyMaxActiveBlocksPerMultiprocessor(&per_cu, (const void*)fwd, 512, LDS_BYTES) != hipSuccess || per_cu < 1) fprintf(stderr, "kernel_launch: occupancy query reports %d\n", per_cu);
        (void)hipGetLastError();
        grid = cus;
    }
    if (grid < 0) return;
    if (hipMemsetAsync((char*)d_ws + WS_CTL, 0, CTL_ZERO_BYTES, stream) != hipSuccess) return;
    Args a{};
    for (int i = 0; i < 30; ++i) a.in[i] = (const float*)d_in[i];
    a.out = (float*)d_out; a.ws = (unsigned char*)d_ws;
    const int last = MK_LAST_PHASE < NPHASE - 1 ? MK_LAST_PHASE : NPHASE - 1;
#if MK_ONE_LAUNCH
    a.ph_lo = 0; a.ph_hi = last + 1;
    hipLaunchKernelGGL(fwd, dim3(grid), dim3(512), LDS_BYTES, stream, a);
#else
    for (int p = 0; p <= last; ++p) { a.ph_lo = p; a.ph_hi = p + 1; hipLaunchKernelGGL(fwd, dim3(grid), dim3(512), LDS_BYTES, stream, a); }
#endif
    const hipError_t le = hipPeekAtLastError();
    if (le != hipSuccess) fprintf(stderr, "kernel_launch: launch failed: %s\n", hipGetErrorName(le));
}
```

```cpp
#include <hip/hip_runtime.h>
#include <cstdio>
#include <cstdint>

#ifndef MK_ONE_LAUNCH
#define MK_ONE_LAUNCH 1
#endif
#ifndef MK_LAST_PHASE
#define MK_LAST_PHASE 99
#endif

#ifndef PROBE_REP
#define PROBE_REP 0
#endif
#define PT_LO -1
#define PT_HI -1
#define PT_AMP 4
#define PT_PRE 0
#define PROBE_ABL_SET 0
#define PROBE_ABL PROBE_ABL_SET
#define PT_SUB 0

#define GAS __attribute__((address_space(1)))
#define LAS __attribute__((address_space(3)))
typedef unsigned short bf16_t;
typedef short bf16x8 __attribute__((ext_vector_type(8)));
typedef short s16x4 __attribute__((ext_vector_type(4)));
typedef float f32x4 __attribute__((ext_vector_type(4)));
typedef float f32x2 __attribute__((ext_vector_type(2)));
typedef float f32x16 __attribute__((ext_vector_type(16)));
typedef unsigned u32x4 __attribute__((ext_vector_type(4)));
typedef unsigned u32x2 __attribute__((ext_vector_type(2)));

constexpr int D = 1024, NB = 8, SEQ = 4096, CTXL = 256, TPB = SEQ + CTXL;
constexpr int NTOK = NB * TPB, NLAT = NB * SEQ, NCTX = NB * CTXL;
constexpr int NMOD = 6;
constexpr float EPS = 1e-6f;
constexpr int NEXP = 32, NBUCK = 48, DEXP = 256, LCAP = NTOK;
constexpr int PW = 2048;
constexpr int UW = 1536;
constexpr int PC_CQ = 0, PC_QD = 256, PC_CKV = 768, PC_KROPE = 896, PC_KD = 960, PC_VD = 1472;
constexpr float LAM_INIT = 0.35550906759096934f;
constexpr int MOE_MAXT = NTOK / 256 + NBUCK;

constexpr size_t MiB = 1u << 20;
constexpr size_t WS_CTL = 0, CTL_ZERO_BYTES = 3 * MiB;
constexpr size_t WS_MOD = 2 * MiB;
constexpr size_t WS_COS = 3 * MiB, WS_SIN = 3 * MiB + 512 * 1024;
constexpr size_t WS_XC = 4 * MiB;
constexpr size_t WS_LIST = 12 * MiB;
constexpr size_t WS_TW = 19 * MiB;
constexpr size_t WS_WIN0 = 20 * MiB, WS_WOUT0 = 23 * MiB, WS_WIN1 = 25 * MiB, WS_WUQ = 29 * MiB, WS_WUKV = 29 * MiB + 512 * 1024, WS_WOUT1 = 30 * MiB, WS_WPOOL = 32 * MiB;
constexpr size_t WS_WM1 = 33 * MiB;
constexpr size_t WS_WM2 = 97 * MiB;
constexpr size_t WS_H = 129 * MiB;
constexpr size_t WS_BIG = 197 * MiB;
constexpr size_t WS_YMIX = 333 * MiB;
constexpr size_t WS_QM = 401 * MiB;
constexpr size_t WS_KM = 449 * MiB;
constexpr size_t WS_END = 500 * MiB;
constexpr size_t WS_STASH = WS_WM1;
constexpr int CW_BAR = 4096;
constexpr int CW_CNT = 16384;

constexpr int LDS_BYTES = 155648;
constexpr int LDS_CTL = 153600;

__device__ __forceinline__ unsigned cvt_pk_bf16(float lo, float hi) { unsigned r; asm volatile("v_cvt_pk_bf16_f32 %0, %1, %2" : "=v"(r) : "v"(lo), "v"(hi)); return r; }
__device__ __forceinline__ float bf2f(unsigned short u) { return __uint_as_float((unsigned)u << 16); }
__device__ __forceinline__ float bflo(unsigned w) { return __uint_as_float(w << 16); }
__device__ __forceinline__ float bfhi(unsigned w) { return __uint_as_float(w & 0xffff0000u); }
__device__ __forceinline__ unsigned short f2bf(float f) { return (unsigned short)(cvt_pk_bf16(f, 0.f) & 0xffffu); }
__device__ __forceinline__ float wave_sum(float v) {
#pragma unroll
    for (int o = 1; o < 64; o <<= 1) v += __shfl_xor(v, o);
    return v;
}
__device__ __forceinline__ float sigmoidf_(float x) { return 1.f / (1.f + __expf(-x)); }
__device__ __forceinline__ float siluf_(float x) { return x / (1.f + __expf(-x)); }
__device__ __forceinline__ int crow(int r, int hi) { return (r & 3) + 8 * (r >> 2) + 4 * hi; }
#define LDS_WAIT() asm volatile("s_waitcnt lgkmcnt(0)" ::: "memory")
#define VM_WAIT() asm volatile("s_waitcnt vmcnt(0)" ::: "memory")

#define XB_TMO      128
#define XB_XCNT(j)  (256  + 64 * (j))
#define XB_XSUB(j)  (1280 + 64 * (j))
#define XB_XGEN(j)  (2304 + 64 * (j))
#define XB_TOP      3328
#define XB_TOPGEN   3392
#define XCD_BAR_WORDS 3456
#define XB_SPIN_CAP (1u << 18)
__device__ __forceinline__ unsigned xb_ld(unsigned* p)              { return __hip_atomic_load(p, __ATOMIC_RELAXED, __HIP_MEMORY_SCOPE_AGENT); }
__device__ __forceinline__ unsigned xb_add(unsigned* p, unsigned v) { return __hip_atomic_fetch_add(p, v, __ATOMIC_RELAXED, __HIP_MEMORY_SCOPE_AGENT); }
__device__ __forceinline__ unsigned xb_xcc_id() { return (unsigned)__builtin_amdgcn_s_getreg((3 << 11) | 20) & 0xFu; }
#define XB_SPIN(cond, bar) do { unsigned _sp = 0; while (cond) { __builtin_amdgcn_s_sleep(1); \
    if ((++_sp & 255u) == 0u) { if (xb_ld(&(bar)[XB_TMO])) break; if (_sp > XB_SPIN_CAP) { atomicAdd(&(bar)[XB_TMO], 1u); break; } } } } while (0)
struct XcdBarrier { unsigned* bar; unsigned x; volatile LAS unsigned* st; };
__device__ __forceinline__ XcdBarrier xcd_barrier_post(unsigned* bar, volatile LAS unsigned* st) {
    XcdBarrier b; b.bar = bar; b.x = xb_xcc_id(); b.st = st;
    if (threadIdx.x == 0) (void)xb_add(&bar[XB_XCNT(b.x)], 1u);
    return b;
}
__device__ __forceinline__ void xcd_barrier_complete(unsigned* bar, unsigned x, unsigned& nloc, unsigned& nx) {
    const unsigned G = gridDim.x * gridDim.y * gridDim.z;
    unsigned sum, cnt, mine, sp = 0u;
    for (;;) {
        sum = 0u; cnt = 0u; mine = 0u;
#pragma unroll
        for (unsigned j = 0; j < 16; ++j) { const unsigned c = xb_ld(&bar[XB_XCNT(j)]); sum += c; cnt += (c > 0u) ? 1u : 0u; mine = (j == x) ? c : mine; }
        if (sum == G) break;
        __builtin_amdgcn_s_sleep(1);
        if ((++sp & 255u) == 0u) { if (xb_ld(&bar[XB_TMO])) break; if (sp > XB_SPIN_CAP) { atomicAdd(&bar[XB_TMO], 1u); break; } }
    }
    nloc = mine > 0u ? mine : 1u; nx = cnt > 0u ? cnt : 1u;
}
__device__ __forceinline__ void xcd_barrier(const XcdBarrier& b) {
    asm volatile("s_waitcnt vmcnt(0)" ::: "memory");
    __syncthreads();
    if (threadIdx.x == 0) {
        unsigned* bar = b.bar;
        __builtin_amdgcn_s_waitcnt(0);
        unsigned nloc = b.st[0], nx = b.st[1];
        if (nloc == 0u) { xcd_barrier_complete(bar, b.x, nloc, nx); b.st[0] = nloc; b.st[1] = nx; }
        const unsigned old = xb_add(&bar[XB_XSUB(b.x)], 1u);
        const unsigned gen = old / nloc;
        if (old + 1u == (gen + 1u) * nloc) {
            __builtin_amdgcn_fence(__ATOMIC_RELEASE, "agent");
            asm volatile("s_waitcnt vmcnt(0)" ::: "memory");
            const unsigned og = xb_add(&bar[XB_TOP], 1u);
            const unsigned tg = og / nx;
            if (og + 1u == (tg + 1u) * nx) xb_add(&bar[XB_TOPGEN], 1u);
            else XB_SPIN(xb_ld(&bar[XB_TOPGEN]) == tg, bar);
            __builtin_amdgcn_fence(__ATOMIC_ACQUIRE, "agent");
            xb_add(&bar[XB_XGEN(b.x)], 1u);
            asm volatile("s_waitcnt vmcnt(0)" ::: "memory");
        } else {
            XB_SPIN(xb_ld(&bar[XB_XGEN(b.x)]) == gen, bar);
            __builtin_amdgcn_fence(__ATOMIC_ACQUIRE, "agent");
            asm volatile("s_waitcnt vmcnt(0)" ::: "memory");
        }
    }
    __syncthreads();
}

namespace pg8 {
constexpr int BM = 256, BK = 64, HALF = 128, HTB = HALF * BK * 2, STAGE_BYTES = 8 * HTB, NXCD = 8, WGM = 8;
__device__ __forceinline__ int lds_byte(int r, int c) { const int st = (r >> 4) * 2 + (c >> 5), rr = r & 15, cc = c & 31, ob = rr * 64 + cc * 2; return st * 1024 + (ob ^ (((ob >> 9) & 1) << 5)); }
__device__ __forceinline__ void stage_rc(int b, int& R, int& C) { const int st = b / 1024, sb = b % 1024, swz = sb ^ (((sb >> 9) & 1) << 5); R = (st >> 1) * 16 + swz / 64; C = (st & 1) * 32 + (swz % 64) / 2; }
__device__ __forceinline__ int perm32(int rho) { const int n = rho >> 4, i = rho & 15; return 8 * (i >> 2) + 4 * n + (i & 3); }

struct Unit {
    int pm, pn, po;
    const char* A;
    const char* B;
    const char* B2;
    const int* rows;
    int nvalid, aux;
};

template <class Epi, class Sched>
__device__ __forceinline__ void gemm_phase(LAS unsigned char* lds, int K, int lda, int ldb, int ksplit, const Sched& S, const Epi& E) {
    asm volatile("" : "+s"(K), "+s"(lda), "+s"(ldb), "+s"(ksplit));
    const int tid = threadIdx.x, wid = __builtin_amdgcn_readfirstlane(tid >> 6), lane = tid & 63, wr = wid >> 2, wc = wid & 3, fr = lane & 15, fq = lane >> 4;
    const int nt = K / BK;
    unsigned voffB[2];
#pragma unroll
    for (int i = 0; i < 2; ++i) { int R, C; stage_rc(tid * 16 + i * 8192, R, C); const int Rb = (R & ~31) + perm32(R & 31); voffB[i] = (unsigned)(Rb * ldb + C) * 2u; }
    const size_t kstep = (size_t)(BK * 2);
    const size_t hstepB = (size_t)HALF * ldb * 2;
    const unsigned ldsw = (unsigned)wid * 1024u;
    const int aoff = lds_byte(wr * 64 + fr, fq * 8), boff = lds_byte(wc * 32 + fr, fq * 8);
#define PG8_SA(b, h) (((b) * 2 + (h)) * HTB)
#define PG8_SB(b, h) ((4 + (b) * 2 + (h)) * HTB)
#define PG8_STAGE(bufoff, gbase, voff) do { _Pragma("unroll") for (int _i = 0; _i < 2; ++_i) \
        __builtin_amdgcn_global_load_lds((const unsigned*)((const char*)(gbase) + (voff)[_i]), (LAS unsigned*)(lds + (bufoff) + ldsw + _i * 8192), 16, 0, 0); } while (0)
#define PG8_LDA(dst, b, h) do { _Pragma("unroll") for (int m = 0; m < 4; ++m) _Pragma("unroll") for (int k = 0; k < 2; ++k) dst[m][k] = *(const LAS bf16x8*)(lds + PG8_SA(b, h) + aoff + m * 2048 + k * 1024); } while (0)
#define PG8_LDB(dst, b, h) do { _Pragma("unroll") for (int n = 0; n < 2; ++n) _Pragma("unroll") for (int k = 0; k < 2; ++k) dst[n][k] = *(const LAS bf16x8*)(lds + PG8_SB(b, h) + boff + n * 2048 + k * 1024); } while (0)
#define PG8_MMA(ai, bj, At, Bt) do { __builtin_amdgcn_s_setprio(1); _Pragma("unroll") for (int m = 0; m < 4; ++m) _Pragma("unroll") for (int n = 0; n < 2; ++n) _Pragma("unroll") for (int k = 0; k < 2; ++k) \
        acc[ai][bj][m][n] = __builtin_amdgcn_mfma_f32_16x16x32_bf16(Bt[n][k], At[m][k], acc[ai][bj][m][n], 0, 0, 0); __builtin_amdgcn_s_setprio(0); } while (0)
#define PG8_WAIT_V(n) asm volatile("s_waitcnt vmcnt(" #n ")" ::: "memory")
#define PG8_WAIT_L(n) asm volatile("s_waitcnt lgkmcnt(" #n ")" ::: "memory")
#define PG8_BAR __builtin_amdgcn_s_barrier()
#define PG8_SCHED __builtin_amdgcn_sched_barrier(0)
#define PG8_BK(u, t) (((t) < ksplit ? (u).B : (u).B2) + (size_t)(t) * kstep)
#define PG8_VOFF(dst, u) do { int _tl = tid; asm volatile("" : "+v"(_tl)); _Pragma("unroll") for (int _h = 0; _h < 2; ++_h) _Pragma("unroll") for (int _i = 0; _i < 2; ++_i) { int _R, _C; stage_rc(_tl * 16 + _i * 8192, _R, _C); int _r = _R + HALF * _h; \
        if constexpr (Sched::GATHER) { const int _rr = _r < (u).nvalid ? _r : 0; _r = (u).rows[_rr]; } dst[_h][_i] = (unsigned)(_r * lda + _C) * 2u; } } while (0)
    Unit cur, nxt; int ui = 0;
    if (!S.next(0, cur)) return;
    f32x4 acc[2][2][4][2];
#pragma unroll
    for (int a = 0; a < 2; ++a)
#pragma unroll
        for (int b = 0; b < 2; ++b)
#pragma unroll
            for (int m = 0; m < 4; ++m)
#pragma unroll
                for (int n = 0; n < 2; ++n) acc[a][b][m][n] = (f32x4){0.f, 0.f, 0.f, 0.f};
    bf16x8 At[4][2], B0[2][2], B1[2][2];
    LAS unsigned* VO = (LAS unsigned*)(lds + STAGE_BYTES) + tid;
#define PG8_VO(slot, h, i) VO[(((slot) & 1) * 4 + (h) * 2 + (i)) * 512]
    unsigned vfix[2][2];
    {
        unsigned vc[2][2];
        PG8_VOFF(vc, cur);
#pragma unroll
        for (int h = 0; h < 2; ++h)
#pragma unroll
            for (int i = 0; i < 2; ++i) { vfix[h][i] = vc[h][i]; if constexpr (Sched::GATHER) PG8_VO(0, h, i) = vc[h][i]; }
        const char* cA0 = cur.A;
        const char* b0 = PG8_BK(cur, 0); const char* b1 = PG8_BK(cur, 1);
        PG8_STAGE(PG8_SB(0, 0), b0, voffB); PG8_STAGE(PG8_SB(0, 1), b0 + hstepB, voffB); PG8_STAGE(PG8_SA(0, 0), cA0, vc[0]); PG8_STAGE(PG8_SA(0, 1), cA0, vc[1]);
        if (wr == 1) PG8_BAR;
        PG8_WAIT_V(2); PG8_BAR;
        PG8_STAGE(PG8_SB(1, 0), b1, voffB); PG8_STAGE(PG8_SA(1, 0), cA0 + kstep, vc[0]); PG8_STAGE(PG8_SB(1, 1), b1 + hstepB, voffB);
        PG8_WAIT_V(6); PG8_BAR;
    }
    const char* cA = cur.A;
    for (;;) {
        const bool has_next = S.next(ui + 1, nxt);
        if (!has_next) nxt = cur;
        if constexpr (Sched::GATHER) { unsigned vn[2][2]; PG8_VOFF(vn, nxt);
#pragma unroll
            for (int h = 0; h < 2; ++h)
#pragma unroll
                for (int i = 0; i < 2; ++i) PG8_VO(ui + 1, h, i) = vn[h][i]; }
        const char* nA = nxt.A;
#pragma nounroll
        for (int t = 0; t < nt; t += 2) {
            const bool last = (t == nt - 2);
            const char* a1 = cA + (size_t)(t + 1) * kstep;
            const char* a2 = last ? nA : cA + (size_t)(t + 2) * kstep;
            const char* a3 = a2 + kstep;
            const char* b2 = last ? PG8_BK(nxt, 0) : PG8_BK(cur, t + 2);
            const char* b3 = last ? PG8_BK(nxt, 1) : PG8_BK(cur, t + 3);
            unsigned v1[2], v2[2][2];
            if constexpr (Sched::GATHER) { const int s2 = last ? ui + 1 : ui;
                v1[0] = PG8_VO(ui, 1, 0); v1[1] = PG8_VO(ui, 1, 1);
#pragma unroll
                for (int h = 0; h < 2; ++h)
#pragma unroll
                    for (int i = 0; i < 2; ++i) v2[h][i] = PG8_VO(s2, h, i);
            } else { v1[0] = vfix[1][0]; v1[1] = vfix[1][1];
#pragma unroll
                for (int h = 0; h < 2; ++h)
#pragma unroll
                    for (int i = 0; i < 2; ++i) v2[h][i] = vfix[h][i]; }
            PG8_LDB(B0, 0, 0); PG8_LDB(B1, 0, 1); PG8_SCHED; PG8_LDA(At, 0, 0); PG8_STAGE(PG8_SA(1, 1), a1, v1);
            PG8_WAIT_V(8); PG8_WAIT_L(0); PG8_BAR; PG8_MMA(0, 0, At, B0); PG8_MMA(0, 1, At, B1); PG8_BAR; PG8_SCHED;
            PG8_LDA(At, 0, 1); PG8_STAGE(PG8_SB(0, 0), b2, voffB); PG8_STAGE(PG8_SB(0, 1), b2 + hstepB, voffB); PG8_STAGE(PG8_SA(0, 0), a2, v2[0]);
            PG8_WAIT_V(8); PG8_WAIT_L(0); PG8_BAR; PG8_MMA(1, 0, At, B0); PG8_MMA(1, 1, At, B1); PG8_BAR; PG8_SCHED;
            PG8_LDB(B0, 1, 0); PG8_LDB(B1, 1, 1); PG8_SCHED; PG8_LDA(At, 1, 0); PG8_STAGE(PG8_SA(0, 1), a2, v2[1]);
            PG8_WAIT_V(8); PG8_WAIT_L(0); PG8_BAR; PG8_MMA(0, 0, At, B0); PG8_MMA(0, 1, At, B1); PG8_BAR; PG8_SCHED;
            PG8_LDA(At, 1, 1); PG8_STAGE(PG8_SB(1, 0), b3, voffB); PG8_STAGE(PG8_SB(1, 1), b3 + hstepB, voffB); PG8_STAGE(PG8_SA(1, 0), a3, v2[0]);
            PG8_WAIT_V(8); PG8_WAIT_L(0); PG8_BAR; PG8_MMA(1, 0, At, B0); PG8_MMA(1, 1, At, B1); PG8_BAR; PG8_SCHED;
        }
        if (wr == 0) PG8_BAR;
        E(acc, cur, wr, wc, fr, fq);
        if (!has_next) break;
#pragma unroll
        for (int a = 0; a < 2; ++a)
#pragma unroll
            for (int b = 0; b < 2; ++b)
#pragma unroll
                for (int m = 0; m < 4; ++m)
#pragma unroll
                    for (int n = 0; n < 2; ++n) acc[a][b][m][n] = (f32x4){0.f, 0.f, 0.f, 0.f};
        cur = nxt; cA = nA; ++ui;
        if (wr == 1) PG8_BAR;
    }
    PG8_WAIT_V(0);
    PG8_BAR;
#undef PG8_SA
#undef PG8_SB
#undef PG8_STAGE
#undef PG8_LDA
#undef PG8_LDB
#undef PG8_MMA
#undef PG8_WAIT_V
#undef PG8_WAIT_L
#undef PG8_BAR
#undef PG8_SCHED
#undef PG8_BK
#undef PG8_VOFF
#undef PG8_VO
}

struct PlainSched {
    static constexpr bool GATHER = false;
    int nM, nN, nwg, G, c; const char* A; const char* Bt; int lda, ldb, K; int rowmap;
    __device__ __forceinline__ void init(const void* A_, const void* Bt_, int M, int N, int K_, int lda_, int ldb_, int G_, int c_, int rowmap_) {
        A = (const char*)A_; Bt = (const char*)Bt_; nM = M / BM; nN = N / BM; nwg = nM * nN; G = G_; c = c_; lda = lda_; ldb = ldb_; K = K_; rowmap = rowmap_; }
    __device__ __forceinline__ bool next(int i, Unit& u) const {
        const int L = i * G + c; if (L >= nwg) return false;
        int wgid = L; { const int q = nwg / NXCD, r = nwg % NXCD, xcd = wgid % NXCD, off = wgid / NXCD; wgid = (xcd < r ? xcd * (q + 1) : r * (q + 1) + (xcd - r) * q) + off; }
        const int nig = WGM * nN, gid = wgid / nig, fm = gid * WGM, gsz = (nM - fm) < WGM ? (nM - fm) : WGM;
        const int pm = fm + ((wgid % nig) % gsz), pn = (wgid % nig) / gsz;
        u.po = pm; u.pn = pn; u.pm = rowmap ? (pm / 16) * 17 + 1 + (pm % 16) : pm;
        u.A = A + (size_t)u.pm * BM * lda * 2; u.B = Bt + (size_t)pn * BM * ldb * 2; u.B2 = u.B; u.rows = nullptr; u.nvalid = BM; u.aux = 0;
        return true;
    }
};

struct EpiStoreBf16 {
    bf16_t* O; int ldc;
    __device__ __forceinline__ void operator()(const f32x4 (&acc)[2][2][4][2], const Unit& u, int wr, int wc, int fr, int fq) const {
        bf16_t* base = O + (size_t)(u.po * BM + wr * 64 + fr) * ldc + u.pn * BM + wc * 32 + 8 * fq;
#pragma unroll
        for (int ai = 0; ai < 2; ++ai)
#pragma unroll
            for (int m = 0; m < 4; ++m) { bf16_t* rowp = base + (size_t)(ai * HALF + m * 16) * ldc;
#pragma unroll
                for (int bj = 0; bj < 2; ++bj) { const f32x4 v0 = acc[ai][bj][m][0], v1 = acc[ai][bj][m][1];
                    u32x4 w; w.x = cvt_pk_bf16(v0[0], v0[1]); w.y = cvt_pk_bf16(v0[2], v0[3]); w.z = cvt_pk_bf16(v1[0], v1[1]); w.w = cvt_pk_bf16(v1[2], v1[3]);
                    *(u32x4*)(rowp + bj * HALF) = w; } }
    }
};
struct EpiResid {
    const float* x; const float* ctx; float* out; float* xc; const float* modl; int mode;
    __device__ __forceinline__ void operator()(const f32x4 (&acc)[2][2][4][2], const Unit& u, int wr, int wc, int fr, int fq) const {
        const float* src; float* dst; int mrow;
        if (mode == 0) { const int b = u.po / 17, jt = u.po % 17;
            if (jt == 0) { src = ctx + (size_t)b * CTXL * D; dst = xc + (size_t)b * CTXL * D; mrow = 8; }
            else { src = x + ((size_t)b * SEQ + (jt - 1) * 256) * D; dst = out + ((size_t)b * SEQ + (jt - 1) * 256) * D; mrow = b; } }
        else { src = out + (size_t)u.po * BM * D; dst = out + (size_t)u.po * BM * D; mrow = u.po / 16; }
        const float* gate = modl + (size_t)mrow * (NMOD * D) + 2 * D;
        const int col0 = u.pn * BM + wc * 32 + 8 * fq;
        f32x4 gv[2][2];
#pragma unroll
        for (int bj = 0; bj < 2; ++bj)
#pragma unroll
            for (int n = 0; n < 2; ++n) gv[bj][n] = *(const f32x4*)(gate + col0 + bj * HALF + 4 * n);
#pragma unroll
        for (int ai = 0; ai < 2; ++ai)
#pragma unroll
        for (int mp = 0; mp < 2; ++mp) {
            f32x4 sv[2][2][2];
#pragma unroll
            for (int mm = 0; mm < 2; ++mm) { const size_t ro = (size_t)(ai * HALF + wr * 64 + (mp * 2 + mm) * 16 + fr) * D + col0;
#pragma unroll
                for (int bj = 0; bj < 2; ++bj)
#pragma unroll
                    for (int n = 0; n < 2; ++n) sv[mm][bj][n] = *(const f32x4*)(src + ro + bj * HALF + 4 * n); }
            __builtin_amdgcn_sched_barrier(0);
#pragma unroll
            for (int mm = 0; mm < 2; ++mm) { const int m = mp * 2 + mm; const size_t ro = (size_t)(ai * HALF + wr * 64 + m * 16 + fr) * D + col0;
#pragma unroll
                for (int bj = 0; bj < 2; ++bj)
#pragma unroll
                    for (int n = 0; n < 2; ++n) *(f32x4*)(dst + ro + bj * HALF + 4 * n) = sv[mm][bj][n] + gv[bj][n] * acc[ai][bj][m][n]; }
            __builtin_amdgcn_sched_barrier(0);
        }
    }
};
}

struct Args { const float* in[30]; float* out; unsigned char* ws; int ph_lo, ph_hi; };
typedef const __attribute__((address_space(4))) Args& CArgsRef;
#define ARGP() (*({ const __attribute__((address_space(4))) Args* _p = (const __attribute__((address_space(4))) Args*)__builtin_amdgcn_kernarg_segment_ptr(); asm volatile("" : "+s"(_p)); _p; }))
struct Frame {
    LAS unsigned char* lds;
    int tid, lane, wave, G, bid;
    float* out; unsigned char* ws;
    unsigned* ctl;
};
#define WSP(T, off) ((T*)(F.ws + (off)))

__device__ __forceinline__ float* xl_row(const Frame& F, int ta) {
    const int b = ta / TPB, j = ta - b * TPB;
    return j < CTXL ? WSP(float, WS_XC) + (size_t)(b * CTXL + j) * D : F.out + ((size_t)b * SEQ + (j - CTXL)) * D;
}

struct TrItem { const float* src; bf16_t* dst; int N, ldo; };
__device__ __forceinline__ void tr_load(const TrItem& t, f32x4 (&v)[8], int lane) {
#pragma unroll
    for (int i = 0; i < 8; ++i) { const int kk = 8 * i + (lane >> 3); v[i] = *(const f32x4*)(t.src + (size_t)kk * t.N + 4 * (lane & 7)); }
}
__device__ __forceinline__ void tr_finish(const TrItem& t, const f32x4 (&v)[8], LAS float* scr, int lane) {
#pragma unroll
    for (int i = 0; i < 8; ++i) { const int kk = 8 * i + (lane >> 3); LAS float* p = scr + kk * 33 + 4 * (lane & 7); p[0] = v[i].x; p[1] = v[i].y; p[2] = v[i].z; p[3] = v[i].w; }
    LDS_WAIT(); asm volatile("" ::: "memory");
    const int c = lane & 7;
#pragma unroll
    for (int j = 0; j < 4; ++j) { const int n = (lane >> 3) + 8 * j; const LAS float* s = scr + (8 * c) * 33 + n;
        u32x4 o; o.x = cvt_pk_bf16(s[0 * 33], s[1 * 33]); o.y = cvt_pk_bf16(s[2 * 33], s[3 * 33]); o.z = cvt_pk_bf16(s[4 * 33], s[5 * 33]); o.w = cvt_pk_bf16(s[6 * 33], s[7 * 33]);
        *(u32x4*)(t.dst + (size_t)n * t.ldo + 8 * c) = o; }
    LDS_WAIT(); asm volatile("" ::: "memory");
}
__device__ __forceinline__ TrItem tr_generic(const float* W, int K, int N, bf16_t* WT, int item) {
    const int nblk = N / 32, kb = item / nblk, nb = item % nblk;
    return TrItem{W + (size_t)(64 * kb) * N + 32 * nb, WT + (size_t)(32 * nb) * K + 64 * kb, N, K};
}

__device__ __forceinline__ void p0_prologue(Frame& F, CArgsRef A, unsigned long long& pt1) {
    const int tid = F.tid, lane = F.lane, wave = F.wave;
    constexpr int NMODU = 96;
    if (F.bid < NMODU) {
        LAS float* SC = (LAS float*)F.lds;
        LAS float* RED = (LAS float*)(F.lds + 36864);
        {
            float cv[18];
#pragma unroll
            for (int q = 0; q < 18; ++q) { const int i = tid + 512 * q, r = i >> 10, k = i & 1023; cv[q] = r < 8 ? A.in[1][r * 1024 + k] : A.in[3][k]; }
            __builtin_amdgcn_sched_barrier(0);
#pragma unroll
            for (int q = 0; q < 18; ++q) SC[tid + 512 * q] = siluf_(cv[q]);
        }
        __syncthreads();
        float* MOD = WSP(float, WS_MOD);
        for (int u = F.bid; u < NMODU; u += F.G) {
            const int l = u / 48, cb = (u % 48) >> 1, kh = u & 1;
            const float* W = A.in[4] + (size_t)l * D * (NMOD * D) + cb * 256 + 4 * lane;
            f32x4 a[9];
#pragma unroll
            for (int r = 0; r < 9; ++r) a[r] = (f32x4){0.f, 0.f, 0.f, 0.f};
#pragma unroll 1
            for (int kk0 = 0; kk0 < 64; kk0 += 16) { const int k0 = kh * 512 + 64 * wave + kk0;
                f32x4 w[16];
#pragma unroll
                for (int i = 0; i < 16; ++i) w[i] = *(const f32x4*)(W + (size_t)(k0 + i) * (NMOD * D));
                __builtin_amdgcn_sched_barrier(0);
#pragma unroll
                for (int i = 0; i < 16; ++i)
#pragma unroll
                    for (int r = 0; r < 9; ++r) a[r] += w[i] * SC[r * 1024 + k0 + i]; }
#pragma unroll
            for (int r = 0; r < 9; ++r) *(LAS f32x4*)(RED + (wave * 9 + r) * 256 + 4 * lane) = a[r];
            __syncthreads();
            {
                float bs[5];
#pragma unroll
                for (int q = 0; q < 5; ++q) { const int o = tid + 512 * q; bs[q] = (kh == 0 && o < 9 * 256) ? A.in[5][l * (NMOD * D) + cb * 256 + (o & 255)] : 0.f; }
#pragma unroll
                for (int q = 0; q < 5; ++q) { const int o = tid + 512 * q; if (o < 9 * 256) { const int r = o >> 8, cc = o & 255; float sm = 0.f;
#pragma unroll
                    for (int w = 0; w < 8; ++w) sm += RED[(w * 9 + r) * 256 + cc];
                    atomicAdd(&MOD[((size_t)l * 9 + r) * (NMOD * D) + cb * 256 + cc], sm + bs[q]); } }
            }
            __syncthreads();
        }
    }
    if (PT_SUB == 1) pt1 = __builtin_amdgcn_s_memrealtime();
    {
        const float invf[16] = {1.000000000e+00f, 5.623413324e-01f, 3.162277639e-01f, 1.778279394e-01f, 1.000000015e-01f, 5.623413250e-02f, 3.162277490e-02f, 1.778279431e-02f,
                                9.999999776e-03f, 5.623413250e-03f, 3.162277630e-03f, 1.778279431e-03f, 1.000000047e-03f, 5.623413017e-04f, 3.162277571e-04f, 1.778279402e-04f};
        float* COS = WSP(float, WS_COS); float* SIN = WSP(float, WS_SIN);
        for (int i = F.bid * 512 + tid; i < SEQ * 32; i += F.G * 512) {
            const int pos = i >> 5, j = i & 31, f = j & 15; const float p = (float)(j < 16 ? (pos >> 6) : (pos & 63));
            float fr = 1.f;
#pragma unroll
            for (int q = 0; q < 16; ++q) fr = (f == q) ? invf[q] : fr;
            const float angf = p * fr; const double x = (double)angf;
            const double n = __builtin_rint(x * 0.63661977236758134308);
            const double y = (x - n * 1.57079632679489655800e+00) - n * 6.12323399573676603587e-17;
            const double y2 = y * y;
            double sn = y * (1.0 + y2 * (-1.0 / 6 + y2 * (1.0 / 120 + y2 * (-1.0 / 5040 + y2 * (1.0 / 362880 + y2 * (-1.0 / 39916800 + y2 * (1.0 / 6227020800.0)))))));
            double cs = 1.0 + y2 * (-0.5 + y2 * (1.0 / 24 + y2 * (-1.0 / 720 + y2 * (1.0 / 40320 + y2 * (-1.0 / 3628800 + y2 * (1.0 / 479001600.0 + y2 * (-1.0 / 87178291200.0)))))));
            const int q4 = ((int)n) & 3;
            const double c = (q4 == 0) ? cs : (q4 == 1) ? -sn : (q4 == 2) ? -cs : sn;
            const double s = (q4 == 0) ? sn : (q4 == 1) ? cs : (q4 == 2) ? -sn : -cs;
            COS[i] = (float)c; SIN[i] = (float)s;
        }
    }
    if (PT_SUB == 2) pt1 = __builtin_amdgcn_s_memrealtime();
    {
        LAS float* scr = (LAS float*)(F.lds + wave * 16384);
        constexpr int I_IN0 = 16 * 48, I_OUT = 16 * 32, I_IN1 = 16 * 62, I_UQ = 4 * 24, I_UKV = 2 * 32, I_POOL = 4 * 8, I_MOE = 64 * 384;
        constexpr int NIT = I_IN0 + I_OUT + I_IN1 + I_UQ + I_UKV + I_OUT + I_POOL + I_MOE;
        int it0, it1, step;
        if (F.G == 256) {
            const int wv = F.bid * 8 + wave;
            it0 = F.bid < NMODU ? wv * 12 : NMODU * 8 * 12 + (wv - NMODU * 8) * 15; it1 = it0 + (F.bid < NMODU ? 12 : 15); if (it1 > NIT) it1 = NIT; if (it0 > NIT) it0 = NIT; step = 1;
            static_assert(NMODU * 8 * 12 + (256 - NMODU) * 8 * 15 >= NIT, "prologue item split");
        } else { it0 = F.bid * 8 + wave; it1 = NIT; step = F.G * 8; }
        unsigned char* ws_ = F.ws;
        auto item_of = [&](int it) -> TrItem {
            int r = it;
            if (r < I_IN0) return tr_generic(A.in[7], D, 1536, (bf16_t*)(ws_ + WS_WIN0), r); r -= I_IN0;
            if (r < I_OUT) return tr_generic(A.in[14], D, D, (bf16_t*)(ws_ + WS_WOUT0), r); r -= I_OUT;
            if (r < I_IN1) return tr_generic(A.in[15], D, 1984, (bf16_t*)(ws_ + WS_WIN1), r); r -= I_IN1;
            if (r < I_UQ) return tr_generic(A.in[17], 256, 768, (bf16_t*)(ws_ + WS_WUQ), r); r -= I_UQ;
            if (r < I_UKV) return tr_generic(A.in[19], 128, 1024, (bf16_t*)(ws_ + WS_WUKV), r); r -= I_UKV;
            if (r < I_OUT) return tr_generic(A.in[24], D, D, (bf16_t*)(ws_ + WS_WOUT1), r); r -= I_OUT;
            if (r < I_POOL) { const int g = r / 8; return tr_generic(A.in[12] + (size_t)g * 128 * 128, 128, 128, (bf16_t*)(ws_ + WS_WPOOL) + (size_t)g * 128 * 128, r % 8); } r -= I_POOL;
            const int le = r / 384, q = r % 384;
            bf16_t* W1 = (bf16_t*)(ws_ + WS_WM1) + (size_t)le * 512 * 1024; bf16_t* W2 = (bf16_t*)(ws_ + WS_WM2) + (size_t)le * 1024 * 256;
            if (q < 256) {
                const int up = q >> 7, item = q & 127, kb = item / 8, nb = item % 8, n0 = 32 * nb;
                const float* W = A.in[up ? 28 : 27] + (size_t)le * 1024 * 256;
                const int drow = (n0 >> 7) * 256 + up * 128 + (n0 & 127);
                return TrItem{W + (size_t)(64 * kb) * 256 + n0, W1 + (size_t)drow * 1024 + 64 * kb, 256, 1024};
            }
            return tr_generic(A.in[29] + (size_t)le * 256 * 1024, 256, 1024, W2, q - 256);
        };
        for (int it = it0; it < it1; it += 4 * step) {
            TrItem t0 = item_of(it), t1 = item_of(it + step < it1 ? it + step : it), t2 = item_of(it + 2 * step < it1 ? it + 2 * step : it), t3 = item_of(it + 3 * step < it1 ? it + 3 * step : it);
            f32x4 v0[8], v1[8], v2[8], v3[8];
            tr_load(t0, v0, lane); tr_load(t1, v1, lane); tr_load(t2, v2, lane); tr_load(t3, v3, lane);
            __builtin_amdgcn_sched_barrier(0);
            tr_finish(t0, v0, scr, lane);
            if (it + step < it1) tr_finish(t1, v1, scr, lane);
            if (it + 2 * step < it1) tr_finish(t2, v2, scr, lane);
            if (it + 3 * step < it1) tr_finish(t3, v3, scr, lane);
        }
        { u32x4* z = (u32x4*)(WSP(bf16_t, WS_WIN1) + (size_t)1984 * 1024); const u32x4 zero = {0u, 0u, 0u, 0u};
          for (int i = F.bid * 512 + tid; i < 64 * 1024 / 8; i += F.G * 512) z[i] = zero; }
    }
}

__device__ __forceinline__ void norm_mod_phase(Frame& F, CArgsRef A, int layer) {
    const int gw = F.bid * 8 + F.wave, NGW = F.G * 8, lane = F.lane;
    const float* g = A.in[6] + (size_t)(layer * 2 + 0) * D;
    const float* MODL = WSP(float, WS_MOD) + (size_t)layer * 9 * (NMOD * D);
    bf16_t* H = WSP(bf16_t, WS_H);
    f32x4 gvec[4];
#pragma unroll
    for (int q = 0; q < 4; ++q) gvec[q] = *(const f32x4*)(g + 4 * lane + 256 * q);
    for (int ta0 = gw; ta0 < NTOK; ta0 += 2 * NGW) {
        const int ta1 = ta0 + NGW; const bool has1 = ta1 < NTOK;
        f32x4 v[2][4], s4[2][4], h4[2][4];
#pragma unroll
        for (int e = 0; e < 2; ++e) { const int ta = e ? (has1 ? ta1 : ta0) : ta0; const int b = ta / TPB, j = ta - b * TPB, mrow = j < CTXL ? 8 : b;
            const float* src = layer == 0 ? (j < CTXL ? A.in[2] + (size_t)(b * CTXL + j) * D : A.in[0] + ((size_t)b * SEQ + (j - CTXL)) * D) : xl_row(F, ta);
            const f32x4* xr = (const f32x4*)src + lane;
            const float* sh = MODL + (size_t)mrow * (NMOD * D); const float* sc = sh + D;
#pragma unroll
            for (int q = 0; q < 4; ++q) { v[e][q] = xr[64 * q]; s4[e][q] = *(const f32x4*)(sc + 4 * lane + 256 * q); h4[e][q] = *(const f32x4*)(sh + 4 * lane + 256 * q); } }
        __builtin_amdgcn_sched_barrier(0);
#pragma unroll
        for (int e = 0; e < 2; ++e) { const int ta = e ? ta1 : ta0; if (e && !has1) break;
            float s = 0.f;
#pragma unroll
            for (int q = 0; q < 4; ++q) s += (v[e][q].x * v[e][q].x + v[e][q].y * v[e][q].y) + (v[e][q].z * v[e][q].z + v[e][q].w * v[e][q].w);
            const float r = 1.f / sqrtf(wave_sum(s) * (1.f / D) + EPS);
            u32x2* o8 = (u32x2*)(H + (size_t)ta * D) + lane;
#pragma unroll
            for (int q = 0; q < 4; ++q) { const f32x4 y = (v[e][q] * r) * gvec[q] * (s4[e][q] + 1.f) + h4[e][q];
                u32x2 w; w.x = cvt_pk_bf16(y.x, y.y); w.y = cvt_pk_bf16(y.z, y.w); o8[64 * q] = w; } }
    }
}

__device__ __forceinline__ void convpool_phase(Frame& F, CArgsRef A, unsigned long long& pt1) {
    const int tid = F.tid, lane = F.lane, wave = F.wave, r32 = lane & 31, hi = lane >> 5;
    const bf16_t* __restrict__ U = WSP(bf16_t, WS_BIG); bf16_t* __restrict__ Y = WSP(bf16_t, WS_YMIX); const bf16_t* __restrict__ WP = WSP(bf16_t, WS_WPOOL);
    {
        LAS bf16_t* GL = (LAS bf16_t*)F.lds;
        LAS float* CV = (LAS float*)(F.lds + 63488);
        const int c0 = wave * 64 + lane;
        float w0[31];
#pragma unroll
        for (int k = 0; k < 31; ++k) w0[k] = A.in[8][k * 512 + c0];
        const float dwb = A.in[9][c0];
        const f32x4 lg0 = *(const f32x4*)(A.in[10] + 8 * lane), lg1 = *(const f32x4*)(A.in[10] + 8 * lane + 4), lb0 = *(const f32x4*)(A.in[11] + 8 * lane), lb1 = *(const f32x4*)(A.in[11] + 8 * lane + 4);
#define CP_UNIT(u_, b, n, tb, t0, TS) int b, n, tb, t0, TS; if ((u_) < 1024) { b = (u_) >> 7; n = SEQ; tb = b * TPB + CTXL; t0 = ((u_) & 127) * 32; TS = 32; } else { const int uu = (u_) - 1024; b = uu >> 5; n = CTXL; tb = b * TPB; t0 = (uu & 31) * 8; TS = 8; }
#define CPA_LOAD(u_) do { CP_UNIT(u_, b_, n_, tb_, t0_, TS_); const int nG_ = (TS_ + 30) * 64; (void)b_; \
            _Pragma("unroll") for (int q = 0; q < 8; ++q) { const int ch = q * 512 + tid, ri = ch >> 6, c8 = (ch & 63) * 8, pos = t0_ + ri - 15; const bool ok = (ch < nG_) && pos >= 0 && pos < n_; \
                const bf16_t* up = U + (size_t)(tb_ + (ok ? pos : t0_)) * UW + c8; av[q] = *(const u32x4*)up; gv[q] = *(const u32x4*)(up + 512); } } while (0)
        u32x4 av[8], gv[8];
        if (F.bid < 1280) CPA_LOAD(F.bid);
        for (int u = F.bid; u < 1280; u += F.G) {
            CP_UNIT(u, b, n, tb, t0, TS); (void)b;
            __syncthreads();
            const int nG = (TS + 30) * 64;
#pragma unroll
            for (int q = 0; q < 8; ++q) { const int ch = q * 512 + tid, ri = ch >> 6, c8 = (ch & 63) * 8, pos = t0 + ri - 15; const bool ok = pos >= 0 && pos < n;
                u32x4 o;
#pragma unroll
                for (int e = 0; e < 4; ++e) { const float a0 = bflo(av[q][e]), a1 = bfhi(av[q][e]), g0 = bflo(gv[q][e]), g1 = bfhi(gv[q][e]);
                    o[e] = cvt_pk_bf16(a0 * __builtin_amdgcn_rcpf(1.f + __expf(-g0)), a1 * __builtin_amdgcn_rcpf(1.f + __expf(-g1))); }
                if (!ok) o = (u32x4){0u, 0u, 0u, 0u};
                if (ch < nG) *(LAS u32x4*)(GL + ri * 512 + c8) = o; }
            __builtin_amdgcn_sched_barrier(0);
            if (u + F.G < 1280) CPA_LOAD(u + F.G);
            __builtin_amdgcn_sched_barrier(0);
            __syncthreads();
#pragma unroll 1
            for (int i0 = 0; i0 < TS; i0 += 4) {
                float x0[4];
#pragma unroll
                for (int q = 0; q < 4; ++q) x0[q] = dwb;
#pragma unroll
                for (int r = 0; r < 34; ++r) { const float g0 = bf2f(*(const LAS unsigned short*)(GL + (i0 + r) * 512 + c0));
#pragma unroll
                    for (int q = 0; q < 4; ++q) { const int k = r - q; if (k >= 0 && k < 31) x0[q] += g0 * w0[k]; } }
#pragma unroll
                for (int q = 0; q < 4; ++q) CV[(i0 + q) * 512 + c0] = x0[q];
            }
            __syncthreads();
            for (int tk = wave; tk < TS; tk += 8) {
                const f32x4 v0 = *(const LAS f32x4*)(CV + tk * 512 + 8 * lane), v1 = *(const LAS f32x4*)(CV + tk * 512 + 8 * lane + 4);
                const float sm = wave_sum((v0.x + v0.y) + (v0.z + v0.w) + (v1.x + v1.y) + (v1.z + v1.w));
                const float mean = sm * (1.f / 512.f);
                const f32x4 d0 = v0 - mean, d1 = v1 - mean;
                const float s2 = wave_sum((d0.x * d0.x + d0.y * d0.y) + (d0.z * d0.z + d0.w * d0.w) + (d1.x * d1.x + d1.y * d1.y) + (d1.z * d1.z + d1.w * d1.w));
                const float rstd = 1.f / sqrtf(s2 * (1.f / 512.f) + EPS);
                const f32x4 y0 = d0 * rstd * lg0 + lb0, y1 = d1 * rstd * lg1 + lb1;
                u32x4 o; o.x = cvt_pk_bf16(siluf_(y0.x), siluf_(y0.y)); o.y = cvt_pk_bf16(siluf_(y0.z), siluf_(y0.w)); o.z = cvt_pk_bf16(siluf_(y1.x), siluf_(y1.y)); o.w = cvt_pk_bf16(siluf_(y1.z), siluf_(y1.w));
                *(u32x4*)(Y + (size_t)(tb + t0 + tk) * D + 8 * lane) = o;
            }
        }
    }
    if (PT_SUB == 4) pt1 = __builtin_amdgcn_s_memrealtime();
    {
        LAS bf16_t* UP = (LAS bf16_t*)F.lds;
        LAS bf16_t* PL = (LAS bf16_t*)(F.lds + 49152);
        bf16x8 wfr[2][8]; float pscv[2];
#pragma unroll
        for (int ntile = 0; ntile < 2; ++ntile) { const int gi = wave >> 1, n0 = (wave & 1) * 64 + ntile * 32; pscv[ntile] = A.in[13][gi * 128 + n0 + r32];
#pragma unroll
            for (int ks = 0; ks < 8; ++ks) wfr[ntile][ks] = *(const bf16x8*)(WP + ((size_t)(gi * 128 + n0 + r32)) * 128 + ks * 16 + hi * 8); }
#define CPB_LOAD(u_) do { CP_UNIT(u_, b_, n_, tb_, t0_, TS_); const int nU_ = (TS_ + 16) * 64; (void)b_; \
            _Pragma("unroll") for (int q = 0; q < 6; ++q) { const int ch = q * 512 + tid, ri = ch >> 6, c8 = (ch & 63) * 8, pos = t0_ + ri - 8; const bool ok = (ch < nU_) && pos >= 0 && pos < n_; \
                uv[q] = *(const u32x4*)(U + (size_t)(tb_ + (ok ? pos : t0_)) * UW + 1024 + c8); if (!ok) uv[q] = (u32x4){0u, 0u, 0u, 0u}; } } while (0)
        u32x4 uv[6];
        if (F.bid < 1280) CPB_LOAD(F.bid);
        for (int u = F.bid; u < 1280; u += F.G) {
            CP_UNIT(u, b, n, tb, t0, TS); (void)b;
            __syncthreads();
            const int nU = (TS + 16) * 64;
#pragma unroll
            for (int q = 0; q < 6; ++q) { const int ch = q * 512 + tid, ri = ch >> 6, c8 = (ch & 63) * 8; if (ch < nU) *(LAS u32x4*)(UP + ri * 512 + c8) = uv[q]; }
            __builtin_amdgcn_sched_barrier(0);
            if (u + F.G < 1280) CPB_LOAD(u + F.G);
            __builtin_amdgcn_sched_barrier(0);
            __syncthreads();
#pragma unroll 1
            for (int e = tid; e < 32 * 64; e += 512) { const int i = e >> 6, c8 = (e & 63) * 8, gi = c8 >> 7, hw = 1 << gi, pos = t0 + i;
                u32x4 o = {0u, 0u, 0u, 0u};
                if (i < TS) {
                    const int lo = (pos - hw) > 0 ? (pos - hw) : 0, hh = (pos + hw) < n ? (pos + hw) : n;
                    float s[8];
#pragma unroll
                    for (int j = 0; j < 8; ++j) s[j] = 0.f;
                    for (int p = lo; p < hh; ++p) { const u32x4 v = *(const LAS u32x4*)(UP + (p - t0 + 8) * 512 + c8);
                        s[0] += bflo(v.x); s[1] += bfhi(v.x); s[2] += bflo(v.y); s[3] += bfhi(v.y); s[4] += bflo(v.z); s[5] += bfhi(v.z); s[6] += bflo(v.w); s[7] += bfhi(v.w); }
                    const float ic = 1.f / (float)(hh - lo);
                    const u32x4 v = *(const LAS u32x4*)(UP + (i + 8) * 512 + c8);
                    o.x = cvt_pk_bf16(s[0] * ic - bflo(v.x), s[1] * ic - bfhi(v.x)); o.y = cvt_pk_bf16(s[2] * ic - bflo(v.y), s[3] * ic - bfhi(v.y));
                    o.z = cvt_pk_bf16(s[4] * ic - bflo(v.z), s[5] * ic - bfhi(v.z)); o.w = cvt_pk_bf16(s[6] * ic - bflo(v.w), s[7] * ic - bfhi(v.w)); }
                *(LAS u32x4*)(PL + i * 512 + c8) = o; }
            __syncthreads();
            {
                const int gi = wave >> 1, nh = wave & 1;
#pragma unroll
                for (int ntile = 0; ntile < 2; ++ntile) { const int n0 = nh * 64 + ntile * 32;
                    f32x16 acc = {};
#pragma unroll
                    for (int ks = 0; ks < 8; ++ks) { const bf16x8 a = *(const LAS bf16x8*)(PL + r32 * 512 + gi * 128 + ks * 16 + hi * 8);
                        acc = __builtin_amdgcn_mfma_f32_32x32x16_bf16(a, wfr[ntile][ks], acc, 0, 0, 0); }
                    const float psc = pscv[ntile];
#pragma unroll
                    for (int r = 0; r < 16; ++r) { const int tk = crow(r, hi); if (tk < TS) Y[(size_t)(tb + t0 + tk) * D + 512 + gi * 128 + n0 + r32] = f2bf(acc[r] * psc); } }
            }
        }
    }
#undef CP_UNIT
#undef CPA_LOAD
#undef CPB_LOAD
    __syncthreads();
}

__device__ __forceinline__ void router_phase(Frame& F, CArgsRef A, int layer) {
    const int tid = F.tid, lane = F.lane, wave = F.wave, r32 = lane & 31, hi = lane >> 5;
    LAS float* T = (LAS float*)F.lds;
    LAS float* LOG = (LAS float*)(F.lds + 133120);
    LAS float* BIA = (LAS float*)(F.lds + 133120 + 4224);
    const float rbias = A.in[26][tid & 31];
    LAS float* VA = (LAS float*)(F.lds + 141568);
    LAS float* VB = VA + 1024;
    const float* g = A.in[6] + (size_t)(layer * 2 + 1) * D;
    const float* MODL = WSP(float, WS_MOD) + (size_t)layer * 9 * (NMOD * D);
    bf16_t* H = WSP(bf16_t, WS_H);
    unsigned* CNT = F.ctl + CW_CNT + layer * 64; int* LIST = WSP(int, WS_LIST); f32x2* TW = WSP(f32x2, WS_TW);
    float rwreg[64];
#pragma unroll
    for (int s = 0; s < 64; ++s) rwreg[s] = A.in[25][(size_t)(128 * wave + 2 * s + hi) * NEXP + r32];
    const int ngroups = layer == 0 ? NTOK / 32 : NLAT / 32;
    for (int grp = F.bid; grp < ngroups; grp += F.G) {
        const int ta0 = layer == 0 ? grp * 32 : (grp >> 7) * TPB + CTXL + (grp & 127) * 32;
        __syncthreads();
        {
            f32x4 v[4][4];
#pragma unroll
            for (int q = 0; q < 4; ++q) { const f32x4* xr = (const f32x4*)xl_row(F, ta0 + 4 * wave + q) + lane;
#pragma unroll
                for (int c = 0; c < 4; ++c) v[q][c] = xr[64 * c]; }
            {
                const int b0 = ta0 / TPB, j0 = ta0 - b0 * TPB, mrow = j0 < CTXL ? 8 : b0;
                const float* sh = MODL + (size_t)mrow * (NMOD * D) + 3 * D; const float* sc = sh + D;
                const f32x2 g2 = *(const f32x2*)(g + 2 * tid), s2 = *(const f32x2*)(sc + 2 * tid), h2 = *(const f32x2*)(sh + 2 * tid);
                __builtin_amdgcn_sched_barrier(0);
                *(LAS f32x2*)(VA + 2 * tid) = g2 * (s2 + 1.f); *(LAS f32x2*)(VB + 2 * tid) = h2;
            }
            float rr[4];
#pragma unroll
            for (int q = 0; q < 4; ++q) { float s = 0.f;
#pragma unroll
                for (int c = 0; c < 4; ++c) s += (v[q][c].x * v[q][c].x + v[q][c].y * v[q][c].y) + (v[q][c].z * v[q][c].z + v[q][c].w * v[q][c].w);
                rr[q] = 1.f / sqrtf(wave_sum(s) * (1.f / D) + EPS); }
            __syncthreads();
#pragma unroll
            for (int q = 0; q < 4; ++q) { const int ti = 4 * wave + q, ta = ta0 + ti;
                u32x2* o8 = (u32x2*)(H + (size_t)ta * D) + lane;
#pragma unroll
                for (int c = 0; c < 4; ++c) { const int col = 4 * lane + 256 * c;
                    const f32x4 a4 = *(const LAS f32x4*)(VA + col), b4 = *(const LAS f32x4*)(VB + col);
                    const f32x4 y = (v[q][c] * rr[q]) * a4 + b4;
                    u32x2 w; w.x = cvt_pk_bf16(y.x, y.y); w.y = cvt_pk_bf16(y.z, y.w); o8[64 * c] = w;
                    LAS float* tp = T + ti * 1025 + col; tp[0] = y.x; tp[1] = y.y; tp[2] = y.z; tp[3] = y.w; } }
        }
        __syncthreads();
        f32x16 acc = {};
#pragma unroll
        for (int s = 0; s < 64; ++s) { const float a = T[r32 * 1025 + 128 * wave + 2 * s + hi]; acc = __builtin_amdgcn_mfma_f32_32x32x2f32(a, rwreg[s], acc, 0, 0, 0); }
        __syncthreads();
        { LAS float* RED = T + wave * (32 * 33);
#pragma unroll
          for (int r = 0; r < 16; ++r) RED[crow(r, hi) * 33 + r32] = acc[r]; }
        __syncthreads();
        for (int e = tid; e < 1024; e += 512) { const int tk = e >> 5, ex = e & 31; float s = 0.f;
#pragma unroll
            for (int w = 0; w < 8; ++w) s += T[w * (32 * 33) + tk * 33 + ex];
            const float sg = __builtin_amdgcn_rcpf(1.f + __expf(-s));
            LOG[tk * 33 + ex] = sg; BIA[tk * 33 + ex] = sg + rbias; }
        __syncthreads();
        if (tid < 32) { const int ta = ta0 + tid;
            float bestg = -1e30f, bs1 = 0.f, bs2 = 0.f; int bi1 = 0, bi2 = 1, bgrp = 0;
#pragma unroll
            for (int gq = 0; gq < 8; ++gq) { float sc[4], bb[4];
#pragma unroll
                for (int q = 0; q < 4; ++q) { sc[q] = LOG[tid * 33 + gq * 4 + q]; bb[q] = BIA[tid * 33 + gq * 4 + q]; }
                int i1 = 0; float m1 = bb[0];
#pragma unroll
                for (int q = 1; q < 4; ++q) if (bb[q] > m1) { m1 = bb[q]; i1 = q; }
                int i2 = -1; float m2 = -1e30f;
#pragma unroll
                for (int q = 0; q < 4; ++q) if (q != i1 && bb[q] > m2) { m2 = bb[q]; i2 = q; }
                const float gs = m1 + m2;
                float s1 = sc[0], s2 = sc[0];
#pragma unroll
                for (int q = 1; q < 4; ++q) { s1 = (i1 == q) ? sc[q] : s1; s2 = (i2 == q) ? sc[q] : s2; }
                if (gs > bestg) { bestg = gs; bgrp = gq; bi1 = i1; bi2 = i2; bs1 = s1; bs2 = s2; } }
            const float inv = 1.f / (bs1 + bs2); const float w1 = bs1 * inv, w2 = bs2 * inv;
            const int lo = bi1 < bi2 ? bi1 : bi2, hh = bi1 < bi2 ? bi2 : bi1;
            const float wlo = bi1 < bi2 ? w1 : w2, whi = bi1 < bi2 ? w2 : w1;
            const int pair = (lo == 0) ? (hh - 1) : (lo == 1 ? (hh + 1) : 5);
            const int bucket = bgrp * 6 + pair;
            const unsigned pos = atomicAdd(&CNT[bucket], 1u);
            LIST[(size_t)bucket * LCAP + pos] = ta; TW[ta] = (f32x2){wlo, whi}; }
    }
    __syncthreads();
}

struct MoeSched {
    static constexpr bool GATHER_ = true;
    int G, c, ntiles, layer, stage; const unsigned* cnt; const int* list; const char* A; const char* W; LAS int* pre;
};
template <bool G1> struct MoeSchedT {
    static constexpr bool GATHER = G1;
    MoeSched m;
    __device__ __forceinline__ bool next(int i, pg8::Unit& u) const {
        const int L = i * m.G + m.c; if (L >= m.ntiles * 4) return false;
        const int tile = L >> 2, pn = L & 3;
        int bk = 0;
        for (int q = 1; q < NBUCK; ++q) bk = (m.pre[q] <= tile) ? q : bk;
        const int tin = tile - m.pre[bk], cntb = (int)m.cnt[bk];
        const int grp = bk / 6, pair = bk % 6;
        const int lo = pair < 3 ? 0 : (pair < 5 ? 1 : 2), hh = pair < 3 ? pair + 1 : (pair < 5 ? pair - 1 : 3);
        const int e1 = grp * 4 + lo, e2 = grp * 4 + hh;
        u.pm = tile; u.po = tile; u.pn = pn; u.rows = m.list + (size_t)bk * LCAP + tin * 256; u.nvalid = (cntb - tin * 256) < 256 ? (cntb - tin * 256) : 256; u.aux = pn >> 1;
        if (G1) {
            const int e = (pn < 2) ? e1 : e2;
            u.A = m.A; u.B = m.W + ((size_t)(m.layer * NEXP + e) * 512 + (pn & 1) * 256) * 1024 * 2; u.B2 = u.B;
        } else {
            u.A = m.A + (size_t)tile * 256 * 512 * 2;
            u.B = m.W + ((size_t)(m.layer * NEXP + e1) * 1024 + pn * 256) * 256 * 2;
            u.B2 = m.W + ((size_t)(m.layer * NEXP + e2) * 1024 + pn * 256) * 256 * 2 - (size_t)4 * 128;
        }
        return true;
    }
};
struct EpiMoe1 {
    bf16_t* HE; const f32x2* TW;
    __device__ __forceinline__ void operator()(const f32x4 (&acc)[2][2][4][2], const pg8::Unit& u, int wr, int wc, int fr, int fq) const {
        const int slot = u.aux;
        int tok[8]; f32x2 tw[8];
#pragma unroll
        for (int q = 0; q < 8; ++q) { const int r = (q >> 2) * 128 + wr * 64 + (q & 3) * 16 + fr; tok[q] = u.rows[r < u.nvalid ? r : 0]; }
        __builtin_amdgcn_sched_barrier(0);
#pragma unroll
        for (int q = 0; q < 8; ++q) tw[q] = TW[tok[q]];
        __builtin_amdgcn_sched_barrier(0);
#pragma unroll
        for (int ai = 0; ai < 2; ++ai)
#pragma unroll
            for (int m = 0; m < 4; ++m) { const int r = ai * 128 + wr * 64 + m * 16 + fr; const float w = slot ? tw[ai * 4 + m].y : tw[ai * 4 + m].x;
                float o[8];
#pragma unroll
                for (int n = 0; n < 2; ++n)
#pragma unroll
                    for (int q = 0; q < 4; ++q) { const float gt = acc[ai][0][m][n][q], up = acc[ai][1][m][n][q]; o[4 * n + q] = gt * __builtin_amdgcn_rcpf(1.f + __expf(-gt)) * up * w; }
                u32x4 wv; wv.x = cvt_pk_bf16(o[0], o[1]); wv.y = cvt_pk_bf16(o[2], o[3]); wv.z = cvt_pk_bf16(o[4], o[5]); wv.w = cvt_pk_bf16(o[6], o[7]);
                *(u32x4*)(HE + (size_t)(u.po * 256 + r) * 512 + slot * 256 + (u.pn & 1) * 128 + wc * 32 + 8 * fq) = wv; }
    }
};
struct EpiMoe2 {
    float* out; float* xc; const float* modl;
    __device__ __forceinline__ void operator()(const f32x4 (&acc)[2][2][4][2], const pg8::Unit& u, int wr, int wc, int fr, int fq) const {
        const int col0 = u.pn * 256 + wc * 32 + 8 * fq;
        int tok[8];
#pragma unroll
        for (int q = 0; q < 8; ++q) { const int r = (q >> 2) * 128 + wr * 64 + (q & 3) * 16 + fr; tok[q] = u.rows[r < u.nvalid ? r : 0]; }
        __builtin_amdgcn_sched_barrier(0);
#pragma unroll
        for (int ai = 0; ai < 2; ++ai)
#pragma unroll
        for (int mp = 0; mp < 2; ++mp) {
            f32x4 sv[2][2][2]; float* dp[2]; const float* gp[2];
#pragma unroll
            for (int mm = 0; mm < 2; ++mm) { const int m = mp * 2 + mm; const int tk = tok[ai * 4 + m]; const int b = tk / TPB, j = tk - b * TPB; const int mrow = j < CTXL ? 8 : b;
                gp[mm] = modl + (size_t)mrow * (NMOD * D) + 5 * D + col0;
                dp[mm] = (j < CTXL ? xc + (size_t)(b * CTXL + j) * D : out + ((size_t)b * SEQ + (j - CTXL)) * D) + col0;
#pragma unroll
                for (int bj = 0; bj < 2; ++bj)
#pragma unroll
                    for (int n = 0; n < 2; ++n) sv[mm][bj][n] = *(const f32x4*)(dp[mm] + bj * 128 + 4 * n); }
            __builtin_amdgcn_sched_barrier(0);
#pragma unroll
            for (int mm = 0; mm < 2; ++mm) { const int m = mp * 2 + mm; const int r = ai * 128 + wr * 64 + m * 16 + fr;
                if (r < u.nvalid) {
#pragma unroll
                    for (int bj = 0; bj < 2; ++bj)
#pragma unroll
                        for (int n = 0; n < 2; ++n) { const f32x4 gvv = *(const f32x4*)(gp[mm] + bj * 128 + 4 * n); *(f32x4*)(dp[mm] + bj * 128 + 4 * n) = sv[mm][bj][n] + gvv * acc[ai][bj][m][n]; } } }
            __builtin_amdgcn_sched_barrier(0);
        }
    }
};
__device__ __forceinline__ int moe_prefix(Frame& F, int layer, LAS int* pre) {
    __syncthreads();
    if (F.tid == 0) { int s = 0; const unsigned* cnt = F.ctl + CW_CNT + layer * 64; for (int q = 0; q < NBUCK; ++q) { pre[q] = s; s += ((int)cnt[q] + 255) >> 8; } pre[NBUCK] = s; }
    __syncthreads();
    return pre[NBUCK];
}

__device__ __forceinline__ void p9_phase(Frame& F, CArgsRef A) {
    const int gw = F.bid * 8 + F.wave, NGW = F.G * 8, l = F.lane;
    bf16_t* P = WSP(bf16_t, WS_BIG); const float* COS = WSP(float, WS_COS); const float* SIN = WSP(float, WS_SIN);
    const int kind = l < 8 ? 0 : l < 24 ? 1 : l < 28 ? 2 : l < 30 ? 5 : l < 46 ? 3 : 5;
    float gg[32];
    {
        const float* gp = nullptr;
        if (kind == 0) gp = A.in[16] + 32 * l; else if (kind == 1) gp = A.in[21] + 0 * 64 + (l & 1) * 32; else if (kind == 2) gp = A.in[18] + 32 * (l - 24); else if (kind == 3) gp = A.in[21] + 1 * 64 + (l & 1) * 32;
#pragma unroll
        for (int j = 0; j < 32; ++j) gg[j] = gp ? gp[j] : 1.f;
    }
    for (int tb0 = gw; tb0 < NTOK; tb0 += 2 * NGW) {
        const int tb1 = tb0 + NGW; const bool has1 = tb1 < NTOK;
        u32x4 wq[2][4]; f32x4 csv[2][8], snv[2][8];
#pragma unroll
        for (int e = 0; e < 2; ++e) { const int ta = e ? (has1 ? tb1 : tb0) : tb0; const bf16_t* rp = P + (size_t)ta * PW + 32 * l;
            const int b_ = ta / TPB, jj_ = ta - b_ * TPB; const int pos_ = jj_ >= CTXL ? jj_ - CTXL : 0;
            const f32x4* cp = (const f32x4*)(COS + (size_t)pos_ * 32); const f32x4* sp = (const f32x4*)(SIN + (size_t)pos_ * 32);
#pragma unroll
            for (int q = 0; q < 4; ++q) wq[e][q] = *(const u32x4*)(rp + 8 * q);
#pragma unroll
            for (int q = 0; q < 8; ++q) { csv[e][q] = cp[q]; snv[e][q] = sp[q]; } }
        __builtin_amdgcn_sched_barrier(0);
#pragma unroll
        for (int e = 0; e < 2; ++e) {
            const int ta = e ? tb1 : tb0; if (e && !has1) break;
            const int b = ta / TPB, jj = ta - b * TPB; const bool lat = jj >= CTXL; const int pos = jj - CTXL;
            bf16_t* rowp = P + (size_t)ta * PW + 32 * l;
            float v[32]; float ss = 0.f;
#pragma unroll
            for (int q = 0; q < 4; ++q)
#pragma unroll
                for (int c = 0; c < 4; ++c) { v[8 * q + 2 * c] = bflo(wq[e][q][c]); v[8 * q + 2 * c + 1] = bfhi(wq[e][q][c]); }
#pragma unroll
            for (int j = 0; j < 32; ++j) ss += v[j] * v[j];
            const float s1 = ss + __shfl_xor(ss, 1), s2 = s1 + __shfl_xor(s1, 2), s4 = s2 + __shfl_xor(s2, 4);
            const float tot = kind == 0 ? s4 : kind == 2 ? s2 : s1;
            const float nn = kind == 0 ? 256.f : kind == 2 ? 128.f : 64.f;
            const float r = 1.f / sqrtf(tot / nn + EPS);
            const bool act = (kind == 0 && lat) || (kind == 1 && lat) || kind == 2 || kind == 3;
#pragma unroll
            for (int j = 0; j < 32; ++j) v[j] = v[j] * r * gg[j];
            const bool rope = (kind == 1 || kind == 3) && lat;
            {
#pragma unroll
                for (int j4 = 0; j4 < 8; ++j4) { const f32x4 cs4 = csv[e][j4], sn4 = snv[e][j4];
#pragma unroll
                    for (int c = 0; c < 4; ++c) { const int j = 4 * j4 + c; const float other = __shfl_xor(v[j], 1); const float cs = cs4[c], sn = sn4[c];
                        const float rv = (l & 1) ? (v[j] * cs + other * sn) : (v[j] * cs - other * sn);
                        v[j] = rope ? rv : v[j]; } }
            }
            if (act) {
#pragma unroll
                for (int q = 0; q < 4; ++q) { u32x4 o; o.x = cvt_pk_bf16(v[8 * q], v[8 * q + 1]); o.y = cvt_pk_bf16(v[8 * q + 2], v[8 * q + 3]); o.z = cvt_pk_bf16(v[8 * q + 4], v[8 * q + 5]); o.w = cvt_pk_bf16(v[8 * q + 6], v[8 * q + 7]);
                    *(u32x4*)(rowp + 8 * q) = o; }
            }
        }
    }
}

__device__ __forceinline__ void p11_phase(Frame& F, CArgsRef A) {
    const int gw = F.bid * 8 + F.wave, NGW = F.G * 8, l = F.lane, h = l >> 4, j = l & 15;
    const bf16_t* __restrict__ P = WSP(bf16_t, WS_BIG); bf16_t* __restrict__ QM = WSP(bf16_t, WS_QM); bf16_t* __restrict__ KM = WSP(bf16_t, WS_KM); const bf16_t* __restrict__ KV = WSP(bf16_t, WS_H);
    const float* __restrict__ COS = WSP(float, WS_COS); const float* __restrict__ SIN = WSP(float, WS_SIN);
#define P11_BODY(wa, wb, DST, GP, DOROPE, CSV, SNV) do { \
        float v[12]; \
        _Pragma("unroll") for (int c = 0; c < 4; ++c) { v[2 * c] = bflo(wa[c]); v[2 * c + 1] = bfhi(wa[c]); } \
        v[8] = bflo(wb.x); v[9] = bfhi(wb.x); v[10] = bflo(wb.y); v[11] = bfhi(wb.y); \
        float ss = 0.f; \
        _Pragma("unroll") for (int c = 0; c < 12; ++c) ss += v[c] * v[c]; \
        ss += __shfl_xor(ss, 1); ss += __shfl_xor(ss, 2); ss += __shfl_xor(ss, 4); ss += __shfl_xor(ss, 8); \
        const float r = 1.f / sqrtf(ss * (1.f / 192.f) + EPS); \
        const f32x4 ga = GP##a, gb = GP##b, gc = GP##c; \
        v[0] *= r * ga.x; v[1] *= r * ga.y; v[2] *= r * ga.z; v[3] *= r * ga.w; v[4] *= r * gb.x; v[5] *= r * gb.y; v[6] *= r * gb.z; v[7] *= r * gb.w; \
        v[8] *= r * gc.x; v[9] *= r * gc.y; v[10] *= r * gc.z; v[11] *= r * gc.w; \
        const f32x4 cs = CSV, sn = SNV; \
        _Pragma("unroll") for (int c = 0; c < 4; ++c) { const float other = __shfl_xor(v[8 + c], 8); const float rv = (j < 8) ? (v[8 + c] * cs[c] - other * sn[c]) : (v[8 + c] * cs[c] + other * sn[c]); v[8 + c] = (DOROPE) ? rv : v[8 + c]; } \
        u32x4 oa; oa.x = cvt_pk_bf16(v[0], v[1]); oa.y = cvt_pk_bf16(v[2], v[3]); oa.z = cvt_pk_bf16(v[4], v[5]); oa.w = cvt_pk_bf16(v[6], v[7]); \
        u32x2 ob; ob.x = cvt_pk_bf16(v[8], v[9]); ob.y = cvt_pk_bf16(v[10], v[11]); \
        *(u32x4*)((DST) + 8 * j) = oa; *(u32x2*)((DST) + 128 + 4 * j) = ob; } while (0)
    const f32x4 gqa = *(const f32x4*)(A.in[20] + 8 * j), gqb = *(const f32x4*)(A.in[20] + 8 * j + 4), gqc = *(const f32x4*)(A.in[20] + 128 + 4 * j);
    const f32x4 gka = *(const f32x4*)(A.in[20] + 192 + 8 * j), gkb = *(const f32x4*)(A.in[20] + 192 + 8 * j + 4), gkc = *(const f32x4*)(A.in[20] + 192 + 128 + 4 * j);
    constexpr int NB4 = 4;
    for (int t0 = gw; t0 < NLAT; t0 += NB4 * NGW) {
        u32x4 wa[NB4]; u32x2 wb[NB4]; f32x4 cv[NB4], sv[NB4];
#pragma unroll
        for (int e = 0; e < NB4; ++e) { const int tl = (t0 + e * NGW) < NLAT ? (t0 + e * NGW) : t0; const bf16_t* q = QM + (size_t)tl * 768 + h * 192; wa[e] = *(const u32x4*)(q + 8 * j); wb[e] = *(const u32x2*)(q + 128 + 4 * j);
            const int pos = tl & (SEQ - 1); cv[e] = *(const f32x4*)(COS + (size_t)pos * 32 + 4 * (j & 7)); sv[e] = *(const f32x4*)(SIN + (size_t)pos * 32 + 4 * (j & 7)); }
        __builtin_amdgcn_sched_barrier(0);
#pragma unroll
        for (int e = 0; e < NB4; ++e) { const int tl = t0 + e * NGW; if (tl < NLAT) { bf16_t* q = QM + (size_t)tl * 768 + h * 192;
            P11_BODY(wa[e], wb[e], q, gq, true, cv[e], sv[e]); } }
    }
    for (int t0 = gw; t0 < NTOK; t0 += NB4 * NGW) {
        u32x4 wa[NB4]; u32x2 wb[NB4]; f32x4 cv[NB4], sv[NB4];
#pragma unroll
        for (int e = 0; e < NB4; ++e) { const int ta = (t0 + e * NGW) < NTOK ? (t0 + e * NGW) : t0; wa[e] = *(const u32x4*)(KV + (size_t)ta * 1024 + h * 256 + 8 * j); wb[e] = *(const u32x2*)(P + (size_t)ta * PW + PC_KROPE + 4 * j);
            const int b_ = ta / TPB, jj_ = ta - b_ * TPB; const int pos = jj_ >= CTXL ? jj_ - CTXL : 0; cv[e] = *(const f32x4*)(COS + (size_t)pos * 32 + 4 * (j & 7)); sv[e] = *(const f32x4*)(SIN + (size_t)pos * 32 + 4 * (j & 7)); }
        __builtin_amdgcn_sched_barrier(0);
#pragma unroll
        for (int e = 0; e < NB4; ++e) { const int ta = t0 + e * NGW; if (ta < NTOK) { const int b = ta / TPB, jj = ta - b * TPB; const bool lat = jj >= CTXL;
            bf16_t* k = KM + ((size_t)(b * 4 + h) * TPB + jj) * 192;
            P11_BODY(wa[e], wb[e], k, gk, lat, cv[e], sv[e]); } }
    }
#undef P11_BODY
}

#define SBAR() __builtin_amdgcn_sched_barrier(0)
__device__ __forceinline__ void partialSM(f32x16& p0, f32x16& p1, float& m_reg, float& mn, float& alpha, const float C, const float thr) {
    float pmax = p0[0];
#pragma unroll
    for (int r = 1; r < 16; ++r) pmax = fmaxf(pmax, p0[r]);
#pragma unroll
    for (int r = 0; r < 16; ++r) pmax = fmaxf(pmax, p1[r]);
    { auto rr = __builtin_amdgcn_permlane32_swap(__float_as_uint(pmax), __float_as_uint(pmax), false, false);
      pmax = fmaxf(__uint_as_float(rr[0]), __uint_as_float(rr[1])); }
    if (__builtin_expect(__all(pmax - m_reg <= thr), 1)) { mn = m_reg; alpha = 1.f; }
    else { mn = fmaxf(m_reg, pmax); alpha = __builtin_amdgcn_exp2f((m_reg - mn) * C); m_reg = mn; }
    const float mnC = -mn * C;
#pragma unroll
    for (int r = 0; r < 16; ++r) p0[r] = fmaf(p0[r], C, mnC);
#pragma unroll
    for (int r = 0; r < 16; ++r) p1[r] = fmaf(p1[r], C, mnC);
#pragma unroll
    for (int r = 0; r < 16; ++r) p0[r] = __builtin_amdgcn_exp2f(p0[r]);
}
__device__ __forceinline__ void finishSM(f32x16& p0, f32x16& p1, float alpha, float& l_reg, bf16x8& pa0, bf16x8& pa1, bf16x8& pa2, bf16x8& pa3) {
#pragma unroll
    for (int r = 0; r < 16; ++r) p1[r] = __builtin_amdgcn_exp2f(p1[r]);
    float ps = 0;
#pragma unroll
    for (int r = 0; r < 16; ++r) ps += p0[r];
#pragma unroll
    for (int r = 0; r < 16; ++r) ps += p1[r];
    { auto rr = __builtin_amdgcn_permlane32_swap(__float_as_uint(ps), __float_as_uint(ps), false, false);
      ps = __uint_as_float(rr[0]) + __uint_as_float(rr[1]); }
    l_reg = l_reg * alpha + ps;
#define PK4(P, BASE, OUT) do { unsigned a0 = cvt_pk_bf16(P[BASE + 0], P[BASE + 1]), a1 = cvt_pk_bf16(P[BASE + 2], P[BASE + 3]);   \
    unsigned b0 = cvt_pk_bf16(P[BASE + 4], P[BASE + 5]), b1 = cvt_pk_bf16(P[BASE + 6], P[BASE + 7]);                              \
    auto r0 = __builtin_amdgcn_permlane32_swap(a0, b0, false, false); auto r1 = __builtin_amdgcn_permlane32_swap(a1, b1, false, false); \
    u32x4 w = {r0[0], r1[0], r0[1], r1[1]}; OUT = *reinterpret_cast<bf16x8*>(&w); } while (0)
    PK4(p0, 0, pa0); PK4(p0, 8, pa1); PK4(p1, 0, pa2); PK4(p1, 8, pa3);
#undef PK4
}
__device__ __forceinline__ void partialSM_fs(f32x16& p0, f32x16& p1, const float C, const float nBC) {
#pragma unroll
    for (int r = 0; r < 16; ++r) p0[r] = fmaf(p0[r], C, nBC);
#pragma unroll
    for (int r = 0; r < 16; ++r) p1[r] = fmaf(p1[r], C, nBC);
#pragma unroll
    for (int r = 0; r < 16; ++r) p0[r] = __builtin_amdgcn_exp2f(p0[r]);
}
__device__ __forceinline__ void finishSM_fs(f32x16& p0, f32x16& p1, float& l_reg, bf16x8& pa0, bf16x8& pa1, bf16x8& pa2, bf16x8& pa3) {
#pragma unroll
    for (int r = 0; r < 16; ++r) p1[r] = __builtin_amdgcn_exp2f(p1[r]);
    float ps = 0;
#pragma unroll
    for (int r = 0; r < 16; ++r) ps += p0[r];
#pragma unroll
    for (int r = 0; r < 16; ++r) ps += p1[r];
    l_reg += ps;
#define PK4(P, BASE, OUT) do { unsigned a0 = cvt_pk_bf16(P[BASE + 0], P[BASE + 1]), a1 = cvt_pk_bf16(P[BASE + 2], P[BASE + 3]);   \
    unsigned b0 = cvt_pk_bf16(P[BASE + 4], P[BASE + 5]), b1 = cvt_pk_bf16(P[BASE + 6], P[BASE + 7]);                              \
    auto r0 = __builtin_amdgcn_permlane32_swap(a0, b0, false, false); auto r1 = __builtin_amdgcn_permlane32_swap(a1, b1, false, false); \
    u32x4 w = {r0[0], r1[0], r0[1], r1[1]}; OUT = *reinterpret_cast<bf16x8*>(&w); } while (0)
    PK4(p0, 0, pa0); PK4(p0, 8, pa1); PK4(p1, 0, pa2); PK4(p1, 8, pa3);
#undef PK4
}
__device__ __forceinline__ int v_st(int k, int c) { const int kk = (k & ~0xC) | ((k & 4) << 1) | ((k & 8) >> 1); return ((kk >> 3) * 4 + (c >> 5)) * 512 + ((kk & 7) * 32 + (c & 31)) * 2; }
__device__ __forceinline__ int v_rd_base(int lane) { return ((lane & 3) << 3) | (((lane >> 2) & 3) << 6) | (((lane >> 4) & 1) << 5) | (((lane >> 5) & 1) << 8); }
constexpr int v_rd_off(int d0, int ks, int half) { return d0 * 512 + ks * 4096 + half * 2048; }
template <int OFF> __device__ __forceinline__ s16x4 tr_read(int vb) {
    s16x4 r; asm volatile("ds_read_b64_tr_b16 %0, %1 offset:%2" : "=&v"(r) : "v"(vb), "i"(OFF) : "memory"); return r;
}
template <int D0> __device__ __forceinline__ void pv_one(f32x16& od, int vb, bf16x8 pa0, bf16x8 pa1, bf16x8 pa2, bf16x8 pa3) {
    const s16x4 l0 = tr_read<v_rd_off(D0, 0, 0)>(vb), h0 = tr_read<v_rd_off(D0, 0, 1)>(vb), l1 = tr_read<v_rd_off(D0, 1, 0)>(vb), h1 = tr_read<v_rd_off(D0, 1, 1)>(vb);
    const s16x4 l2 = tr_read<v_rd_off(D0, 2, 0)>(vb), h2 = tr_read<v_rd_off(D0, 2, 1)>(vb), l3 = tr_read<v_rd_off(D0, 3, 0)>(vb), h3 = tr_read<v_rd_off(D0, 3, 1)>(vb);
    asm volatile("s_waitcnt lgkmcnt(0)" ::: "memory"); SBAR();
#define PK(L, H) (bf16x8){L[0], L[1], L[2], L[3], H[0], H[1], H[2], H[3]}
    od = __builtin_amdgcn_mfma_f32_32x32x16_bf16(pa0, PK(l0, h0), od, 0, 0, 0);
    od = __builtin_amdgcn_mfma_f32_32x32x16_bf16(pa1, PK(l1, h1), od, 0, 0, 0);
    od = __builtin_amdgcn_mfma_f32_32x32x16_bf16(pa2, PK(l2, h2), od, 0, 0, 0);
    od = __builtin_amdgcn_mfma_f32_32x32x16_bf16(pa3, PK(l3, h3), od, 0, 0, 0);
#undef PK
}
__device__ __forceinline__ void pv_d0(f32x16* o, int vb, bf16x8 pa0, bf16x8 pa1, bf16x8 pa2, bf16x8 pa3) {
    pv_one<0>(o[0], vb, pa0, pa1, pa2, pa3); pv_one<1>(o[1], vb, pa0, pa1, pa2, pa3); pv_one<2>(o[2], vb, pa0, pa1, pa2, pa3); pv_one<3>(o[3], vb, pa0, pa1, pa2, pa3);
}

#define PV_READS(D0, L0, H0, L1, H1, L2, H2, L3, H3) do { L0 = tr_read<v_rd_off(D0, 0, 0)>(vb); H0 = tr_read<v_rd_off(D0, 0, 1)>(vb); L1 = tr_read<v_rd_off(D0, 1, 0)>(vb); H1 = tr_read<v_rd_off(D0, 1, 1)>(vb); \
    L2 = tr_read<v_rd_off(D0, 2, 0)>(vb); H2 = tr_read<v_rd_off(D0, 2, 1)>(vb); L3 = tr_read<v_rd_off(D0, 3, 0)>(vb); H3 = tr_read<v_rd_off(D0, 3, 1)>(vb); } while (0)
#define PV_PK(L, H) (bf16x8){L[0], L[1], L[2], L[3], H[0], H[1], H[2], H[3]}
#define PV_MMA(OD, L0, H0, L1, H1, L2, H2, L3, H3) do { OD = __builtin_amdgcn_mfma_f32_32x32x16_bf16(pa0, PV_PK(L0, H0), OD, 0, 0, 0); OD = __builtin_amdgcn_mfma_f32_32x32x16_bf16(pa1, PV_PK(L1, H1), OD, 0, 0, 0); \
    OD = __builtin_amdgcn_mfma_f32_32x32x16_bf16(pa2, PV_PK(L2, H2), OD, 0, 0, 0); OD = __builtin_amdgcn_mfma_f32_32x32x16_bf16(pa3, PV_PK(L3, H3), OD, 0, 0, 0); } while (0)
__device__ __forceinline__ void pv_d0_pipe(f32x16* o, int vb, bf16x8 pa0, bf16x8 pa1, bf16x8 pa2, bf16x8 pa3) {
    s16x4 a0, a1, a2, a3, a4, a5, a6, a7, b0, b1, b2, b3, b4, b5, b6, b7;
    PV_READS(0, a0, a1, a2, a3, a4, a5, a6, a7);
    PV_READS(1, b0, b1, b2, b3, b4, b5, b6, b7);
    asm volatile("s_waitcnt lgkmcnt(8)" ::: "memory"); SBAR();
    PV_MMA(o[0], a0, a1, a2, a3, a4, a5, a6, a7); SBAR();
    PV_READS(2, a0, a1, a2, a3, a4, a5, a6, a7);
    asm volatile("s_waitcnt lgkmcnt(8)" ::: "memory"); SBAR();
    PV_MMA(o[1], b0, b1, b2, b3, b4, b5, b6, b7); SBAR();
    PV_READS(3, b0, b1, b2, b3, b4, b5, b6, b7);
    asm volatile("s_waitcnt lgkmcnt(8)" ::: "memory"); SBAR();
    PV_MMA(o[2], a0, a1, a2, a3, a4, a5, a6, a7); SBAR();
    asm volatile("s_waitcnt lgkmcnt(0)" ::: "memory"); SBAR();
    PV_MMA(o[3], b0, b1, b2, b3, b4, b5, b6, b7);
}

template <int DK, int LDQ, int LDK, int LDV, int SDEPTH, int NQL, bool FS, bool PVP, int ABL = 0>
__device__ __forceinline__ void attn_body(const int tid, const bf16_t* __restrict__ Qb, const bf16_t* __restrict__ Kh, const bf16_t* __restrict__ Vh, const int seq, char* lds,
                                          const float C, const float thr, f32x16 (&o)[4], float& l_out) {
    constexpr int RB = DK * 2, SHM_V = 64 * 256, SHM_K = 64 * RB, CPR = DK / 8, NKC = CPR / 8, ND0 = DK / 16, NQR = ND0 - NQL, QTB = NQL * 32;
#define KSWZ(row, colB) ((row) * RB + ((colB) ^ ((((row) >> 1) & 7) << 4)))
    const int wid = tid >> 6, lane = tid & 63, r32 = lane & 31, hi = lane >> 5;
    char* V_lds = lds; char* K_lds = lds + 2 * SHM_V;
    float* ws = (float*)(lds + 2 * SHM_V + 2 * SHM_K) + wid * 64; float* al_l = ws + 32;
    char* Qt = lds + 2 * SHM_V + 2 * SHM_K + 2048 + wid * (32 * (QTB > 0 ? QTB : 1));
    float m_reg = -1e30f, l_reg = 0;
#pragma unroll
    for (int d = 0; d < 4; ++d) o[d] = f32x16{};
    bf16x8 qr[NQR];
    const bf16_t* Qw = Qb + (size_t)(wid * 32 + r32) * LDQ + hi * 8;
#pragma unroll
    for (int d0 = 0; d0 < NQR; ++d0) qr[d0] = *(const bf16x8*)(Qw + d0 * 16);
    if constexpr (NQL > 0) {
        constexpr int CH = QTB / 16;
#pragma unroll
        for (int i = 0; i < (32 * CH) / 64; ++i) { const int c = lane + 64 * i, row = c / CH, cc = c % CH;
            const bf16x8 v = *(const bf16x8*)(Qb + (size_t)(wid * 32 + row) * LDQ + NQR * 16 + cc * 8);
            *(bf16x8*)(Qt + row * QTB + ((cc * 16) ^ (((row) & (CH - 1)) << 4))) = v; }
        asm volatile("s_waitcnt lgkmcnt(0)" ::: "memory");
    }
    const int sr = tid >> 4, sc = (tid & 15) * 8, vst0 = v_st(sr, sc), vst1 = v_st(32 + sr, sc);
    const int vb0 = (int)(uintptr_t)V_lds + v_rd_base(lane);
    int krow[NKC], kcc[NKC];
#pragma unroll
    for (int i = 0; i < NKC; ++i) { const int c = tid + 512 * i; krow[i] = c / CPR; kcc[i] = c % CPR; }
    struct { bf16x8 vs0, vs1, ks[NKC]; } sr_[SDEPTH];
    constexpr int SE = 0, SO = SDEPTH - 1;
#define SLOAD(i, k0) do { sr_[i].vs0 = *(const bf16x8*)(&Vh[(size_t)((k0) + sr) * LDV + sc]); sr_[i].vs1 = *(const bf16x8*)(&Vh[(size_t)((k0) + 32 + sr) * LDV + sc]); \
    _Pragma("unroll") for (int _q = 0; _q < NKC; ++_q) sr_[i].ks[_q] = *(const bf16x8*)(&Kh[(size_t)((k0) + krow[_q]) * LDK + kcc[_q] * 8]); } while (0)
#define SWRITE(b, i) do { *(bf16x8*)(V_lds + (b) * SHM_V + vst0) = sr_[i].vs0; *(bf16x8*)(V_lds + (b) * SHM_V + vst1) = sr_[i].vs1; \
    _Pragma("unroll") for (int _q = 0; _q < NKC; ++_q) *(bf16x8*)(K_lds + (b) * SHM_K + KSWZ(krow[_q], kcc[_q] * 16)) = sr_[i].ks[_q]; } while (0)
#define SWAIT() do { if constexpr (SDEPTH == 2) asm volatile("s_waitcnt vmcnt(%0)" :: "n"(2 + NKC) : "memory"); else asm volatile("s_waitcnt vmcnt(0)" ::: "memory"); } while (0)
#define RESC(a) do { if (__any((a) < 1.f)) { if (hi == 0) al_l[r32] = (a); asm volatile("s_waitcnt lgkmcnt(0)" ::: "memory"); \
    _Pragma("unroll") for (int d = 0; d < 4; ++d) _Pragma("unroll") for (int r = 0; r < 16; ++r) o[d][r] *= al_l[crow(r, hi)]; } } while (0)
#define QFRAG(d0) ((d0) < NQR ? qr[(d0) < NQR ? (d0) : 0] : *(const bf16x8*)(Qt + r32 * QTB + (((((d0) - NQR) * 2 + hi) * 16) ^ ((r32 & ((QTB / 16) - 1)) << 4))))
#define QKT(P0, P1, KB) do { P0 = f32x16{}; P1 = f32x16{}; if constexpr (ABL & 2) { asm volatile("" : "+v"(P0), "+v"(P1)); } else _Pragma("unroll") for (int d0 = 0; d0 < ND0; ++d0) { const int cb = (d0 * 16 + hi * 8) * 2; \
    const bf16x8 b0 = *(const bf16x8*)((KB) + KSWZ(r32, cb)); const bf16x8 b1 = *(const bf16x8*)((KB) + KSWZ(32 + r32, cb)); const bf16x8 qf = QFRAG(d0); \
    P0 = __builtin_amdgcn_mfma_f32_32x32x16_bf16(b0, qf, P0, 0, 0, 0); P1 = __builtin_amdgcn_mfma_f32_32x32x16_bf16(b1, qf, P1, 0, 0, 0); } } while (0)
    f32x16 pA0, pA1, pB0, pB1; float mnA, mnB, alA, alB; bf16x8 pa0, pa1, pa2, pa3; const int NT = seq / 64;
#define PVD(VB) do { if constexpr (!(ABL & 1)) { if constexpr (PVP) pv_d0_pipe(o, VB, pa0, pa1, pa2, pa3); else pv_d0(o, VB, pa0, pa1, pa2, pa3); } else { asm volatile("" : "+v"(pa0), "+v"(pa1), "+v"(pa2), "+v"(pa3)); } } while (0)
    const float nBC = -thr * C;
#define PSM(P0, P1, MN, AL) do { if constexpr (ABL & 4) { asm volatile("" : "+v"(P0), "+v"(P1)); } else if constexpr (FS) partialSM_fs(P0, P1, C, nBC); else partialSM(P0, P1, m_reg, MN, AL, C, thr); } while (0)
#define FSM(P0, P1, AL) do { if constexpr (ABL & 4) { asm volatile("" : "+v"(P0), "+v"(P1)); pa0 = (bf16x8){1,2,3,4,5,6,7,8}; pa1 = pa0; pa2 = pa0; pa3 = pa0; asm volatile("" : "+v"(pa0), "+v"(pa1), "+v"(pa2), "+v"(pa3)); } else if constexpr (FS) finishSM_fs(P0, P1, l_reg, pa0, pa1, pa2, pa3); else finishSM(P0, P1, AL, l_reg, pa0, pa1, pa2, pa3); } while (0)
#define RSC(a) do { if constexpr (!FS) { RESC(a); } } while (0)
#define ABAR() do { if constexpr (!(ABL & 16)) __syncthreads(); } while (0)
    SLOAD(SE, 0); asm volatile("s_waitcnt vmcnt(0)" ::: "memory"); SWRITE(0, SE); __syncthreads();
    QKT(pA0, pA1, K_lds); PSM(pA0, pA1, mnA, alA);
    SLOAD(SO, 64); if constexpr (SDEPTH == 2) { if (2 < NT) SLOAD(SE, 128); }
    SWAIT(); SWRITE(1, SO); __syncthreads();
    for (int j = 1; j + 1 < NT; j += 2) {
        if constexpr (SDEPTH == 1 && !(ABL & 8)) { SBAR(); SLOAD(SO, (j + SDEPTH) * 64); }
        SBAR(); QKT(pB0, pB1, K_lds + SHM_K);
        FSM(pA0, pA1, alA); SBAR();
        if constexpr (SDEPTH != 1 && !(ABL & 8)) SLOAD(SO, (j + SDEPTH) * 64); SBAR();
        PVD(vb0); PSM(pB0, pB1, mnB, alB);
        ABAR(); if constexpr (!(ABL & 8)) { SWAIT(); SWRITE(0, SE); }
        RSC(alB); ABAR();
        if constexpr (SDEPTH == 1 && !(ABL & 8)) { SBAR(); SLOAD(SE, (j + 1 + SDEPTH) * 64); }
        SBAR(); QKT(pA0, pA1, K_lds);
        FSM(pB0, pB1, alB); SBAR();
        if constexpr (SDEPTH != 1 && !(ABL & 8)) { if (j + 3 < NT) SLOAD(SE, (j + 1 + SDEPTH) * 64); } SBAR();
        PVD(vb0 + SHM_V); PSM(pA0, pA1, mnA, alA);
        ABAR(); if constexpr (!(ABL & 8)) { SWAIT(); SWRITE(1, SO); }
        RSC(alA); ABAR();
    }
    SBAR(); QKT(pB0, pB1, K_lds + SHM_K);
    FSM(pA0, pA1, alA); SBAR();
    PVD(vb0); PSM(pB0, pB1, mnB, alB);
    __syncthreads(); RSC(alB);
    FSM(pB0, pB1, alB); SBAR();
    PVD(vb0 + SHM_V);
    if constexpr (FS) { auto rr = __builtin_amdgcn_permlane32_swap(__float_as_uint(l_reg), __float_as_uint(l_reg), false, false); l_reg = __uint_as_float(rr[0]) + __uint_as_float(rr[1]); }
#undef PSM
#undef PVD
#undef FSM
#undef RSC
#undef ABAR
    l_out = l_reg;
#undef SLOAD
#undef SWRITE
#undef SWAIT
#undef RESC
#undef QKT
#undef QFRAG
#undef KSWZ
}

__device__ __forceinline__ void attn_phase(Frame& F, CArgsRef A, unsigned long long& pt1, unsigned long long& pt0) {
    char* lds = (char*)F.lds;
    const bf16_t* P = WSP(bf16_t, WS_BIG); const bf16_t* QM = WSP(bf16_t, WS_QM); const bf16_t* KM = WSP(bf16_t, WS_KM); const bf16_t* KV = WSP(bf16_t, WS_H);
    bf16_t* Y = WSP(bf16_t, WS_YMIX); float* ST = WSP(float, WS_STASH) + (size_t)F.bid * 256 * 128;
    float lam;
    { const int lane = F.lane; const float* dl = A.in[22]; const float a = dl[lane] * dl[64 + lane], b = dl[128 + lane] * dl[192 + lane]; lam = __expf(wave_sum(a)) - __expf(wave_sum(b)) + LAM_INIT; lam = __uint_as_float(__builtin_amdgcn_readfirstlane(__float_as_uint(lam))); }
    constexpr float LOG2E = 1.4426950408889634f;
#ifndef ATT_KINDS
#define ATT_KINDS 3
#endif
#ifndef ATT_PVP_MLA
#define ATT_PVP_MLA 0
#endif
#ifndef ATT_PVP_DIFF
#define ATT_PVP_DIFF 1
#endif
#ifndef ATT_FS
#define ATT_FS 1
#endif
    float bnd_mla, bnd_diff;
    { const int lane = F.lane; const float* gm = A.in[20]; const float* gd = A.in[21];
      float a = fmaxf(fmaxf(fabsf(gm[lane]), fabsf(gm[64 + lane])), fabsf(gm[128 + lane])), b = fmaxf(fmaxf(fabsf(gm[192 + lane]), fabsf(gm[256 + lane])), fabsf(gm[320 + lane]));
      float c = fabsf(gd[lane]), d = fabsf(gd[64 + lane]);
#pragma unroll
      for (int o = 1; o < 64; o <<= 1) { a = fmaxf(a, __shfl_xor(a, o)); b = fmaxf(b, __shfl_xor(b, o)); c = fmaxf(c, __shfl_xor(c, o)); d = fmaxf(d, __shfl_xor(d, o)); }
      bnd_mla = __uint_as_float(__builtin_amdgcn_readfirstlane(__float_as_uint(fminf(0.07216878364870322f * 192.f * a * b * 1.001f, 60.f))));
      bnd_diff = __uint_as_float(__builtin_amdgcn_readfirstlane(__float_as_uint(fminf(0.125f * 64.f * c * d * 1.001f, 60.f)))); }
#ifndef PROBE_ABL
#define PROBE_ABL 0
#endif
    if (PT_SUB == 7 || PT_SUB == 8) {
        int tid = threadIdx.x; asm volatile("" : "+v"(tid));
        const int wid = tid >> 6, lane = tid & 63, r32 = lane & 31, hi = lane >> 5;
        const int u = F.bid, bh = u >> 4, qb = u & 15, b = bh >> 2, h = bh & 3;
        f32x16 o[4]; float l_reg;
        __syncthreads();
        pt0 = __builtin_amdgcn_s_memrealtime();
        if (PT_SUB == 7) { const bf16_t* Pb = P + (size_t)(b * TPB) * PW;
            attn_body<64, PW, PW, PW, 1, 0, ATT_FS != 0, ATT_PVP_DIFF != 0, PROBE_ABL>(tid, Pb + (size_t)(CTXL + qb * 256) * PW + PC_QD + h * 128, Pb + PC_KD + h * 128, Pb + PC_VD + h * 128, TPB, lds, 0.125f * LOG2E, bnd_diff / 0.125f, o, l_reg); }
        else attn_body<192, 768, 192, 1024, 1, 8, ATT_FS != 0, ATT_PVP_MLA != 0, PROBE_ABL>(tid, QM + ((size_t)(b * SEQ + qb * 256)) * 768 + h * 192, KM + (size_t)(b * 4 + h) * TPB * 192, KV + (size_t)(b * TPB) * 1024 + h * 256 + 128, TPB, lds, 0.07216878364870322f * LOG2E, bnd_mla / 0.07216878364870322f, o, l_reg);
        pt1 = __builtin_amdgcn_s_memrealtime();
        float* Sw = ST + (size_t)(wid * 32) * 128;
#pragma unroll
        for (int r = 0; r < 16; ++r)
#pragma unroll
            for (int d0 = 0; d0 < 4; ++d0) Sw[(size_t)crow(r, hi) * 128 + d0 * 32 + r32] = o[d0][r] * l_reg;
        __syncthreads();
    }
    if (ATT_KINDS & 1)
    for (int u = F.bid, rnd = 0; u < 512; u += F.G, ++rnd) {
        int tid = threadIdx.x; asm volatile("" : "+v"(tid));
        const int wid = tid >> 6, lane = tid & 63, r32 = lane & 31, hi = lane >> 5;
        const int ux = (F.G == 256) ? ((((F.bid & 7) * 4 + rnd * 2 + ((F.bid >> 3) >> 4)) << 4) | ((F.bid >> 3) & 15)) : u;
        const int bh = ux >> 4, qb = ux & 15, b = bh >> 2, h = bh & 3;
        f32x16 o[4]; float l_reg;
        __syncthreads();
        attn_body<192, 768, 192, 1024, 1, 8, ATT_FS != 0, ATT_PVP_MLA != 0>(tid, QM + ((size_t)(b * SEQ + qb * 256)) * 768 + h * 192, KM + (size_t)(b * 4 + h) * TPB * 192, KV + (size_t)(b * TPB) * 1024 + h * 256 + 128,
                                       TPB, lds, 0.07216878364870322f * LOG2E, ATT_FS ? bnd_mla / 0.07216878364870322f : 8.f / 0.07216878364870322f, o, l_reg);
        float* li_l = (float*)(lds + 2 * 16384 + 2 * 64 * 384) + wid * 64;
        if (hi == 0) li_l[r32] = l_reg; LDS_WAIT();
        float rli[16];
#pragma unroll
        for (int r = 0; r < 16; ++r) rli[r] = __builtin_amdgcn_rcpf(li_l[crow(r, hi)]);
        bf16_t* Ow = Y + (size_t)(b * SEQ + qb * 256 + wid * 32) * D + h * 128;
#pragma unroll
        for (int r = 0; r < 16; ++r)
#pragma unroll
            for (int d0 = 0; d0 < 4; ++d0) Ow[(size_t)crow(r, hi) * D + d0 * 32 + r32] = f2bf(o[d0][r] * rli[r]);
    }
    if (PT_SUB == 3) pt1 = __builtin_amdgcn_s_memrealtime();
    if (ATT_KINDS & 2)
    for (int u = F.bid, rnd = 0; u < 512; u += F.G, ++rnd) {
        int tid = threadIdx.x; asm volatile("" : "+v"(tid));
        const int wid = tid >> 6, lane = tid & 63, r32 = lane & 31, hi = lane >> 5;
        const int ux = (F.G == 256) ? ((((F.bid & 7) * 4 + rnd * 2 + ((F.bid >> 3) >> 4)) << 4) | ((F.bid >> 3) & 15)) : u;
        const int bh = ux >> 4, qb = ux & 15, b = bh >> 2, h = bh & 3;
        const bf16_t* Pb = P + (size_t)(b * TPB) * PW;
        float* Sw = ST + (size_t)(wid * 32) * 128;
        float* li_l = (float*)(lds + 2 * 16384 + 2 * 64 * 128) + wid * 64;
        {
            f32x16 o[4]; float l_reg;
            __syncthreads();
            attn_body<64, PW, PW, PW, 1, 0, ATT_FS != 0, ATT_PVP_DIFF != 0>(tid, Pb + (size_t)(CTXL + qb * 256) * PW + PC_QD + h * 128, Pb + PC_KD + h * 128, Pb + PC_VD + h * 128, TPB, lds, 0.125f * LOG2E, ATT_FS ? bnd_diff / 0.125f : 8.f / 0.125f, o, l_reg);
            if (hi == 0) li_l[r32] = l_reg; LDS_WAIT();
            float rli[16];
#pragma unroll
            for (int r = 0; r < 16; ++r) rli[r] = __builtin_amdgcn_rcpf(li_l[crow(r, hi)]);
#pragma unroll
            for (int r = 0; r < 16; ++r)
#pragma unroll
                for (int d0 = 0; d0 < 4; ++d0) Sw[(size_t)crow(r, hi) * 128 + d0 * 32 + r32] = o[d0][r] * rli[r];
        }
        {
            f32x16 o[4]; float l_reg;
            __syncthreads();
            attn_body<64, PW, PW, PW, 1, 0, ATT_FS != 0, ATT_PVP_DIFF != 0>(tid, Pb + (size_t)(CTXL + qb * 256) * PW + PC_QD + h * 128 + 64, Pb + PC_KD + h * 128 + 64, Pb + PC_VD + h * 128, TPB, lds, 0.125f * LOG2E, ATT_FS ? bnd_diff / 0.125f : 8.f / 0.125f, o, l_reg);
            if (hi == 0) li_l[r32] = l_reg; LDS_WAIT();
            float ss[16];
#pragma unroll
            for (int r = 0; r < 16; ++r) { const float rl = __builtin_amdgcn_rcpf(li_l[crow(r, hi)]); float s = 0.f;
#pragma unroll
                for (int d0 = 0; d0 < 4; ++d0) { const float a1 = Sw[(size_t)crow(r, hi) * 128 + d0 * 32 + r32]; const float v = a1 - lam * (o[d0][r] * rl); o[d0][r] = v; s += v * v; }
                ss[r] = s; }
#pragma unroll
            for (int r = 0; r < 16; ++r) {
#pragma unroll
                for (int sh = 1; sh < 32; sh <<= 1) ss[r] += __shfl_xor(ss[r], sh);
                ss[r] = (1.f / sqrtf(ss[r] * (1.f / 128.f) + EPS)) * (1.f - LAM_INIT); }
            bf16_t* Ow = Y + (size_t)(b * SEQ + qb * 256 + wid * 32) * D + 512 + h * 128;
#pragma unroll
            for (int d0 = 0; d0 < 4; ++d0) { const float gs = A.in[23][d0 * 32 + r32];
#pragma unroll
                for (int r = 0; r < 16; ++r) Ow[(size_t)crow(r, hi) * D + d0 * 32 + r32] = f2bf(o[d0][r] * ss[r] * gs); }
        }
    }
    __syncthreads();
}

constexpr int NPHASE = 18;

__global__ void __launch_bounds__(512, 2) fwd(Args args) {
    extern __shared__ __attribute__((aligned(16))) unsigned char lds_raw[];
    Frame F;
    F.lds = (LAS unsigned char*)lds_raw;
    F.tid = threadIdx.x; F.lane = F.tid & 63; F.wave = __builtin_amdgcn_readfirstlane(F.tid >> 6);
    F.G = gridDim.x; F.bid = blockIdx.x;
    F.out = args.out; F.ws = args.ws; F.ctl = (unsigned*)(args.ws + WS_CTL);
    volatile LAS unsigned* MISC = (volatile LAS unsigned*)(F.lds + LDS_CTL);
    LAS int* PRE = (LAS int*)(F.lds + LDS_CTL + 64);
    if (F.tid < 4) MISC[F.tid] = 0u;
    __syncthreads();
    XcdBarrier bar; bar.bar = F.ctl + CW_BAR; bar.x = 0; bar.st = nullptr;
#if MK_ONE_LAUNCH
    bar = xcd_barrier_post(F.ctl + CW_BAR, MISC);
#define GRID_BAR() xcd_barrier(bar)
#else
#define GRID_BAR() do {} while (0)
#endif
    const int lo = args.ph_lo, hi = args.ph_hi;
    unsigned long long pt0 = 0, pt1 = 0;
#ifndef PH_MASK
#define PH_MASK 0x3ffff
#endif
#define IN(k) (((PH_MASK >> (k)) & 1) && lo <= (k) && (k) < hi)
#define SEAM(k) do { if (IN((k) + 1)) GRID_BAR(); } while (0)
#define REP(k) for (int _rep = 0; _rep <= ((PROBE_REP >> (k)) & 1); ++_rep, (void)((_rep <= ((PROBE_REP >> (k)) & 1)) ? (GRID_BAR(), 0) : 0))

    if (IN(0)) { if (PT_LO == 0) pt0 = __builtin_amdgcn_s_memrealtime(); REP(0) { p0_prologue(F, ARGP(), pt1); } if (!PT_SUB && PT_PRE && PT_HI == 0) pt1 = __builtin_amdgcn_s_memrealtime(); SEAM(0); if (!PT_SUB && !PT_PRE && PT_HI == 0) pt1 = __builtin_amdgcn_s_memrealtime(); }
    if (IN(1)) { if (PT_LO == 1) pt0 = __builtin_amdgcn_s_memrealtime(); REP(1) { norm_mod_phase(F, ARGP(), 0); } if (PT_PRE && PT_HI == 1) pt1 = __builtin_amdgcn_s_memrealtime(); SEAM(1); if (!PT_PRE && PT_HI == 1) pt1 = __builtin_amdgcn_s_memrealtime(); }
    if (IN(2)) { if (PT_LO == 2) pt0 = __builtin_amdgcn_s_memrealtime(); REP(2) {
        pg8::PlainSched S; S.init(WSP(bf16_t, WS_H), WSP(bf16_t, WS_WIN0), NTOK, 1536, D, D, D, F.G, F.bid, 0);
        pg8::EpiStoreBf16 E{WSP(bf16_t, WS_BIG), UW};
        pg8::gemm_phase(F.lds, D, D, D, 1 << 30, S, E);
    } if (PT_PRE && PT_HI == 2) pt1 = __builtin_amdgcn_s_memrealtime(); SEAM(2); if (!PT_PRE && PT_HI == 2) pt1 = __builtin_amdgcn_s_memrealtime(); }
    if (IN(3)) { if (PT_LO == 3) pt0 = __builtin_amdgcn_s_memrealtime(); REP(3) { convpool_phase(F, ARGP(), pt1); } if (!PT_SUB && PT_PRE && PT_HI == 3) pt1 = __builtin_amdgcn_s_memrealtime(); SEAM(3); if (!PT_SUB && !PT_PRE && PT_HI == 3) pt1 = __builtin_amdgcn_s_memrealtime(); }
    if (IN(4)) { if (PT_LO == 4) pt0 = __builtin_amdgcn_s_memrealtime(); REP(4) {
        pg8::PlainSched S; S.init(WSP(bf16_t, WS_YMIX), WSP(bf16_t, WS_WOUT0), NTOK, D, D, D, D, F.G, F.bid, 0);
        pg8::EpiResid E{ARGP().in[0], ARGP().in[2], F.out, WSP(float, WS_XC), WSP(float, WS_MOD), 0};
        pg8::gemm_phase(F.lds, D, D, D, 1 << 30, S, E);
    } if (PT_PRE && PT_HI == 4) pt1 = __builtin_amdgcn_s_memrealtime(); SEAM(4); if (!PT_PRE && PT_HI == 4) pt1 = __builtin_amdgcn_s_memrealtime(); }
    if (IN(5)) { if (PT_LO == 5) pt0 = __builtin_amdgcn_s_memrealtime(); REP(5) { router_phase(F, ARGP(), 0); } if (PT_PRE && PT_HI == 5) pt1 = __builtin_amdgcn_s_memrealtime(); SEAM(5); if (!PT_PRE && PT_HI == 5) pt1 = __builtin_amdgcn_s_memrealtime(); }
    if (IN(6)) { if (PT_LO == 6) pt0 = __builtin_amdgcn_s_memrealtime(); REP(6) {
        const int nt = moe_prefix(F, 0, PRE);
        MoeSchedT<true> S; S.m = MoeSched{F.G, F.bid, nt, 0, 0, F.ctl + CW_CNT, WSP(int, WS_LIST), (const char*)WSP(bf16_t, WS_H), (const char*)WSP(bf16_t, WS_WM1), PRE};
        EpiMoe1 E{WSP(bf16_t, WS_BIG), WSP(f32x2, WS_TW)};
        pg8::gemm_phase(F.lds, D, D, D, 1 << 30, S, E);
    } if (PT_PRE && PT_HI == 6) pt1 = __builtin_amdgcn_s_memrealtime(); SEAM(6); if (!PT_PRE && PT_HI == 6) pt1 = __builtin_amdgcn_s_memrealtime(); }
    if (IN(7)) { if (PT_LO == 7) pt0 = __builtin_amdgcn_s_memrealtime(); REP(7) {
        const int nt = moe_prefix(F, 0, PRE);
        MoeSchedT<false> S; S.m = MoeSched{F.G, F.bid, nt, 0, 1, F.ctl + CW_CNT, WSP(int, WS_LIST), (const char*)WSP(bf16_t, WS_BIG), (const char*)WSP(bf16_t, WS_WM2), PRE};
        EpiMoe2 E{F.out, WSP(float, WS_XC), WSP(float, WS_MOD)};
        pg8::gemm_phase(F.lds, 512, 512, 256, 4, S, E);
    } if (PT_PRE && PT_HI == 7) pt1 = __builtin_amdgcn_s_memrealtime(); SEAM(7); if (!PT_PRE && PT_HI == 7) pt1 = __builtin_amdgcn_s_memrealtime(); }
    if (IN(8)) { if (PT_LO == 8) pt0 = __builtin_amdgcn_s_memrealtime(); REP(8) { norm_mod_phase(F, ARGP(), 1); } if (PT_PRE && PT_HI == 8) pt1 = __builtin_amdgcn_s_memrealtime(); SEAM(8); if (!PT_PRE && PT_HI == 8) pt1 = __builtin_amdgcn_s_memrealtime(); }
    if (IN(9)) { if (PT_LO == 9) pt0 = __builtin_amdgcn_s_memrealtime(); REP(9) {
        pg8::PlainSched S; S.init(WSP(bf16_t, WS_H), WSP(bf16_t, WS_WIN1), NTOK, PW, D, D, D, F.G, F.bid, 0);
        pg8::EpiStoreBf16 E{WSP(bf16_t, WS_BIG), PW};
        pg8::gemm_phase(F.lds, D, D, D, 1 << 30, S, E);
    } if (PT_PRE && PT_HI == 9) pt1 = __builtin_amdgcn_s_memrealtime(); SEAM(9); if (!PT_PRE && PT_HI == 9) pt1 = __builtin_amdgcn_s_memrealtime(); }
    if (IN(10)) { if (PT_LO == 10) pt0 = __builtin_amdgcn_s_memrealtime(); REP(10) { p9_phase(F, ARGP()); } if (PT_PRE && PT_HI == 10) pt1 = __builtin_amdgcn_s_memrealtime(); SEAM(10); if (!PT_PRE && PT_HI == 10) pt1 = __builtin_amdgcn_s_memrealtime(); }
    if (IN(11)) { if (PT_LO == 11) pt0 = __builtin_amdgcn_s_memrealtime(); REP(11) {
        { pg8::PlainSched S; S.init(WSP(bf16_t, WS_BIG) + PC_CQ, WSP(bf16_t, WS_WUQ), NLAT, 768, 256, PW, 256, F.G, F.bid, 1);
          pg8::EpiStoreBf16 E{WSP(bf16_t, WS_QM), 768};
          pg8::gemm_phase(F.lds, 256, PW, 256, 1 << 30, S, E); }
        { pg8::PlainSched S; S.init(WSP(bf16_t, WS_BIG) + PC_CKV, WSP(bf16_t, WS_WUKV), NTOK, 1024, 128, PW, 128, F.G, F.bid, 0);
          pg8::EpiStoreBf16 E{WSP(bf16_t, WS_H), 1024};
          pg8::gemm_phase(F.lds, 128, PW, 128, 1 << 30, S, E); }

    } if (PT_PRE && PT_HI == 11) pt1 = __builtin_amdgcn_s_memrealtime(); SEAM(11); if (!PT_PRE && PT_HI == 11) pt1 = __builtin_amdgcn_s_memrealtime(); }
    if (IN(12)) { if (PT_LO == 12) pt0 = __builtin_amdgcn_s_memrealtime(); REP(12) { p11_phase(F, ARGP()); } if (PT_PRE && PT_HI == 12) pt1 = __builtin_amdgcn_s_memrealtime(); SEAM(12); if (!PT_PRE && PT_HI == 12) pt1 = __builtin_amdgcn_s_memrealtime(); }
    if (IN(13)) { if (PT_LO == 13 && PT_SUB != 7 && PT_SUB != 8) pt0 = __builtin_amdgcn_s_memrealtime(); REP(13) { attn_phase(F, ARGP(), pt1, pt0); } if (!PT_SUB && PT_PRE && PT_HI == 13) pt1 = __builtin_amdgcn_s_memrealtime(); SEAM(13); if (!PT_SUB && !PT_PRE && PT_HI == 13) pt1 = __builtin_amdgcn_s_memrealtime(); }
    if (IN(14)) { if (PT_LO == 14) pt0 = __builtin_amdgcn_s_memrealtime(); REP(14) {
        pg8::PlainSched S; S.init(WSP(bf16_t, WS_YMIX), WSP(bf16_t, WS_WOUT1), NLAT, D, D, D, D, F.G, F.bid, 0);
        pg8::EpiResid E{ARGP().in[0], ARGP().in[2], F.out, WSP(float, WS_XC), WSP(float, WS_MOD) + (size_t)9 * NMOD * D, 1};
        pg8::gemm_phase(F.lds, D, D, D, 1 << 30, S, E);
    } if (PT_PRE && PT_HI == 14) pt1 = __builtin_amdgcn_s_memrealtime(); SEAM(14); if (!PT_PRE && PT_HI == 14) pt1 = __builtin_amdgcn_s_memrealtime(); }
    if (IN(15)) { if (PT_LO == 15) pt0 = __builtin_amdgcn_s_memrealtime(); REP(15) { router_phase(F, ARGP(), 1); } if (PT_PRE && PT_HI == 15) pt1 = __builtin_amdgcn_s_memrealtime(); SEAM(15); if (!PT_PRE && PT_HI == 15) pt1 = __builtin_amdgcn_s_memrealtime(); }
    if (IN(16)) { if (PT_LO == 16) pt0 = __builtin_amdgcn_s_memrealtime(); REP(16) {
        const int nt = moe_prefix(F, 1, PRE);
        MoeSchedT<true> S; S.m = MoeSched{F.G, F.bid, nt, 1, 0, F.ctl + CW_CNT + 64, WSP(int, WS_LIST), (const char*)WSP(bf16_t, WS_H), (const char*)WSP(bf16_t, WS_WM1), PRE};
        EpiMoe1 E{WSP(bf16_t, WS_BIG), WSP(f32x2, WS_TW)};
        pg8::gemm_phase(F.lds, D, D, D, 1 << 30, S, E);
    } if (PT_PRE && PT_HI == 16) pt1 = __builtin_amdgcn_s_memrealtime(); SEAM(16); if (!PT_PRE && PT_HI == 16) pt1 = __builtin_amdgcn_s_memrealtime(); }
    if (IN(17)) { if (PT_LO == 17) pt0 = __builtin_amdgcn_s_memrealtime(); REP(17) {
        const int nt = moe_prefix(F, 1, PRE);
        MoeSchedT<false> S; S.m = MoeSched{F.G, F.bid, nt, 1, 1, F.ctl + CW_CNT + 64, WSP(int, WS_LIST), (const char*)WSP(bf16_t, WS_BIG), (const char*)WSP(bf16_t, WS_WM2), PRE};
        EpiMoe2 E{F.out, WSP(float, WS_XC), WSP(float, WS_MOD) + (size_t)9 * NMOD * D};
        pg8::gemm_phase(F.lds, 512, 512, 256, 4, S, E);
    } if (PT_HI == 17) pt1 = __builtin_amdgcn_s_memrealtime(); }
    if (PT_LO >= 0 && F.bid == 0 && F.tid == 0) { const unsigned long long tend = __builtin_amdgcn_s_memrealtime() + (unsigned long long)PT_AMP * (pt1 - pt0);
        while (__builtin_amdgcn_s_memrealtime() < tend) __builtin_amdgcn_s_sleep(8); }
#undef IN
#undef SEAM
}

extern "C" void kernel_launch(void* const* d_in, const int* in_sizes, int n_in, void* d_out, int out_size, void* d_ws, size_t ws_size, hipStream_t stream) {
    static int grid = 0;
    if (grid == 0) {
        if (n_in != 30 || in_sizes[0] != NLAT * D || out_size != NLAT * D || ws_size < WS_END) { fprintf(stderr, "kernel_launch: unexpected shapes (n_in %d, in0 %d, out %d, ws %zu)\n", n_in, n_in > 0 ? in_sizes[0] : -1, out_size, ws_size); grid = -1; return; }
        int dev = 0, cus = 0, per_cu = 0;
        if (hipGetDevice(&dev) != hipSuccess || hipDeviceGetAttribute(&cus, hipDeviceAttributeMultiprocessorCount, dev) != hipSuccess) { grid = -1; return; }
        if (hipFuncSetAttribute((const void*)fwd, hipFuncAttributeMaxDynamicSharedMemorySize, LDS_BYTES) != hipSuccess) { fprintf(stderr, "kernel_launch: hipFuncSetAttribute failed\n"); grid = -1; return; }
        if (hipOccupancyMaxActiveBlocksPerMultiprocessor(&per_cu, (const void*)fwd, 512, LDS_BYTES) != hipSuccess || per_cu < 1) fprintf(stderr, "kernel_launch: occupancy query reports %d\n", per_cu);
        (void)hipGetLastError();
        grid = cus;
    }
    if (grid < 0) return;
    if (hipMemsetAsync((char*)d_ws + WS_CTL, 0, CTL_ZERO_BYTES, stream) != hipSuccess) return;
    Args a{};
    for (int i = 0; i < 30; ++i) a.in[i] = (const float*)d_in[i];
    a.out = (float*)d_out; a.ws = (unsigned char*)d_ws;
    const int last = MK_LAST_PHASE < NPHASE - 1 ? MK_LAST_PHASE : NPHASE - 1;
#if MK_ONE_LAUNCH
    a.ph_lo = 0; a.ph_hi = last + 1;
    hipLaunchKernelGGL(fwd, dim3(grid), dim3(512), LDS_BYTES, stream, a);
#else
    for (int p = 0; p <= last; ++p) { a.ph_lo = p; a.ph_hi = p + 1; hipLaunchKernelGGL(fwd, dim3(grid), dim3(512), LDS_BYTES, stream, a); }
#endif
    const hipError_t le = hipPeekAtLastError();
    if (le != hipSuccess) fprintf(stderr, "kernel_launch: launch failed: %s\n", hipGetErrorName(le));
}
```

```cpp
#include <hip/hip_runtime.h>
#include <cstdio>
#include <cstdint>

#ifndef MK_ONE_LAUNCH
#define MK_ONE_LAUNCH 1
#endif
#ifndef MK_LAST_PHASE
#define MK_LAST_PHASE 99
#endif

#ifndef PROBE_REP
#define PROBE_REP 0
#endif
#define PT_LO -1
#define PT_HI -1
#define PT_AMP 4
#define PT_PRE 0
#define PROBE_ABL_SET 0
#define PROBE_ABL PROBE_ABL_SET
#define PT_SUB 0

#define GAS __attribute__((address_space(1)))
#define LAS __attribute__((address_space(3)))
typedef unsigned short bf16_t;
typedef short bf16x8 __attribute__((ext_vector_type(8)));
typedef short s16x4 __attribute__((ext_vector_type(4)));
typedef float f32x4 __attribute__((ext_vector_type(4)));
typedef float f32x2 __attribute__((ext_vector_type(2)));
typedef float f32x16 __attribute__((ext_vector_type(16)));
typedef unsigned u32x4 __attribute__((ext_vector_type(4)));
typedef unsigned u32x2 __attribute__((ext_vector_type(2)));

constexpr int D = 1024, NB = 8, SEQ = 4096, CTXL = 256, TPB = SEQ + CTXL;
constexpr int NTOK = NB * TPB, NLAT = NB * SEQ, NCTX = NB * CTXL;
constexpr int NMOD = 6;
constexpr float EPS = 1e-6f;
constexpr int NEXP = 32, NBUCK = 48, DEXP = 256, LCAP = NTOK;
constexpr int PW = 2048;
constexpr int UW = 1536;
constexpr int PC_CQ = 0, PC_QD = 256, PC_CKV = 768, PC_KROPE = 896, PC_KD = 960, PC_VD = 1472;
constexpr float LAM_INIT = 0.35550906759096934f;
constexpr int MOE_MAXT = NTOK / 256 + NBUCK;

constexpr size_t MiB = 1u << 20;
constexpr size_t WS_CTL = 0, CTL_ZERO_BYTES = 3 * MiB;
constexpr size_t WS_MOD = 2 * MiB;
constexpr size_t WS_COS = 3 * MiB, WS_SIN = 3 * MiB + 512 * 1024;
constexpr size_t WS_XC = 4 * MiB;
constexpr size_t WS_LIST = 12 * MiB;
constexpr size_t WS_TW = 19 * MiB;
constexpr size_t WS_WIN0 = 20 * MiB, WS_WOUT0 = 23 * MiB, WS_WIN1 = 25 * MiB, WS_WUQ = 29 * MiB, WS_WUKV = 29 * MiB + 512 * 1024, WS_WOUT1 = 30 * MiB, WS_WPOOL = 32 * MiB;
constexpr size_t WS_WM1 = 33 * MiB;
constexpr size_t WS_WM2 = 97 * MiB;
constexpr size_t WS_H = 129 * MiB;
constexpr size_t WS_BIG = 197 * MiB;
constexpr size_t WS_YMIX = 333 * MiB;
constexpr size_t WS_QM = 401 * MiB;
constexpr size_t WS_KM = 449 * MiB;
constexpr size_t WS_END = 500 * MiB;
constexpr size_t WS_STASH = WS_WM1;
constexpr int CW_BAR = 4096;
constexpr int CW_CNT = 16384;

constexpr int LDS_BYTES = 155648;
constexpr int LDS_CTL = 153600;

__device__ __forceinline__ unsigned cvt_pk_bf16(float lo, float hi) { unsigned r; asm volatile("v_cvt_pk_bf16_f32 %0, %1, %2" : "=v"(r) : "v"(lo), "v"(hi)); return r; }
__device__ __forceinline__ float bf2f(unsigned short u) { return __uint_as_float((unsigned)u << 16); }
__device__ __forceinline__ float bflo(unsigned w) { return __uint_as_float(w << 16); }
__device__ __forceinline__ float bfhi(unsigned w) { return __uint_as_float(w & 0xffff0000u); }
__device__ __forceinline__ unsigned short f2bf(float f) { return (unsigned short)(cvt_pk_bf16(f, 0.f) & 0xffffu); }
__device__ __forceinline__ float wave_sum(float v) {
#pragma unroll
    for (int o = 1; o < 64; o <<= 1) v += __shfl_xor(v, o);
    return v;
}
__device__ __forceinline__ float sigmoidf_(float x) { return 1.f / (1.f + __expf(-x)); }
__device__ __forceinline__ float siluf_(float x) { return x / (1.f + __expf(-x)); }
__device__ __forceinline__ int crow(int r, int hi) { return (r & 3) + 8 * (r >> 2) + 4 * hi; }
#define LDS_WAIT() asm volatile("s_waitcnt lgkmcnt(0)" ::: "memory")
#define VM_WAIT() asm volatile("s_waitcnt vmcnt(0)" ::: "memory")

#define XB_TMO      128
#define XB_XCNT(j)  (256  + 64 * (j))
#define XB_XSUB(j)  (1280 + 64 * (j))
#define XB_XGEN(j)  (2304 + 64 * (j))
#define XB_TOP      3328
#define XB_TOPGEN   3392
#define XCD_BAR_WORDS 3456
#define XB_SPIN_CAP (1u << 18)
__device__ __forceinline__ unsigned xb_ld(unsigned* p)              { return __hip_atomic_load(p, __ATOMIC_RELAXED, __HIP_MEMORY_SCOPE_AGENT); }
__device__ __forceinline__ unsigned xb_add(unsigned* p, unsigned v) { return __hip_atomic_fetch_add(p, v, __ATOMIC_RELAXED, __HIP_MEMORY_SCOPE_AGENT); }
__device__ __forceinline__ unsigned xb_xcc_id() { return (unsigned)__builtin_amdgcn_s_getreg((3 << 11) | 20) & 0xFu; }
#define XB_SPIN(cond, bar) do { unsigned _sp = 0; while (cond) { __builtin_amdgcn_s_sleep(1); \
    if ((++_sp & 255u) == 0u) { if (xb_ld(&(bar)[XB_TMO])) break; if (_sp > XB_SPIN_CAP) { atomicAdd(&(bar)[XB_TMO], 1u); break; } } } } while (0)
struct XcdBarrier { unsigned* bar; unsigned x; volatile LAS unsigned* st; };
__device__ __forceinline__ XcdBarrier xcd_barrier_post(unsigned* bar, volatile LAS unsigned* st) {
    XcdBarrier b; b.bar = bar; b.x = xb_xcc_id(); b.st = st;
    if (threadIdx.x == 0) (void)xb_add(&bar[XB_XCNT(b.x)], 1u);
    return b;
}
__device__ __forceinline__ void xcd_barrier_complete(unsigned* bar, unsigned x, unsigned& nloc, unsigned& nx) {
    const unsigned G = gridDim.x * gridDim.y * gridDim.z;
    unsigned sum, cnt, mine, sp = 0u;
    for (;;) {
        sum = 0u; cnt = 0u; mine = 0u;
#pragma unroll
        for (unsigned j = 0; j < 16; ++j) { const unsigned c = xb_ld(&bar[XB_XCNT(j)]); sum += c; cnt += (c > 0u) ? 1u : 0u; mine = (j == x) ? c : mine; }
        if (sum == G) break;
        __builtin_amdgcn_s_sleep(1);
        if ((++sp & 255u) == 0u) { if (xb_ld(&bar[XB_TMO])) break; if (sp > XB_SPIN_CAP) { atomicAdd(&bar[XB_TMO], 1u); break; } }
    }
    nloc = mine > 0u ? mine : 1u; nx = cnt > 0u ? cnt : 1u;
}
__device__ __forceinline__ void xcd_barrier(const XcdBarrier& b) {
    asm volatile("s_waitcnt vmcnt(0)" ::: "memory");
    __syncthreads();
    if (threadIdx.x == 0) {
        unsigned* bar = b.bar;
        __builtin_amdgcn_s_waitcnt(0);
        unsigned nloc = b.st[0], nx = b.st[1];
        if (nloc == 0u) { xcd_barrier_complete(bar, b.x, nloc, nx); b.st[0] = nloc; b.st[1] = nx; }
        const unsigned old = xb_add(&bar[XB_XSUB(b.x)], 1u);
        const unsigned gen = old / nloc;
        if (old + 1u == (gen + 1u) * nloc) {
            __builtin_amdgcn_fence(__ATOMIC_RELEASE, "agent");
            asm volatile("s_waitcnt vmcnt(0)" ::: "memory");
            const unsigned og = xb_add(&bar[XB_TOP], 1u);
            const unsigned tg = og / nx;
            if (og + 1u == (tg + 1u) * nx) xb_add(&bar[XB_TOPGEN], 1u);
            else XB_SPIN(xb_ld(&bar[XB_TOPGEN]) == tg, bar);
            __builtin_amdgcn_fence(__ATOMIC_ACQUIRE, "agent");
            xb_add(&bar[XB_XGEN(b.x)], 1u);
            asm volatile("s_waitcnt vmcnt(0)" ::: "memory");
        } else {
            XB_SPIN(xb_ld(&bar[XB_XGEN(b.x)]) == gen, bar);
            __builtin_amdgcn_fence(__ATOMIC_ACQUIRE, "agent");
            asm volatile("s_waitcnt vmcnt(0)" ::: "memory");
        }
    }
    __syncthreads();
}

namespace pg8 {
constexpr int BM = 256, BK = 64, HALF = 128, HTB = HALF * BK * 2, STAGE_BYTES = 8 * HTB, NXCD = 8, WGM = 8;
__device__ __forceinline__ int lds_byte(int r, int c) { const int st = (r >> 4) * 2 + (c >> 5), rr = r & 15, cc = c & 31, ob = rr * 64 + cc * 2; return st * 1024 + (ob ^ (((ob >> 9) & 1) << 5)); }
__device__ __forceinline__ void stage_rc(int b, int& R, int& C) { const int st = b / 1024, sb = b % 1024, swz = sb ^ (((sb >> 9) & 1) << 5); R = (st >> 1) * 16 + swz / 64; C = (st & 1) * 32 + (swz % 64) / 2; }
__device__ __forceinline__ int perm32(int rho) { const int n = rho >> 4, i = rho & 15; return 8 * (i >> 2) + 4 * n + (i & 3); }

struct Unit {
    int pm, pn, po;
    const char* A;
    const char* B;
    const char* B2;
    const int* rows;
    int nvalid, aux;
};

template <class Epi, class Sched>
__device__ __forceinline__ void gemm_phase(LAS unsigned char* lds, int K, int lda, int ldb, int ksplit, const Sched& S, const Epi& E) {
    asm volatile("" : "+s"(K), "+s"(lda), "+s"(ldb), "+s"(ksplit));
    const int tid = threadIdx.x, wid = __builtin_amdgcn_readfirstlane(tid >> 6), lane = tid & 63, wr = wid >> 2, wc = wid & 3, fr = lane & 15, fq = lane >> 4;
    const int nt = K / BK;
    unsigned voffB[2];
#pragma unroll
    for (int i = 0; i < 2; ++i) { int R, C; stage_rc(tid * 16 + i * 8192, R, C); const int Rb = (R & ~31) + perm32(R & 31); voffB[i] = (unsigned)(Rb * ldb + C) * 2u; }
    const size_t kstep = (size_t)(BK * 2);
    const size_t hstepB = (size_t)HALF * ldb * 2;
    const unsigned ldsw = (unsigned)wid * 1024u;
    const int aoff = lds_byte(wr * 64 + fr, fq * 8), boff = lds_byte(wc * 32 + fr, fq * 8);
#define PG8_SA(b, h) (((b) * 2 + (h)) * HTB)
#define PG8_SB(b, h) ((4 + (b) * 2 + (h)) * HTB)
#define PG8_STAGE(bufoff, gbase, voff) do { _Pragma("unroll") for (int _i = 0; _i < 2; ++_i) \
        __builtin_amdgcn_global_load_lds((const unsigned*)((const char*)(gbase) + (voff)[_i]), (LAS unsigned*)(lds + (bufoff) + ldsw + _i * 8192), 16, 0, 0); } while (0)
#define PG8_LDA(dst, b, h) do { _Pragma("unroll") for (int m = 0; m < 4; ++m) _Pragma("unroll") for (int k = 0; k < 2; ++k) dst[m][k] = *(const LAS bf16x8*)(lds + PG8_SA(b, h) + aoff + m * 2048 + k * 1024); } while (0)
#define PG8_LDB(dst, b, h) do { _Pragma("unroll") for (int n = 0; n < 2; ++n) _Pragma("unroll") for (int k = 0; k < 2; ++k) dst[n][k] = *(const LAS bf16x8*)(lds + PG8_SB(b, h) + boff + n * 2048 + k * 1024); } while (0)
#define PG8_MMA(ai, bj, At, Bt) do { __builtin_amdgcn_s_setprio(1); _Pragma("unroll") for (int m = 0; m < 4; ++m) _Pragma("unroll") for (int n = 0; n < 2; ++n) _Pragma("unroll") for (int k = 0; k < 2; ++k) \
        acc[ai][bj][m][n] = __builtin_amdgcn_mfma_f32_16x16x32_bf16(Bt[n][k], At[m][k], acc[ai][bj][m][n], 0, 0, 0); __builtin_amdgcn_s_setprio(0); } while (0)
#define PG8_WAIT_V(n) asm volatile("s_waitcnt vmcnt(" #n ")" ::: "memory")
#define PG8_WAIT_L(n) asm volatile("s_waitcnt lgkmcnt(" #n ")" ::: "memory")
#define PG8_BAR __builtin_amdgcn_s_barrier()
#define PG8_SCHED __builtin_amdgcn_sched_barrier(0)
#define PG8_BK(u, t) (((t) < ksplit ? (u).B : (u).B2) + (size_t)(t) * kstep)
#define PG8_VOFF(dst, u) do { int _tl = tid; asm volatile("" : "+v"(_tl)); _Pragma("unroll") for (int _h = 0; _h < 2; ++_h) _Pragma("unroll") for (int _i = 0; _i < 2; ++_i) { int _R, _C; stage_rc(_tl * 16 + _i * 8192, _R, _C); int _r = _R + HALF * _h; \
        if constexpr (Sched::GATHER) { const int _rr = _r < (u).nvalid ? _r : 0; _r = (u).rows[_rr]; } dst[_h][_i] = (unsigned)(_r * lda + _C) * 2u; } } while (0)
    Unit cur, nxt; int ui = 0;
    if (!S.next(0, cur)) return;
    f32x4 acc[2][2][4][2];
#pragma unroll
    for (int a = 0; a < 2; ++a)
#pragma unroll
        for (int b = 0; b < 2; ++b)
#pragma unroll
            for (int m = 0; m < 4; ++m)
#pragma unroll
                for (int n = 0; n < 2; ++n) acc[a][b][m][n] = (f32x4){0.f, 0.f, 0.f, 0.f};
    bf16x8 At[4][2], B0[2][2], B1[2][2];
    LAS unsigned* VO = (LAS unsigned*)(lds + STAGE_BYTES) + tid;
#define PG8_VO(slot, h, i) VO[(((slot) & 1) * 4 + (h) * 2 + (i)) * 512]
    unsigned vfix[2][2];
    {
        unsigned vc[2][2];
        PG8_VOFF(vc, cur);
#pragma unroll
        for (int h = 0; h < 2; ++h)
#pragma unroll
            for (int i = 0; i < 2; ++i) { vfix[h][i] = vc[h][i]; if constexpr (Sched::GATHER) PG8_VO(0, h, i) = vc[h][i]; }
        const char* cA0 = cur.A;
        const char* b0 = PG8_BK(cur, 0); const char* b1 = PG8_BK(cur, 1);
        PG8_STAGE(PG8_SB(0, 0), b0, voffB); PG8_STAGE(PG8_SB(0, 1), b0 + hstepB, voffB); PG8_STAGE(PG8_SA(0, 0), cA0, vc[0]); PG8_STAGE(PG8_SA(0, 1), cA0, vc[1]);
        if (wr == 1) PG8_BAR;
        PG8_WAIT_V(2); PG8_BAR;
        PG8_STAGE(PG8_SB(1, 0), b1, voffB); PG8_STAGE(PG8_SA(1, 0), cA0 + kstep, vc[0]); PG8_STAGE(PG8_SB(1, 1), b1 + hstepB, voffB);
        PG8_WAIT_V(6); PG8_BAR;
    }
    const char* cA = cur.A;
    for (;;) {
        const bool has_next = S.next(ui + 1, nxt);
        if (!has_next) nxt = cur;
        if constexpr (Sched::GATHER) { unsigned vn[2][2]; PG8_VOFF(vn, nxt);
#pragma unroll
            for (int h = 0; h < 2; ++h)
#pragma unroll
                for (int i = 0; i < 2; ++i) PG8_VO(ui + 1, h, i) = vn[h][i]; }
        const char* nA = nxt.A;
#pragma nounroll
        for (int t = 0; t < nt; t += 2) {
            const bool last = (t == nt - 2);
            const char* a1 = cA + (size_t)(t + 1) * kstep;
            const char* a2 = last ? nA : cA + (size_t)(t + 2) * kstep;
            const char* a3 = a2 + kstep;
            const char* b2 = last ? PG8_BK(nxt, 0) : PG8_BK(cur, t + 2);
            const char* b3 = last ? PG8_BK(nxt, 1) : PG8_BK(cur, t + 3);
            unsigned v1[2], v2[2][2];
            if constexpr (Sched::GATHER) { const int s2 = last ? ui + 1 : ui;
                v1[0] = PG8_VO(ui, 1, 0); v1[1] = PG8_VO(ui, 1, 1);
#pragma unroll
                for (int h = 0; h < 2; ++h)
#pragma unroll
                    for (int i = 0; i < 2; ++i) v2[h][i] = PG8_VO(s2, h, i);
            } else { v1[0] = vfix[1][0]; v1[1] = vfix[1][1];
#pragma unroll
                for (int h = 0; h < 2; ++h)
#pragma unroll
                    for (int i = 0; i < 2; ++i) v2[h][i] = vfix[h][i]; }
            PG8_LDB(B0, 0, 0); PG8_LDB(B1, 0, 1); PG8_SCHED; PG8_LDA(At, 0, 0); PG8_STAGE(PG8_SA(1, 1), a1, v1);
            PG8_WAIT_V(8); PG8_WAIT_L(0); PG8_BAR; PG8_MMA(0, 0, At, B0); PG8_MMA(0, 1, At, B1); PG8_BAR; PG8_SCHED;
            PG8_LDA(At, 0, 1); PG8_STAGE(PG8_SB(0, 0), b2, voffB); PG8_STAGE(PG8_SB(0, 1), b2 + hstepB, voffB); PG8_STAGE(PG8_SA(0, 0), a2, v2[0]);
            PG8_WAIT_V(8); PG8_WAIT_L(0); PG8_BAR; PG8_MMA(1, 0, At, B0); PG8_MMA(1, 1, At, B1); PG8_BAR; PG8_SCHED;
            PG8_LDB(B0, 1, 0); PG8_LDB(B1, 1, 1); PG8_SCHED; PG8_LDA(At, 1, 0); PG8_STAGE(PG8_SA(0, 1), a2, v2[1]);
            PG8_WAIT_V(8); PG8_WAIT_L(0); PG8_BAR; PG8_MMA(0, 0, At, B0); PG8_MMA(0, 1, At, B1); PG8_BAR; PG8_SCHED;
            PG8_LDA(At, 1, 1); PG8_STAGE(PG8_SB(1, 0), b3, voffB); PG8_STAGE(PG8_SB(1, 1), b3 + hstepB, voffB); PG8_STAGE(PG8_SA(1, 0), a3, v2[0]);
            PG8_WAIT_V(8); PG8_WAIT_L(0); PG8_BAR; PG8_MMA(1, 0, At, B0); PG8_MMA(1, 1, At, B1); PG8_BAR; PG8_SCHED;
        }
        if (wr == 0) PG8_BAR;
        E(acc, cur, wr, wc, fr, fq);
        if (!has_next) break;
#pragma unroll
        for (int a = 0; a < 2; ++a)
#pragma unroll
            for (int b = 0; b < 2; ++b)
#pragma unroll
                for (int m = 0; m < 4; ++m)
#pragma unroll
                    for (int n = 0; n < 2; ++n) acc[a][b][m][n] = (f32x4){0.f, 0.f, 0.f, 0.f};
        cur = nxt; cA = nA; ++ui;
        if (wr == 1) PG8_BAR;
    }
    PG8_WAIT_V(0);
    PG8_BAR;
#undef PG8_SA
#undef PG8_SB
#undef PG8_STAGE
#undef PG8_LDA
#undef PG8_LDB
#undef PG8_MMA
#undef PG8_WAIT_V
#undef PG8_WAIT_L
#undef PG8_BAR
#undef PG8_SCHED
#undef PG8_BK
#undef PG8_VOFF
#undef PG8_VO
}

struct PlainSched {
    static constexpr bool GATHER = false;
    int nM, nN, nwg, G, c; const char* A; const char* Bt; int lda, ldb, K; int rowmap;
    __device__ __forceinline__ void init(const void* A_, const void* Bt_, int M, int N, int K_, int lda_, int ldb_, int G_, int c_, int rowmap_) {
        A = (const char*)A_; Bt = (const char*)Bt_; nM = M / BM; nN = N / BM; nwg = nM * nN; G = G_; c = c_; lda = lda_; ldb = ldb_; K = K_; rowmap = rowmap_; }
    __device__ __forceinline__ bool next(int i, Unit& u) const {
        const int L = i * G + c; if (L >= nwg) return false;
        int wgid = L; { const int q = nwg / NXCD, r = nwg % NXCD, xcd = wgid % NXCD, off = wgid / NXCD; wgid = (xcd < r ? xcd * (q + 1) : r * (q + 1) + (xcd - r) * q) + off; }
        const int nig = WGM * nN, gid = wgid / nig, fm = gid * WGM, gsz = (nM - fm) < WGM ? (nM - fm) : WGM;
        const int pm = fm + ((wgid % nig) % gsz), pn = (wgid % nig) / gsz;
        u.po = pm; u.pn = pn; u.pm = rowmap ? (pm / 16) * 17 + 1 + (pm % 16) : pm;
        u.A = A + (size_t)u.pm * BM * lda * 2; u.B = Bt + (size_t)pn * BM * ldb * 2; u.B2 = u.B; u.rows = nullptr; u.nvalid = BM; u.aux = 0;
        return true;
    }
};

struct EpiStoreBf16 {
    bf16_t* O; int ldc;
    __device__ __forceinline__ void operator()(const f32x4 (&acc)[2][2][4][2], const Unit& u, int wr, int wc, int fr, int fq) const {
        bf16_t* base = O + (size_t)(u.po * BM + wr * 64 + fr) * ldc + u.pn * BM + wc * 32 + 8 * fq;
#pragma unroll
        for (int ai = 0; ai < 2; ++ai)
#pragma unroll
            for (int m = 0; m < 4; ++m) { bf16_t* rowp = base + (size_t)(ai * HALF + m * 16) * ldc;
#pragma unroll
                for (int bj = 0; bj < 2; ++bj) { const f32x4 v0 = acc[ai][bj][m][0], v1 = acc[ai][bj][m][1];
                    u32x4 w; w.x = cvt_pk_bf16(v0[0], v0[1]); w.y = cvt_pk_bf16(v0[2], v0[3]); w.z = cvt_pk_bf16(v1[0], v1[1]); w.w = cvt_pk_bf16(v1[2], v1[3]);
                    *(u32x4*)(rowp + bj * HALF) = w; } }
    }
};
struct EpiResid {
    const float* x; const float* ctx; float* out; float* xc; const float* modl; int mode;
    __device__ __forceinline__ void operator()(const f32x4 (&acc)[2][2][4][2], const Unit& u, int wr, int wc, int fr, int fq) const {
        const float* src; float* dst; int mrow;
        if (mode == 0) { const int b = u.po / 17, jt = u.po % 17;
            if (jt == 0) { src = ctx + (size_t)b * CTXL * D; dst = xc + (size_t)b * CTXL * D; mrow = 8; }
            else { src = x + ((size_t)b * SEQ + (jt - 1) * 256) * D; dst = out + ((size_t)b * SEQ + (jt - 1) * 256) * D; mrow = b; } }
        else { src = out + (size_t)u.po * BM * D; dst = out + (size_t)u.po * BM * D; mrow = u.po / 16; }
        const float* gate = modl + (size_t)mrow * (NMOD * D) + 2 * D;
        const int col0 = u.pn * BM + wc * 32 + 8 * fq;
        f32x4 gv[2][2];
#pragma unroll
        for (int bj = 0; bj < 2; ++bj)
#pragma unroll
            for (int n = 0; n < 2; ++n) gv[bj][n] = *(const f32x4*)(gate + col0 + bj * HALF + 4 * n);
#pragma unroll
        for (int ai = 0; ai < 2; ++ai)
#pragma unroll
        for (int mp = 0; mp < 2; ++mp) {
            f32x4 sv[2][2][2];
#pragma unroll
            for (int mm = 0; mm < 2; ++mm) { const size_t ro = (size_t)(ai * HALF + wr * 64 + (mp * 2 + mm) * 16 + fr) * D + col0;
#pragma unroll
                for (int bj = 0; bj < 2; ++bj)
#pragma unroll
                    for (int n = 0; n < 2; ++n) sv[mm][bj][n] = *(const f32x4*)(src + ro + bj * HALF + 4 * n); }
            __builtin_amdgcn_sched_barrier(0);
#pragma unroll
            for (int mm = 0; mm < 2; ++mm) { const int m = mp * 2 + mm; const size_t ro = (size_t)(ai * HALF + wr * 64 + m * 16 + fr) * D + col0;
#pragma unroll
                for (int bj = 0; bj < 2; ++bj)
#pragma unroll
                    for (int n = 0; n < 2; ++n) *(f32x4*)(dst + ro + bj * HALF + 4 * n) = sv[mm][bj][n] + gv[bj][n] * acc[ai][bj][m][n]; }
            __builtin_amdgcn_sched_barrier(0);
        }
    }
};
}

struct Args { const float* in[30]; float* out; unsigned char* ws; int ph_lo, ph_hi; };
typedef const __attribute__((address_space(4))) Args& CArgsRef;
#define ARGP() (*({ const __attribute__((address_space(4))) Args* _p = (const __attribute__((address_space(4))) Args*)__builtin_amdgcn_kernarg_segment_ptr(); asm volatile("" : "+s"(_p)); _p; }))
struct Frame {
    LAS unsigned char* lds;
    int tid, lane, wave, G, bid;
    float* out; unsigned char* ws;
    unsigned* ctl;
};
#define WSP(T, off) ((T*)(F.ws + (off)))

__device__ __forceinline__ float* xl_row(const Frame& F, int ta) {
    const int b = ta / TPB, j = ta - b * TPB;
    return j < CTXL ? WSP(float, WS_XC) + (size_t)(b * CTXL + j) * D : F.out + ((size_t)b * SEQ + (j - CTXL)) * D;
}

struct TrItem { const float* src; bf16_t* dst; int N, ldo; };
__device__ __forceinline__ void tr_load(const TrItem& t, f32x4 (&v)[8], int lane) {
#pragma unroll
    for (int i = 0; i < 8; ++i) { const int kk = 8 * i + (lane >> 3); v[i] = *(const f32x4*)(t.src + (size_t)kk * t.N + 4 * (lane & 7)); }
}
__device__ __forceinline__ void tr_finish(const TrItem& t, const f32x4 (&v)[8], LAS float* scr, int lane) {
#pragma unroll
    for (int i = 0; i < 8; ++i) { const int kk = 8 * i + (lane >> 3); LAS float* p = scr + kk * 33 + 4 * (lane & 7); p[0] = v[i].x; p[1] = v[i].y; p[2] = v[i].z; p[3] = v[i].w; }
    LDS_WAIT(); asm volatile("" ::: "memory");
    const int c = lane & 7;
#pragma unroll
    for (int j = 0; j < 4; ++j) { const int n = (lane >> 3) + 8 * j; const LAS float* s = scr + (8 * c) * 33 + n;
        u32x4 o; o.x = cvt_pk_bf16(s[0 * 33], s[1 * 33]); o.y = cvt_pk_bf16(s[2 * 33], s[3 * 33]); o.z = cvt_pk_bf16(s[4 * 33], s[5 * 33]); o.w = cvt_pk_bf16(s[6 * 33], s[7 * 33]);
        *(u32x4*)(t.dst + (size_t)n * t.ldo + 8 * c) = o; }
    LDS_WAIT(); asm volatile("" ::: "memory");
}
__device__ __forceinline__ TrItem tr_generic(const float* W, int K, int N, bf16_t* WT, int item) {
    const int nblk = N / 32, kb = item / nblk, nb = item % nblk;
    return TrItem{W + (size_t)(64 * kb) * N + 32 * nb, WT + (size_t)(32 * nb) * K + 64 * kb, N, K};
}

__device__ __forceinline__ void p0_prologue(Frame& F, CArgsRef A, unsigned long long& pt1) {
    const int tid = F.tid, lane = F.lane, wave = F.wave;
    constexpr int NMODU = 96;
    if (F.bid < NMODU) {
        LAS float* SC = (LAS float*)F.lds;
        LAS float* RED = (LAS float*)(F.lds + 36864);
        {
            float cv[18];
#pragma unroll
            for (int q = 0; q < 18; ++q) { const int i = tid + 512 * q, r = i >> 10, k = i & 1023; cv[q] = r < 8 ? A.in[1][r * 1024 + k] : A.in[3][k]; }
            __builtin_amdgcn_sched_barrier(0);
#pragma unroll
            for (int q = 0; q < 18; ++q) SC[tid + 512 * q] = siluf_(cv[q]);
        }
        __syncthreads();
        float* MOD = WSP(float, WS_MOD);
        for (int u = F.bid; u < NMODU; u += F.G) {
            const int l = u / 48, cb = (u % 48) >> 1, kh = u & 1;
            const float* W = A.in[4] + (size_t)l * D * (NMOD * D) + cb * 256 + 4 * lane;
            f32x4 a[9];
#pragma unroll
            for (int r = 0; r < 9; ++r) a[r] = (f32x4){0.f, 0.f, 0.f, 0.f};
#pragma unroll 1
            for (int kk0 = 0; kk0 < 64; kk0 += 16) { const int k0 = kh * 512 + 64 * wave + kk0;
                f32x4 w[16];
#pragma unroll
                for (int i = 0; i < 16; ++i) w[i] = *(const f32x4*)(W + (size_t)(k0 + i) * (NMOD * D));
                __builtin_amdgcn_sched_barrier(0);
#pragma unroll
                for (int i = 0; i < 16; ++i)
#pragma unroll
                    for (int r = 0; r < 9; ++r) a[r] += w[i] * SC[r * 1024 + k0 + i]; }
#pragma unroll
            for (int r = 0; r < 9; ++r) *(LAS f32x4*)(RED + (wave * 9 + r) * 256 + 4 * lane) = a[r];
            __syncthreads();
            {
                float bs[5];
#pragma unroll
                for (int q = 0; q < 5; ++q) { const int o = tid + 512 * q; bs[q] = (kh == 0 && o < 9 * 256) ? A.in[5][l * (NMOD * D) + cb * 256 + (o & 255)] : 0.f; }
#pragma unroll
                for (int q = 0; q < 5; ++q) { const int o = tid + 512 * q; if (o < 9 * 256) { const int r = o >> 8, cc = o & 255; float sm = 0.f;
#pragma unroll
                    for (int w = 0; w < 8; ++w) sm += RED[(w * 9 + r) * 256 + cc];
                    atomicAdd(&MOD[((size_t)l * 9 + r) * (NMOD * D) + cb * 256 + cc], sm + bs[q]); } }
            }
            __syncthreads();
        }
    }
    if (PT_SUB == 1) pt1 = __builtin_amdgcn_s_memrealtime();
    {
        const float invf[16] = {1.000000000e+00f, 5.623413324e-01f, 3.162277639e-01f, 1.778279394e-01f, 1.000000015e-01f, 5.623413250e-02f, 3.162277490e-02f, 1.778279431e-02f,
                                9.999999776e-03f, 5.623413250e-03f, 3.162277630e-03f, 1.778279431e-03f, 1.000000047e-03f, 5.623413017e-04f, 3.162277571e-04f, 1.778279402e-04f};
        float* COS = WSP(float, WS_COS); float* SIN = WSP(float, WS_SIN);
        for (int i = F.bid * 512 + tid; i < SEQ * 32; i += F.G * 512) {
            const int pos = i >> 5, j = i & 31, f = j & 15; const float p = (float)(j < 16 ? (pos >> 6) : (pos & 63));
            float fr = 1.f;
#pragma unroll
            for (int q = 0; q < 16; ++q) fr = (f == q) ? invf[q] : fr;
            const float angf = p * fr; const double x = (double)angf;
            const double n = __builtin_rint(x * 0.63661977236758134308);
            const double y = (x - n * 1.57079632679489655800e+00) - n * 6.12323399573676603587e-17;
            const double y2 = y * y;
            double sn = y * (1.0 + y2 * (-1.0 / 6 + y2 * (1.0 / 120 + y2 * (-1.0 / 5040 + y2 * (1.0 / 362880 + y2 * (-1.0 / 39916800 + y2 * (1.0 / 6227020800.0)))))));
            double cs = 1.0 + y2 * (-0.5 + y2 * (1.0 / 24 + y2 * (-1.0 / 720 + y2 * (1.0 / 40320 + y2 * (-1.0 / 3628800 + y2 * (1.0 / 479001600.0 + y2 * (-1.0 / 87178291200.0)))))));
            const int q4 = ((int)n) & 3;
            const double c = (q4 == 0) ? cs : (q4 == 1) ? -sn : (q4 == 2) ? -cs : sn;
            const double s = (q4 == 0) ? sn : (q4 == 1) ? cs : (q4 == 2) ? -sn : -cs;
            COS[i] = (float)c; SIN[i] = (float)s;
        }
    }
    if (PT_SUB == 2) pt1 = __builtin_amdgcn_s_memrealtime();
    {
        LAS float* scr = (LAS float*)(F.lds + wave * 16384);
        constexpr int I_IN0 = 16 * 48, I_OUT = 16 * 32, I_IN1 = 16 * 62, I_UQ = 4 * 24, I_UKV = 2 * 32, I_POOL = 4 * 8, I_MOE = 64 * 384;
        constexpr int NIT = I_IN0 + I_OUT + I_IN1 + I_UQ + I_UKV + I_OUT + I_POOL + I_MOE;
        int it0, it1, step;
        if (F.G == 256) {
            const int wv = F.bid * 8 + wave;
            it0 = F.bid < NMODU ? wv * 12 : NMODU * 8 * 12 + (wv - NMODU * 8) * 15; it1 = it0 + (F.bid < NMODU ? 12 : 15); if (it1 > NIT) it1 = NIT; if (it0 > NIT) it0 = NIT; step = 1;
            static_assert(NMODU * 8 * 12 + (256 - NMODU) * 8 * 15 >= NIT, "prologue item split");
        } else { it0 = F.bid * 8 + wave; it1 = NIT; step = F.G * 8; }
        unsigned char* ws_ = F.ws;
        auto item_of = [&](int it) -> TrItem {
            int r = it;
            if (r < I_IN0) return tr_generic(A.in[7], D, 1536, (bf16_t*)(ws_ + WS_WIN0), r); r -= I_IN0;
            if (r < I_OUT) return tr_generic(A.in[14], D, D, (bf16_t*)(ws_ + WS_WOUT0), r); r -= I_OUT;
            if (r < I_IN1) return tr_generic(A.in[15], D, 1984, (bf16_t*)(ws_ + WS_WIN1), r); r -= I_IN1;
            if (r < I_UQ) return tr_generic(A.in[17], 256, 768, (bf16_t*)(ws_ + WS_WUQ), r); r -= I_UQ;
            if (r < I_UKV) return tr_generic(A.in[19], 128, 1024, (bf16_t*)(ws_ + WS_WUKV), r); r -= I_UKV;
            if (r < I_OUT) return tr_generic(A.in[24], D, D, (bf16_t*)(ws_ + WS_WOUT1), r); r -= I_OUT;
            if (r < I_POOL) { const int g = r / 8; return tr_generic(A.in[12] + (size_t)g * 128 * 128, 128, 128, (bf16_t*)(ws_ + WS_WPOOL) + (size_t)g * 128 * 128, r % 8); } r -= I_POOL;
            const int le = r / 384, q = r % 384;
            bf16_t* W1 = (bf16_t*)(ws_ + WS_WM1) + (size_t)le * 512 * 1024; bf16_t* W2 = (bf16_t*)(ws_ + WS_WM2) + (size_t)le * 1024 * 256;
            if (q < 256) {
                const int up = q >> 7, item = q & 127, kb = item / 8, nb = item % 8, n0 = 32 * nb;
                const float* W = A.in[up ? 28 : 27] + (size_t)le * 1024 * 256;
                const int drow = (n0 >> 7) * 256 + up * 128 + (n0 & 127);
                return TrItem{W + (size_t)(64 * kb) * 256 + n0, W1 + (size_t)drow * 1024 + 64 * kb, 256, 1024};
            }
            return tr_generic(A.in[29] + (size_t)le * 256 * 1024, 256, 1024, W2, q - 256);
        };
        for (int it = it0; it < it1; it += 4 * step) {
            TrItem t0 = item_of(it), t1 = item_of(it + step < it1 ? it + step : it), t2 = item_of(it + 2 * step < it1 ? it + 2 * step : it), t3 = item_of(it + 3 * step < it1 ? it + 3 * step : it);
            f32x4 v0[8], v1[8], v2[8], v3[8];
            tr_load(t0, v0, lane); tr_load(t1, v1, lane); tr_load(t2, v2, lane); tr_load(t3, v3, lane);
            __builtin_amdgcn_sched_barrier(0);
            tr_finish(t0, v0, scr, lane);
            if (it + step < it1) tr_finish(t1, v1, scr, lane);
            if (it + 2 * step < it1) tr_finish(t2, v2, scr, lane);
            if (it + 3 * step < it1) tr_finish(t3, v3, scr, lane);
        }
        { u32x4* z = (u32x4*)(WSP(bf16_t, WS_WIN1) + (size_t)1984 * 1024); const u32x4 zero = {0u, 0u, 0u, 0u};
          for (int i = F.bid * 512 + tid; i < 64 * 1024 / 8; i += F.G * 512) z[i] = zero; }
    }
}

__device__ __forceinline__ void norm_mod_phase(Frame& F, CArgsRef A, int layer) {
    const int gw = F.bid * 8 + F.wave, NGW = F.G * 8, lane = F.lane;
    const float* g = A.in[6] + (size_t)(layer * 2 + 0) * D;
    const float* MODL = WSP(float, WS_MOD) + (size_t)layer * 9 * (NMOD * D);
    bf16_t* H = WSP(bf16_t, WS_H);
    f32x4 gvec[4];
#pragma unroll
    for (int q = 0; q < 4; ++q) gvec[q] = *(const f32x4*)(g + 4 * lane + 256 * q);
    for (int ta0 = gw; ta0 < NTOK; ta0 += 2 * NGW) {
        const int ta1 = ta0 + NGW; const bool has1 = ta1 < NTOK;
        f32x4 v[2][4], s4[2][4], h4[2][4];
#pragma unroll
        for (int e = 0; e < 2; ++e) { const int ta = e ? (has1 ? ta1 : ta0) : ta0; const int b = ta / TPB, j = ta - b * TPB, mrow = j < CTXL ? 8 : b;
            const float* src = layer == 0 ? (j < CTXL ? A.in[2] + (size_t)(b * CTXL + j) * D : A.in[0] + ((size_t)b * SEQ + (j - CTXL)) * D) : xl_row(F, ta);
            const f32x4* xr = (const f32x4*)src + lane;
            const float* sh = MODL + (size_t)mrow * (NMOD * D); const float* sc = sh + D;
#pragma unroll
            for (int q = 0; q < 4; ++q) { v[e][q] = xr[64 * q]; s4[e][q] = *(const f32x4*)(sc + 4 * lane + 256 * q); h4[e][q] = *(const f32x4*)(sh + 4 * lane + 256 * q); } }
        __builtin_amdgcn_sched_barrier(0);
#pragma unroll
        for (int e = 0; e < 2; ++e) { const int ta = e ? ta1 : ta0; if (e && !has1) break;
            float s = 0.f;
#pragma unroll
            for (int q = 0; q < 4; ++q) s += (v[e][q].x * v[e][q].x + v[e][q].y * v[e][q].y) + (v[e][q].z * v[e][q].z + v[e][q].w * v[e][q].w);
            const float r = 1.f / sqrtf(wave_sum(s) * (1.f / D) + EPS);
            u32x2* o8 = (u32x2*)(H + (size_t)ta * D) + lane;
#pragma unroll
            for (int q = 0; q < 4; ++q) { const f32x4 y = (v[e][q] * r) * gvec[q] * (s4[e][q] + 1.f) + h4[e][q];
                u32x2 w; w.x = cvt_pk_bf16(y.x, y.y); w.y = cvt_pk_bf16(y.z, y.w); o8[64 * q] = w; } }
    }
}

__device__ __forceinline__ void convpool_phase(Frame& F, CArgsRef A, unsigned long long& pt1) {
    const int tid = F.tid, lane = F.lane, wave = F.wave, r32 = lane & 31, hi = lane >> 5;
    const bf16_t* __restrict__ U = WSP(bf16_t, WS_BIG); bf16_t* __restrict__ Y = WSP(bf16_t, WS_YMIX); const bf16_t* __restrict__ WP = WSP(bf16_t, WS_WPOOL);
    {
        LAS bf16_t* GL = (LAS bf16_t*)F.lds;
        LAS float* CV = (LAS float*)(F.lds + 63488);
        const int c0 = wave * 64 + lane;
        float w0[31];
#pragma unroll
        for (int k = 0; k < 31; ++k) w0[k] = A.in[8][k * 512 + c0];
        __builtin_amdgcn_sched_barrier(0);
        const float dwb = A.in[9][c0];
        const f32x4 lg0 = *(const f32x4*)(A.in[10] + 8 * lane), lg1 = *(const f32x4*)(A.in[10] + 8 * lane + 4), lb0 = *(const f32x4*)(A.in[11] + 8 * lane), lb1 = *(const f32x4*)(A.in[11] + 8 * lane + 4);
#define CP_UNIT(u_, b, n, tb, t0, TS) int b, n, tb, t0, TS; if ((u_) < 1024) { b = (u_) >> 7; n = SEQ; tb = b * TPB + CTXL; t0 = ((u_) & 127) * 32; TS = 32; } else { const int uu = (u_) - 1024; b = uu >> 5; n = CTXL; tb = b * TPB; t0 = (uu & 31) * 8; TS = 8; }
#define CPA_LOAD(u_) do { CP_UNIT(u_, b_, n_, tb_, t0_, TS_); const int nG_ = (TS_ + 30) * 64; (void)b_; \
            _Pragma("unroll") for (int q = 0; q < 8; ++q) { const int ch = q * 512 + tid, ri = ch >> 6, c8 = (ch & 63) * 8, pos = t0_ + ri - 15; const bool ok = (ch < nG_) && pos >= 0 && pos < n_; \
                const bf16_t* up = U + (size_t)(tb_ + (ok ? pos : t0_)) * UW + c8; av[q] = *(const u32x4*)up; gv[q] = *(const u32x4*)(up + 512); } } while (0)
        u32x4 av[8], gv[8];
        if (F.bid < 1280) CPA_LOAD(F.bid);
        for (int u = F.bid; u < 1280; u += F.G) {
            CP_UNIT(u, b, n, tb, t0, TS); (void)b;
            __syncthreads();
            const int nG = (TS + 30) * 64;
#pragma unroll
            for (int q = 0; q < 8; ++q) { const int ch = q * 512 + tid, ri = ch >> 6, c8 = (ch & 63) * 8, pos = t0 + ri - 15; const bool ok = pos >= 0 && pos < n;
                u32x4 o;
#pragma unroll
                for (int e = 0; e < 4; ++e) { const float a0 = bflo(av[q][e]), a1 = bfhi(av[q][e]), g0 = bflo(gv[q][e]), g1 = bfhi(gv[q][e]);
                    o[e] = cvt_pk_bf16(a0 * __builtin_amdgcn_rcpf(1.f + __expf(-g0)), a1 * __builtin_amdgcn_rcpf(1.f + __expf(-g1))); }
                if (!ok) o = (u32x4){0u, 0u, 0u, 0u};
                if (ch < nG) *(LAS u32x4*)(GL + ri * 512 + c8) = o; }
            __builtin_amdgcn_sched_barrier(0);
            if (u + F.G < 1280) CPA_LOAD(u + F.G);
            __builtin_amdgcn_sched_barrier(0);
            __syncthreads();
#pragma unroll 1
            for (int i0 = 0; i0 < TS; i0 += 4) {
                float x0[4];
#pragma unroll
                for (int q = 0; q < 4; ++q) x0[q] = dwb;
#pragma unroll
                for (int r = 0; r < 34; ++r) { const float g0 = bf2f(*(const LAS unsigned short*)(GL + (i0 + r) * 512 + c0));
#pragma unroll
                    for (int q = 0; q < 4; ++q) { const int k = r - q; if (k >= 0 && k < 31) x0[q] += g0 * w0[k]; } }
#pragma unroll
                for (int q = 0; q < 4; ++q) CV[(i0 + q) * 512 + c0] = x0[q];
            }
            __syncthreads();
            for (int tk = wave; tk < TS; tk += 8) {
                const f32x4 v0 = *(const LAS f32x4*)(CV + tk * 512 + 8 * lane), v1 = *(const LAS f32x4*)(CV + tk * 512 + 8 * lane + 4);
                const float sm = wave_sum((v0.x + v0.y) + (v0.z + v0.w) + (v1.x + v1.y) + (v1.z + v1.w));
                const float mean = sm * (1.f / 512.f);
                const f32x4 d0 = v0 - mean, d1 = v1 - mean;
                const float s2 = wave_sum((d0.x * d0.x + d0.y * d0.y) + (d0.z * d0.z + d0.w * d0.w) + (d1.x * d1.x + d1.y * d1.y) + (d1.z * d1.z + d1.w * d1.w));
                const float rstd = 1.f / sqrtf(s2 * (1.f / 512.f) + EPS);
                const f32x4 y0 = d0 * rstd * lg0 + lb0, y1 = d1 * rstd * lg1 + lb1;
                u32x4 o; o.x = cvt_pk_bf16(siluf_(y0.x), siluf_(y0.y)); o.y = cvt_pk_bf16(siluf_(y0.z), siluf_(y0.w)); o.z = cvt_pk_bf16(siluf_(y1.x), siluf_(y1.y)); o.w = cvt_pk_bf16(siluf_(y1.z), siluf_(y1.w));
                *(u32x4*)(Y + (size_t)(tb + t0 + tk) * D + 8 * lane) = o;
            }
        }
    }
    if (PT_SUB == 4) pt1 = __builtin_amdgcn_s_memrealtime();
    {
        LAS bf16_t* UP = (LAS bf16_t*)F.lds;
        LAS bf16_t* PL = (LAS bf16_t*)(F.lds + 49152);
        bf16x8 wfr[2][8]; float pscv[2];
#pragma unroll
        for (int ntile = 0; ntile < 2; ++ntile) { const int gi = wave >> 1, n0 = (wave & 1) * 64 + ntile * 32; pscv[ntile] = A.in[13][gi * 128 + n0 + r32];
#pragma unroll
            for (int ks = 0; ks < 8; ++ks) wfr[ntile][ks] = *(const bf16x8*)(WP + ((size_t)(gi * 128 + n0 + r32)) * 128 + ks * 16 + hi * 8); }
        __builtin_amdgcn_sched_barrier(0);
#define CPB_LOAD(u_) do { CP_UNIT(u_, b_, n_, tb_, t0_, TS_); const int nU_ = (TS_ + 16) * 64; (void)b_; \
            _Pragma("unroll") for (int q = 0; q < 6; ++q) { const int ch = q * 512 + tid, ri = ch >> 6, c8 = (ch & 63) * 8, pos = t0_ + ri - 8; const bool ok = (ch < nU_) && pos >= 0 && pos < n_; \
                uv[q] = *(const u32x4*)(U + (size_t)(tb_ + (ok ? pos : t0_)) * UW + 1024 + c8); if (!ok) uv[q] = (u32x4){0u, 0u, 0u, 0u}; } } while (0)
        u32x4 uv[6];
        if (F.bid < 1280) CPB_LOAD(F.bid);
        for (int u = F.bid; u < 1280; u += F.G) {
            CP_UNIT(u, b, n, tb, t0, TS); (void)b;
            __syncthreads();
            const int nU = (TS + 16) * 64;
#pragma unroll
            for (int q = 0; q < 6; ++q) { const int ch = q * 512 + tid, ri = ch >> 6, c8 = (ch & 63) * 8; if (ch < nU) *(LAS u32x4*)(UP + ri * 512 + c8) = uv[q]; }
            __builtin_amdgcn_sched_barrier(0);
            if (u + F.G < 1280) CPB_LOAD(u + F.G);
            __builtin_amdgcn_sched_barrier(0);
            __syncthreads();
#pragma unroll 1
            for (int e = tid; e < 32 * 64; e += 512) { const int i = e >> 6, c8 = (e & 63) * 8, gi = c8 >> 7, hw = 1 << gi, pos = t0 + i;
                u32x4 o = {0u, 0u, 0u, 0u};
                if (i < TS) {
                    const int lo = (pos - hw) > 0 ? (pos - hw) : 0, hh = (pos + hw) < n ? (pos + hw) : n;
                    float s[8];
#pragma unroll
                    for (int j = 0; j < 8; ++j) s[j] = 0.f;
                    for (int p = lo; p < hh; ++p) { const u32x4 v = *(const LAS u32x4*)(UP + (p - t0 + 8) * 512 + c8);
                        s[0] += bflo(v.x); s[1] += bfhi(v.x); s[2] += bflo(v.y); s[3] += bfhi(v.y); s[4] += bflo(v.z); s[5] += bfhi(v.z); s[6] += bflo(v.w); s[7] += bfhi(v.w); }
                    const float ic = 1.f / (float)(hh - lo);
                    const u32x4 v = *(const LAS u32x4*)(UP + (i + 8) * 512 + c8);
                    o.x = cvt_pk_bf16(s[0] * ic - bflo(v.x), s[1] * ic - bfhi(v.x)); o.y = cvt_pk_bf16(s[2] * ic - bflo(v.y), s[3] * ic - bfhi(v.y));
                    o.z = cvt_pk_bf16(s[4] * ic - bflo(v.z), s[5] * ic - bfhi(v.z)); o.w = cvt_pk_bf16(s[6] * ic - bflo(v.w), s[7] * ic - bfhi(v.w)); }
                *(LAS u32x4*)(PL + i * 512 + c8) = o; }
            __syncthreads();
            {
                const int gi = wave >> 1, nh = wave & 1;
#pragma unroll
                for (int ntile = 0; ntile < 2; ++ntile) { const int n0 = nh * 64 + ntile * 32;
                    f32x16 acc = {};
#pragma unroll
                    for (int ks = 0; ks < 8; ++ks) { const bf16x8 a = *(const LAS bf16x8*)(PL + r32 * 512 + gi * 128 + ks * 16 + hi * 8);
                        acc = __builtin_amdgcn_mfma_f32_32x32x16_bf16(a, wfr[ntile][ks], acc, 0, 0, 0); }
                    const float psc = pscv[ntile];
#pragma unroll
                    for (int r = 0; r < 16; ++r) { const int tk = crow(r, hi); if (tk < TS) Y[(size_t)(tb + t0 + tk) * D + 512 + gi * 128 + n0 + r32] = f2bf(acc[r] * psc); } }
            }
        }
    }
#undef CP_UNIT
#undef CPA_LOAD
#undef CPB_LOAD
    __syncthreads();
}

__device__ __forceinline__ void router_phase(Frame& F, CArgsRef A, int layer) {
    const int tid = F.tid, lane = F.lane, wave = F.wave, r32 = lane & 31, hi = lane >> 5;
    LAS float* T = (LAS float*)F.lds;
    LAS float* LOG = (LAS float*)(F.lds + 133120);
    LAS float* BIA = (LAS float*)(F.lds + 133120 + 4224);
    const float rbias = A.in[26][tid & 31];
    LAS float* VA = (LAS float*)(F.lds + 141568);
    LAS float* VB = VA + 1024;
    const float* g = A.in[6] + (size_t)(layer * 2 + 1) * D;
    const float* MODL = WSP(float, WS_MOD) + (size_t)layer * 9 * (NMOD * D);
    bf16_t* H = WSP(bf16_t, WS_H);
    unsigned* CNT = F.ctl + CW_CNT + layer * 64; int* LIST = WSP(int, WS_LIST); f32x2* TW = WSP(f32x2, WS_TW);
    float rwreg[64];
#pragma unroll
    for (int s = 0; s < 64; ++s) rwreg[s] = A.in[25][(size_t)(128 * wave + 2 * s + hi) * NEXP + r32];
    __builtin_amdgcn_sched_barrier(0);
    const int ngroups = layer == 0 ? NTOK / 32 : NLAT / 32;
#define RT_TA0(grp_) (layer == 0 ? (grp_) * 32 : ((grp_) >> 7) * TPB + CTXL + ((grp_) & 127) * 32)
#define RT_LOAD(grp_) do { const int ta0_ = RT_TA0(grp_); \
        _Pragma("unroll") for (int q = 0; q < 4; ++q) { const f32x4* xr = (const f32x4*)xl_row(F, ta0_ + 4 * wave + q) + lane; _Pragma("unroll") for (int c = 0; c < 4; ++c) v[q][c] = xr[64 * c]; } \
        const int b0 = ta0_ / TPB, j0 = ta0_ - b0 * TPB, mrow = j0 < CTXL ? 8 : b0; const float* sh = MODL + (size_t)mrow * (NMOD * D) + 3 * D; const float* sc = sh + D; \
        g2 = *(const f32x2*)(g + 2 * tid); s2 = *(const f32x2*)(sc + 2 * tid); h2 = *(const f32x2*)(sh + 2 * tid); } while (0)
    f32x4 v[4][4]; f32x2 g2, s2, h2;
    if (F.bid < ngroups) RT_LOAD(F.bid);
    for (int grp = F.bid; grp < ngroups; grp += F.G) {
        const int ta0 = RT_TA0(grp);
        __syncthreads();
        {
            *(LAS f32x2*)(VA + 2 * tid) = g2 * (s2 + 1.f); *(LAS f32x2*)(VB + 2 * tid) = h2;
            float rr[4];
#pragma unroll
            for (int q = 0; q < 4; ++q) { float s = 0.f;
#pragma unroll
                for (int c = 0; c < 4; ++c) s += (v[q][c].x * v[q][c].x + v[q][c].y * v[q][c].y) + (v[q][c].z * v[q][c].z + v[q][c].w * v[q][c].w);
                rr[q] = 1.f / sqrtf(wave_sum(s) * (1.f / D) + EPS); }
            __syncthreads();
#pragma unroll
            for (int q = 0; q < 4; ++q) { const int ti = 4 * wave + q, ta = ta0 + ti;
                u32x2* o8 = (u32x2*)(H + (size_t)ta * D) + lane;
#pragma unroll
                for (int c = 0; c < 4; ++c) { const int col = 4 * lane + 256 * c;
                    const f32x4 a4 = *(const LAS f32x4*)(VA + col), b4 = *(const LAS f32x4*)(VB + col);
                    const f32x4 y = (v[q][c] * rr[q]) * a4 + b4;
                    u32x2 w; w.x = cvt_pk_bf16(y.x, y.y); w.y = cvt_pk_bf16(y.z, y.w); o8[64 * c] = w;
                    LAS float* tp = T + ti * 1025 + col; tp[0] = y.x; tp[1] = y.y; tp[2] = y.z; tp[3] = y.w; } }
            __builtin_amdgcn_sched_barrier(0);
            if (grp + F.G < ngroups) RT_LOAD(grp + F.G);
            __builtin_amdgcn_sched_barrier(0);
        }
        __syncthreads();
        f32x16 acc = {};
#pragma unroll
        for (int s = 0; s < 64; ++s) { const float a = T[r32 * 1025 + 128 * wave + 2 * s + hi]; acc = __builtin_amdgcn_mfma_f32_32x32x2f32(a, rwreg[s], acc, 0, 0, 0); }
        __syncthreads();
        { LAS float* RED = T + wave * (32 * 33);
#pragma unroll
          for (int r = 0; r < 16; ++r) RED[crow(r, hi) * 33 + r32] = acc[r]; }
        __syncthreads();
        for (int e = tid; e < 1024; e += 512) { const int tk = e >> 5, ex = e & 31; float s = 0.f;
#pragma unroll
            for (int w = 0; w < 8; ++w) s += T[w * (32 * 33) + tk * 33 + ex];
            const float sg = __builtin_amdgcn_rcpf(1.f + __expf(-s));
            LOG[tk * 33 + ex] = sg; BIA[tk * 33 + ex] = sg + rbias; }
        __syncthreads();
        if (tid < 32) { const int ta = ta0 + tid;
            float bestg = -1e30f, bs1 = 0.f, bs2 = 0.f; int bi1 = 0, bi2 = 1, bgrp = 0;
#pragma unroll
            for (int gq = 0; gq < 8; ++gq) { float sc[4], bb[4];
#pragma unroll
                for (int q = 0; q < 4; ++q) { sc[q] = LOG[tid * 33 + gq * 4 + q]; bb[q] = BIA[tid * 33 + gq * 4 + q]; }
                int i1 = 0; float m1 = bb[0];
#pragma unroll
                for (int q = 1; q < 4; ++q) if (bb[q] > m1) { m1 = bb[q]; i1 = q; }
                int i2 = -1; float m2 = -1e30f;
#pragma unroll
                for (int q = 0; q < 4; ++q) if (q != i1 && bb[q] > m2) { m2 = bb[q]; i2 = q; }
                const float gs = m1 + m2;
                float s1 = sc[0], s2 = sc[0];
#pragma unroll
                for (int q = 1; q < 4; ++q) { s1 = (i1 == q) ? sc[q] : s1; s2 = (i2 == q) ? sc[q] : s2; }
                if (gs > bestg) { bestg = gs; bgrp = gq; bi1 = i1; bi2 = i2; bs1 = s1; bs2 = s2; } }
            const float inv = 1.f / (bs1 + bs2); const float w1 = bs1 * inv, w2 = bs2 * inv;
            const int lo = bi1 < bi2 ? bi1 : bi2, hh = bi1 < bi2 ? bi2 : bi1;
            const float wlo = bi1 < bi2 ? w1 : w2, whi = bi1 < bi2 ? w2 : w1;
            const int pair = (lo == 0) ? (hh - 1) : (lo == 1 ? (hh + 1) : 5);
            const int bucket = bgrp * 6 + pair;
            const unsigned pos = atomicAdd(&CNT[bucket], 1u);
            LIST[(size_t)bucket * LCAP + pos] = ta; TW[ta] = (f32x2){wlo, whi}; }
    }
    __syncthreads();
}

#undef RT_TA0
#undef RT_LOAD
struct MoeSched {
    static constexpr bool GATHER_ = true;
    int G, c, ntiles, layer, stage; const unsigned* cnt; const int* list; const char* A; const char* W; LAS int* pre;
};
template <bool G1> struct MoeSchedT {
    static constexpr bool GATHER = G1;
    MoeSched m;
    __device__ __forceinline__ bool next(int i, pg8::Unit& u) const {
        const int L = i * m.G + m.c; if (L >= m.ntiles * 4) return false;
        const int tile = L >> 2, pn = L & 3;
        int bk = 0;
        for (int q = 1; q < NBUCK; ++q) bk = (m.pre[q] <= tile) ? q : bk;
        const int tin = tile - m.pre[bk], cntb = (int)m.cnt[bk];
        const int grp = bk / 6, pair = bk % 6;
        const int lo = pair < 3 ? 0 : (pair < 5 ? 1 : 2), hh = pair < 3 ? pair + 1 : (pair < 5 ? pair - 1 : 3);
        const int e1 = grp * 4 + lo, e2 = grp * 4 + hh;
        u.pm = tile; u.po = tile; u.pn = pn; u.rows = m.list + (size_t)bk * LCAP + tin * 256; u.nvalid = (cntb - tin * 256) < 256 ? (cntb - tin * 256) : 256; u.aux = pn >> 1;
        if (G1) {
            const int e = (pn < 2) ? e1 : e2;
            u.A = m.A; u.B = m.W + ((size_t)(m.layer * NEXP + e) * 512 + (pn & 1) * 256) * 1024 * 2; u.B2 = u.B;
        } else {
            u.A = m.A + (size_t)tile * 256 * 512 * 2;
            u.B = m.W + ((size_t)(m.layer * NEXP + e1) * 1024 + pn * 256) * 256 * 2;
            u.B2 = m.W + ((size_t)(m.layer * NEXP + e2) * 1024 + pn * 256) * 256 * 2 - (size_t)4 * 128;
        }
        return true;
    }
};
struct EpiMoe1 {
    bf16_t* HE; const f32x2* TW;
    __device__ __forceinline__ void operator()(const f32x4 (&acc)[2][2][4][2], const pg8::Unit& u, int wr, int wc, int fr, int fq) const {
        const int slot = u.aux;
        int tok[8]; f32x2 tw[8];
#pragma unroll
        for (int q = 0; q < 8; ++q) { const int r = (q >> 2) * 128 + wr * 64 + (q & 3) * 16 + fr; tok[q] = u.rows[r < u.nvalid ? r : 0]; }
        __builtin_amdgcn_sched_barrier(0);
#pragma unroll
        for (int q = 0; q < 8; ++q) tw[q] = TW[tok[q]];
        __builtin_amdgcn_sched_barrier(0);
#pragma unroll
        for (int ai = 0; ai < 2; ++ai)
#pragma unroll
            for (int m = 0; m < 4; ++m) { const int r = ai * 128 + wr * 64 + m * 16 + fr; const float w = slot ? tw[ai * 4 + m].y : tw[ai * 4 + m].x;
                float o[8];
#pragma unroll
                for (int n = 0; n < 2; ++n)
#pragma unroll
                    for (int q = 0; q < 4; ++q) { const float gt = acc[ai][0][m][n][q], up = acc[ai][1][m][n][q]; o[4 * n + q] = gt * __builtin_amdgcn_rcpf(1.f + __expf(-gt)) * up * w; }
                u32x4 wv; wv.x = cvt_pk_bf16(o[0], o[1]); wv.y = cvt_pk_bf16(o[2], o[3]); wv.z = cvt_pk_bf16(o[4], o[5]); wv.w = cvt_pk_bf16(o[6], o[7]);
                *(u32x4*)(HE + (size_t)(u.po * 256 + r) * 512 + slot * 256 + (u.pn & 1) * 128 + wc * 32 + 8 * fq) = wv; }
    }
};
struct EpiMoe2 {
    float* out; float* xc; const float* modl;
    __device__ __forceinline__ void operator()(const f32x4 (&acc)[2][2][4][2], const pg8::Unit& u, int wr, int wc, int fr, int fq) const {
        const int col0 = u.pn * 256 + wc * 32 + 8 * fq;
        int tok[8];
#pragma unroll
        for (int q = 0; q < 8; ++q) { const int r = (q >> 2) * 128 + wr * 64 + (q & 3) * 16 + fr; tok[q] = u.rows[r < u.nvalid ? r : 0]; }
        __builtin_amdgcn_sched_barrier(0);
#pragma unroll
        for (int ai = 0; ai < 2; ++ai)
#pragma unroll
        for (int mp = 0; mp < 2; ++mp) {
            f32x4 sv[2][2][2]; float* dp[2]; const float* gp[2];
#pragma unroll
            for (int mm = 0; mm < 2; ++mm) { const int m = mp * 2 + mm; const int tk = tok[ai * 4 + m]; const int b = tk / TPB, j = tk - b * TPB; const int mrow = j < CTXL ? 8 : b;
                gp[mm] = modl + (size_t)mrow * (NMOD * D) + 5 * D + col0;
                dp[mm] = (j < CTXL ? xc + (size_t)(b * CTXL + j) * D : out + ((size_t)b * SEQ + (j - CTXL)) * D) + col0;
#pragma unroll
                for (int bj = 0; bj < 2; ++bj)
#pragma unroll
                    for (int n = 0; n < 2; ++n) sv[mm][bj][n] = *(const f32x4*)(dp[mm] + bj * 128 + 4 * n); }
            __builtin_amdgcn_sched_barrier(0);
#pragma unroll
            for (int mm = 0; mm < 2; ++mm) { const int m = mp * 2 + mm; const int r = ai * 128 + wr * 64 + m * 16 + fr;
                if (r < u.nvalid) {
#pragma unroll
                    for (int bj = 0; bj < 2; ++bj)
#pragma unroll
                        for (int n = 0; n < 2; ++n) { const f32x4 gvv = *(const f32x4*)(gp[mm] + bj * 128 + 4 * n); *(f32x4*)(dp[mm] + bj * 128 + 4 * n) = sv[mm][bj][n] + gvv * acc[ai][bj][m][n]; } } }
            __builtin_amdgcn_sched_barrier(0);
        }
    }
};
__device__ __forceinline__ int moe_prefix(Frame& F, int layer, LAS int* pre) {
    __syncthreads();
    if (F.tid == 0) { int s = 0; const unsigned* cnt = F.ctl + CW_CNT + layer * 64; for (int q = 0; q < NBUCK; ++q) { pre[q] = s; s += ((int)cnt[q] + 255) >> 8; } pre[NBUCK] = s; }
    __syncthreads();
    return pre[NBUCK];
}

__device__ __forceinline__ void p9_phase(Frame& F, CArgsRef A) {
    const int gw = F.bid * 8 + F.wave, NGW = F.G * 8, l = F.lane;
    bf16_t* P = WSP(bf16_t, WS_BIG); const float* COS = WSP(float, WS_COS); const float* SIN = WSP(float, WS_SIN);
    const int kind = l < 8 ? 0 : l < 24 ? 1 : l < 28 ? 2 : l < 30 ? 5 : l < 46 ? 3 : 5;
    float gg[32];
    {
        const float* gp = nullptr;
        if (kind == 0) gp = A.in[16] + 32 * l; else if (kind == 1) gp = A.in[21] + 0 * 64 + (l & 1) * 32; else if (kind == 2) gp = A.in[18] + 32 * (l - 24); else if (kind == 3) gp = A.in[21] + 1 * 64 + (l & 1) * 32;
#pragma unroll
        for (int j = 0; j < 32; ++j) gg[j] = gp ? gp[j] : 1.f;
        __builtin_amdgcn_sched_barrier(0);
    }
    for (int tb0 = gw; tb0 < NTOK; tb0 += 2 * NGW) {
        const int tb1 = tb0 + NGW; const bool has1 = tb1 < NTOK;
        u32x4 wq[2][4]; f32x4 csv[2][8], snv[2][8];
#pragma unroll
        for (int e = 0; e < 2; ++e) { const int ta = e ? (has1 ? tb1 : tb0) : tb0; const bf16_t* rp = P + (size_t)ta * PW + 32 * l;
            const int b_ = ta / TPB, jj_ = ta - b_ * TPB; const int pos_ = jj_ >= CTXL ? jj_ - CTXL : 0;
            const f32x4* cp = (const f32x4*)(COS + (size_t)pos_ * 32); const f32x4* sp = (const f32x4*)(SIN + (size_t)pos_ * 32);
#pragma unroll
            for (int q = 0; q < 4; ++q) wq[e][q] = *(const u32x4*)(rp + 8 * q);
#pragma unroll
            for (int q = 0; q < 8; ++q) { csv[e][q] = cp[q]; snv[e][q] = sp[q]; } }
        __builtin_amdgcn_sched_barrier(0);
#pragma unroll
        for (int e = 0; e < 2; ++e) {
            const int ta = e ? tb1 : tb0; if (e && !has1) break;
            const int b = ta / TPB, jj = ta - b * TPB; const bool lat = jj >= CTXL; const int pos = jj - CTXL;
            bf16_t* rowp = P + (size_t)ta * PW + 32 * l;
            float v[32]; float ss = 0.f;
#pragma unroll
            for (int q = 0; q < 4; ++q)
#pragma unroll
                for (int c = 0; c < 4; ++c) { v[8 * q + 2 * c] = bflo(wq[e][q][c]); v[8 * q + 2 * c + 1] = bfhi(wq[e][q][c]); }
#pragma unroll
            for (int j = 0; j < 32; ++j) ss += v[j] * v[j];
            const float s1 = ss + __shfl_xor(ss, 1), s2 = s1 + __shfl_xor(s1, 2), s4 = s2 + __shfl_xor(s2, 4);
            const float tot = kind == 0 ? s4 : kind == 2 ? s2 : s1;
            const float nn = kind == 0 ? 256.f : kind == 2 ? 128.f : 64.f;
            const float r = 1.f / sqrtf(tot / nn + EPS);
            const bool act = (kind == 0 && lat) || (kind == 1 && lat) || kind == 2 || kind == 3;
#pragma unroll
            for (int j = 0; j < 32; ++j) v[j] = v[j] * r * gg[j];
            const bool rope = (kind == 1 || kind == 3) && lat;
            {
#pragma unroll
                for (int j4 = 0; j4 < 8; ++j4) { const f32x4 cs4 = csv[e][j4], sn4 = snv[e][j4];
#pragma unroll
                    for (int c = 0; c < 4; ++c) { const int j = 4 * j4 + c; const float other = __shfl_xor(v[j], 1); const float cs = cs4[c], sn = sn4[c];
                        const float rv = (l & 1) ? (v[j] * cs + other * sn) : (v[j] * cs - other * sn);
                        v[j] = rope ? rv : v[j]; } }
            }
            if (act) {
#pragma unroll
                for (int q = 0; q < 4; ++q) { u32x4 o; o.x = cvt_pk_bf16(v[8 * q], v[8 * q + 1]); o.y = cvt_pk_bf16(v[8 * q + 2], v[8 * q + 3]); o.z = cvt_pk_bf16(v[8 * q + 4], v[8 * q + 5]); o.w = cvt_pk_bf16(v[8 * q + 6], v[8 * q + 7]);
                    *(u32x4*)(rowp + 8 * q) = o; }
            }
        }
    }
}

__device__ __forceinline__ void p11_phase(Frame& F, CArgsRef A) {
    const int gw = F.bid * 8 + F.wave, NGW = F.G * 8, l = F.lane, h = l >> 4, j = l & 15;
    const bf16_t* __restrict__ P = WSP(bf16_t, WS_BIG); bf16_t* __restrict__ QM = WSP(bf16_t, WS_QM); bf16_t* __restrict__ KM = WSP(bf16_t, WS_KM); const bf16_t* __restrict__ KV = WSP(bf16_t, WS_H);
    const float* __restrict__ COS = WSP(float, WS_COS); const float* __restrict__ SIN = WSP(float, WS_SIN);
#define P11_BODY(wa, wb, DST, GP, DOROPE, CSV, SNV) do { \
        float v[12]; \
        _Pragma("unroll") for (int c = 0; c < 4; ++c) { v[2 * c] = bflo(wa[c]); v[2 * c + 1] = bfhi(wa[c]); } \
        v[8] = bflo(wb.x); v[9] = bfhi(wb.x); v[10] = bflo(wb.y); v[11] = bfhi(wb.y); \
        float ss = 0.f; \
        _Pragma("unroll") for (int c = 0; c < 12; ++c) ss += v[c] * v[c]; \
        ss += __shfl_xor(ss, 1); ss += __shfl_xor(ss, 2); ss += __shfl_xor(ss, 4); ss += __shfl_xor(ss, 8); \
        const float r = 1.f / sqrtf(ss * (1.f / 192.f) + EPS); \
        const f32x4 ga = GP##a, gb = GP##b, gc = GP##c; \
        v[0] *= r * ga.x; v[1] *= r * ga.y; v[2] *= r * ga.z; v[3] *= r * ga.w; v[4] *= r * gb.x; v[5] *= r * gb.y; v[6] *= r * gb.z; v[7] *= r * gb.w; \
        v[8] *= r * gc.x; v[9] *= r * gc.y; v[10] *= r * gc.z; v[11] *= r * gc.w; \
        const f32x4 cs = CSV, sn = SNV; \
        _Pragma("unroll") for (int c = 0; c < 4; ++c) { const float other = __shfl_xor(v[8 + c], 8); const float rv = (j < 8) ? (v[8 + c] * cs[c] - other * sn[c]) : (v[8 + c] * cs[c] + other * sn[c]); v[8 + c] = (DOROPE) ? rv : v[8 + c]; } \
        u32x4 oa; oa.x = cvt_pk_bf16(v[0], v[1]); oa.y = cvt_pk_bf16(v[2], v[3]); oa.z = cvt_pk_bf16(v[4], v[5]); oa.w = cvt_pk_bf16(v[6], v[7]); \
        u32x2 ob; ob.x = cvt_pk_bf16(v[8], v[9]); ob.y = cvt_pk_bf16(v[10], v[11]); \
        *(u32x4*)((DST) + 8 * j) = oa; *(u32x2*)((DST) + 128 + 4 * j) = ob; } while (0)
    const f32x4 gqa = *(const f32x4*)(A.in[20] + 8 * j), gqb = *(const f32x4*)(A.in[20] + 8 * j + 4), gqc = *(const f32x4*)(A.in[20] + 128 + 4 * j);
    const f32x4 gka = *(const f32x4*)(A.in[20] + 192 + 8 * j), gkb = *(const f32x4*)(A.in[20] + 192 + 8 * j + 4), gkc = *(const f32x4*)(A.in[20] + 192 + 128 + 4 * j);
    constexpr int NB4 = 4;
    for (int t0 = gw; t0 < NLAT; t0 += NB4 * NGW) {
        u32x4 wa[NB4]; u32x2 wb[NB4]; f32x4 cv[NB4], sv[NB4];
#pragma unroll
        for (int e = 0; e < NB4; ++e) { const int tl = (t0 + e * NGW) < NLAT ? (t0 + e * NGW) : t0; const bf16_t* q = QM + (size_t)tl * 768 + h * 192; wa[e] = *(const u32x4*)(q + 8 * j); wb[e] = *(const u32x2*)(q + 128 + 4 * j);
            const int pos = tl & (SEQ - 1); cv[e] = *(const f32x4*)(COS + (size_t)pos * 32 + 4 * (j & 7)); sv[e] = *(const f32x4*)(SIN + (size_t)pos * 32 + 4 * (j & 7)); }
        __builtin_amdgcn_sched_barrier(0);
#pragma unroll
        for (int e = 0; e < NB4; ++e) { const int tl = t0 + e * NGW; if (tl < NLAT) { bf16_t* q = QM + (size_t)tl * 768 + h * 192;
            P11_BODY(wa[e], wb[e], q, gq, true, cv[e], sv[e]); } }
    }
    for (int t0 = gw; t0 < NTOK; t0 += NB4 * NGW) {
        u32x4 wa[NB4]; u32x2 wb[NB4]; f32x4 cv[NB4], sv[NB4];
#pragma unroll
        for (int e = 0; e < NB4; ++e) { const int ta = (t0 + e * NGW) < NTOK ? (t0 + e * NGW) : t0; wa[e] = *(const u32x4*)(KV + (size_t)ta * 1024 + h * 256 + 8 * j); wb[e] = *(const u32x2*)(P + (size_t)ta * PW + PC_KROPE + 4 * j);
            const int b_ = ta / TPB, jj_ = ta - b_ * TPB; const int pos = jj_ >= CTXL ? jj_ - CTXL : 0; cv[e] = *(const f32x4*)(COS + (size_t)pos * 32 + 4 * (j & 7)); sv[e] = *(const f32x4*)(SIN + (size_t)pos * 32 + 4 * (j & 7)); }
        __builtin_amdgcn_sched_barrier(0);
#pragma unroll
        for (int e = 0; e < NB4; ++e) { const int ta = t0 + e * NGW; if (ta < NTOK) { const int b = ta / TPB, jj = ta - b * TPB; const bool lat = jj >= CTXL;
            bf16_t* k = KM + ((size_t)(b * 4 + h) * TPB + jj) * 192;
            P11_BODY(wa[e], wb[e], k, gk, lat, cv[e], sv[e]); } }
    }
#undef P11_BODY
}

#define SBAR() __builtin_amdgcn_sched_barrier(0)
__device__ __forceinline__ void partialSM(f32x16& p0, f32x16& p1, float& m_reg, float& mn, float& alpha, const float C, const float thr) {
    float pmax = p0[0];
#pragma unroll
    for (int r = 1; r < 16; ++r) pmax = fmaxf(pmax, p0[r]);
#pragma unroll
    for (int r = 0; r < 16; ++r) pmax = fmaxf(pmax, p1[r]);
    { auto rr = __builtin_amdgcn_permlane32_swap(__float_as_uint(pmax), __float_as_uint(pmax), false, false);
      pmax = fmaxf(__uint_as_float(rr[0]), __uint_as_float(rr[1])); }
    if (__builtin_expect(__all(pmax - m_reg <= thr), 1)) { mn = m_reg; alpha = 1.f; }
    else { mn = fmaxf(m_reg, pmax); alpha = __builtin_amdgcn_exp2f((m_reg - mn) * C); m_reg = mn; }
    const float mnC = -mn * C;
#pragma unroll
    for (int r = 0; r < 16; ++r) p0[r] = fmaf(p0[r], C, mnC);
#pragma unroll
    for (int r = 0; r < 16; ++r) p1[r] = fmaf(p1[r], C, mnC);
#pragma unroll
    for (int r = 0; r < 16; ++r) p0[r] = __builtin_amdgcn_exp2f(p0[r]);
}
__device__ __forceinline__ void finishSM(f32x16& p0, f32x16& p1, float alpha, float& l_reg, bf16x8& pa0, bf16x8& pa1, bf16x8& pa2, bf16x8& pa3) {
#pragma unroll
    for (int r = 0; r < 16; ++r) p1[r] = __builtin_amdgcn_exp2f(p1[r]);
    float ps = 0;
#pragma unroll
    for (int r = 0; r < 16; ++r) ps += p0[r];
#pragma unroll
    for (int r = 0; r < 16; ++r) ps += p1[r];
    { auto rr = __builtin_amdgcn_permlane32_swap(__float_as_uint(ps), __float_as_uint(ps), false, false);
      ps = __uint_as_float(rr[0]) + __uint_as_float(rr[1]); }
    l_reg = l_reg * alpha + ps;
#define PK4(P, BASE, OUT) do { unsigned a0 = cvt_pk_bf16(P[BASE + 0], P[BASE + 1]), a1 = cvt_pk_bf16(P[BASE + 2], P[BASE + 3]);   \
    unsigned b0 = cvt_pk_bf16(P[BASE + 4], P[BASE + 5]), b1 = cvt_pk_bf16(P[BASE + 6], P[BASE + 7]);                              \
    auto r0 = __builtin_amdgcn_permlane32_swap(a0, b0, false, false); auto r1 = __builtin_amdgcn_permlane32_swap(a1, b1, false, false); \
    u32x4 w = {r0[0], r1[0], r0[1], r1[1]}; OUT = *reinterpret_cast<bf16x8*>(&w); } while (0)
    PK4(p0, 0, pa0); PK4(p0, 8, pa1); PK4(p1, 0, pa2); PK4(p1, 8, pa3);
#undef PK4
}
__device__ __forceinline__ void partialSM_fs(f32x16& p0, f32x16& p1, const float C, const float nBC) {
#pragma unroll
    for (int r = 0; r < 16; ++r) p0[r] = fmaf(p0[r], C, nBC);
#pragma unroll
    for (int r = 0; r < 16; ++r) p1[r] = fmaf(p1[r], C, nBC);
#pragma unroll
    for (int r = 0; r < 16; ++r) p0[r] = __builtin_amdgcn_exp2f(p0[r]);
}
__device__ __forceinline__ void finishSM_fs(f32x16& p0, f32x16& p1, float& l_reg, bf16x8& pa0, bf16x8& pa1, bf16x8& pa2, bf16x8& pa3) {
#pragma unroll
    for (int r = 0; r < 16; ++r) p1[r] = __builtin_amdgcn_exp2f(p1[r]);
    float ps = 0;
#pragma unroll
    for (int r = 0; r < 16; ++r) ps += p0[r];
#pragma unroll
    for (int r = 0; r < 16; ++r) ps += p1[r];
    l_reg += ps;
#define PK4(P, BASE, OUT) do { unsigned a0 = cvt_pk_bf16(P[BASE + 0], P[BASE + 1]), a1 = cvt_pk_bf16(P[BASE + 2], P[BASE + 3]);   \
    unsigned b0 = cvt_pk_bf16(P[BASE + 4], P[BASE + 5]), b1 = cvt_pk_bf16(P[BASE + 6], P[BASE + 7]);                              \
    auto r0 = __builtin_amdgcn_permlane32_swap(a0, b0, false, false); auto r1 = __builtin_amdgcn_permlane32_swap(a1, b1, false, false); \
    u32x4 w = {r0[0], r1[0], r0[1], r1[1]}; OUT = *reinterpret_cast<bf16x8*>(&w); } while (0)
    PK4(p0, 0, pa0); PK4(p0, 8, pa1); PK4(p1, 0, pa2); PK4(p1, 8, pa3);
#undef PK4
}
__device__ __forceinline__ int v_st(int k, int c) { const int kk = (k & ~0xC) | ((k & 4) << 1) | ((k & 8) >> 1); return ((kk >> 3) * 4 + (c >> 5)) * 512 + ((kk & 7) * 32 + (c & 31)) * 2; }
__device__ __forceinline__ int v_rd_base(int lane) { return ((lane & 3) << 3) | (((lane >> 2) & 3) << 6) | (((lane >> 4) & 1) << 5) | (((lane >> 5) & 1) << 8); }
constexpr int v_rd_off(int d0, int ks, int half) { return d0 * 512 + ks * 4096 + half * 2048; }
template <int OFF> __device__ __forceinline__ s16x4 tr_read(int vb) {
    s16x4 r; asm volatile("ds_read_b64_tr_b16 %0, %1 offset:%2" : "=&v"(r) : "v"(vb), "i"(OFF) : "memory"); return r;
}
template <int D0> __device__ __forceinline__ void pv_one(f32x16& od, int vb, bf16x8 pa0, bf16x8 pa1, bf16x8 pa2, bf16x8 pa3) {
    const s16x4 l0 = tr_read<v_rd_off(D0, 0, 0)>(vb), h0 = tr_read<v_rd_off(D0, 0, 1)>(vb), l1 = tr_read<v_rd_off(D0, 1, 0)>(vb), h1 = tr_read<v_rd_off(D0, 1, 1)>(vb);
    const s16x4 l2 = tr_read<v_rd_off(D0, 2, 0)>(vb), h2 = tr_read<v_rd_off(D0, 2, 1)>(vb), l3 = tr_read<v_rd_off(D0, 3, 0)>(vb), h3 = tr_read<v_rd_off(D0, 3, 1)>(vb);
    asm volatile("s_waitcnt lgkmcnt(0)" ::: "memory"); SBAR();
#define PK(L, H) (bf16x8){L[0], L[1], L[2], L[3], H[0], H[1], H[2], H[3]}
    od = __builtin_amdgcn_mfma_f32_32x32x16_bf16(pa0, PK(l0, h0), od, 0, 0, 0);
    od = __builtin_amdgcn_mfma_f32_32x32x16_bf16(pa1, PK(l1, h1), od, 0, 0, 0);
    od = __builtin_amdgcn_mfma_f32_32x32x16_bf16(pa2, PK(l2, h2), od, 0, 0, 0);
    od = __builtin_amdgcn_mfma_f32_32x32x16_bf16(pa3, PK(l3, h3), od, 0, 0, 0);
#undef PK
}
__device__ __forceinline__ void pv_d0(f32x16* o, int vb, bf16x8 pa0, bf16x8 pa1, bf16x8 pa2, bf16x8 pa3) {
    pv_one<0>(o[0], vb, pa0, pa1, pa2, pa3); pv_one<1>(o[1], vb, pa0, pa1, pa2, pa3); pv_one<2>(o[2], vb, pa0, pa1, pa2, pa3); pv_one<3>(o[3], vb, pa0, pa1, pa2, pa3);
}

#define PV_READS(D0, L0, H0, L1, H1, L2, H2, L3, H3) do { L0 = tr_read<v_rd_off(D0, 0, 0)>(vb); H0 = tr_read<v_rd_off(D0, 0, 1)>(vb); L1 = tr_read<v_rd_off(D0, 1, 0)>(vb); H1 = tr_read<v_rd_off(D0, 1, 1)>(vb); \
    L2 = tr_read<v_rd_off(D0, 2, 0)>(vb); H2 = tr_read<v_rd_off(D0, 2, 1)>(vb); L3 = tr_read<v_rd_off(D0, 3, 0)>(vb); H3 = tr_read<v_rd_off(D0, 3, 1)>(vb); } while (0)
#define PV_PK(L, H) (bf16x8){L[0], L[1], L[2], L[3], H[0], H[1], H[2], H[3]}
#define PV_MMA(OD, L0, H0, L1, H1, L2, H2, L3, H3) do { OD = __builtin_amdgcn_mfma_f32_32x32x16_bf16(pa0, PV_PK(L0, H0), OD, 0, 0, 0); OD = __builtin_amdgcn_mfma_f32_32x32x16_bf16(pa1, PV_PK(L1, H1), OD, 0, 0, 0); \
    OD = __builtin_amdgcn_mfma_f32_32x32x16_bf16(pa2, PV_PK(L2, H2), OD, 0, 0, 0); OD = __builtin_amdgcn_mfma_f32_32x32x16_bf16(pa3, PV_PK(L3, H3), OD, 0, 0, 0); } while (0)
__device__ __forceinline__ void pv_d0_pipe(f32x16* o, int vb, bf16x8 pa0, bf16x8 pa1, bf16x8 pa2, bf16x8 pa3) {
    s16x4 a0, a1, a2, a3, a4, a5, a6, a7, b0, b1, b2, b3, b4, b5, b6, b7;
    PV_READS(0, a0, a1, a2, a3, a4, a5, a6, a7);
    PV_READS(1, b0, b1, b2, b3, b4, b5, b6, b7);
    asm volatile("s_waitcnt lgkmcnt(8)" ::: "memory"); SBAR();
    PV_MMA(o[0], a0, a1, a2, a3, a4, a5, a6, a7); SBAR();
    PV_READS(2, a0, a1, a2, a3, a4, a5, a6, a7);
    asm volatile("s_waitcnt lgkmcnt(8)" ::: "memory"); SBAR();
    PV_MMA(o[1], b0, b1, b2, b3, b4, b5, b6, b7); SBAR();
    PV_READS(3, b0, b1, b2, b3, b4, b5, b6, b7);
    asm volatile("s_waitcnt lgkmcnt(8)" ::: "memory"); SBAR();
    PV_MMA(o[2], a0, a1, a2, a3, a4, a5, a6, a7); SBAR();
    asm volatile("s_waitcnt lgkmcnt(0)" ::: "memory"); SBAR();
    PV_MMA(o[3], b0, b1, b2, b3, b4, b5, b6, b7);
}

template <int DK, int LDQ, int LDK, int LDV, int SDEPTH, int NQL, bool FS, bool PVP, int ABL = 0>
__device__ __forceinline__ void attn_body(const int tid, const bf16_t* __restrict__ Qb, const bf16_t* __restrict__ Kh, const bf16_t* __restrict__ Vh, const int seq, char* lds,
                                          const float C, const float thr, f32x16 (&o)[4], float& l_out) {
    constexpr int RB = DK * 2, SHM_V = 64 * 256, SHM_K = 64 * RB, CPR = DK / 8, NKC = CPR / 8, ND0 = DK / 16, NQR = ND0 - NQL, QTB = NQL * 32;
#define KSWZ(row, colB) ((row) * RB + ((colB) ^ ((((row) >> 1) & 7) << 4)))
    const int wid = tid >> 6, lane = tid & 63, r32 = lane & 31, hi = lane >> 5;
    char* V_lds = lds; char* K_lds = lds + 2 * SHM_V;
    float* ws = (float*)(lds + 2 * SHM_V + 2 * SHM_K) + wid * 64; float* al_l = ws + 32;
    char* Qt = lds + 2 * SHM_V + 2 * SHM_K + 2048 + wid * (32 * (QTB > 0 ? QTB : 1));
    float m_reg = -1e30f, l_reg = 0;
#pragma unroll
    for (int d = 0; d < 4; ++d) o[d] = f32x16{};
    bf16x8 qr[NQR];
    const bf16_t* Qw = Qb + (size_t)(wid * 32 + r32) * LDQ + hi * 8;
#pragma unroll
    for (int d0 = 0; d0 < NQR; ++d0) qr[d0] = *(const bf16x8*)(Qw + d0 * 16);
    if constexpr (NQL > 0) {
        constexpr int CH = QTB / 16;
#pragma unroll
        for (int i = 0; i < (32 * CH) / 64; ++i) { const int c = lane + 64 * i, row = c / CH, cc = c % CH;
            const bf16x8 v = *(const bf16x8*)(Qb + (size_t)(wid * 32 + row) * LDQ + NQR * 16 + cc * 8);
            *(bf16x8*)(Qt + row * QTB + ((cc * 16) ^ (((row) & (CH - 1)) << 4))) = v; }
        asm volatile("s_waitcnt lgkmcnt(0)" ::: "memory");
    }
    const int sr = tid >> 4, sc = (tid & 15) * 8, vst0 = v_st(sr, sc), vst1 = v_st(32 + sr, sc);
    const int vb0 = (int)(uintptr_t)V_lds + v_rd_base(lane);
    int krow[NKC], kcc[NKC];
#pragma unroll
    for (int i = 0; i < NKC; ++i) { const int c = tid + 512 * i; krow[i] = c / CPR; kcc[i] = c % CPR; }
    struct { bf16x8 vs0, vs1, ks[NKC]; } sr_[SDEPTH];
    constexpr int SE = 0, SO = SDEPTH - 1;
#define SLOAD(i, k0) do { sr_[i].vs0 = *(const bf16x8*)(&Vh[(size_t)((k0) + sr) * LDV + sc]); sr_[i].vs1 = *(const bf16x8*)(&Vh[(size_t)((k0) + 32 + sr) * LDV + sc]); \
    _Pragma("unroll") for (int _q = 0; _q < NKC; ++_q) sr_[i].ks[_q] = *(const bf16x8*)(&Kh[(size_t)((k0) + krow[_q]) * LDK + kcc[_q] * 8]); } while (0)
#define SWRITE(b, i) do { *(bf16x8*)(V_lds + (b) * SHM_V + vst0) = sr_[i].vs0; *(bf16x8*)(V_lds + (b) * SHM_V + vst1) = sr_[i].vs1; \
    _Pragma("unroll") for (int _q = 0; _q < NKC; ++_q) *(bf16x8*)(K_lds + (b) * SHM_K + KSWZ(krow[_q], kcc[_q] * 16)) = sr_[i].ks[_q]; } while (0)
#define SWAIT() do { if constexpr (SDEPTH == 2) asm volatile("s_waitcnt vmcnt(%0)" :: "n"(2 + NKC) : "memory"); else asm volatile("s_waitcnt vmcnt(0)" ::: "memory"); } while (0)
#define RESC(a) do { if (__any((a) < 1.f)) { if (hi == 0) al_l[r32] = (a); asm volatile("s_waitcnt lgkmcnt(0)" ::: "memory"); \
    _Pragma("unroll") for (int d = 0; d < 4; ++d) _Pragma("unroll") for (int r = 0; r < 16; ++r) o[d][r] *= al_l[crow(r, hi)]; } } while (0)
#define QFRAG(d0) ((d0) < NQR ? qr[(d0) < NQR ? (d0) : 0] : *(const bf16x8*)(Qt + r32 * QTB + (((((d0) - NQR) * 2 + hi) * 16) ^ ((r32 & ((QTB / 16) - 1)) << 4))))
#define QKT(P0, P1, KB) do { P0 = f32x16{}; P1 = f32x16{}; if constexpr (ABL & 2) { asm volatile("" : "+v"(P0), "+v"(P1)); } else _Pragma("unroll") for (int d0 = 0; d0 < ND0; ++d0) { const int cb = (d0 * 16 + hi * 8) * 2; \
    const bf16x8 b0 = *(const bf16x8*)((KB) + KSWZ(r32, cb)); const bf16x8 b1 = *(const bf16x8*)((KB) + KSWZ(32 + r32, cb)); const bf16x8 qf = QFRAG(d0); \
    P0 = __builtin_amdgcn_mfma_f32_32x32x16_bf16(b0, qf, P0, 0, 0, 0); P1 = __builtin_amdgcn_mfma_f32_32x32x16_bf16(b1, qf, P1, 0, 0, 0); } } while (0)
    f32x16 pA0, pA1, pB0, pB1; float mnA, mnB, alA, alB; bf16x8 pa0, pa1, pa2, pa3; const int NT = seq / 64;
#define PVD(VB) do { if constexpr (!(ABL & 1)) { if constexpr (PVP) pv_d0_pipe(o, VB, pa0, pa1, pa2, pa3); else pv_d0(o, VB, pa0, pa1, pa2, pa3); } else { asm volatile("" : "+v"(pa0), "+v"(pa1), "+v"(pa2), "+v"(pa3)); } } while (0)
    const float nBC = -thr * C;
#define PSM(P0, P1, MN, AL) do { if constexpr (ABL & 4) { asm volatile("" : "+v"(P0), "+v"(P1)); } else if constexpr (FS) partialSM_fs(P0, P1, C, nBC); else partialSM(P0, P1, m_reg, MN, AL, C, thr); } while (0)
#define FSM(P0, P1, AL) do { if constexpr (ABL & 4) { asm volatile("" : "+v"(P0), "+v"(P1)); pa0 = (bf16x8){1,2,3,4,5,6,7,8}; pa1 = pa0; pa2 = pa0; pa3 = pa0; asm volatile("" : "+v"(pa0), "+v"(pa1), "+v"(pa2), "+v"(pa3)); } else if constexpr (FS) finishSM_fs(P0, P1, l_reg, pa0, pa1, pa2, pa3); else finishSM(P0, P1, AL, l_reg, pa0, pa1, pa2, pa3); } while (0)
#define RSC(a) do { if constexpr (!FS) { RESC(a); } } while (0)
#define ABAR() do { if constexpr (!(ABL & 16)) __syncthreads(); } while (0)
    SLOAD(SE, 0); asm volatile("s_waitcnt vmcnt(0)" ::: "memory"); SWRITE(0, SE); __syncthreads();
    QKT(pA0, pA1, K_lds); PSM(pA0, pA1, mnA, alA);
    SLOAD(SO, 64); if constexpr (SDEPTH == 2) { if (2 < NT) SLOAD(SE, 128); }
    SWAIT(); SWRITE(1, SO); __syncthreads();
    for (int j = 1; j + 1 < NT; j += 2) {
        if constexpr (SDEPTH == 1 && !(ABL & 8)) { SBAR(); SLOAD(SO, (j + SDEPTH) * 64); }
        SBAR(); QKT(pB0, pB1, K_lds + SHM_K);
        FSM(pA0, pA1, alA); SBAR();
        if constexpr (SDEPTH != 1 && !(ABL & 8)) SLOAD(SO, (j + SDEPTH) * 64); SBAR();
        PVD(vb0); PSM(pB0, pB1, mnB, alB);
        ABAR(); if constexpr (!(ABL & 8)) { SWAIT(); SWRITE(0, SE); }
        RSC(alB); ABAR();
        if constexpr (SDEPTH == 1 && !(ABL & 8)) { SBAR(); SLOAD(SE, (j + 1 + SDEPTH) * 64); }
        SBAR(); QKT(pA0, pA1, K_lds);
        FSM(pB0, pB1, alB); SBAR();
        if constexpr (SDEPTH != 1 && !(ABL & 8)) { if (j + 3 < NT) SLOAD(SE, (j + 1 + SDEPTH) * 64); } SBAR();
        PVD(vb0 + SHM_V); PSM(pA0, pA1, mnA, alA);
        ABAR(); if constexpr (!(ABL & 8)) { SWAIT(); SWRITE(1, SO); }
        RSC(alA); ABAR();
    }
    SBAR(); QKT(pB0, pB1, K_lds + SHM_K);
    FSM(pA0, pA1, alA); SBAR();
    PVD(vb0); PSM(pB0, pB1, mnB, alB);
    __syncthreads(); RSC(alB);
    FSM(pB0, pB1, alB); SBAR();
    PVD(vb0 + SHM_V);
    if constexpr (FS) { auto rr = __builtin_amdgcn_permlane32_swap(__float_as_uint(l_reg), __float_as_uint(l_reg), false, false); l_reg = __uint_as_float(rr[0]) + __uint_as_float(rr[1]); }
#undef PSM
#undef PVD
#undef FSM
#undef RSC
#undef ABAR
    l_out = l_reg;
#undef SLOAD
#undef SWRITE
#undef SWAIT
#undef RESC
#undef QKT
#undef QFRAG
#undef KSWZ
}

__device__ __forceinline__ void attn_phase(Frame& F, CArgsRef A, unsigned long long& pt1, unsigned long long& pt0) {
    char* lds = (char*)F.lds;
    const bf16_t* P = WSP(bf16_t, WS_BIG); const bf16_t* QM = WSP(bf16_t, WS_QM); const bf16_t* KM = WSP(bf16_t, WS_KM); const bf16_t* KV = WSP(bf16_t, WS_H);
    bf16_t* Y = WSP(bf16_t, WS_YMIX); float* ST = WSP(float, WS_STASH) + (size_t)F.bid * 256 * 128;
    float lam;
    { const int lane = F.lane; const float* dl = A.in[22]; const float a = dl[lane] * dl[64 + lane], b = dl[128 + lane] * dl[192 + lane]; lam = __expf(wave_sum(a)) - __expf(wave_sum(b)) + LAM_INIT; lam = __uint_as_float(__builtin_amdgcn_readfirstlane(__float_as_uint(lam))); }
    constexpr float LOG2E = 1.4426950408889634f;
#ifndef ATT_KINDS
#define ATT_KINDS 3
#endif
#ifndef ATT_PVP_MLA
#define ATT_PVP_MLA 0
#endif
#ifndef ATT_PVP_DIFF
#define ATT_PVP_DIFF 1
#endif
#ifndef ATT_FS
#define ATT_FS 1
#endif
    float bnd_mla, bnd_diff;
    { const int lane = F.lane; const float* gm = A.in[20]; const float* gd = A.in[21];
      float a = fmaxf(fmaxf(fabsf(gm[lane]), fabsf(gm[64 + lane])), fabsf(gm[128 + lane])), b = fmaxf(fmaxf(fabsf(gm[192 + lane]), fabsf(gm[256 + lane])), fabsf(gm[320 + lane]));
      float c = fabsf(gd[lane]), d = fabsf(gd[64 + lane]);
#pragma unroll
      for (int o = 1; o < 64; o <<= 1) { a = fmaxf(a, __shfl_xor(a, o)); b = fmaxf(b, __shfl_xor(b, o)); c = fmaxf(c, __shfl_xor(c, o)); d = fmaxf(d, __shfl_xor(d, o)); }
      bnd_mla = __uint_as_float(__builtin_amdgcn_readfirstlane(__float_as_uint(fminf(0.07216878364870322f * 192.f * a * b * 1.001f, 60.f))));
      bnd_diff = __uint_as_float(__builtin_amdgcn_readfirstlane(__float_as_uint(fminf(0.125f * 64.f * c * d * 1.001f, 60.f)))); }
#ifndef PROBE_ABL
#define PROBE_ABL 0
#endif
    if (PT_SUB == 7 || PT_SUB == 8) {
        int tid = threadIdx.x; asm volatile("" : "+v"(tid));
        const int wid = tid >> 6, lane = tid & 63, r32 = lane & 31, hi = lane >> 5;
        const int u = F.bid, bh = u >> 4, qb = u & 15, b = bh >> 2, h = bh & 3;
        f32x16 o[4]; float l_reg;
        __syncthreads();
        pt0 = __builtin_amdgcn_s_memrealtime();
        if (PT_SUB == 7) { const bf16_t* Pb = P + (size_t)(b * TPB) * PW;
            attn_body<64, PW, PW, PW, 1, 0, ATT_FS != 0, ATT_PVP_DIFF != 0, PROBE_ABL>(tid, Pb + (size_t)(CTXL + qb * 256) * PW + PC_QD + h * 128, Pb + PC_KD + h * 128, Pb + PC_VD + h * 128, TPB, lds, 0.125f * LOG2E, bnd_diff / 0.125f, o, l_reg); }
        else attn_body<192, 768, 192, 1024, 1, 8, ATT_FS != 0, ATT_PVP_MLA != 0, PROBE_ABL>(tid, QM + ((size_t)(b * SEQ + qb * 256)) * 768 + h * 192, KM + (size_t)(b * 4 + h) * TPB * 192, KV + (size_t)(b * TPB) * 1024 + h * 256 + 128, TPB, lds, 0.07216878364870322f * LOG2E, bnd_mla / 0.07216878364870322f, o, l_reg);
        pt1 = __builtin_amdgcn_s_memrealtime();
        float* Sw = ST + (size_t)(wid * 32) * 128;
#pragma unroll
        for (int r = 0; r < 16; ++r)
#pragma unroll
            for (int d0 = 0; d0 < 4; ++d0) Sw[(size_t)crow(r, hi) * 128 + d0 * 32 + r32] = o[d0][r] * l_reg;
        __syncthreads();
    }
    if (ATT_KINDS & 1)
    for (int u = F.bid, rnd = 0; u < 512; u += F.G, ++rnd) {
        int tid = threadIdx.x; asm volatile("" : "+v"(tid));
        const int wid = tid >> 6, lane = tid & 63, r32 = lane & 31, hi = lane >> 5;
        const int ux = (F.G == 256) ? ((((F.bid & 7) * 4 + rnd * 2 + ((F.bid >> 3) >> 4)) << 4) | ((F.bid >> 3) & 15)) : u;
        const int bh = ux >> 4, qb = ux & 15, b = bh >> 2, h = bh & 3;
        f32x16 o[4]; float l_reg;
        __syncthreads();
        attn_body<192, 768, 192, 1024, 1, 8, ATT_FS != 0, ATT_PVP_MLA != 0>(tid, QM + ((size_t)(b * SEQ + qb * 256)) * 768 + h * 192, KM + (size_t)(b * 4 + h) * TPB * 192, KV + (size_t)(b * TPB) * 1024 + h * 256 + 128,
                                       TPB, lds, 0.07216878364870322f * LOG2E, ATT_FS ? bnd_mla / 0.07216878364870322f : 8.f / 0.07216878364870322f, o, l_reg);
        float* li_l = (float*)(lds + 2 * 16384 + 2 * 64 * 384) + wid * 64;
        if (hi == 0) li_l[r32] = l_reg; LDS_WAIT();
        float rli[16];
#pragma unroll
        for (int r = 0; r < 16; ++r) rli[r] = __builtin_amdgcn_rcpf(li_l[crow(r, hi)]);
        bf16_t* Ow = Y + (size_t)(b * SEQ + qb * 256 + wid * 32) * D + h * 128;
#pragma unroll
        for (int r = 0; r < 16; ++r)
#pragma unroll
            for (int d0 = 0; d0 < 4; ++d0) Ow[(size_t)crow(r, hi) * D + d0 * 32 + r32] = f2bf(o[d0][r] * rli[r]);
    }
    if (PT_SUB == 3) pt1 = __builtin_amdgcn_s_memrealtime();
    if (ATT_KINDS & 2)
    for (int u = F.bid, rnd = 0; u < 512; u += F.G, ++rnd) {
        int tid = threadIdx.x; asm volatile("" : "+v"(tid));
        const int wid = tid >> 6, lane = tid & 63, r32 = lane & 31, hi = lane >> 5;
        const int ux = (F.G == 256) ? ((((F.bid & 7) * 4 + rnd * 2 + ((F.bid >> 3) >> 4)) << 4) | ((F.bid >> 3) & 15)) : u;
        const int bh = ux >> 4, qb = ux & 15, b = bh >> 2, h = bh & 3;
        const bf16_t* Pb = P + (size_t)(b * TPB) * PW;
        float* Sw = ST + (size_t)(wid * 32) * 128;
        float* li_l = (float*)(lds + 2 * 16384 + 2 * 64 * 128) + wid * 64;
        {
            f32x16 o[4]; float l_reg;
            __syncthreads();
            attn_body<64, PW, PW, PW, 1, 0, ATT_FS != 0, ATT_PVP_DIFF != 0>(tid, Pb + (size_t)(CTXL + qb * 256) * PW + PC_QD + h * 128, Pb + PC_KD + h * 128, Pb + PC_VD + h * 128, TPB, lds, 0.125f * LOG2E, ATT_FS ? bnd_diff / 0.125f : 8.f / 0.125f, o, l_reg);
            if (hi == 0) li_l[r32] = l_reg; LDS_WAIT();
            float rli[16];
#pragma unroll
            for (int r = 0; r < 16; ++r) rli[r] = __builtin_amdgcn_rcpf(li_l[crow(r, hi)]);
#pragma unroll
            for (int r = 0; r < 16; ++r)
#pragma unroll
                for (int d0 = 0; d0 < 4; ++d0) Sw[(size_t)crow(r, hi) * 128 + d0 * 32 + r32] = o[d0][r] * rli[r];
        }
        {
            f32x16 o[4]; float l_reg;
            __syncthreads();
            attn_body<64, PW, PW, PW, 1, 0, ATT_FS != 0, ATT_PVP_DIFF != 0>(tid, Pb + (size_t)(CTXL + qb * 256) * PW + PC_QD + h * 128 + 64, Pb + PC_KD + h * 128 + 64, Pb + PC_VD + h * 128, TPB, lds, 0.125f * LOG2E, ATT_FS ? bnd_diff / 0.125f : 8.f / 0.125f, o, l_reg);
            if (hi == 0) li_l[r32] = l_reg; LDS_WAIT();
            float ss[16];
#pragma unroll
            for (int r = 0; r < 16; ++r) { const float rl = __builtin_amdgcn_rcpf(li_l[crow(r, hi)]); float s = 0.f;
#pragma unroll
                for (int d0 = 0; d0 < 4; ++d0) { const float a1 = Sw[(size_t)crow(r, hi) * 128 + d0 * 32 + r32]; const float v = a1 - lam * (o[d0][r] * rl); o[d0][r] = v; s += v * v; }
                ss[r] = s; }
#pragma unroll
            for (int r = 0; r < 16; ++r) {
#pragma unroll
                for (int sh = 1; sh < 32; sh <<= 1) ss[r] += __shfl_xor(ss[r], sh);
                ss[r] = (1.f / sqrtf(ss[r] * (1.f / 128.f) + EPS)) * (1.f - LAM_INIT); }
            bf16_t* Ow = Y + (size_t)(b * SEQ + qb * 256 + wid * 32) * D + 512 + h * 128;
#pragma unroll
            for (int d0 = 0; d0 < 4; ++d0) { const float gs = A.in[23][d0 * 32 + r32];
#pragma unroll
                for (int r = 0; r < 16; ++r) Ow[(size_t)crow(r, hi) * D + d0 * 32 + r32] = f2bf(o[d0][r] * ss[r] * gs); }
        }
    }
    __syncthreads();
}

constexpr int NPHASE = 18;

__global__ void __launch_bounds__(512, 2) fwd(Args args) {
    extern __shared__ __attribute__((aligned(16))) unsigned char lds_raw[];
    Frame F;
    F.lds = (LAS unsigned char*)lds_raw;
    F.tid = threadIdx.x; F.lane = F.tid & 63; F.wave = __builtin_amdgcn_readfirstlane(F.tid >> 6);
    F.G = gridDim.x; F.bid = blockIdx.x;
    F.out = args.out; F.ws = args.ws; F.ctl = (unsigned*)(args.ws + WS_CTL);
    volatile LAS unsigned* MISC = (volatile LAS unsigned*)(F.lds + LDS_CTL);
    LAS int* PRE = (LAS int*)(F.lds + LDS_CTL + 64);
    if (F.tid < 4) MISC[F.tid] = 0u;
    __syncthreads();
    XcdBarrier bar; bar.bar = F.ctl + CW_BAR; bar.x = 0; bar.st = nullptr;
#if MK_ONE_LAUNCH
    bar = xcd_barrier_post(F.ctl + CW_BAR, MISC);
#define GRID_BAR() xcd_barrier(bar)
#else
#define GRID_BAR() do {} while (0)
#endif
    const int lo = args.ph_lo, hi = args.ph_hi;
    unsigned long long pt0 = 0, pt1 = 0;
#ifndef PH_MASK
#define PH_MASK 0x3ffff
#endif
#define IN(k) (((PH_MASK >> (k)) & 1) && lo <= (k) && (k) < hi)
#define SEAM(k) do { if (IN((k) + 1)) GRID_BAR(); } while (0)
#define REP(k) for (int _rep = 0; _rep <= ((PROBE_REP >> (k)) & 1); ++_rep, (void)((_rep <= ((PROBE_REP >> (k)) & 1)) ? (GRID_BAR(), 0) : 0))

    if (IN(0)) { if (PT_LO == 0) pt0 = __builtin_amdgcn_s_memrealtime(); REP(0) { p0_prologue(F, ARGP(), pt1); } if (!PT_SUB && PT_PRE && PT_HI == 0) pt1 = __builtin_amdgcn_s_memrealtime(); SEAM(0); if (!PT_SUB && !PT_PRE && PT_HI == 0) pt1 = __builtin_amdgcn_s_memrealtime(); }
    if (IN(1)) { if (PT_LO == 1) pt0 = __builtin_amdgcn_s_memrealtime(); REP(1) { norm_mod_phase(F, ARGP(), 0); } if (PT_PRE && PT_HI == 1) pt1 = __builtin_amdgcn_s_memrealtime(); SEAM(1); if (!PT_PRE && PT_HI == 1) pt1 = __builtin_amdgcn_s_memrealtime(); }
    if (IN(2)) { if (PT_LO == 2) pt0 = __builtin_amdgcn_s_memrealtime(); REP(2) {
        pg8::PlainSched S; S.init(WSP(bf16_t, WS_H), WSP(bf16_t, WS_WIN0), NTOK, 1536, D, D, D, F.G, F.bid, 0);
        pg8::EpiStoreBf16 E{WSP(bf16_t, WS_BIG), UW};
        pg8::gemm_phase(F.lds, D, D, D, 1 << 30, S, E);
    } if (PT_PRE && PT_HI == 2) pt1 = __builtin_amdgcn_s_memrealtime(); SEAM(2); if (!PT_PRE && PT_HI == 2) pt1 = __builtin_amdgcn_s_memrealtime(); }
    if (IN(3)) { if (PT_LO == 3) pt0 = __builtin_amdgcn_s_memrealtime(); REP(3) { convpool_phase(F, ARGP(), pt1); } if (!PT_SUB && PT_PRE && PT_HI == 3) pt1 = __builtin_amdgcn_s_memrealtime(); SEAM(3); if (!PT_SUB && !PT_PRE && PT_HI == 3) pt1 = __builtin_amdgcn_s_memrealtime(); }
    if (IN(4)) { if (PT_LO == 4) pt0 = __builtin_amdgcn_s_memrealtime(); REP(4) {
        pg8::PlainSched S; S.init(WSP(bf16_t, WS_YMIX), WSP(bf16_t, WS_WOUT0), NTOK, D, D, D, D, F.G, F.bid, 0);
        pg8::EpiResid E{ARGP().in[0], ARGP().in[2], F.out, WSP(float, WS_XC), WSP(float, WS_MOD), 0};
        pg8::gemm_phase(F.lds, D, D, D, 1 << 30, S, E);
    } if (PT_PRE && PT_HI == 4) pt1 = __builtin_amdgcn_s_memrealtime(); SEAM(4); if (!PT_PRE && PT_HI == 4) pt1 = __builtin_amdgcn_s_memrealtime(); }
    if (IN(5)) { if (PT_LO == 5) pt0 = __builtin_amdgcn_s_memrealtime(); REP(5) { router_phase(F, ARGP(), 0); } if (PT_PRE && PT_HI == 5) pt1 = __builtin_amdgcn_s_memrealtime(); SEAM(5); if (!PT_PRE && PT_HI == 5) pt1 = __builtin_amdgcn_s_memrealtime(); }
    if (IN(6)) { if (PT_LO == 6) pt0 = __builtin_amdgcn_s_memrealtime(); REP(6) {
        const int nt = moe_prefix(F, 0, PRE);
        MoeSchedT<true> S; S.m = MoeSched{F.G, F.bid, nt, 0, 0, F.ctl + CW_CNT, WSP(int, WS_LIST), (const char*)WSP(bf16_t, WS_H), (const char*)WSP(bf16_t, WS_WM1), PRE};
        EpiMoe1 E{WSP(bf16_t, WS_BIG), WSP(f32x2, WS_TW)};
        pg8::gemm_phase(F.lds, D, D, D, 1 << 30, S, E);
    } if (PT_PRE && PT_HI == 6) pt1 = __builtin_amdgcn_s_memrealtime(); SEAM(6); if (!PT_PRE && PT_HI == 6) pt1 = __builtin_amdgcn_s_memrealtime(); }
    if (IN(7)) { if (PT_LO == 7) pt0 = __builtin_amdgcn_s_memrealtime(); REP(7) {
        const int nt = moe_prefix(F, 0, PRE);
        MoeSchedT<false> S; S.m = MoeSched{F.G, F.bid, nt, 0, 1, F.ctl + CW_CNT, WSP(int, WS_LIST), (const char*)WSP(bf16_t, WS_BIG), (const char*)WSP(bf16_t, WS_WM2), PRE};
        EpiMoe2 E{F.out, WSP(float, WS_XC), WSP(float, WS_MOD)};
        pg8::gemm_phase(F.lds, 512, 512, 256, 4, S, E);
    } if (PT_PRE && PT_HI == 7) pt1 = __builtin_amdgcn_s_memrealtime(); SEAM(7); if (!PT_PRE && PT_HI == 7) pt1 = __builtin_amdgcn_s_memrealtime(); }
    if (IN(8)) { if (PT_LO == 8) pt0 = __builtin_amdgcn_s_memrealtime(); REP(8) { norm_mod_phase(F, ARGP(), 1); } if (PT_PRE && PT_HI == 8) pt1 = __builtin_amdgcn_s_memrealtime(); SEAM(8); if (!PT_PRE && PT_HI == 8) pt1 = __builtin_amdgcn_s_memrealtime(); }
    if (IN(9)) { if (PT_LO == 9) pt0 = __builtin_amdgcn_s_memrealtime(); REP(9) {
        pg8::PlainSched S; S.init(WSP(bf16_t, WS_H), WSP(bf16_t, WS_WIN1), NTOK, PW, D, D, D, F.G, F.bid, 0);
        pg8::EpiStoreBf16 E{WSP(bf16_t, WS_BIG), PW};
        pg8::gemm_phase(F.lds, D, D, D, 1 << 30, S, E);
    } if (PT_PRE && PT_HI == 9) pt1 = __builtin_amdgcn_s_memrealtime(); SEAM(9); if (!PT_PRE && PT_HI == 9) pt1 = __builtin_amdgcn_s_memrealtime(); }
    if (IN(10)) { if (PT_LO == 10) pt0 = __builtin_amdgcn_s_memrealtime(); REP(10) { p9_phase(F, ARGP()); } if (PT_PRE && PT_HI == 10) pt1 = __builtin_amdgcn_s_memrealtime(); SEAM(10); if (!PT_PRE && PT_HI == 10) pt1 = __builtin_amdgcn_s_memrealtime(); }
    if (IN(11)) { if (PT_LO == 11) pt0 = __builtin_amdgcn_s_memrealtime(); REP(11) {
        { pg8::PlainSched S; S.init(WSP(bf16_t, WS_BIG) + PC_CQ, WSP(bf16_t, WS_WUQ), NLAT, 768, 256, PW, 256, F.G, F.bid, 1);
          pg8::EpiStoreBf16 E{WSP(bf16_t, WS_QM), 768};
          pg8::gemm_phase(F.lds, 256, PW, 256, 1 << 30, S, E); }
        { pg8::PlainSched S; S.init(WSP(bf16_t, WS_BIG) + PC_CKV, WSP(bf16_t, WS_WUKV), NTOK, 1024, 128, PW, 128, F.G, F.bid, 0);
          pg8::EpiStoreBf16 E{WSP(bf16_t, WS_H), 1024};
          pg8::gemm_phase(F.lds, 128, PW, 128, 1 << 30, S, E); }

    } if (PT_PRE && PT_HI == 11) pt1 = __builtin_amdgcn_s_memrealtime(); SEAM(11); if (!PT_PRE && PT_HI == 11) pt1 = __builtin_amdgcn_s_memrealtime(); }
    if (IN(12)) { if (PT_LO == 12) pt0 = __builtin_amdgcn_s_memrealtime(); REP(12) { p11_phase(F, ARGP()); } if (PT_PRE && PT_HI == 12) pt1 = __builtin_amdgcn_s_memrealtime(); SEAM(12); if (!PT_PRE && PT_HI == 12) pt1 = __builtin_amdgcn_s_memrealtime(); }
    if (IN(13)) { if (PT_LO == 13 && PT_SUB != 7 && PT_SUB != 8) pt0 = __builtin_amdgcn_s_memrealtime(); REP(13) { attn_phase(F, ARGP(), pt1, pt0); } if (!PT_SUB && PT_PRE && PT_HI == 13) pt1 = __builtin_amdgcn_s_memrealtime(); SEAM(13); if (!PT_SUB && !PT_PRE && PT_HI == 13) pt1 = __builtin_amdgcn_s_memrealtime(); }
    if (IN(14)) { if (PT_LO == 14) pt0 = __builtin_amdgcn_s_memrealtime(); REP(14) {
        pg8::PlainSched S; S.init(WSP(bf16_t, WS_YMIX), WSP(bf16_t, WS_WOUT1), NLAT, D, D, D, D, F.G, F.bid, 0);
        pg8::EpiResid E{ARGP().in[0], ARGP().in[2], F.out, WSP(float, WS_XC), WSP(float, WS_MOD) + (size_t)9 * NMOD * D, 1};
        pg8::gemm_phase(F.lds, D, D, D, 1 << 30, S, E);
    } if (PT_PRE && PT_HI == 14) pt1 = __builtin_amdgcn_s_memrealtime(); SEAM(14); if (!PT_PRE && PT_HI == 14) pt1 = __builtin_amdgcn_s_memrealtime(); }
    if (IN(15)) { if (PT_LO == 15) pt0 = __builtin_amdgcn_s_memrealtime(); REP(15) { router_phase(F, ARGP(), 1); } if (PT_PRE && PT_HI == 15) pt1 = __builtin_amdgcn_s_memrealtime(); SEAM(15); if (!PT_PRE && PT_HI == 15) pt1 = __builtin_amdgcn_s_memrealtime(); }
    if (IN(16)) { if (PT_LO == 16) pt0 = __builtin_amdgcn_s_memrealtime(); REP(16) {
        const int nt = moe_prefix(F, 1, PRE);
        MoeSchedT<true> S; S.m = MoeSched{F.G, F.bid, nt, 1, 0, F.ctl + CW_CNT + 64, WSP(int, WS_LIST), (const char*)WSP(bf16_t, WS_H), (const char*)WSP(bf16_t, WS_WM1), PRE};
        EpiMoe1 E{WSP(bf16_t, WS_BIG), WSP(f32x2, WS_TW)};
        pg8::gemm_phase(F.lds, D, D, D, 1 << 30, S, E);
    } if (PT_PRE && PT_HI == 16) pt1 = __builtin_amdgcn_s_memrealtime(); SEAM(16); if (!PT_PRE && PT_HI == 16) pt1 = __builtin_amdgcn_s_memrealtime(); }
    if (IN(17)) { if (PT_LO == 17) pt0 = __builtin_amdgcn_s_memrealtime(); REP(17) {
        const int nt = moe_prefix(F, 1, PRE);
        MoeSchedT<false> S; S.m = MoeSched{F.G, F.bid, nt, 1, 1, F.ctl + CW_CNT + 64, WSP(int, WS_LIST), (const char*)WSP(bf16_t, WS_BIG), (const char*)WSP(bf16_t, WS_WM2), PRE};
        EpiMoe2 E{F.out, WSP(float, WS_XC), WSP(float, WS_MOD) + (size_t)9 * NMOD * D};
        pg8::gemm_phase(F.lds, 512, 512, 256, 4, S, E);
    } if (PT_HI == 17) pt1 = __builtin_amdgcn_s_memrealtime(); }
    if (PT_LO >= 0 && F.bid == 0 && F.tid == 0) { const unsigned long long tend = __builtin_amdgcn_s_memrealtime() + (unsigned long long)PT_AMP * (pt1 - pt0);
        while (__builtin_amdgcn_s_memrealtime() < tend) __builtin_amdgcn_s_sleep(8); }
#undef IN
#undef SEAM
}

extern "C" void kernel_launch(void* const* d_in, const int* in_sizes, int n_in, void* d_out, int out_size, void* d_ws, size_t ws_size, hipStream_t stream) {
    static int grid = 0;
    if (grid == 0) {
        if (n_in != 30 || in_sizes[0] != NLAT * D || out_size != NLAT * D || ws_size < WS_END) { fprintf(stderr, "kernel_launch: unexpected shapes (n_in %d, in0 %d, out %d, ws %zu)\n", n_in, n_in > 0 ? in_sizes[0] : -1, out_size, ws_size); grid = -1; return; }
        int dev = 0, cus = 0, per_cu = 0;
        if (hipGetDevice(&dev) != hipSuccess || hipDeviceGetAttribute(&cus, hipDeviceAttributeMultiprocessorCount, dev) != hipSuccess) { grid = -1; return; }
        if (hipFuncSetAttribute((const void*)fwd, hipFuncAttributeMaxDynamicSharedMemorySize, LDS_BYTES) != hipSuccess) { fprintf(stderr, "kernel_launch: hipFuncSetAttribute failed\n"); grid = -1; return; }
        if (hipOccupancyMaxActiveBlocksPerMultiprocessor(&per_cu, (const void*)fwd, 512, LDS_BYTES) != hipSuccess || per_cu < 1) fprintf(stderr, "kernel_launch: occupancy query reports %d\n", per_cu);
        (void)hipGetLastError();
        grid = cus;
    }
    if (grid < 0) return;
    if (hipMemsetAsync((char*)d_ws + WS_CTL, 0, CTL_ZERO_BYTES, stream) != hipSuccess) return;
    Args a{};
    for (int i = 0; i < 30; ++i) a.in[i] = (const float*)d_in[i];
    a.out = (float*)d_out; a.ws = (unsigned char*)d_ws;
    const int last = MK_LAST_PHASE < NPHASE - 1 ? MK_LAST_PHASE : NPHASE - 1;
#if MK_ONE_LAUNCH
    a.ph_lo = 0; a.ph_hi = last + 1;
    hipLaunchKernelGGL(fwd, dim3(grid), dim3(512), LDS_BYTES, stream, a);
#else
    for (int p = 0; p <= last; ++p) { a.ph_lo = p; a.ph_hi = p + 1; hipLaunchKernelGGL(fwd, dim3(grid), dim3(512), LDS_BYTES, stream, a); }
#endif
    const hipError_t le = hipPeekAtLastError();
    if (le != hipSuccess) fprintf(stderr, "kernel_launch: launch failed: %s\n", hipGetErrorName(le));
}
```

```cpp
#include <hip/hip_runtime.h>
#include <cstdio>
#include <cstdint>

#ifndef MK_ONE_LAUNCH
#define MK_ONE_LAUNCH 1
#endif
#ifndef MK_LAST_PHASE
#define MK_LAST_PHASE 99
#endif

#ifndef PROBE_REP
#define PROBE_REP 0
#endif
#define PT_LO -1
#define PT_HI -1
#define PT_AMP 4
#define PT_PRE 0
#define PROBE_ABL_SET 0
#define PROBE_ABL PROBE_ABL_SET
#define PT_SUB 0

#define GAS __attribute__((address_space(1)))
#define LAS __attribute__((address_space(3)))
typedef unsigned short bf16_t;
typedef short bf16x8 __attribute__((ext_vector_type(8)));
typedef short s16x4 __attribute__((ext_vector_type(4)));
typedef float f32x4 __attribute__((ext_vector_type(4)));
typedef float f32x2 __attribute__((ext_vector_type(2)));
typedef float f32x16 __attribute__((ext_vector_type(16)));
typedef unsigned u32x4 __attribute__((ext_vector_type(4)));
typedef unsigned u32x2 __attribute__((ext_vector_type(2)));

constexpr int D = 1024, NB = 8, SEQ = 4096, CTXL = 256, TPB = SEQ + CTXL;
constexpr int NTOK = NB * TPB, NLAT = NB * SEQ, NCTX = NB * CTXL;
constexpr int NMOD = 6;
constexpr float EPS = 1e-6f;
constexpr int NEXP = 32, NBUCK = 48, DEXP = 256, LCAP = NTOK;
constexpr int PW = 2048;
constexpr int UW = 1024;
constexpr int PC_CQ = 0, PC_QD = 256, PC_CKV = 768, PC_KROPE = 896, PC_KD = 960, PC_VD = 1472;
constexpr float LAM_INIT = 0.35550906759096934f;
constexpr int MOE_MAXT = NTOK / 256 + NBUCK;

constexpr size_t MiB = 1u << 20;
constexpr size_t WS_CTL = 0, CTL_ZERO_BYTES = 3 * MiB;
constexpr size_t WS_MOD = 2 * MiB;
constexpr size_t WS_COS = 3 * MiB, WS_SIN = 3 * MiB + 512 * 1024;
constexpr size_t WS_XC = 4 * MiB;
constexpr size_t WS_LIST = 12 * MiB;
constexpr size_t WS_TW = 19 * MiB;
constexpr size_t WS_WIN0 = 20 * MiB, WS_WOUT0 = 23 * MiB, WS_WIN1 = 25 * MiB, WS_WUQ = 29 * MiB, WS_WUKV = 29 * MiB + 512 * 1024, WS_WOUT1 = 30 * MiB, WS_WPOOL = 32 * MiB;
constexpr size_t WS_WM1 = 33 * MiB;
constexpr size_t WS_WM2 = 97 * MiB;
constexpr size_t WS_H = 129 * MiB;
constexpr size_t WS_BIG = 197 * MiB;
constexpr size_t WS_YMIX = 333 * MiB;
constexpr size_t WS_QM = 401 * MiB;
constexpr size_t WS_KM = 449 * MiB;
constexpr size_t WS_END = 500 * MiB;
constexpr size_t WS_STASH = WS_WM1;
constexpr int CW_BAR = 4096;
constexpr int CW_CNT = 16384;

constexpr int LDS_BYTES = 155648;
constexpr int LDS_CTL = 153600;

__device__ __forceinline__ unsigned cvt_pk_bf16(float lo, float hi) { unsigned r; asm volatile("v_cvt_pk_bf16_f32 %0, %1, %2" : "=v"(r) : "v"(lo), "v"(hi)); return r; }
__device__ __forceinline__ float bf2f(unsigned short u) { return __uint_as_float((unsigned)u << 16); }
__device__ __forceinline__ float bflo(unsigned w) { return __uint_as_float(w << 16); }
__device__ __forceinline__ float bfhi(unsigned w) { return __uint_as_float(w & 0xffff0000u); }
__device__ __forceinline__ unsigned short f2bf(float f) { return (unsigned short)(cvt_pk_bf16(f, 0.f) & 0xffffu); }
__device__ __forceinline__ float wave_sum(float v) {
#pragma unroll
    for (int o = 1; o < 64; o <<= 1) v += __shfl_xor(v, o);
    return v;
}
__device__ __forceinline__ float sigmoidf_(float x) { return 1.f / (1.f + __expf(-x)); }
__device__ __forceinline__ float siluf_(float x) { return x / (1.f + __expf(-x)); }
__device__ __forceinline__ int crow(int r, int hi) { return (r & 3) + 8 * (r >> 2) + 4 * hi; }
#define LDS_WAIT() asm volatile("s_waitcnt lgkmcnt(0)" ::: "memory")
#define VM_WAIT() asm volatile("s_waitcnt vmcnt(0)" ::: "memory")

#define XB_TMO      128
#define XB_XCNT(j)  (256  + 64 * (j))
#define XB_XSUB(j)  (1280 + 64 * (j))
#define XB_XGEN(j)  (2304 + 64 * (j))
#define XB_TOP      3328
#define XB_TOPGEN   3392
#define XCD_BAR_WORDS 3456
#define XB_SPIN_CAP (1u << 18)
__device__ __forceinline__ unsigned xb_ld(unsigned* p)              { return __hip_atomic_load(p, __ATOMIC_RELAXED, __HIP_MEMORY_SCOPE_AGENT); }
__device__ __forceinline__ unsigned xb_add(unsigned* p, unsigned v) { return __hip_atomic_fetch_add(p, v, __ATOMIC_RELAXED, __HIP_MEMORY_SCOPE_AGENT); }
__device__ __forceinline__ unsigned xb_xcc_id() { return (unsigned)__builtin_amdgcn_s_getreg((3 << 11) | 20) & 0xFu; }
#define XB_SPIN(cond, bar) do { unsigned _sp = 0; while (cond) { __builtin_amdgcn_s_sleep(1); \
    if ((++_sp & 255u) == 0u) { if (xb_ld(&(bar)[XB_TMO])) break; if (_sp > XB_SPIN_CAP) { atomicAdd(&(bar)[XB_TMO], 1u); break; } } } } while (0)
struct XcdBarrier { unsigned* bar; unsigned x; volatile LAS unsigned* st; };
__device__ __forceinline__ XcdBarrier xcd_barrier_post(unsigned* bar, volatile LAS unsigned* st) {
    XcdBarrier b; b.bar = bar; b.x = xb_xcc_id(); b.st = st;
    if (threadIdx.x == 0) (void)xb_add(&bar[XB_XCNT(b.x)], 1u);
    return b;
}
__device__ __forceinline__ void xcd_barrier_complete(unsigned* bar, unsigned x, unsigned& nloc, unsigned& nx) {
    const unsigned G = gridDim.x * gridDim.y * gridDim.z;
    unsigned sum, cnt, mine, sp = 0u;
    for (;;) {
        sum = 0u; cnt = 0u; mine = 0u;
#pragma unroll
        for (unsigned j = 0; j < 16; ++j) { const unsigned c = xb_ld(&bar[XB_XCNT(j)]); sum += c; cnt += (c > 0u) ? 1u : 0u; mine = (j == x) ? c : mine; }
        if (sum == G) break;
        __builtin_amdgcn_s_sleep(1);
        if ((++sp & 255u) == 0u) { if (xb_ld(&bar[XB_TMO])) break; if (sp > XB_SPIN_CAP) { atomicAdd(&bar[XB_TMO], 1u); break; } }
    }
    nloc = mine > 0u ? mine : 1u; nx = cnt > 0u ? cnt : 1u;
}
__device__ __forceinline__ void xcd_barrier(const XcdBarrier& b) {
    asm volatile("s_waitcnt vmcnt(0)" ::: "memory");
    __syncthreads();
    if (threadIdx.x == 0) {
        unsigned* bar = b.bar;
        __builtin_amdgcn_s_waitcnt(0);
        unsigned nloc = b.st[0], nx = b.st[1];
        if (nloc == 0u) { xcd_barrier_complete(bar, b.x, nloc, nx); b.st[0] = nloc; b.st[1] = nx; }
        const unsigned old = xb_add(&bar[XB_XSUB(b.x)], 1u);
        const unsigned gen = old / nloc;
        if (old + 1u == (gen + 1u) * nloc) {
            __builtin_amdgcn_fence(__ATOMIC_RELEASE, "agent");
            asm volatile("s_waitcnt vmcnt(0)" ::: "memory");
            const unsigned og = xb_add(&bar[XB_TOP], 1u);
            const unsigned tg = og / nx;
            if (og + 1u == (tg + 1u) * nx) xb_add(&bar[XB_TOPGEN], 1u);
            else XB_SPIN(xb_ld(&bar[XB_TOPGEN]) == tg, bar);
            __builtin_amdgcn_fence(__ATOMIC_ACQUIRE, "agent");
            xb_add(&bar[XB_XGEN(b.x)], 1u);
            asm volatile("s_waitcnt vmcnt(0)" ::: "memory");
        } else {
            XB_SPIN(xb_ld(&bar[XB_XGEN(b.x)]) == gen, bar);
            __builtin_amdgcn_fence(__ATOMIC_ACQUIRE, "agent");
            asm volatile("s_waitcnt vmcnt(0)" ::: "memory");
        }
    }
    __syncthreads();
}

namespace pg8 {
constexpr int BM = 256, BK = 64, HALF = 128, HTB = HALF * BK * 2, STAGE_BYTES = 8 * HTB, NXCD = 8, WGM = 8;
__device__ __forceinline__ int lds_byte(int r, int c) { const int st = (r >> 4) * 2 + (c >> 5), rr = r & 15, cc = c & 31, ob = rr * 64 + cc * 2; return st * 1024 + (ob ^ (((ob >> 9) & 1) << 5)); }
__device__ __forceinline__ void stage_rc(int b, int& R, int& C) { const int st = b / 1024, sb = b % 1024, swz = sb ^ (((sb >> 9) & 1) << 5); R = (st >> 1) * 16 + swz / 64; C = (st & 1) * 32 + (swz % 64) / 2; }
__device__ __forceinline__ int perm32(int rho) { const int n = rho >> 4, i = rho & 15; return 8 * (i >> 2) + 4 * n + (i & 3); }

struct Unit {
    int pm, pn, po;
    const char* A;
    const char* B;
    const char* B2;
    const int* rows;
    int nvalid, aux;
};

template <class Epi, class Sched>
__device__ __forceinline__ void gemm_phase(LAS unsigned char* lds, int K, int lda, int ldb, int ksplit, const Sched& S, const Epi& E) {
    asm volatile("" : "+s"(K), "+s"(lda), "+s"(ldb), "+s"(ksplit));
    const int tid = threadIdx.x, wid = __builtin_amdgcn_readfirstlane(tid >> 6), lane = tid & 63, wr = wid >> 2, wc = wid & 3, fr = lane & 15, fq = lane >> 4;
    const int nt = K / BK;
    unsigned voffB[2];
#pragma unroll
    for (int i = 0; i < 2; ++i) { int R, C; stage_rc(tid * 16 + i * 8192, R, C); const int Rb = (R & ~31) + perm32(R & 31); voffB[i] = (unsigned)(Rb * ldb + C) * 2u; }
    const size_t kstep = (size_t)(BK * 2);
    const size_t hstepB = (size_t)HALF * ldb * 2;
    const unsigned ldsw = (unsigned)wid * 1024u;
    const int aoff = lds_byte(wr * 64 + fr, fq * 8), boff = lds_byte(wc * 32 + fr, fq * 8);
#define PG8_SA(b, h) (((b) * 2 + (h)) * HTB)
#define PG8_SB(b, h) ((4 + (b) * 2 + (h)) * HTB)
#define PG8_STAGE(bufoff, gbase, voff) do { _Pragma("unroll") for (int _i = 0; _i < 2; ++_i) \
        __builtin_amdgcn_global_load_lds((const unsigned*)((const char*)(gbase) + (voff)[_i]), (LAS unsigned*)(lds + (bufoff) + ldsw + _i * 8192), 16, 0, 0); } while (0)
#define PG8_LDA(dst, b, h) do { _Pragma("unroll") for (int m = 0; m < 4; ++m) _Pragma("unroll") for (int k = 0; k < 2; ++k) dst[m][k] = *(const LAS bf16x8*)(lds + PG8_SA(b, h) + aoff + m * 2048 + k * 1024); } while (0)
#define PG8_LDB(dst, b, h) do { _Pragma("unroll") for (int n = 0; n < 2; ++n) _Pragma("unroll") for (int k = 0; k < 2; ++k) dst[n][k] = *(const LAS bf16x8*)(lds + PG8_SB(b, h) + boff + n * 2048 + k * 1024); } while (0)
#define PG8_MMA(ai, bj, At, Bt) do { __builtin_amdgcn_s_setprio(1); _Pragma("unroll") for (int m = 0; m < 4; ++m) _Pragma("unroll") for (int n = 0; n < 2; ++n) _Pragma("unroll") for (int k = 0; k < 2; ++k) \
        acc[ai][bj][m][n] = __builtin_amdgcn_mfma_f32_16x16x32_bf16(Bt[n][k], At[m][k], acc[ai][bj][m][n], 0, 0, 0); __builtin_amdgcn_s_setprio(0); } while (0)
#define PG8_WAIT_V(n) asm volatile("s_waitcnt vmcnt(" #n ")" ::: "memory")
#define PG8_WAIT_L(n) asm volatile("s_waitcnt lgkmcnt(" #n ")" ::: "memory")
#define PG8_BAR __builtin_amdgcn_s_barrier()
#define PG8_SCHED __builtin_amdgcn_sched_barrier(0)
#define PG8_BK(u, t) (((t) < ksplit ? (u).B : (u).B2) + (size_t)(t) * kstep)
#define PG8_VOFF(dst, u) do { int _tl = tid; asm volatile("" : "+v"(_tl)); _Pragma("unroll") for (int _h = 0; _h < 2; ++_h) _Pragma("unroll") for (int _i = 0; _i < 2; ++_i) { int _R, _C; stage_rc(_tl * 16 + _i * 8192, _R, _C); int _r = _R + HALF * _h; \
        if constexpr (Sched::GATHER) { const int _rr = _r < (u).nvalid ? _r : 0; _r = (u).rows[_rr]; } dst[_h][_i] = (unsigned)(_r * lda + _C) * 2u; } } while (0)
    Unit cur, nxt; int ui = 0;
    if (!S.next(0, cur)) return;
    f32x4 acc[2][2][4][2];
#pragma unroll
    for (int a = 0; a < 2; ++a)
#pragma unroll
        for (int b = 0; b < 2; ++b)
#pragma unroll
            for (int m = 0; m < 4; ++m)
#pragma unroll
                for (int n = 0; n < 2; ++n) acc[a][b][m][n] = (f32x4){0.f, 0.f, 0.f, 0.f};
    bf16x8 At[4][2], B0[2][2], B1[2][2];
    LAS unsigned* VO = (LAS unsigned*)(lds + STAGE_BYTES) + tid;
#define PG8_VO(slot, h, i) VO[(((slot) & 1) * 4 + (h) * 2 + (i)) * 512]
    unsigned vfix[2][2];
    {
        unsigned vc[2][2];
        PG8_VOFF(vc, cur);
#pragma unroll
        for (int h = 0; h < 2; ++h)
#pragma unroll
            for (int i = 0; i < 2; ++i) { vfix[h][i] = vc[h][i]; if constexpr (Sched::GATHER) PG8_VO(0, h, i) = vc[h][i]; }
        const char* cA0 = cur.A;
        const char* b0 = PG8_BK(cur, 0); const char* b1 = PG8_BK(cur, 1);
        PG8_STAGE(PG8_SB(0, 0), b0, voffB); PG8_STAGE(PG8_SB(0, 1), b0 + hstepB, voffB); PG8_STAGE(PG8_SA(0, 0), cA0, vc[0]); PG8_STAGE(PG8_SA(0, 1), cA0, vc[1]);
        if (wr == 1) PG8_BAR;
        PG8_WAIT_V(2); PG8_BAR;
        PG8_STAGE(PG8_SB(1, 0), b1, voffB); PG8_STAGE(PG8_SA(1, 0), cA0 + kstep, vc[0]); PG8_STAGE(PG8_SB(1, 1), b1 + hstepB, voffB);
        PG8_WAIT_V(6); PG8_BAR;
    }
    const char* cA = cur.A;
    for (;;) {
        const bool has_next = S.next(ui + 1, nxt);
        if (!has_next) nxt = cur;
        if constexpr (Sched::GATHER) { unsigned vn[2][2]; PG8_VOFF(vn, nxt);
#pragma unroll
            for (int h = 0; h < 2; ++h)
#pragma unroll
                for (int i = 0; i < 2; ++i) PG8_VO(ui + 1, h, i) = vn[h][i]; }
        const char* nA = nxt.A;
#pragma nounroll
        for (int t = 0; t < nt; t += 2) {
            const bool last = (t == nt - 2);
            const char* a1 = cA + (size_t)(t + 1) * kstep;
            const char* a2 = last ? nA : cA + (size_t)(t + 2) * kstep;
            const char* a3 = a2 + kstep;
            const char* b2 = last ? PG8_BK(nxt, 0) : PG8_BK(cur, t + 2);
            const char* b3 = last ? PG8_BK(nxt, 1) : PG8_BK(cur, t + 3);
            unsigned v1[2], v2[2][2];
            if constexpr (Sched::GATHER) { const int s2 = last ? ui + 1 : ui;
                v1[0] = PG8_VO(ui, 1, 0); v1[1] = PG8_VO(ui, 1, 1);
#pragma unroll
                for (int h = 0; h < 2; ++h)
#pragma unroll
                    for (int i = 0; i < 2; ++i) v2[h][i] = PG8_VO(s2, h, i);
            } else { v1[0] = vfix[1][0]; v1[1] = vfix[1][1];
#pragma unroll
                for (int h = 0; h < 2; ++h)
#pragma unroll
                    for (int i = 0; i < 2; ++i) v2[h][i] = vfix[h][i]; }
            PG8_LDB(B0, 0, 0); PG8_LDB(B1, 0, 1); PG8_SCHED; PG8_LDA(At, 0, 0); PG8_STAGE(PG8_SA(1, 1), a1, v1);
            PG8_WAIT_V(8); PG8_WAIT_L(0); PG8_BAR; PG8_MMA(0, 0, At, B0); PG8_MMA(0, 1, At, B1); PG8_BAR; PG8_SCHED;
            PG8_LDA(At, 0, 1); PG8_STAGE(PG8_SB(0, 0), b2, voffB); PG8_STAGE(PG8_SB(0, 1), b2 + hstepB, voffB); PG8_STAGE(PG8_SA(0, 0), a2, v2[0]);
            PG8_WAIT_V(8); PG8_WAIT_L(0); PG8_BAR; PG8_MMA(1, 0, At, B0); PG8_MMA(1, 1, At, B1); PG8_BAR; PG8_SCHED;
            PG8_LDB(B0, 1, 0); PG8_LDB(B1, 1, 1); PG8_SCHED; PG8_LDA(At, 1, 0); PG8_STAGE(PG8_SA(0, 1), a2, v2[1]);
            PG8_WAIT_V(8); PG8_WAIT_L(0); PG8_BAR; PG8_MMA(0, 0, At, B0); PG8_MMA(0, 1, At, B1); PG8_BAR; PG8_SCHED;
            PG8_LDA(At, 1, 1); PG8_STAGE(PG8_SB(1, 0), b3, voffB); PG8_STAGE(PG8_SB(1, 1), b3 + hstepB, voffB); PG8_STAGE(PG8_SA(1, 0), a3, v2[0]);
            PG8_WAIT_V(8); PG8_WAIT_L(0); PG8_BAR; PG8_MMA(1, 0, At, B0); PG8_MMA(1, 1, At, B1); PG8_BAR; PG8_SCHED;
        }
        if (wr == 0) PG8_BAR;
        E(acc, cur, wr, wc, fr, fq);
        if (!has_next) break;
#pragma unroll
        for (int a = 0; a < 2; ++a)
#pragma unroll
            for (int b = 0; b < 2; ++b)
#pragma unroll
                for (int m = 0; m < 4; ++m)
#pragma unroll
                    for (int n = 0; n < 2; ++n) acc[a][b][m][n] = (f32x4){0.f, 0.f, 0.f, 0.f};
        cur = nxt; cA = nA; ++ui;
        if (wr == 1) PG8_BAR;
    }
    PG8_WAIT_V(0);
    PG8_BAR;
#undef PG8_SA
#undef PG8_SB
#undef PG8_STAGE
#undef PG8_LDA
#undef PG8_LDB
#undef PG8_MMA
#undef PG8_WAIT_V
#undef PG8_WAIT_L
#undef PG8_BAR
#undef PG8_SCHED
#undef PG8_BK
#undef PG8_VOFF
#undef PG8_VO
}

struct PlainSched {
    static constexpr bool GATHER = false;
    int nM, nN, nwg, G, c; const char* A; const char* Bt; int lda, ldb, K; int rowmap;
    __device__ __forceinline__ void init(const void* A_, const void* Bt_, int M, int N, int K_, int lda_, int ldb_, int G_, int c_, int rowmap_) {
        A = (const char*)A_; Bt = (const char*)Bt_; nM = M / BM; nN = N / BM; nwg = nM * nN; G = G_; c = c_; lda = lda_; ldb = ldb_; K = K_; rowmap = rowmap_; }
    __device__ __forceinline__ bool next(int i, Unit& u) const {
        const int L = i * G + c; if (L >= nwg) return false;
        int wgid = L; { const int q = nwg / NXCD, r = nwg % NXCD, xcd = wgid % NXCD, off = wgid / NXCD; wgid = (xcd < r ? xcd * (q + 1) : r * (q + 1) + (xcd - r) * q) + off; }
        const int nig = WGM * nN, gid = wgid / nig, fm = gid * WGM, gsz = (nM - fm) < WGM ? (nM - fm) : WGM;
        const int pm = fm + ((wgid % nig) % gsz), pn = (wgid % nig) / gsz;
        u.po = pm; u.pn = pn; u.pm = rowmap ? (pm / 16) * 17 + 1 + (pm % 16) : pm;
        u.A = A + (size_t)u.pm * BM * lda * 2; u.B = Bt + (size_t)pn * BM * ldb * 2; u.B2 = u.B; u.rows = nullptr; u.nvalid = BM; u.aux = 0;
        return true;
    }
};

struct EpiStoreBf16 {
    bf16_t* O; int ldc;
    __device__ __forceinline__ void operator()(const f32x4 (&acc)[2][2][4][2], const Unit& u, int wr, int wc, int fr, int fq) const {
        bf16_t* base = O + (size_t)(u.po * BM + wr * 64 + fr) * ldc + u.pn * BM + wc * 32 + 8 * fq;
#pragma unroll
        for (int ai = 0; ai < 2; ++ai)
#pragma unroll
            for (int m = 0; m < 4; ++m) { bf16_t* rowp = base + (size_t)(ai * HALF + m * 16) * ldc;
#pragma unroll
                for (int bj = 0; bj < 2; ++bj) { const f32x4 v0 = acc[ai][bj][m][0], v1 = acc[ai][bj][m][1];
                    u32x4 w; w.x = cvt_pk_bf16(v0[0], v0[1]); w.y = cvt_pk_bf16(v0[2], v0[3]); w.z = cvt_pk_bf16(v1[0], v1[1]); w.w = cvt_pk_bf16(v1[2], v1[3]);
                    *(u32x4*)(rowp + bj * HALF) = w; } }
    }
};
struct EpiGlu {
    bf16_t* O; int ldc;
    __device__ __forceinline__ void operator()(const f32x4 (&acc)[2][2][4][2], const Unit& u, int wr, int wc, int fr, int fq) const {
        if (u.pn < 4) {
            bf16_t* base = O + (size_t)(u.po * BM + wr * 64 + fr) * ldc + u.pn * 128 + wc * 32 + 8 * fq;
#pragma unroll
            for (int ai = 0; ai < 2; ++ai)
#pragma unroll
                for (int m = 0; m < 4; ++m) { float o[8];
#pragma unroll
                    for (int n = 0; n < 2; ++n)
#pragma unroll
                        for (int q = 0; q < 4; ++q) { const float a = acc[ai][0][m][n][q], g = acc[ai][1][m][n][q]; o[4 * n + q] = a * __builtin_amdgcn_rcpf(1.f + __expf(-g)); }
                    u32x4 w; w.x = cvt_pk_bf16(o[0], o[1]); w.y = cvt_pk_bf16(o[2], o[3]); w.z = cvt_pk_bf16(o[4], o[5]); w.w = cvt_pk_bf16(o[6], o[7]);
                    *(u32x4*)(base + (size_t)(ai * HALF + m * 16) * ldc) = w; }
        } else {
            bf16_t* base = O + (size_t)(u.po * BM + wr * 64 + fr) * ldc + 512 + (u.pn - 4) * BM + wc * 32 + 8 * fq;
#pragma unroll
            for (int ai = 0; ai < 2; ++ai)
#pragma unroll
                for (int m = 0; m < 4; ++m) { bf16_t* rowp = base + (size_t)(ai * HALF + m * 16) * ldc;
#pragma unroll
                    for (int bj = 0; bj < 2; ++bj) { const f32x4 v0 = acc[ai][bj][m][0], v1 = acc[ai][bj][m][1];
                        u32x4 w; w.x = cvt_pk_bf16(v0[0], v0[1]); w.y = cvt_pk_bf16(v0[2], v0[3]); w.z = cvt_pk_bf16(v1[0], v1[1]); w.w = cvt_pk_bf16(v1[2], v1[3]);
                        *(u32x4*)(rowp + bj * HALF) = w; } }
        }
    }
};
struct EpiResid {
    const float* x; const float* ctx; float* out; float* xc; const float* modl; int mode;
    __device__ __forceinline__ void operator()(const f32x4 (&acc)[2][2][4][2], const Unit& u, int wr, int wc, int fr, int fq) const {
        const float* src; float* dst; int mrow;
        if (mode == 0) { const int b = u.po / 17, jt = u.po % 17;
            if (jt == 0) { src = ctx + (size_t)b * CTXL * D; dst = xc + (size_t)b * CTXL * D; mrow = 8; }
            else { src = x + ((size_t)b * SEQ + (jt - 1) * 256) * D; dst = out + ((size_t)b * SEQ + (jt - 1) * 256) * D; mrow = b; } }
        else { src = out + (size_t)u.po * BM * D; dst = out + (size_t)u.po * BM * D; mrow = u.po / 16; }
        const float* gate = modl + (size_t)mrow * (NMOD * D) + 2 * D;
        const int col0 = u.pn * BM + wc * 32 + 8 * fq;
        f32x4 gv[2][2];
#pragma unroll
        for (int bj = 0; bj < 2; ++bj)
#pragma unroll
            for (int n = 0; n < 2; ++n) gv[bj][n] = *(const f32x4*)(gate + col0 + bj * HALF + 4 * n);
#pragma unroll
        for (int ai = 0; ai < 2; ++ai)
#pragma unroll
        for (int mp = 0; mp < 2; ++mp) {
            f32x4 sv[2][2][2];
#pragma unroll
            for (int mm = 0; mm < 2; ++mm) { const size_t ro = (size_t)(ai * HALF + wr * 64 + (mp * 2 + mm) * 16 + fr) * D + col0;
#pragma unroll
                for (int bj = 0; bj < 2; ++bj)
#pragma unroll
                    for (int n = 0; n < 2; ++n) sv[mm][bj][n] = *(const f32x4*)(src + ro + bj * HALF + 4 * n); }
            __builtin_amdgcn_sched_barrier(0);
#pragma unroll
            for (int mm = 0; mm < 2; ++mm) { const int m = mp * 2 + mm; const size_t ro = (size_t)(ai * HALF + wr * 64 + m * 16 + fr) * D + col0;
#pragma unroll
                for (int bj = 0; bj < 2; ++bj)
#pragma unroll
                    for (int n = 0; n < 2; ++n) *(f32x4*)(dst + ro + bj * HALF + 4 * n) = sv[mm][bj][n] + gv[bj][n] * acc[ai][bj][m][n]; }
            __builtin_amdgcn_sched_barrier(0);
        }
    }
};
}

struct Args { const float* in[30]; float* out; unsigned char* ws; int ph_lo, ph_hi; };
typedef const __attribute__((address_space(4))) Args& CArgsRef;
#define ARGP() (*({ const __attribute__((address_space(4))) Args* _p = (const __attribute__((address_space(4))) Args*)__builtin_amdgcn_kernarg_segment_ptr(); asm volatile("" : "+s"(_p)); _p; }))
struct Frame {
    LAS unsigned char* lds;
    int tid, lane, wave, G, bid;
    float* out; unsigned char* ws;
    unsigned* ctl;
};
#define WSP(T, off) ((T*)(F.ws + (off)))

__device__ __forceinline__ float* xl_row(const Frame& F, int ta) {
    const int b = ta / TPB, j = ta - b * TPB;
    return j < CTXL ? WSP(float, WS_XC) + (size_t)(b * CTXL + j) * D : F.out + ((size_t)b * SEQ + (j - CTXL)) * D;
}

struct TrItem { const float* src; bf16_t* dst; int N, ldo; };
__device__ __forceinline__ void tr_load(const TrItem& t, f32x4 (&v)[8], int lane) {
#pragma unroll
    for (int i = 0; i < 8; ++i) { const int kk = 8 * i + (lane >> 3); v[i] = *(const f32x4*)(t.src + (size_t)kk * t.N + 4 * (lane & 7)); }
}
__device__ __forceinline__ void tr_finish(const TrItem& t, const f32x4 (&v)[8], LAS float* scr, int lane) {
#pragma unroll
    for (int i = 0; i < 8; ++i) { const int kk = 8 * i + (lane >> 3); LAS float* p = scr + kk * 33 + 4 * (lane & 7); p[0] = v[i].x; p[1] = v[i].y; p[2] = v[i].z; p[3] = v[i].w; }
    LDS_WAIT(); asm volatile("" ::: "memory");
    const int c = lane & 7;
#pragma unroll
    for (int j = 0; j < 4; ++j) { const int n = (lane >> 3) + 8 * j; const LAS float* s = scr + (8 * c) * 33 + n;
        u32x4 o; o.x = cvt_pk_bf16(s[0 * 33], s[1 * 33]); o.y = cvt_pk_bf16(s[2 * 33], s[3 * 33]); o.z = cvt_pk_bf16(s[4 * 33], s[5 * 33]); o.w = cvt_pk_bf16(s[6 * 33], s[7 * 33]);
        *(u32x4*)(t.dst + (size_t)n * t.ldo + 8 * c) = o; }
    LDS_WAIT(); asm volatile("" ::: "memory");
}
__device__ __forceinline__ TrItem tr_generic(const float* W, int K, int N, bf16_t* WT, int item) {
    const int nblk = N / 32, kb = item / nblk, nb = item % nblk;
    return TrItem{W + (size_t)(64 * kb) * N + 32 * nb, WT + (size_t)(32 * nb) * K + 64 * kb, N, K};
}

__device__ __forceinline__ TrItem moe_tr_item(CArgsRef A, unsigned char* ws_, int le, int q) {
    bf16_t* W1 = (bf16_t*)(ws_ + WS_WM1) + (size_t)le * 512 * 1024; bf16_t* W2 = (bf16_t*)(ws_ + WS_WM2) + (size_t)le * 1024 * 256;
    if (q < 256) {
        const int up = q >> 7, item = q & 127, kb = item / 8, nb = item % 8, n0 = 32 * nb;
        const float* W = A.in[up ? 28 : 27] + (size_t)le * 1024 * 256;
        const int drow = (n0 >> 7) * 256 + up * 128 + (n0 & 127);
        return TrItem{W + (size_t)(64 * kb) * 256 + n0, W1 + (size_t)drow * 1024 + 64 * kb, 256, 1024};
    }
    return tr_generic(A.in[29] + (size_t)le * 256 * 1024, 256, 1024, W2, q - 256);
}
__device__ __forceinline__ void moe_fill(Frame& F, CArgsRef A, int le0, int nle, int rank, int nranks) {
    const int lane = F.lane, wave = F.wave;
    LAS float* scr = (LAS float*)(F.lds + wave * 16384);
    const int items = nle * 384, nw = nranks * 8, per = (items + nw - 1) / nw, wv = rank * 8 + wave;
    int it0 = wv * per, it1 = it0 + per; if (it1 > items) it1 = items;
    unsigned char* ws_ = F.ws;
    for (int it = it0; it < it1; it += 4) {
#define MF_ITEM(k) moe_tr_item(A, ws_, le0 + ((it + (k)) < it1 ? (it + (k)) : it) / 384, ((it + (k)) < it1 ? (it + (k)) : it) % 384)
        TrItem t0 = MF_ITEM(0), t1 = MF_ITEM(1), t2 = MF_ITEM(2), t3 = MF_ITEM(3);
#undef MF_ITEM
        f32x4 v0[8], v1[8], v2[8], v3[8];
        tr_load(t0, v0, lane); tr_load(t1, v1, lane); tr_load(t2, v2, lane); tr_load(t3, v3, lane);
        __builtin_amdgcn_sched_barrier(0);
        tr_finish(t0, v0, scr, lane);
        if (it + 1 < it1) tr_finish(t1, v1, scr, lane);
        if (it + 2 < it1) tr_finish(t2, v2, scr, lane);
        if (it + 3 < it1) tr_finish(t3, v3, scr, lane);
    }
}

__device__ __forceinline__ void p0_prologue(Frame& F, CArgsRef A, unsigned long long& pt1) {
    const int tid = F.tid, lane = F.lane, wave = F.wave;
    constexpr int NMODU = 96;
    if (F.bid < NMODU) {
        LAS float* SC = (LAS float*)F.lds;
        LAS float* RED = (LAS float*)(F.lds + 36864);
        {
            float cv[18];
#pragma unroll
            for (int q = 0; q < 18; ++q) { const int i = tid + 512 * q, r = i >> 10, k = i & 1023; cv[q] = r < 8 ? A.in[1][r * 1024 + k] : A.in[3][k]; }
            __builtin_amdgcn_sched_barrier(0);
#pragma unroll
            for (int q = 0; q < 18; ++q) SC[tid + 512 * q] = siluf_(cv[q]);
        }
        __syncthreads();
        float* MOD = WSP(float, WS_MOD);
        for (int u = F.bid; u < NMODU; u += F.G) {
            const int l = u / 48, cb = (u % 48) >> 1, kh = u & 1;
            const float* W = A.in[4] + (size_t)l * D * (NMOD * D) + cb * 256 + 4 * lane;
            f32x4 a[9];
#pragma unroll
            for (int r = 0; r < 9; ++r) a[r] = (f32x4){0.f, 0.f, 0.f, 0.f};
#pragma unroll 1
            for (int kk0 = 0; kk0 < 64; kk0 += 16) { const int k0 = kh * 512 + 64 * wave + kk0;
                f32x4 w[16];
#pragma unroll
                for (int i = 0; i < 16; ++i) w[i] = *(const f32x4*)(W + (size_t)(k0 + i) * (NMOD * D));
                __builtin_amdgcn_sched_barrier(0);
#pragma unroll
                for (int i = 0; i < 16; ++i)
#pragma unroll
                    for (int r = 0; r < 9; ++r) a[r] += w[i] * SC[r * 1024 + k0 + i]; }
#pragma unroll
            for (int r = 0; r < 9; ++r) *(LAS f32x4*)(RED + (wave * 9 + r) * 256 + 4 * lane) = a[r];
            __syncthreads();
            {
                float bs[5];
#pragma unroll
                for (int q = 0; q < 5; ++q) { const int o = tid + 512 * q; bs[q] = (kh == 0 && o < 9 * 256) ? A.in[5][l * (NMOD * D) + cb * 256 + (o & 255)] : 0.f; }
#pragma unroll
                for (int q = 0; q < 5; ++q) { const int o = tid + 512 * q; if (o < 9 * 256) { const int r = o >> 8, cc = o & 255; float sm = 0.f;
#pragma unroll
                    for (int w = 0; w < 8; ++w) sm += RED[(w * 9 + r) * 256 + cc];
                    atomicAdd(&MOD[((size_t)l * 9 + r) * (NMOD * D) + cb * 256 + cc], sm + bs[q]); } }
            }
            __syncthreads();
        }
    }
    if (PT_SUB == 1) pt1 = __builtin_amdgcn_s_memrealtime();
    {
        const float invf[16] = {1.000000000e+00f, 5.623413324e-01f, 3.162277639e-01f, 1.778279394e-01f, 1.000000015e-01f, 5.623413250e-02f, 3.162277490e-02f, 1.778279431e-02f,
                                9.999999776e-03f, 5.623413250e-03f, 3.162277630e-03f, 1.778279431e-03f, 1.000000047e-03f, 5.623413017e-04f, 3.162277571e-04f, 1.778279402e-04f};
        float* COS = WSP(float, WS_COS); float* SIN = WSP(float, WS_SIN);
        for (int i = F.bid * 512 + tid; i < SEQ * 32; i += F.G * 512) {
            const int pos = i >> 5, j = i & 31, f = j & 15; const float p = (float)(j < 16 ? (pos >> 6) : (pos & 63));
            float fr = 1.f;
#pragma unroll
            for (int q = 0; q < 16; ++q) fr = (f == q) ? invf[q] : fr;
            const float angf = p * fr; const double x = (double)angf;
            const double n = __builtin_rint(x * 0.63661977236758134308);
            const double y = (x - n * 1.57079632679489655800e+00) - n * 6.12323399573676603587e-17;
            const double y2 = y * y;
            double sn = y * (1.0 + y2 * (-1.0 / 6 + y2 * (1.0 / 120 + y2 * (-1.0 / 5040 + y2 * (1.0 / 362880 + y2 * (-1.0 / 39916800 + y2 * (1.0 / 6227020800.0)))))));
            double cs = 1.0 + y2 * (-0.5 + y2 * (1.0 / 24 + y2 * (-1.0 / 720 + y2 * (1.0 / 40320 + y2 * (-1.0 / 3628800 + y2 * (1.0 / 479001600.0 + y2 * (-1.0 / 87178291200.0)))))));
            const int q4 = ((int)n) & 3;
            const double c = (q4 == 0) ? cs : (q4 == 1) ? -sn : (q4 == 2) ? -cs : sn;
            const double s = (q4 == 0) ? sn : (q4 == 1) ? cs : (q4 == 2) ? -sn : -cs;
            COS[i] = (float)c; SIN[i] = (float)s;
        }
    }
    if (PT_SUB == 2) pt1 = __builtin_amdgcn_s_memrealtime();
    {
        LAS float* scr = (LAS float*)(F.lds + wave * 16384);
        constexpr int I_IN0 = 16 * 48, I_OUT = 16 * 32, I_IN1 = 16 * 62, I_UQ = 4 * 24, I_UKV = 2 * 32, I_POOL = 4 * 8, I_MOE = 16 * 384;
        constexpr int NIT = I_IN0 + I_OUT + I_IN1 + I_UQ + I_UKV + I_OUT + I_POOL + I_MOE;
        int it0, it1, step;
        if (F.G == 256) {
            const int wv = F.bid * 8 + wave;
            it0 = F.bid < NMODU ? 0 : (wv - NMODU * 8) * 8; it1 = F.bid < NMODU ? 0 : it0 + 8; if (it1 > NIT) it1 = NIT; if (it0 > NIT) it0 = NIT; step = 1;
            static_assert((256 - NMODU) * 8 * 8 >= NIT, "prologue item split");
        } else { it0 = F.bid * 8 + wave; it1 = NIT; step = F.G * 8; }
        unsigned char* ws_ = F.ws;
        auto item_of = [&](int it) -> TrItem {
            int r = it;
            if (r < I_IN0) {
                const int kb = r / 48, nb = r % 48, n0 = 32 * nb;
                const int drow = n0 < 512 ? (n0 >> 7) * 256 + (n0 & 127) : n0 < 1024 ? ((n0 - 512) >> 7) * 256 + 128 + ((n0 - 512) & 127) : n0;
                return TrItem{A.in[7] + (size_t)(64 * kb) * 1536 + n0, (bf16_t*)(ws_ + WS_WIN0) + (size_t)drow * D + 64 * kb, 1536, D}; }
            r -= I_IN0;
            if (r < I_OUT) return tr_generic(A.in[14], D, D, (bf16_t*)(ws_ + WS_WOUT0), r); r -= I_OUT;
            if (r < I_IN1) return tr_generic(A.in[15], D, 1984, (bf16_t*)(ws_ + WS_WIN1), r); r -= I_IN1;
            if (r < I_UQ) return tr_generic(A.in[17], 256, 768, (bf16_t*)(ws_ + WS_WUQ), r); r -= I_UQ;
            if (r < I_UKV) return tr_generic(A.in[19], 128, 1024, (bf16_t*)(ws_ + WS_WUKV), r); r -= I_UKV;
            if (r < I_OUT) return tr_generic(A.in[24], D, D, (bf16_t*)(ws_ + WS_WOUT1), r); r -= I_OUT;
            if (r < I_POOL) { const int g = r / 8; return tr_generic(A.in[12] + (size_t)g * 128 * 128, 128, 128, (bf16_t*)(ws_ + WS_WPOOL) + (size_t)g * 128 * 128, r % 8); } r -= I_POOL;
            return moe_tr_item(A, ws_, 32 + r / 384, r % 384);
        };
        for (int it = it0; it < it1; it += 4 * step) {
            TrItem t0 = item_of(it), t1 = item_of(it + step < it1 ? it + step : it), t2 = item_of(it + 2 * step < it1 ? it + 2 * step : it), t3 = item_of(it + 3 * step < it1 ? it + 3 * step : it);
            f32x4 v0[8], v1[8], v2[8], v3[8];
            tr_load(t0, v0, lane); tr_load(t1, v1, lane); tr_load(t2, v2, lane); tr_load(t3, v3, lane);
            __builtin_amdgcn_sched_barrier(0);
            tr_finish(t0, v0, scr, lane);
            if (it + step < it1) tr_finish(t1, v1, scr, lane);
            if (it + 2 * step < it1) tr_finish(t2, v2, scr, lane);
            if (it + 3 * step < it1) tr_finish(t3, v3, scr, lane);
        }
        { u32x4* z = (u32x4*)(WSP(bf16_t, WS_WIN1) + (size_t)1984 * 1024); const u32x4 zero = {0u, 0u, 0u, 0u};
          for (int i = F.bid * 512 + tid; i < 64 * 1024 / 8; i += F.G * 512) z[i] = zero; }
    }
}

__device__ __forceinline__ void norm_mod_phase(Frame& F, CArgsRef A, int layer) {
    const int gw = F.bid * 8 + F.wave, NGW = F.G * 8, lane = F.lane;
    const float* g = A.in[6] + (size_t)(layer * 2 + 0) * D;
    const float* MODL = WSP(float, WS_MOD) + (size_t)layer * 9 * (NMOD * D);
    bf16_t* H = WSP(bf16_t, WS_H);
    f32x4 gvec[4];
#pragma unroll
    for (int q = 0; q < 4; ++q) gvec[q] = *(const f32x4*)(g + 4 * lane + 256 * q);
    for (int ta0 = gw; ta0 < NTOK; ta0 += 2 * NGW) {
        const int ta1 = ta0 + NGW; const bool has1 = ta1 < NTOK;
        f32x4 v[2][4], s4[2][4], h4[2][4];
#pragma unroll
        for (int e = 0; e < 2; ++e) { const int ta = e ? (has1 ? ta1 : ta0) : ta0; const int b = ta / TPB, j = ta - b * TPB, mrow = j < CTXL ? 8 : b;
            const float* src = layer == 0 ? (j < CTXL ? A.in[2] + (size_t)(b * CTXL + j) * D : A.in[0] + ((size_t)b * SEQ + (j - CTXL)) * D) : xl_row(F, ta);
            const f32x4* xr = (const f32x4*)src + lane;
            const float* sh = MODL + (size_t)mrow * (NMOD * D); const float* sc = sh + D;
#pragma unroll
            for (int q = 0; q < 4; ++q) { v[e][q] = xr[64 * q]; s4[e][q] = *(const f32x4*)(sc + 4 * lane + 256 * q); h4[e][q] = *(const f32x4*)(sh + 4 * lane + 256 * q); } }
        __builtin_amdgcn_sched_barrier(0);
#pragma unroll
        for (int e = 0; e < 2; ++e) { const int ta = e ? ta1 : ta0; if (e && !has1) break;
            float s = 0.f;
#pragma unroll
            for (int q = 0; q < 4; ++q) s += (v[e][q].x * v[e][q].x + v[e][q].y * v[e][q].y) + (v[e][q].z * v[e][q].z + v[e][q].w * v[e][q].w);
            const float r = 1.f / sqrtf(wave_sum(s) * (1.f / D) + EPS);
            u32x2* o8 = (u32x2*)(H + (size_t)ta * D) + lane;
#pragma unroll
            for (int q = 0; q < 4; ++q) { const f32x4 y = (v[e][q] * r) * gvec[q] * (s4[e][q] + 1.f) + h4[e][q];
                u32x2 w; w.x = cvt_pk_bf16(y.x, y.y); w.y = cvt_pk_bf16(y.z, y.w); o8[64 * q] = w; } }
    }
}

__device__ __forceinline__ void convpool_phase(Frame& F, CArgsRef A, unsigned long long& pt1) {
    const int tid = F.tid, lane = F.lane, wave = F.wave, r32 = lane & 31, hi = lane >> 5;
    const bf16_t* __restrict__ U = WSP(bf16_t, WS_BIG); bf16_t* __restrict__ Y = WSP(bf16_t, WS_YMIX); const bf16_t* __restrict__ WP = WSP(bf16_t, WS_WPOOL);
    {
        LAS bf16_t* GL = (LAS bf16_t*)F.lds;
        LAS float* CV = (LAS float*)(F.lds + 63488);
        const int c0 = wave * 64 + lane;
        float w0[31];
#pragma unroll
        for (int k = 0; k < 31; ++k) w0[k] = A.in[8][k * 512 + c0];
        __builtin_amdgcn_sched_barrier(0);
        const float dwb = A.in[9][c0];
        const f32x4 lg0 = *(const f32x4*)(A.in[10] + 8 * lane), lg1 = *(const f32x4*)(A.in[10] + 8 * lane + 4), lb0 = *(const f32x4*)(A.in[11] + 8 * lane), lb1 = *(const f32x4*)(A.in[11] + 8 * lane + 4);
#define CP_UNIT(u_, b, n, tb, t0, TS) int b, n, tb, t0, TS; if ((u_) < 1024) { b = (u_) >> 7; n = SEQ; tb = b * TPB + CTXL; t0 = ((u_) & 127) * 32; TS = 32; } else { const int uu = (u_) - 1024; b = uu >> 5; n = CTXL; tb = b * TPB; t0 = (uu & 31) * 8; TS = 8; }
#define CPA_LOAD(u_) do { CP_UNIT(u_, b_, n_, tb_, t0_, TS_); const int nG_ = (TS_ + 30) * 64; (void)b_; \
            _Pragma("unroll") for (int q = 0; q < 8; ++q) { const int ch = q * 512 + tid, ri = ch >> 6, c8 = (ch & 63) * 8, pos = t0_ + ri - 15; const bool ok = (ch < nG_) && pos >= 0 && pos < n_; \
                const bf16_t* up = U + (size_t)(tb_ + (ok ? pos : t0_)) * UW + c8; av[q] = *(const u32x4*)up; } } while (0)
        u32x4 av[8];
        if (F.bid < 1280) CPA_LOAD(F.bid);
        for (int u = F.bid; u < 1280; u += F.G) {
            CP_UNIT(u, b, n, tb, t0, TS); (void)b;
            __syncthreads();
            const int nG = (TS + 30) * 64;
#pragma unroll
            for (int q = 0; q < 8; ++q) { const int ch = q * 512 + tid, ri = ch >> 6, c8 = (ch & 63) * 8, pos = t0 + ri - 15; const bool ok = pos >= 0 && pos < n;
                u32x4 o = av[q];
                if (!ok) o = (u32x4){0u, 0u, 0u, 0u};
                if (ch < nG) *(LAS u32x4*)(GL + ri * 512 + c8) = o; }
            __builtin_amdgcn_sched_barrier(0);
            if (u + F.G < 1280) CPA_LOAD(u + F.G);
            __builtin_amdgcn_sched_barrier(0);
            __syncthreads();
#pragma unroll 1
            for (int i0 = 0; i0 < TS; i0 += 4) {
                float x0[4];
#pragma unroll
                for (int q = 0; q < 4; ++q) x0[q] = dwb;
#pragma unroll
                for (int r = 0; r < 34; ++r) { const float g0 = bf2f(*(const LAS unsigned short*)(GL + (i0 + r) * 512 + c0));
#pragma unroll
                    for (int q = 0; q < 4; ++q) { const int k = r - q; if (k >= 0 && k < 31) x0[q] += g0 * w0[k]; } }
#pragma unroll
                for (int q = 0; q < 4; ++q) CV[(i0 + q) * 512 + c0] = x0[q];
            }
            __syncthreads();
            for (int tk = wave; tk < TS; tk += 8) {
                const f32x4 v0 = *(const LAS f32x4*)(CV + tk * 512 + 8 * lane), v1 = *(const LAS f32x4*)(CV + tk * 512 + 8 * lane + 4);
                const float sm = wave_sum((v0.x + v0.y) + (v0.z + v0.w) + (v1.x + v1.y) + (v1.z + v1.w));
                const float mean = sm * (1.f / 512.f);
                const f32x4 d0 = v0 - mean, d1 = v1 - mean;
                const float s2 = wave_sum((d0.x * d0.x + d0.y * d0.y) + (d0.z * d0.z + d0.w * d0.w) + (d1.x * d1.x + d1.y * d1.y) + (d1.z * d1.z + d1.w * d1.w));
                const float rstd = 1.f / sqrtf(s2 * (1.f / 512.f) + EPS);
                const f32x4 y0 = d0 * rstd * lg0 + lb0, y1 = d1 * rstd * lg1 + lb1;
                u32x4 o; o.x = cvt_pk_bf16(siluf_(y0.x), siluf_(y0.y)); o.y = cvt_pk_bf16(siluf_(y0.z), siluf_(y0.w)); o.z = cvt_pk_bf16(siluf_(y1.x), siluf_(y1.y)); o.w = cvt_pk_bf16(siluf_(y1.z), siluf_(y1.w));
                *(u32x4*)(Y + (size_t)(tb + t0 + tk) * D + 8 * lane) = o;
            }
        }
    }
    if (PT_SUB == 4) pt1 = __builtin_amdgcn_s_memrealtime();
    {
        LAS bf16_t* UP = (LAS bf16_t*)F.lds;
        LAS bf16_t* PL = (LAS bf16_t*)(F.lds + 49152);
        bf16x8 wfr[2][8]; float pscv[2];
#pragma unroll
        for (int ntile = 0; ntile < 2; ++ntile) { const int gi = wave >> 1, n0 = (wave & 1) * 64 + ntile * 32; pscv[ntile] = A.in[13][gi * 128 + n0 + r32];
#pragma unroll
            for (int ks = 0; ks < 8; ++ks) wfr[ntile][ks] = *(const bf16x8*)(WP + ((size_t)(gi * 128 + n0 + r32)) * 128 + ks * 16 + hi * 8); }
        __builtin_amdgcn_sched_barrier(0);
#define CPB_LOAD(u_) do { CP_UNIT(u_, b_, n_, tb_, t0_, TS_); const int nU_ = (TS_ + 16) * 64; (void)b_; \
            _Pragma("unroll") for (int q = 0; q < 6; ++q) { const int ch = q * 512 + tid, ri = ch >> 6, c8 = (ch & 63) * 8, pos = t0_ + ri - 8; const bool ok = (ch < nU_) && pos >= 0 && pos < n_; \
                uv[q] = *(const u32x4*)(U + (size_t)(tb_ + (ok ? pos : t0_)) * UW + 512 + c8); if (!ok) uv[q] = (u32x4){0u, 0u, 0u, 0u}; } } while (0)
        u32x4 uv[6];
        if (F.bid < 1280) CPB_LOAD(F.bid);
        for (int u = F.bid; u < 1280; u += F.G) {
            CP_UNIT(u, b, n, tb, t0, TS); (void)b;
            __syncthreads();
            const int nU = (TS + 16) * 64;
#pragma unroll
            for (int q = 0; q < 6; ++q) { const int ch = q * 512 + tid, ri = ch >> 6, c8 = (ch & 63) * 8; if (ch < nU) *(LAS u32x4*)(UP + ri * 512 + c8) = uv[q]; }
            __builtin_amdgcn_sched_barrier(0);
            if (u + F.G < 1280) CPB_LOAD(u + F.G);
            __builtin_amdgcn_sched_barrier(0);
            __syncthreads();
#pragma unroll 1
            for (int e = tid; e < 32 * 64; e += 512) { const int i = e >> 6, c8 = (e & 63) * 8, gi = c8 >> 7, hw = 1 << gi, pos = t0 + i;
                u32x4 o = {0u, 0u, 0u, 0u};
                if (i < TS) {
                    const int lo = (pos - hw) > 0 ? (pos - hw) : 0, hh = (pos + hw) < n ? (pos + hw) : n;
                    float s[8];
#pragma unroll
                    for (int j = 0; j < 8; ++j) s[j] = 0.f;
                    for (int p = lo; p < hh; ++p) { const u32x4 v = *(const LAS u32x4*)(UP + (p - t0 + 8) * 512 + c8);
                        s[0] += bflo(v.x); s[1] += bfhi(v.x); s[2] += bflo(v.y); s[3] += bfhi(v.y); s[4] += bflo(v.z); s[5] += bfhi(v.z); s[6] += bflo(v.w); s[7] += bfhi(v.w); }
                    const float ic = 1.f / (float)(hh - lo);
                    const u32x4 v = *(const LAS u32x4*)(UP + (i + 8) * 512 + c8);
                    o.x = cvt_pk_bf16(s[0] * ic - bflo(v.x), s[1] * ic - bfhi(v.x)); o.y = cvt_pk_bf16(s[2] * ic - bflo(v.y), s[3] * ic - bfhi(v.y));
                    o.z = cvt_pk_bf16(s[4] * ic - bflo(v.z), s[5] * ic - bfhi(v.z)); o.w = cvt_pk_bf16(s[6] * ic - bflo(v.w), s[7] * ic - bfhi(v.w)); }
                *(LAS u32x4*)(PL + i * 512 + c8) = o; }
            __syncthreads();
            {
                const int gi = wave >> 1, nh = wave & 1;
#pragma unroll
                for (int ntile = 0; ntile < 2; ++ntile) { const int n0 = nh * 64 + ntile * 32;
                    f32x16 acc = {};
#pragma unroll
                    for (int ks = 0; ks < 8; ++ks) { const bf16x8 a = *(const LAS bf16x8*)(PL + r32 * 512 + gi * 128 + ks * 16 + hi * 8);
                        acc = __builtin_amdgcn_mfma_f32_32x32x16_bf16(a, wfr[ntile][ks], acc, 0, 0, 0); }
                    const float psc = pscv[ntile];
#pragma unroll
                    for (int r = 0; r < 16; ++r) { const int tk = crow(r, hi); if (tk < TS) Y[(size_t)(tb + t0 + tk) * D + 512 + gi * 128 + n0 + r32] = f2bf(acc[r] * psc); } }
            }
        }
    }
#undef CP_UNIT
#undef CPA_LOAD
#undef CPB_LOAD
    __syncthreads();
}

__device__ __forceinline__ void router_phase(Frame& F, CArgsRef A, int layer) {
    const int tid = F.tid, lane = F.lane, wave = F.wave, r32 = lane & 31, hi = lane >> 5;
    LAS float* T = (LAS float*)F.lds;
    LAS bf16_t* TH = (LAS bf16_t*)F.lds;
    LAS bf16_t* TL = TH + 32 * 1032;
    LAS float* LOG = (LAS float*)(F.lds + 133120);
    LAS float* BIA = (LAS float*)(F.lds + 133120 + 4224);
    const float rbias = A.in[26][tid & 31];
    LAS float* VA = (LAS float*)(F.lds + 141568);
    LAS float* VB = VA + 1024;
    const float* g = A.in[6] + (size_t)(layer * 2 + 1) * D;
    const float* MODL = WSP(float, WS_MOD) + (size_t)layer * 9 * (NMOD * D);
    bf16_t* H = WSP(bf16_t, WS_H);
    unsigned* CNT = F.ctl + CW_CNT + layer * 64; int* LIST = WSP(int, WS_LIST); f32x2* TW = WSP(f32x2, WS_TW);
    bf16x8 rwh[8], rwl[8];
    {
        float rwreg[64];
#pragma unroll
        for (int s = 0; s < 64; ++s) rwreg[s] = A.in[25][(size_t)(128 * wave + 16 * (s >> 3) + 8 * hi + (s & 7)) * NEXP + r32];
        __builtin_amdgcn_sched_barrier(0);
#pragma unroll
        for (int ks = 0; ks < 8; ++ks) { u32x4 wh, wl;
#pragma unroll
            for (int p = 0; p < 4; ++p) { const float a = rwreg[8 * ks + 2 * p], b = rwreg[8 * ks + 2 * p + 1]; const unsigned hh = cvt_pk_bf16(a, b);
                wh[p] = hh; wl[p] = cvt_pk_bf16(a - bflo(hh), b - bfhi(hh)); }
            rwh[ks] = *reinterpret_cast<bf16x8*>(&wh); rwl[ks] = *reinterpret_cast<bf16x8*>(&wl); }
    }
    const int ngroups = layer == 0 ? NTOK / 32 : NLAT / 32;
#define RT_TA0(grp_) (layer == 0 ? (grp_) * 32 : ((grp_) >> 7) * TPB + CTXL + ((grp_) & 127) * 32)
#define RT_LOAD(grp_) do { const int ta0_ = RT_TA0(grp_); \
        _Pragma("unroll") for (int q = 0; q < 4; ++q) { const f32x4* xr = (const f32x4*)xl_row(F, ta0_ + 4 * wave + q) + lane; _Pragma("unroll") for (int c = 0; c < 4; ++c) v[q][c] = xr[64 * c]; } \
        const int b0 = ta0_ / TPB, j0 = ta0_ - b0 * TPB, mrow = j0 < CTXL ? 8 : b0; const float* sh = MODL + (size_t)mrow * (NMOD * D) + 3 * D; const float* sc = sh + D; \
        g2 = *(const f32x2*)(g + 2 * tid); s2 = *(const f32x2*)(sc + 2 * tid); h2 = *(const f32x2*)(sh + 2 * tid); } while (0)
    f32x4 v[4][4]; f32x2 g2, s2, h2;
    if (F.bid < ngroups) RT_LOAD(F.bid);
    for (int grp = F.bid; grp < ngroups; grp += F.G) {
        const int ta0 = RT_TA0(grp);
        __syncthreads();
        {
            *(LAS f32x2*)(VA + 2 * tid) = g2 * (s2 + 1.f); *(LAS f32x2*)(VB + 2 * tid) = h2;
            float rr[4];
#pragma unroll
            for (int q = 0; q < 4; ++q) { float s = 0.f;
#pragma unroll
                for (int c = 0; c < 4; ++c) s += (v[q][c].x * v[q][c].x + v[q][c].y * v[q][c].y) + (v[q][c].z * v[q][c].z + v[q][c].w * v[q][c].w);
                rr[q] = 1.f / sqrtf(wave_sum(s) * (1.f / D) + EPS); }
            __syncthreads();
#pragma unroll
            for (int q = 0; q < 4; ++q) { const int ti = 4 * wave + q, ta = ta0 + ti;
                u32x2* o8 = (u32x2*)(H + (size_t)ta * D) + lane;
#pragma unroll
                for (int c = 0; c < 4; ++c) { const int col = 4 * lane + 256 * c;
                    const f32x4 a4 = *(const LAS f32x4*)(VA + col), b4 = *(const LAS f32x4*)(VB + col);
                    const f32x4 y = (v[q][c] * rr[q]) * a4 + b4;
                    u32x2 w; w.x = cvt_pk_bf16(y.x, y.y); w.y = cvt_pk_bf16(y.z, y.w); o8[64 * c] = w;
                    u32x2 wl; wl.x = cvt_pk_bf16(y.x - bflo(w.x), y.y - bfhi(w.x)); wl.y = cvt_pk_bf16(y.z - bflo(w.y), y.w - bfhi(w.y));
                    *(LAS u32x2*)(TH + ti * 1032 + col) = w; *(LAS u32x2*)(TL + ti * 1032 + col) = wl; } }
            __builtin_amdgcn_sched_barrier(0);
            if (grp + F.G < ngroups) RT_LOAD(grp + F.G);
            __builtin_amdgcn_sched_barrier(0);
        }
        __syncthreads();
        f32x16 acc = {};
#pragma unroll
        for (int ks = 0; ks < 8; ++ks) { const bf16x8 ah = *(const LAS bf16x8*)(TH + r32 * 1032 + 128 * wave + 16 * ks + 8 * hi), al = *(const LAS bf16x8*)(TL + r32 * 1032 + 128 * wave + 16 * ks + 8 * hi);
            acc = __builtin_amdgcn_mfma_f32_32x32x16_bf16(ah, rwh[ks], acc, 0, 0, 0); acc = __builtin_amdgcn_mfma_f32_32x32x16_bf16(ah, rwl[ks], acc, 0, 0, 0); acc = __builtin_amdgcn_mfma_f32_32x32x16_bf16(al, rwh[ks], acc, 0, 0, 0); }
        __syncthreads();
        { LAS float* RED = T + wave * (32 * 33);
#pragma unroll
          for (int r = 0; r < 16; ++r) RED[crow(r, hi) * 33 + r32] = acc[r]; }
        __syncthreads();
        for (int e = tid; e < 1024; e += 512) { const int tk = e >> 5, ex = e & 31; float s = 0.f;
#pragma unroll
            for (int w = 0; w < 8; ++w) s += T[w * (32 * 33) + tk * 33 + ex];
            const float sg = __builtin_amdgcn_rcpf(1.f + __expf(-s));
            LOG[tk * 33 + ex] = sg; BIA[tk * 33 + ex] = sg + rbias; }
        __syncthreads();
        if (tid < 32) { const int ta = ta0 + tid;
            float bestg = -1e30f, bs1 = 0.f, bs2 = 0.f; int bi1 = 0, bi2 = 1, bgrp = 0;
#pragma unroll
            for (int gq = 0; gq < 8; ++gq) { float sc[4], bb[4];
#pragma unroll
                for (int q = 0; q < 4; ++q) { sc[q] = LOG[tid * 33 + gq * 4 + q]; bb[q] = BIA[tid * 33 + gq * 4 + q]; }
                int i1 = 0; float m1 = bb[0];
#pragma unroll
                for (int q = 1; q < 4; ++q) if (bb[q] > m1) { m1 = bb[q]; i1 = q; }
                int i2 = -1; float m2 = -1e30f;
#pragma unroll
                for (int q = 0; q < 4; ++q) if (q != i1 && bb[q] > m2) { m2 = bb[q]; i2 = q; }
                const float gs = m1 + m2;
                float s1 = sc[0], s2 = sc[0];
#pragma unroll
                for (int q = 1; q < 4; ++q) { s1 = (i1 == q) ? sc[q] : s1; s2 = (i2 == q) ? sc[q] : s2; }
                if (gs > bestg) { bestg = gs; bgrp = gq; bi1 = i1; bi2 = i2; bs1 = s1; bs2 = s2; } }
            const float inv = 1.f / (bs1 + bs2); const float w1 = bs1 * inv, w2 = bs2 * inv;
            const int lo = bi1 < bi2 ? bi1 : bi2, hh = bi1 < bi2 ? bi2 : bi1;
            const float wlo = bi1 < bi2 ? w1 : w2, whi = bi1 < bi2 ? w2 : w1;
            const int pair = (lo == 0) ? (hh - 1) : (lo == 1 ? (hh + 1) : 5);
            const int bucket = bgrp * 6 + pair;
            const unsigned pos = atomicAdd(&CNT[bucket], 1u);
            LIST[(size_t)bucket * LCAP + pos] = ta; TW[ta] = (f32x2){wlo, whi}; }
    }
    __syncthreads();
}

#undef RT_TA0
#undef RT_LOAD
struct MoeSched {
    static constexpr bool GATHER_ = true;
    int G, c, ntiles, layer, stage; const unsigned* cnt; const int* list; const char* A; const char* W; LAS int* pre;
};
template <bool G1> struct MoeSchedT {
    static constexpr bool GATHER = G1;
    MoeSched m;
    __device__ __forceinline__ bool next(int i, pg8::Unit& u) const {
        const int L = i * m.G + m.c; if (L >= m.ntiles * 4) return false;
        const int tile = L >> 2, pn = L & 3;
        int bk = 0;
        for (int q = 1; q < NBUCK; ++q) bk = (m.pre[q] <= tile) ? q : bk;
        const int tin = tile - m.pre[bk], cntb = (int)m.cnt[bk];
        const int grp = bk / 6, pair = bk % 6;
        const int lo = pair < 3 ? 0 : (pair < 5 ? 1 : 2), hh = pair < 3 ? pair + 1 : (pair < 5 ? pair - 1 : 3);
        const int e1 = grp * 4 + lo, e2 = grp * 4 + hh;
        u.pm = tile; u.po = tile; u.pn = pn; u.rows = m.list + (size_t)bk * LCAP + tin * 256; u.nvalid = (cntb - tin * 256) < 256 ? (cntb - tin * 256) : 256; u.aux = pn >> 1;
        if (G1) {
            const int e = (pn < 2) ? e1 : e2;
            u.A = m.A; u.B = m.W + ((size_t)(m.layer * NEXP + e) * 512 + (pn & 1) * 256) * 1024 * 2; u.B2 = u.B;
        } else {
            u.A = m.A + (size_t)tile * 256 * 512 * 2;
            u.B = m.W + ((size_t)(m.layer * NEXP + e1) * 1024 + pn * 256) * 256 * 2;
            u.B2 = m.W + ((size_t)(m.layer * NEXP + e2) * 1024 + pn * 256) * 256 * 2 - (size_t)4 * 128;
        }
        return true;
    }
};
struct EpiMoe1 {
    bf16_t* HE; const f32x2* TW;
    __device__ __forceinline__ void operator()(const f32x4 (&acc)[2][2][4][2], const pg8::Unit& u, int wr, int wc, int fr, int fq) const {
        const int slot = u.aux;
        int tok[8]; f32x2 tw[8];
#pragma unroll
        for (int q = 0; q < 8; ++q) { const int r = (q >> 2) * 128 + wr * 64 + (q & 3) * 16 + fr; tok[q] = u.rows[r < u.nvalid ? r : 0]; }
        __builtin_amdgcn_sched_barrier(0);
#pragma unroll
        for (int q = 0; q < 8; ++q) tw[q] = TW[tok[q]];
        __builtin_amdgcn_sched_barrier(0);
#pragma unroll
        for (int ai = 0; ai < 2; ++ai)
#pragma unroll
            for (int m = 0; m < 4; ++m) { const int r = ai * 128 + wr * 64 + m * 16 + fr; const float w = slot ? tw[ai * 4 + m].y : tw[ai * 4 + m].x;
                float o[8];
#pragma unroll
                for (int n = 0; n < 2; ++n)
#pragma unroll
                    for (int q = 0; q < 4; ++q) { const float gt = acc[ai][0][m][n][q], up = acc[ai][1][m][n][q]; o[4 * n + q] = gt * __builtin_amdgcn_rcpf(1.f + __expf(-gt)) * up * w; }
                u32x4 wv; wv.x = cvt_pk_bf16(o[0], o[1]); wv.y = cvt_pk_bf16(o[2], o[3]); wv.z = cvt_pk_bf16(o[4], o[5]); wv.w = cvt_pk_bf16(o[6], o[7]);
                *(u32x4*)(HE + (size_t)(u.po * 256 + r) * 512 + slot * 256 + (u.pn & 1) * 128 + wc * 32 + 8 * fq) = wv; }
    }
};
struct EpiMoe2 {
    float* out; float* xc; const float* modl;
    __device__ __forceinline__ void operator()(const f32x4 (&acc)[2][2][4][2], const pg8::Unit& u, int wr, int wc, int fr, int fq) const {
        const int col0 = u.pn * 256 + wc * 32 + 8 * fq;
        int tok[8];
#pragma unroll
        for (int q = 0; q < 8; ++q) { const int r = (q >> 2) * 128 + wr * 64 + (q & 3) * 16 + fr; tok[q] = u.rows[r < u.nvalid ? r : 0]; }
        __builtin_amdgcn_sched_barrier(0);
#pragma unroll
        for (int ai = 0; ai < 2; ++ai)
#pragma unroll
        for (int mp = 0; mp < 2; ++mp) {
            f32x4 sv[2][2][2]; float* dp[2]; const float* gp[2];
#pragma unroll
            for (int mm = 0; mm < 2; ++mm) { const int m = mp * 2 + mm; const int tk = tok[ai * 4 + m]; const int b = tk / TPB, j = tk - b * TPB; const int mrow = j < CTXL ? 8 : b;
                gp[mm] = modl + (size_t)mrow * (NMOD * D) + 5 * D + col0;
                dp[mm] = (j < CTXL ? xc + (size_t)(b * CTXL + j) * D : out + ((size_t)b * SEQ + (j - CTXL)) * D) + col0;
#pragma unroll
                for (int bj = 0; bj < 2; ++bj)
#pragma unroll
                    for (int n = 0; n < 2; ++n) sv[mm][bj][n] = *(const f32x4*)(dp[mm] + bj * 128 + 4 * n); }
            __builtin_amdgcn_sched_barrier(0);
#pragma unroll
            for (int mm = 0; mm < 2; ++mm) { const int m = mp * 2 + mm; const int r = ai * 128 + wr * 64 + m * 16 + fr;
                if (r < u.nvalid) {
#pragma unroll
                    for (int bj = 0; bj < 2; ++bj)
#pragma unroll
                        for (int n = 0; n < 2; ++n) { const f32x4 gvv = *(const f32x4*)(gp[mm] + bj * 128 + 4 * n); *(f32x4*)(dp[mm] + bj * 128 + 4 * n) = sv[mm][bj][n] + gvv * acc[ai][bj][m][n]; } } }
            __builtin_amdgcn_sched_barrier(0);
        }
    }
};
__device__ __forceinline__ int moe_prefix(Frame& F, int layer, LAS int* pre) {
    __syncthreads();
    if (F.tid == 0) { int s = 0; const unsigned* cnt = F.ctl + CW_CNT + layer * 64; for (int q = 0; q < NBUCK; ++q) { pre[q] = s; s += ((int)cnt[q] + 255) >> 8; } pre[NBUCK] = s; }
    __syncthreads();
    return pre[NBUCK];
}

__device__ __forceinline__ void p9_phase(Frame& F, CArgsRef A) {
    const int gw = F.bid * 8 + F.wave, NGW = F.G * 8, l = F.lane;
    bf16_t* P = WSP(bf16_t, WS_BIG); const float* COS = WSP(float, WS_COS); const float* SIN = WSP(float, WS_SIN);
    const int kind = l < 8 ? 0 : l < 24 ? 1 : l < 28 ? 2 : l < 30 ? 5 : l < 46 ? 3 : 5;
    float gg[32];
    {
        const float* gp = nullptr;
        if (kind == 0) gp = A.in[16] + 32 * l; else if (kind == 1) gp = A.in[21] + 0 * 64 + (l & 1) * 32; else if (kind == 2) gp = A.in[18] + 32 * (l - 24); else if (kind == 3) gp = A.in[21] + 1 * 64 + (l & 1) * 32;
#pragma unroll
        for (int j = 0; j < 32; ++j) gg[j] = gp ? gp[j] : 1.f;
        __builtin_amdgcn_sched_barrier(0);
    }
    for (int tb0 = gw; tb0 < NTOK; tb0 += 2 * NGW) {
        const int tb1 = tb0 + NGW; const bool has1 = tb1 < NTOK;
        u32x4 wq[2][4]; f32x4 csv[2][8], snv[2][8];
#pragma unroll
        for (int e = 0; e < 2; ++e) { const int ta = e ? (has1 ? tb1 : tb0) : tb0; const bf16_t* rp = P + (size_t)ta * PW + 32 * l;
            const int b_ = ta / TPB, jj_ = ta - b_ * TPB; const int pos_ = jj_ >= CTXL ? jj_ - CTXL : 0;
            const f32x4* cp = (const f32x4*)(COS + (size_t)pos_ * 32); const f32x4* sp = (const f32x4*)(SIN + (size_t)pos_ * 32);
            const bool need = (kind == 2 || kind == 3) || ((kind == 0 || kind == 1) && jj_ >= CTXL);
            const bool nrope = (kind == 1 || kind == 3) && jj_ >= CTXL;
#pragma unroll
            for (int q = 0; q < 4; ++q) { wq[e][q] = (u32x4){0u, 0u, 0u, 0u}; if (need) wq[e][q] = *(const u32x4*)(rp + 8 * q); }
#pragma unroll
            for (int q = 0; q < 8; ++q) { csv[e][q] = (f32x4){1.f, 1.f, 1.f, 1.f}; snv[e][q] = (f32x4){0.f, 0.f, 0.f, 0.f}; if (nrope) { csv[e][q] = cp[q]; snv[e][q] = sp[q]; } } }
        __builtin_amdgcn_sched_barrier(0);
#pragma unroll
        for (int e = 0; e < 2; ++e) {
            const int ta = e ? tb1 : tb0; if (e && !has1) break;
            const int b = ta / TPB, jj = ta - b * TPB; const bool lat = jj >= CTXL; const int pos = jj - CTXL;
            bf16_t* rowp = P + (size_t)ta * PW + 32 * l;
            float v[32]; float ss = 0.f;
#pragma unroll
            for (int q = 0; q < 4; ++q)
#pragma unroll
                for (int c = 0; c < 4; ++c) { v[8 * q + 2 * c] = bflo(wq[e][q][c]); v[8 * q + 2 * c + 1] = bfhi(wq[e][q][c]); }
#pragma unroll
            for (int j = 0; j < 32; ++j) ss += v[j] * v[j];
            const float s1 = ss + __shfl_xor(ss, 1), s2 = s1 + __shfl_xor(s1, 2), s4 = s2 + __shfl_xor(s2, 4);
            const float tot = kind == 0 ? s4 : kind == 2 ? s2 : s1;
            const float nn = kind == 0 ? 256.f : kind == 2 ? 128.f : 64.f;
            const float r = 1.f / sqrtf(tot / nn + EPS);
            const bool act = (kind == 0 && lat) || (kind == 1 && lat) || kind == 2 || kind == 3;
#pragma unroll
            for (int j = 0; j < 32; ++j) v[j] = v[j] * r * gg[j];
            const bool rope = (kind == 1 || kind == 3) && lat;
            {
#pragma unroll
                for (int j4 = 0; j4 < 8; ++j4) { const f32x4 cs4 = csv[e][j4], sn4 = snv[e][j4];
#pragma unroll
                    for (int c = 0; c < 4; ++c) { const int j = 4 * j4 + c; const float other = __shfl_xor(v[j], 1); const float cs = cs4[c], sn = sn4[c];
                        const float rv = (l & 1) ? (v[j] * cs + other * sn) : (v[j] * cs - other * sn);
                        v[j] = rope ? rv : v[j]; } }
            }
            if (act) {
#pragma unroll
                for (int q = 0; q < 4; ++q) { u32x4 o; o.x = cvt_pk_bf16(v[8 * q], v[8 * q + 1]); o.y = cvt_pk_bf16(v[8 * q + 2], v[8 * q + 3]); o.z = cvt_pk_bf16(v[8 * q + 4], v[8 * q + 5]); o.w = cvt_pk_bf16(v[8 * q + 6], v[8 * q + 7]);
                    *(u32x4*)(rowp + 8 * q) = o; }
            }
        }
    }
}

__device__ __forceinline__ void p11_phase(Frame& F, CArgsRef A) {
    const int gw = F.bid * 8 + F.wave, NGW = F.G * 8, l = F.lane, h = l >> 4, j = l & 15;
    const bf16_t* __restrict__ P = WSP(bf16_t, WS_BIG); bf16_t* __restrict__ QM = WSP(bf16_t, WS_QM); bf16_t* __restrict__ KM = WSP(bf16_t, WS_KM); const bf16_t* __restrict__ KV = WSP(bf16_t, WS_H);
    const float* __restrict__ COS = WSP(float, WS_COS); const float* __restrict__ SIN = WSP(float, WS_SIN);
#define P11_BODY(wa, wb, DST, GP, DOROPE, CSV, SNV) do { \
        float v[12]; \
        _Pragma("unroll") for (int c = 0; c < 4; ++c) { v[2 * c] = bflo(wa[c]); v[2 * c + 1] = bfhi(wa[c]); } \
        v[8] = bflo(wb.x); v[9] = bfhi(wb.x); v[10] = bflo(wb.y); v[11] = bfhi(wb.y); \
        float ss = 0.f; \
        _Pragma("unroll") for (int c = 0; c < 12; ++c) ss += v[c] * v[c]; \
        ss += __shfl_xor(ss, 1); ss += __shfl_xor(ss, 2); ss += __shfl_xor(ss, 4); ss += __shfl_xor(ss, 8); \
        const float r = 1.f / sqrtf(ss * (1.f / 192.f) + EPS); \
        const f32x4 ga = GP##a, gb = GP##b, gc = GP##c; \
        v[0] *= r * ga.x; v[1] *= r * ga.y; v[2] *= r * ga.z; v[3] *= r * ga.w; v[4] *= r * gb.x; v[5] *= r * gb.y; v[6] *= r * gb.z; v[7] *= r * gb.w; \
        v[8] *= r * gc.x; v[9] *= r * gc.y; v[10] *= r * gc.z; v[11] *= r * gc.w; \
        const f32x4 cs = CSV, sn = SNV; \
        _Pragma("unroll") for (int c = 0; c < 4; ++c) { const float other = __shfl_xor(v[8 + c], 8); const float rv = (j < 8) ? (v[8 + c] * cs[c] - other * sn[c]) : (v[8 + c] * cs[c] + other * sn[c]); v[8 + c] = (DOROPE) ? rv : v[8 + c]; } \
        u32x4 oa; oa.x = cvt_pk_bf16(v[0], v[1]); oa.y = cvt_pk_bf16(v[2], v[3]); oa.z = cvt_pk_bf16(v[4], v[5]); oa.w = cvt_pk_bf16(v[6], v[7]); \
        u32x2 ob; ob.x = cvt_pk_bf16(v[8], v[9]); ob.y = cvt_pk_bf16(v[10], v[11]); \
        *(u32x4*)((DST) + 8 * j) = oa; *(u32x2*)((DST) + 128 + 4 * j) = ob; } while (0)
    const f32x4 gqa = *(const f32x4*)(A.in[20] + 8 * j), gqb = *(const f32x4*)(A.in[20] + 8 * j + 4), gqc = *(const f32x4*)(A.in[20] + 128 + 4 * j);
    const f32x4 gka = *(const f32x4*)(A.in[20] + 192 + 8 * j), gkb = *(const f32x4*)(A.in[20] + 192 + 8 * j + 4), gkc = *(const f32x4*)(A.in[20] + 192 + 128 + 4 * j);
    constexpr int NB4 = 4;
    for (int t0 = gw; t0 < NLAT; t0 += NB4 * NGW) {
        u32x4 wa[NB4]; u32x2 wb[NB4]; f32x4 cv[NB4], sv[NB4];
#pragma unroll
        for (int e = 0; e < NB4; ++e) { const int tl = (t0 + e * NGW) < NLAT ? (t0 + e * NGW) : t0; const bf16_t* q = QM + (size_t)tl * 768 + h * 192; wa[e] = *(const u32x4*)(q + 8 * j); wb[e] = *(const u32x2*)(q + 128 + 4 * j);
            const int pos = tl & (SEQ - 1); cv[e] = *(const f32x4*)(COS + (size_t)pos * 32 + 4 * (j & 7)); sv[e] = *(const f32x4*)(SIN + (size_t)pos * 32 + 4 * (j & 7)); }
        __builtin_amdgcn_sched_barrier(0);
#pragma unroll
        for (int e = 0; e < NB4; ++e) { const int tl = t0 + e * NGW; if (tl < NLAT) { bf16_t* q = QM + (size_t)tl * 768 + h * 192;
            P11_BODY(wa[e], wb[e], q, gq, true, cv[e], sv[e]); } }
    }
    for (int t0 = gw; t0 < NTOK; t0 += NB4 * NGW) {
        u32x4 wa[NB4]; u32x2 wb[NB4]; f32x4 cv[NB4], sv[NB4];
#pragma unroll
        for (int e = 0; e < NB4; ++e) { const int ta = (t0 + e * NGW) < NTOK ? (t0 + e * NGW) : t0; wa[e] = *(const u32x4*)(KV + (size_t)ta * 1024 + h * 256 + 8 * j); wb[e] = *(const u32x2*)(P + (size_t)ta * PW + PC_KROPE + 4 * j);
            const int b_ = ta / TPB, jj_ = ta - b_ * TPB; const int pos = jj_ >= CTXL ? jj_ - CTXL : 0; cv[e] = *(const f32x4*)(COS + (size_t)pos * 32 + 4 * (j & 7)); sv[e] = *(const f32x4*)(SIN + (size_t)pos * 32 + 4 * (j & 7)); }
        __builtin_amdgcn_sched_barrier(0);
#pragma unroll
        for (int e = 0; e < NB4; ++e) { const int ta = t0 + e * NGW; if (ta < NTOK) { const int b = ta / TPB, jj = ta - b * TPB; const bool lat = jj >= CTXL;
            bf16_t* k = KM + ((size_t)(b * 4 + h) * TPB + jj) * 192;
            P11_BODY(wa[e], wb[e], k, gk, lat, cv[e], sv[e]); } }
    }
#undef P11_BODY
}

#define SBAR() __builtin_amdgcn_sched_barrier(0)
__device__ __forceinline__ void partialSM(f32x16& p0, f32x16& p1, float& m_reg, float& mn, float& alpha, const float C, const float thr) {
    float pmax = p0[0];
#pragma unroll
    for (int r = 1; r < 16; ++r) pmax = fmaxf(pmax, p0[r]);
#pragma unroll
    for (int r = 0; r < 16; ++r) pmax = fmaxf(pmax, p1[r]);
    { auto rr = __builtin_amdgcn_permlane32_swap(__float_as_uint(pmax), __float_as_uint(pmax), false, false);
      pmax = fmaxf(__uint_as_float(rr[0]), __uint_as_float(rr[1])); }
    if (__builtin_expect(__all(pmax - m_reg <= thr), 1)) { mn = m_reg; alpha = 1.f; }
    else { mn = fmaxf(m_reg, pmax); alpha = __builtin_amdgcn_exp2f((m_reg - mn) * C); m_reg = mn; }
    const float mnC = -mn * C;
#pragma unroll
    for (int r = 0; r < 16; ++r) p0[r] = fmaf(p0[r], C, mnC);
#pragma unroll
    for (int r = 0; r < 16; ++r) p1[r] = fmaf(p1[r], C, mnC);
#pragma unroll
    for (int r = 0; r < 16; ++r) p0[r] = __builtin_amdgcn_exp2f(p0[r]);
}
__device__ __forceinline__ void finishSM(f32x16& p0, f32x16& p1, float alpha, float& l_reg, bf16x8& pa0, bf16x8& pa1, bf16x8& pa2, bf16x8& pa3) {
#pragma unroll
    for (int r = 0; r < 16; ++r) p1[r] = __builtin_amdgcn_exp2f(p1[r]);
    float ps = 0;
#pragma unroll
    for (int r = 0; r < 16; ++r) ps += p0[r];
#pragma unroll
    for (int r = 0; r < 16; ++r) ps += p1[r];
    { auto rr = __builtin_amdgcn_permlane32_swap(__float_as_uint(ps), __float_as_uint(ps), false, false);
      ps = __uint_as_float(rr[0]) + __uint_as_float(rr[1]); }
    l_reg = l_reg * alpha + ps;
#define PK4(P, BASE, OUT) do { unsigned a0 = cvt_pk_bf16(P[BASE + 0], P[BASE + 1]), a1 = cvt_pk_bf16(P[BASE + 2], P[BASE + 3]);   \
    unsigned b0 = cvt_pk_bf16(P[BASE + 4], P[BASE + 5]), b1 = cvt_pk_bf16(P[BASE + 6], P[BASE + 7]);                              \
    auto r0 = __builtin_amdgcn_permlane32_swap(a0, b0, false, false); auto r1 = __builtin_amdgcn_permlane32_swap(a1, b1, false, false); \
    u32x4 w = {r0[0], r1[0], r0[1], r1[1]}; OUT = *reinterpret_cast<bf16x8*>(&w); } while (0)
    PK4(p0, 0, pa0); PK4(p0, 8, pa1); PK4(p1, 0, pa2); PK4(p1, 8, pa3);
#undef PK4
}
__device__ __forceinline__ void partialSM_fs(f32x16& p0, f32x16& p1, const float C, const float nBC) {
#pragma unroll
    for (int r = 0; r < 16; ++r) p0[r] = fmaf(p0[r], C, nBC);
#pragma unroll
    for (int r = 0; r < 16; ++r) p1[r] = fmaf(p1[r], C, nBC);
#pragma unroll
    for (int r = 0; r < 16; ++r) p0[r] = __builtin_amdgcn_exp2f(p0[r]);
}
__device__ __forceinline__ void finishSM_fs(f32x16& p0, f32x16& p1, float& l_reg, bf16x8& pa0, bf16x8& pa1, bf16x8& pa2, bf16x8& pa3) {
#pragma unroll
    for (int r = 0; r < 16; ++r) p1[r] = __builtin_amdgcn_exp2f(p1[r]);
    float ps = 0;
#pragma unroll
    for (int r = 0; r < 16; ++r) ps += p0[r];
#pragma unroll
    for (int r = 0; r < 16; ++r) ps += p1[r];
    l_reg += ps;
#define PK4(P, BASE, OUT) do { unsigned a0 = cvt_pk_bf16(P[BASE + 0], P[BASE + 1]), a1 = cvt_pk_bf16(P[BASE + 2], P[BASE + 3]);   \
    unsigned b0 = cvt_pk_bf16(P[BASE + 4], P[BASE + 5]), b1 = cvt_pk_bf16(P[BASE + 6], P[BASE + 7]);                              \
    auto r0 = __builtin_amdgcn_permlane32_swap(a0, b0, false, false); auto r1 = __builtin_amdgcn_permlane32_swap(a1, b1, false, false); \
    u32x4 w = {r0[0], r1[0], r0[1], r1[1]}; OUT = *reinterpret_cast<bf16x8*>(&w); } while (0)
    PK4(p0, 0, pa0); PK4(p0, 8, pa1); PK4(p1, 0, pa2); PK4(p1, 8, pa3);
#undef PK4
}
__device__ __forceinline__ int v_st(int k, int c) { const int kk = (k & ~0xC) | ((k & 4) << 1) | ((k & 8) >> 1); return ((kk >> 3) * 4 + (c >> 5)) * 512 + ((kk & 7) * 32 + (c & 31)) * 2; }
__device__ __forceinline__ int v_rd_base(int lane) { return ((lane & 3) << 3) | (((lane >> 2) & 3) << 6) | (((lane >> 4) & 1) << 5) | (((lane >> 5) & 1) << 8); }
constexpr int v_rd_off(int d0, int ks, int half) { return d0 * 512 + ks * 4096 + half * 2048; }
template <int OFF> __device__ __forceinline__ s16x4 tr_read(int vb) {
    s16x4 r; asm volatile("ds_read_b64_tr_b16 %0, %1 offset:%2" : "=&v"(r) : "v"(vb), "i"(OFF) : "memory"); return r;
}
template <int D0> __device__ __forceinline__ void pv_one(f32x16& od, int vb, bf16x8 pa0, bf16x8 pa1, bf16x8 pa2, bf16x8 pa3) {
    const s16x4 l0 = tr_read<v_rd_off(D0, 0, 0)>(vb), h0 = tr_read<v_rd_off(D0, 0, 1)>(vb), l1 = tr_read<v_rd_off(D0, 1, 0)>(vb), h1 = tr_read<v_rd_off(D0, 1, 1)>(vb);
    const s16x4 l2 = tr_read<v_rd_off(D0, 2, 0)>(vb), h2 = tr_read<v_rd_off(D0, 2, 1)>(vb), l3 = tr_read<v_rd_off(D0, 3, 0)>(vb), h3 = tr_read<v_rd_off(D0, 3, 1)>(vb);
    asm volatile("s_waitcnt lgkmcnt(0)" ::: "memory"); SBAR();
#define PK(L, H) (bf16x8){L[0], L[1], L[2], L[3], H[0], H[1], H[2], H[3]}
    od = __builtin_amdgcn_mfma_f32_32x32x16_bf16(pa0, PK(l0, h0), od, 0, 0, 0);
    od = __builtin_amdgcn_mfma_f32_32x32x16_bf16(pa1, PK(l1, h1), od, 0, 0, 0);
    od = __builtin_amdgcn_mfma_f32_32x32x16_bf16(pa2, PK(l2, h2), od, 0, 0, 0);
    od = __builtin_amdgcn_mfma_f32_32x32x16_bf16(pa3, PK(l3, h3), od, 0, 0, 0);
#undef PK
}
__device__ __forceinline__ void pv_d0(f32x16* o, int vb, bf16x8 pa0, bf16x8 pa1, bf16x8 pa2, bf16x8 pa3) {
    pv_one<0>(o[0], vb, pa0, pa1, pa2, pa3); pv_one<1>(o[1], vb, pa0, pa1, pa2, pa3); pv_one<2>(o[2], vb, pa0, pa1, pa2, pa3); pv_one<3>(o[3], vb, pa0, pa1, pa2, pa3);
}

#define PV_READS(D0, L0, H0, L1, H1, L2, H2, L3, H3) do { L0 = tr_read<v_rd_off(D0, 0, 0)>(vb); H0 = tr_read<v_rd_off(D0, 0, 1)>(vb); L1 = tr_read<v_rd_off(D0, 1, 0)>(vb); H1 = tr_read<v_rd_off(D0, 1, 1)>(vb); \
    L2 = tr_read<v_rd_off(D0, 2, 0)>(vb); H2 = tr_read<v_rd_off(D0, 2, 1)>(vb); L3 = tr_read<v_rd_off(D0, 3, 0)>(vb); H3 = tr_read<v_rd_off(D0, 3, 1)>(vb); } while (0)
#define PV_PK(L, H) (bf16x8){L[0], L[1], L[2], L[3], H[0], H[1], H[2], H[3]}
#define PV_MMA(OD, L0, H0, L1, H1, L2, H2, L3, H3) do { OD = __builtin_amdgcn_mfma_f32_32x32x16_bf16(pa0, PV_PK(L0, H0), OD, 0, 0, 0); OD = __builtin_amdgcn_mfma_f32_32x32x16_bf16(pa1, PV_PK(L1, H1), OD, 0, 0, 0); \
    OD = __builtin_amdgcn_mfma_f32_32x32x16_bf16(pa2, PV_PK(L2, H2), OD, 0, 0, 0); OD = __builtin_amdgcn_mfma_f32_32x32x16_bf16(pa3, PV_PK(L3, H3), OD, 0, 0, 0); } while (0)
__device__ __forceinline__ void pv_d0_pipe(f32x16* o, int vb, bf16x8 pa0, bf16x8 pa1, bf16x8 pa2, bf16x8 pa3) {
    s16x4 a0, a1, a2, a3, a4, a5, a6, a7, b0, b1, b2, b3, b4, b5, b6, b7;
    PV_READS(0, a0, a1, a2, a3, a4, a5, a6, a7);
    PV_READS(1, b0, b1, b2, b3, b4, b5, b6, b7);
    asm volatile("s_waitcnt lgkmcnt(8)" ::: "memory"); SBAR();
    PV_MMA(o[0], a0, a1, a2, a3, a4, a5, a6, a7); SBAR();
    PV_READS(2, a0, a1, a2, a3, a4, a5, a6, a7);
    asm volatile("s_waitcnt lgkmcnt(8)" ::: "memory"); SBAR();
    PV_MMA(o[1], b0, b1, b2, b3, b4, b5, b6, b7); SBAR();
    PV_READS(3, b0, b1, b2, b3, b4, b5, b6, b7);
    asm volatile("s_waitcnt lgkmcnt(8)" ::: "memory"); SBAR();
    PV_MMA(o[2], a0, a1, a2, a3, a4, a5, a6, a7); SBAR();
    asm volatile("s_waitcnt lgkmcnt(0)" ::: "memory"); SBAR();
    PV_MMA(o[3], b0, b1, b2, b3, b4, b5, b6, b7);
}

template <int DK, int LDQ, int LDK, int LDV, int SDEPTH, int NQL, bool FS, bool PVP, int ABL = 0>
__device__ __forceinline__ void attn_body(const int tid, const bf16_t* __restrict__ Qb, const bf16_t* __restrict__ Kh, const bf16_t* __restrict__ Vh, const int seq, char* lds,
                                          const float C, const float thr, f32x16 (&o)[4], float& l_out) {
    constexpr int RB = DK * 2, SHM_V = 64 * 256, SHM_K = 64 * RB, CPR = DK / 8, NKC = CPR / 8, ND0 = DK / 16, NQR = ND0 - NQL, QTB = NQL * 32;
#define KSWZ(row, colB) ((row) * RB + ((colB) ^ ((((row) >> 1) & 7) << 4)))
    const int wid = tid >> 6, lane = tid & 63, r32 = lane & 31, hi = lane >> 5;
    char* V_lds = lds; char* K_lds = lds + 2 * SHM_V;
    float* ws = (float*)(lds + 2 * SHM_V + 2 * SHM_K) + wid * 64; float* al_l = ws + 32;
    char* Qt = lds + 2 * SHM_V + 2 * SHM_K + 2048 + wid * (32 * (QTB > 0 ? QTB : 1));
    float m_reg = -1e30f, l_reg = 0;
#pragma unroll
    for (int d = 0; d < 4; ++d) o[d] = f32x16{};
    bf16x8 qr[NQR];
    const bf16_t* Qw = Qb + (size_t)(wid * 32 + r32) * LDQ + hi * 8;
#pragma unroll
    for (int d0 = 0; d0 < NQR; ++d0) qr[d0] = *(const bf16x8*)(Qw + d0 * 16);
    if constexpr (NQL > 0) {
        constexpr int CH = QTB / 16;
#pragma unroll
        for (int i = 0; i < (32 * CH) / 64; ++i) { const int c = lane + 64 * i, row = c / CH, cc = c % CH;
            const bf16x8 v = *(const bf16x8*)(Qb + (size_t)(wid * 32 + row) * LDQ + NQR * 16 + cc * 8);
            *(bf16x8*)(Qt + row * QTB + ((cc * 16) ^ (((row) & (CH - 1)) << 4))) = v; }
        asm volatile("s_waitcnt lgkmcnt(0)" ::: "memory");
    }
    const int sr = tid >> 4, sc = (tid & 15) * 8, vst0 = v_st(sr, sc), vst1 = v_st(32 + sr, sc);
    const int vb0 = (int)(uintptr_t)V_lds + v_rd_base(lane);
    int krow[NKC], kcc[NKC];
#pragma unroll
    for (int i = 0; i < NKC; ++i) { const int c = tid + 512 * i; krow[i] = c / CPR; kcc[i] = c % CPR; }
    struct { bf16x8 vs0, vs1, ks[NKC]; } sr_[SDEPTH];
    constexpr int SE = 0, SO = SDEPTH - 1;
#define SLOAD(i, k0) do { sr_[i].vs0 = *(const bf16x8*)(&Vh[(size_t)((k0) + sr) * LDV + sc]); sr_[i].vs1 = *(const bf16x8*)(&Vh[(size_t)((k0) + 32 + sr) * LDV + sc]); \
    _Pragma("unroll") for (int _q = 0; _q < NKC; ++_q) sr_[i].ks[_q] = *(const bf16x8*)(&Kh[(size_t)((k0) + krow[_q]) * LDK + kcc[_q] * 8]); } while (0)
#define SWRITE(b, i) do { *(bf16x8*)(V_lds + (b) * SHM_V + vst0) = sr_[i].vs0; *(bf16x8*)(V_lds + (b) * SHM_V + vst1) = sr_[i].vs1; \
    _Pragma("unroll") for (int _q = 0; _q < NKC; ++_q) *(bf16x8*)(K_lds + (b) * SHM_K + KSWZ(krow[_q], kcc[_q] * 16)) = sr_[i].ks[_q]; } while (0)
#define SWAIT() do { if constexpr (SDEPTH == 2) asm volatile("s_waitcnt vmcnt(%0)" :: "n"(2 + NKC) : "memory"); else asm volatile("s_waitcnt vmcnt(0)" ::: "memory"); } while (0)
#define RESC(a) do { if (__any((a) < 1.f)) { if (hi == 0) al_l[r32] = (a); asm volatile("s_waitcnt lgkmcnt(0)" ::: "memory"); \
    _Pragma("unroll") for (int d = 0; d < 4; ++d) _Pragma("unroll") for (int r = 0; r < 16; ++r) o[d][r] *= al_l[crow(r, hi)]; } } while (0)
#define QFRAG(d0) ((d0) < NQR ? qr[(d0) < NQR ? (d0) : 0] : *(const bf16x8*)(Qt + r32 * QTB + (((((d0) - NQR) * 2 + hi) * 16) ^ ((r32 & ((QTB / 16) - 1)) << 4))))
#define QKT(P0, P1, KB) do { P0 = f32x16{}; P1 = f32x16{}; if constexpr (ABL & 2) { asm volatile("" : "+v"(P0), "+v"(P1)); } else _Pragma("unroll") for (int d0 = 0; d0 < ND0; ++d0) { const int cb = (d0 * 16 + hi * 8) * 2; \
    const bf16x8 b0 = *(const bf16x8*)((KB) + KSWZ(r32, cb)); const bf16x8 b1 = *(const bf16x8*)((KB) + KSWZ(32 + r32, cb)); const bf16x8 qf = QFRAG(d0); \
    P0 = __builtin_amdgcn_mfma_f32_32x32x16_bf16(b0, qf, P0, 0, 0, 0); P1 = __builtin_amdgcn_mfma_f32_32x32x16_bf16(b1, qf, P1, 0, 0, 0); } } while (0)
    f32x16 pA0, pA1, pB0, pB1; float mnA, mnB, alA, alB; bf16x8 pa0, pa1, pa2, pa3; const int NT = seq / 64;
#define PVD(VB) do { if constexpr (!(ABL & 1)) { if constexpr (PVP) pv_d0_pipe(o, VB, pa0, pa1, pa2, pa3); else pv_d0(o, VB, pa0, pa1, pa2, pa3); } else { asm volatile("" : "+v"(pa0), "+v"(pa1), "+v"(pa2), "+v"(pa3)); } } while (0)
    const float nBC = -thr * C;
#define PSM(P0, P1, MN, AL) do { if constexpr (ABL & 4) { asm volatile("" : "+v"(P0), "+v"(P1)); } else if constexpr (FS) partialSM_fs(P0, P1, C, nBC); else partialSM(P0, P1, m_reg, MN, AL, C, thr); } while (0)
#define FSM(P0, P1, AL) do { if constexpr (ABL & 4) { asm volatile("" : "+v"(P0), "+v"(P1)); pa0 = (bf16x8){1,2,3,4,5,6,7,8}; pa1 = pa0; pa2 = pa0; pa3 = pa0; asm volatile("" : "+v"(pa0), "+v"(pa1), "+v"(pa2), "+v"(pa3)); } else if constexpr (FS) finishSM_fs(P0, P1, l_reg, pa0, pa1, pa2, pa3); else finishSM(P0, P1, AL, l_reg, pa0, pa1, pa2, pa3); } while (0)
#define RSC(a) do { if constexpr (!FS) { RESC(a); } } while (0)
#define ABAR() do { if constexpr (!(ABL & 16)) __syncthreads(); } while (0)
    SLOAD(SE, 0); asm volatile("s_waitcnt vmcnt(0)" ::: "memory"); SWRITE(0, SE); __syncthreads();
    QKT(pA0, pA1, K_lds); PSM(pA0, pA1, mnA, alA);
    SLOAD(SO, 64); if constexpr (SDEPTH == 2) { if (2 < NT) SLOAD(SE, 128); }
    SWAIT(); SWRITE(1, SO); __syncthreads();
    for (int j = 1; j + 1 < NT; j += 2) {
        if constexpr (SDEPTH == 1 && !(ABL & 8)) { SBAR(); SLOAD(SO, (j + SDEPTH) * 64); }
        SBAR(); QKT(pB0, pB1, K_lds + SHM_K);
        FSM(pA0, pA1, alA); SBAR();
        if constexpr (SDEPTH != 1 && !(ABL & 8)) SLOAD(SO, (j + SDEPTH) * 64); SBAR();
        PVD(vb0); PSM(pB0, pB1, mnB, alB);
        ABAR(); if constexpr (!(ABL & 8)) { SWAIT(); SWRITE(0, SE); }
        RSC(alB); ABAR();
        if constexpr (SDEPTH == 1 && !(ABL & 8)) { SBAR(); SLOAD(SE, (j + 1 + SDEPTH) * 64); }
        SBAR(); QKT(pA0, pA1, K_lds);
        FSM(pB0, pB1, alB); SBAR();
        if constexpr (SDEPTH != 1 && !(ABL & 8)) { if (j + 3 < NT) SLOAD(SE, (j + 1 + SDEPTH) * 64); } SBAR();
        PVD(vb0 + SHM_V); PSM(pA0, pA1, mnA, alA);
        ABAR(); if constexpr (!(ABL & 8)) { SWAIT(); SWRITE(1, SO); }
        RSC(alA); ABAR();
    }
    SBAR(); QKT(pB0, pB1, K_lds + SHM_K);
    FSM(pA0, pA1, alA); SBAR();
    PVD(vb0); PSM(pB0, pB1, mnB, alB);
    __syncthreads(); RSC(alB);
    FSM(pB0, pB1, alB); SBAR();
    PVD(vb0 + SHM_V);
    if constexpr (FS) { auto rr = __builtin_amdgcn_permlane32_swap(__float_as_uint(l_reg), __float_as_uint(l_reg), false, false); l_reg = __uint_as_float(rr[0]) + __uint_as_float(rr[1]); }
#undef PSM
#undef PVD
#undef FSM
#undef RSC
#undef ABAR
    l_out = l_reg;
#undef SLOAD
#undef SWRITE
#undef SWAIT
#undef RESC
#undef QKT
#undef QFRAG
#undef KSWZ
}

__device__ __forceinline__ void attn_phase(Frame& F, CArgsRef A, unsigned long long& pt1, unsigned long long& pt0) {
    char* lds = (char*)F.lds;
    const bf16_t* P = WSP(bf16_t, WS_BIG); const bf16_t* QM = WSP(bf16_t, WS_QM); const bf16_t* KM = WSP(bf16_t, WS_KM); const bf16_t* KV = WSP(bf16_t, WS_H);
    bf16_t* Y = WSP(bf16_t, WS_YMIX); float* ST = WSP(float, WS_STASH) + (size_t)F.bid * 256 * 128;
    float lam;
    { const int lane = F.lane; const float* dl = A.in[22]; const float a = dl[lane] * dl[64 + lane], b = dl[128 + lane] * dl[192 + lane]; lam = __expf(wave_sum(a)) - __expf(wave_sum(b)) + LAM_INIT; lam = __uint_as_float(__builtin_amdgcn_readfirstlane(__float_as_uint(lam))); }
    constexpr float LOG2E = 1.4426950408889634f;
#ifndef ATT_KINDS
#define ATT_KINDS 3
#endif
#ifndef ATT_PVP_MLA
#define ATT_PVP_MLA 0
#endif
#ifndef ATT_PVP_DIFF
#define ATT_PVP_DIFF 1
#endif
#ifndef ATT_FS
#define ATT_FS 1
#endif
    float bnd_mla, bnd_diff;
    { const int lane = F.lane; const float* gm = A.in[20]; const float* gd = A.in[21];
      float a = fmaxf(fmaxf(fabsf(gm[lane]), fabsf(gm[64 + lane])), fabsf(gm[128 + lane])), b = fmaxf(fmaxf(fabsf(gm[192 + lane]), fabsf(gm[256 + lane])), fabsf(gm[320 + lane]));
      float c = fabsf(gd[lane]), d = fabsf(gd[64 + lane]);
#pragma unroll
      for (int o = 1; o < 64; o <<= 1) { a = fmaxf(a, __shfl_xor(a, o)); b = fmaxf(b, __shfl_xor(b, o)); c = fmaxf(c, __shfl_xor(c, o)); d = fmaxf(d, __shfl_xor(d, o)); }
      bnd_mla = __uint_as_float(__builtin_amdgcn_readfirstlane(__float_as_uint(fminf(0.07216878364870322f * 192.f * a * b * 1.001f, 60.f))));
      bnd_diff = __uint_as_float(__builtin_amdgcn_readfirstlane(__float_as_uint(fminf(0.125f * 64.f * c * d * 1.001f, 60.f)))); }
#ifndef PROBE_ABL
#define PROBE_ABL 0
#endif
    if (PT_SUB == 7 || PT_SUB == 8) {
        int tid = threadIdx.x; asm volatile("" : "+v"(tid));
        const int wid = tid >> 6, lane = tid & 63, r32 = lane & 31, hi = lane >> 5;
        const int u = F.bid, bh = u >> 4, qb = u & 15, b = bh >> 2, h = bh & 3;
        f32x16 o[4]; float l_reg;
        __syncthreads();
        pt0 = __builtin_amdgcn_s_memrealtime();
        if (PT_SUB == 7) { const bf16_t* Pb = P + (size_t)(b * TPB) * PW;
            attn_body<64, PW, PW, PW, 1, 0, ATT_FS != 0, ATT_PVP_DIFF != 0, PROBE_ABL>(tid, Pb + (size_t)(CTXL + qb * 256) * PW + PC_QD + h * 128, Pb + PC_KD + h * 128, Pb + PC_VD + h * 128, TPB, lds, 0.125f * LOG2E, bnd_diff / 0.125f, o, l_reg); }
        else attn_body<192, 768, 192, 1024, 1, 8, ATT_FS != 0, ATT_PVP_MLA != 0, PROBE_ABL>(tid, QM + ((size_t)(b * SEQ + qb * 256)) * 768 + h * 192, KM + (size_t)(b * 4 + h) * TPB * 192, KV + (size_t)(b * TPB) * 1024 + h * 256 + 128, TPB, lds, 0.07216878364870322f * LOG2E, bnd_mla / 0.07216878364870322f, o, l_reg);
        pt1 = __builtin_amdgcn_s_memrealtime();
        float* Sw = ST + (size_t)(wid * 32) * 128;
#pragma unroll
        for (int r = 0; r < 16; ++r)
#pragma unroll
            for (int d0 = 0; d0 < 4; ++d0) Sw[(size_t)crow(r, hi) * 128 + d0 * 32 + r32] = o[d0][r] * l_reg;
        __syncthreads();
    }
    if (ATT_KINDS & 1)
    for (int u = F.bid, rnd = 0; u < 512; u += F.G, ++rnd) {
        int tid = threadIdx.x; asm volatile("" : "+v"(tid));
        const int wid = tid >> 6, lane = tid & 63, r32 = lane & 31, hi = lane >> 5;
        const int ux = (F.G == 256) ? ((((F.bid & 7) * 4 + rnd * 2 + ((F.bid >> 3) >> 4)) << 4) | ((F.bid >> 3) & 15)) : u;
        const int bh = ux >> 4, qb = ux & 15, b = bh >> 2, h = bh & 3;
        f32x16 o[4]; float l_reg;
        __syncthreads();
        attn_body<192, 768, 192, 1024, 1, 8, ATT_FS != 0, ATT_PVP_MLA != 0>(tid, QM + ((size_t)(b * SEQ + qb * 256)) * 768 + h * 192, KM + (size_t)(b * 4 + h) * TPB * 192, KV + (size_t)(b * TPB) * 1024 + h * 256 + 128,
                                       TPB, lds, 0.07216878364870322f * LOG2E, ATT_FS ? bnd_mla / 0.07216878364870322f : 8.f / 0.07216878364870322f, o, l_reg);
        float* li_l = (float*)(lds + 2 * 16384 + 2 * 64 * 384) + wid * 64;
        if (hi == 0) li_l[r32] = l_reg; LDS_WAIT();
        float rli[16];
#pragma unroll
        for (int r = 0; r < 16; ++r) rli[r] = __builtin_amdgcn_rcpf(li_l[crow(r, hi)]);
        bf16_t* Ow = Y + (size_t)(b * SEQ + qb * 256 + wid * 32) * D + h * 128;
#pragma unroll
        for (int r = 0; r < 16; ++r)
#pragma unroll
            for (int d0 = 0; d0 < 4; ++d0) Ow[(size_t)crow(r, hi) * D + d0 * 32 + r32] = f2bf(o[d0][r] * rli[r]);
    }
    if (PT_SUB == 3) pt1 = __builtin_amdgcn_s_memrealtime();
    if (ATT_KINDS & 2)
    for (int u = F.bid, rnd = 0; u < 512; u += F.G, ++rnd) {
        int tid = threadIdx.x; asm volatile("" : "+v"(tid));
        const int wid = tid >> 6, lane = tid & 63, r32 = lane & 31, hi = lane >> 5;
        const int ux = (F.G == 256) ? ((((F.bid & 7) * 4 + rnd * 2 + ((F.bid >> 3) >> 4)) << 4) | ((F.bid >> 3) & 15)) : u;
        const int bh = ux >> 4, qb = ux & 15, b = bh >> 2, h = bh & 3;
        const bf16_t* Pb = P + (size_t)(b * TPB) * PW;
        float* Sw = ST + (size_t)(wid * 32) * 128;
        float* li_l = (float*)(lds + 2 * 16384 + 2 * 64 * 128) + wid * 64;
        {
            f32x16 o[4]; float l_reg;
            __syncthreads();
            attn_body<64, PW, PW, PW, 1, 0, ATT_FS != 0, ATT_PVP_DIFF != 0>(tid, Pb + (size_t)(CTXL + qb * 256) * PW + PC_QD + h * 128, Pb + PC_KD + h * 128, Pb + PC_VD + h * 128, TPB, lds, 0.125f * LOG2E, ATT_FS ? bnd_diff / 0.125f : 8.f / 0.125f, o, l_reg);
            if (hi == 0) li_l[r32] = l_reg; LDS_WAIT();
            float rli[16];
#pragma unroll
            for (int r = 0; r < 16; ++r) rli[r] = __builtin_amdgcn_rcpf(li_l[crow(r, hi)]);
#pragma unroll
            for (int r = 0; r < 16; ++r)
#pragma unroll
                for (int d0 = 0; d0 < 4; ++d0) Sw[(size_t)crow(r, hi) * 128 + d0 * 32 + r32] = o[d0][r] * rli[r];
        }
        {
            f32x16 o[4]; float l_reg;
            __syncthreads();
            attn_body<64, PW, PW, PW, 1, 0, ATT_FS != 0, ATT_PVP_DIFF != 0>(tid, Pb + (size_t)(CTXL + qb * 256) * PW + PC_QD + h * 128 + 64, Pb + PC_KD + h * 128 + 64, Pb + PC_VD + h * 128, TPB, lds, 0.125f * LOG2E, ATT_FS ? bnd_diff / 0.125f : 8.f / 0.125f, o, l_reg);
            if (hi == 0) li_l[r32] = l_reg; LDS_WAIT();
            float ss[16];
#pragma unroll
            for (int r = 0; r < 16; ++r) { const float rl = __builtin_amdgcn_rcpf(li_l[crow(r, hi)]); float s = 0.f;
#pragma unroll
                for (int d0 = 0; d0 < 4; ++d0) { const float a1 = Sw[(size_t)crow(r, hi) * 128 + d0 * 32 + r32]; const float v = a1 - lam * (o[d0][r] * rl); o[d0][r] = v; s += v * v; }
                ss[r] = s; }
#pragma unroll
            for (int r = 0; r < 16; ++r) {
#pragma unroll
                for (int sh = 1; sh < 32; sh <<= 1) ss[r] += __shfl_xor(ss[r], sh);
                ss[r] = (1.f / sqrtf(ss[r] * (1.f / 128.f) + EPS)) * (1.f - LAM_INIT); }
            bf16_t* Ow = Y + (size_t)(b * SEQ + qb * 256 + wid * 32) * D + 512 + h * 128;
#pragma unroll
            for (int d0 = 0; d0 < 4; ++d0) { const float gs = A.in[23][d0 * 32 + r32];
#pragma unroll
                for (int r = 0; r < 16; ++r) Ow[(size_t)crow(r, hi) * D + d0 * 32 + r32] = f2bf(o[d0][r] * ss[r] * gs); }
        }
    }
    __syncthreads();
}

constexpr int NPHASE = 18;

__global__ void __launch_bounds__(512, 2) fwd(Args args) {
    extern __shared__ __attribute__((aligned(16))) unsigned char lds_raw[];
    Frame F;
    F.lds = (LAS unsigned char*)lds_raw;
    F.tid = threadIdx.x; F.lane = F.tid & 63; F.wave = __builtin_amdgcn_readfirstlane(F.tid >> 6);
    F.G = gridDim.x; F.bid = blockIdx.x;
    F.out = args.out; F.ws = args.ws; F.ctl = (unsigned*)(args.ws + WS_CTL);
    volatile LAS unsigned* MISC = (volatile LAS unsigned*)(F.lds + LDS_CTL);
    LAS int* PRE = (LAS int*)(F.lds + LDS_CTL + 64);
    if (F.tid < 4) MISC[F.tid] = 0u;
    __syncthreads();
    XcdBarrier bar; bar.bar = F.ctl + CW_BAR; bar.x = 0; bar.st = nullptr;
#if MK_ONE_LAUNCH
    bar = xcd_barrier_post(F.ctl + CW_BAR, MISC);
#define GRID_BAR() xcd_barrier(bar)
#else
#define GRID_BAR() do {} while (0)
#endif
    const int lo = args.ph_lo, hi = args.ph_hi;
    unsigned long long pt0 = 0, pt1 = 0;
#ifndef PH_MASK
#define PH_MASK 0x3ffff
#endif
#define IN(k) (((PH_MASK >> (k)) & 1) && lo <= (k) && (k) < hi)
#define SEAM(k) do { if (IN((k) + 1)) GRID_BAR(); } while (0)
#define REP(k) for (int _rep = 0; _rep <= ((PROBE_REP >> (k)) & 1); ++_rep, (void)((_rep <= ((PROBE_REP >> (k)) & 1)) ? (GRID_BAR(), 0) : 0))

    if (IN(0)) { if (PT_LO == 0) pt0 = __builtin_amdgcn_s_memrealtime(); REP(0) { p0_prologue(F, ARGP(), pt1); } if (!PT_SUB && PT_PRE && PT_HI == 0) pt1 = __builtin_amdgcn_s_memrealtime(); SEAM(0); if (!PT_SUB && !PT_PRE && PT_HI == 0) pt1 = __builtin_amdgcn_s_memrealtime(); }
    if (IN(1)) { if (PT_LO == 1) pt0 = __builtin_amdgcn_s_memrealtime(); REP(1) { norm_mod_phase(F, ARGP(), 0); } if (PT_PRE && PT_HI == 1) pt1 = __builtin_amdgcn_s_memrealtime(); SEAM(1); if (!PT_PRE && PT_HI == 1) pt1 = __builtin_amdgcn_s_memrealtime(); }
    if (IN(2)) { if (PT_LO == 2) pt0 = __builtin_amdgcn_s_memrealtime(); REP(2) {
        pg8::PlainSched S; S.init(WSP(bf16_t, WS_H), WSP(bf16_t, WS_WIN0), NTOK, 1536, D, D, D, F.G, F.bid, 0);
        pg8::EpiGlu E{WSP(bf16_t, WS_BIG), UW};
        pg8::gemm_phase(F.lds, D, D, D, 1 << 30, S, E);
        { const int nextra = (136 * 6) % F.G; if (nextra == 0) moe_fill(F, ARGP(), 0, 16, F.bid, F.G); else if (F.bid >= nextra) moe_fill(F, ARGP(), 0, 16, F.bid - nextra, F.G - nextra); }
    } if (PT_PRE && PT_HI == 2) pt1 = __builtin_amdgcn_s_memrealtime(); SEAM(2); if (!PT_PRE && PT_HI == 2) pt1 = __builtin_amdgcn_s_memrealtime(); }
    if (IN(3)) { if (PT_LO == 3) pt0 = __builtin_amdgcn_s_memrealtime(); REP(3) { convpool_phase(F, ARGP(), pt1); } if (!PT_SUB && PT_PRE && PT_HI == 3) pt1 = __builtin_amdgcn_s_memrealtime(); SEAM(3); if (!PT_SUB && !PT_PRE && PT_HI == 3) pt1 = __builtin_amdgcn_s_memrealtime(); }
    if (IN(4)) { if (PT_LO == 4) pt0 = __builtin_amdgcn_s_memrealtime(); REP(4) {
        pg8::PlainSched S; S.init(WSP(bf16_t, WS_YMIX), WSP(bf16_t, WS_WOUT0), NTOK, D, D, D, D, F.G, F.bid, 0);
        pg8::EpiResid E{ARGP().in[0], ARGP().in[2], F.out, WSP(float, WS_XC), WSP(float, WS_MOD), 0};
        pg8::gemm_phase(F.lds, D, D, D, 1 << 30, S, E);
        { const int nextra = (136 * 4) % F.G; if (nextra == 0) moe_fill(F, ARGP(), 16, 16, F.bid, F.G); else if (F.bid >= nextra) moe_fill(F, ARGP(), 16, 16, F.bid - nextra, F.G - nextra); }
    } if (PT_PRE && PT_HI == 4) pt1 = __builtin_amdgcn_s_memrealtime(); SEAM(4); if (!PT_PRE && PT_HI == 4) pt1 = __builtin_amdgcn_s_memrealtime(); }
    if (IN(5)) { if (PT_LO == 5) pt0 = __builtin_amdgcn_s_memrealtime(); REP(5) { router_phase(F, ARGP(), 0); } if (PT_PRE && PT_HI == 5) pt1 = __builtin_amdgcn_s_memrealtime(); SEAM(5); if (!PT_PRE && PT_HI == 5) pt1 = __builtin_amdgcn_s_memrealtime(); }
    if (IN(6)) { if (PT_LO == 6) pt0 = __builtin_amdgcn_s_memrealtime(); REP(6) {
        const int nt = moe_prefix(F, 0, PRE);
        MoeSchedT<true> S; S.m = MoeSched{F.G, F.bid, nt, 0, 0, F.ctl + CW_CNT, WSP(int, WS_LIST), (const char*)WSP(bf16_t, WS_H), (const char*)WSP(bf16_t, WS_WM1), PRE};
        EpiMoe1 E{WSP(bf16_t, WS_BIG), WSP(f32x2, WS_TW)};
        pg8::gemm_phase(F.lds, D, D, D, 1 << 30, S, E);
    } if (PT_PRE && PT_HI == 6) pt1 = __builtin_amdgcn_s_memrealtime(); SEAM(6); if (!PT_PRE && PT_HI == 6) pt1 = __builtin_amdgcn_s_memrealtime(); }
    if (IN(7)) { if (PT_LO == 7) pt0 = __builtin_amdgcn_s_memrealtime(); REP(7) {
        const int nt = moe_prefix(F, 0, PRE);
        MoeSchedT<false> S; S.m = MoeSched{F.G, F.bid, nt, 0, 1, F.ctl + CW_CNT, WSP(int, WS_LIST), (const char*)WSP(bf16_t, WS_BIG), (const char*)WSP(bf16_t, WS_WM2), PRE};
        EpiMoe2 E{F.out, WSP(float, WS_XC), WSP(float, WS_MOD)};
        pg8::gemm_phase(F.lds, 512, 512, 256, 4, S, E);
    } if (PT_PRE && PT_HI == 7) pt1 = __builtin_amdgcn_s_memrealtime(); SEAM(7); if (!PT_PRE && PT_HI == 7) pt1 = __builtin_amdgcn_s_memrealtime(); }
    if (IN(8)) { if (PT_LO == 8) pt0 = __builtin_amdgcn_s_memrealtime(); REP(8) { norm_mod_phase(F, ARGP(), 1); } if (PT_PRE && PT_HI == 8) pt1 = __builtin_amdgcn_s_memrealtime(); SEAM(8); if (!PT_PRE && PT_HI == 8) pt1 = __builtin_amdgcn_s_memrealtime(); }
    if (IN(9)) { if (PT_LO == 9) pt0 = __builtin_amdgcn_s_memrealtime(); REP(9) {
        pg8::PlainSched S; S.init(WSP(bf16_t, WS_H), WSP(bf16_t, WS_WIN1), NTOK, PW, D, D, D, F.G, F.bid, 0);
        pg8::EpiStoreBf16 E{WSP(bf16_t, WS_BIG), PW};
        pg8::gemm_phase(F.lds, D, D, D, 1 << 30, S, E);
        { const int nextra = (136 * 8) % F.G; if (nextra == 0) moe_fill(F, ARGP(), 48, 16, F.bid, F.G); else if (F.bid >= nextra) moe_fill(F, ARGP(), 48, 16, F.bid - nextra, F.G - nextra); }
    } if (PT_PRE && PT_HI == 9) pt1 = __builtin_amdgcn_s_memrealtime(); SEAM(9); if (!PT_PRE && PT_HI == 9) pt1 = __builtin_amdgcn_s_memrealtime(); }
    if (IN(10)) { if (PT_LO == 10) pt0 = __builtin_amdgcn_s_memrealtime(); REP(10) { p9_phase(F, ARGP()); } if (PT_PRE && PT_HI == 10) pt1 = __builtin_amdgcn_s_memrealtime(); SEAM(10); if (!PT_PRE && PT_HI == 10) pt1 = __builtin_amdgcn_s_memrealtime(); }
    if (IN(11)) { if (PT_LO == 11) pt0 = __builtin_amdgcn_s_memrealtime(); REP(11) {
        { pg8::PlainSched S; S.init(WSP(bf16_t, WS_BIG) + PC_CQ, WSP(bf16_t, WS_WUQ), NLAT, 768, 256, PW, 256, F.G, F.bid, 1);
          pg8::EpiStoreBf16 E{WSP(bf16_t, WS_QM), 768};
          pg8::gemm_phase(F.lds, 256, PW, 256, 1 << 30, S, E); }
        { pg8::PlainSched S; S.init(WSP(bf16_t, WS_BIG) + PC_CKV, WSP(bf16_t, WS_WUKV), NTOK, 1024, 128, PW, 128, F.G, F.bid, 0);
          pg8::EpiStoreBf16 E{WSP(bf16_t, WS_H), 1024};
          pg8::gemm_phase(F.lds, 128, PW, 128, 1 << 30, S, E); }

    } if (PT_PRE && PT_HI == 11) pt1 = __builtin_amdgcn_s_memrealtime(); SEAM(11); if (!PT_PRE && PT_HI == 11) pt1 = __builtin_amdgcn_s_memrealtime(); }
    if (IN(12)) { if (PT_LO == 12) pt0 = __builtin_amdgcn_s_memrealtime(); REP(12) { p11_phase(F, ARGP()); } if (PT_PRE && PT_HI == 12) pt1 = __builtin_amdgcn_s_memrealtime(); SEAM(12); if (!PT_PRE && PT_HI == 12) pt1 = __builtin_amdgcn_s_memrealtime(); }
    if (IN(13)) { if (PT_LO == 13 && PT_SUB != 7 && PT_SUB != 8) pt0 = __builtin_amdgcn_s_memrealtime(); REP(13) { attn_phase(F, ARGP(), pt1, pt0); } if (!PT_SUB && PT_PRE && PT_HI == 13) pt1 = __builtin_amdgcn_s_memrealtime(); SEAM(13); if (!PT_SUB && !PT_PRE && PT_HI == 13) pt1 = __builtin_amdgcn_s_memrealtime(); }
    if (IN(14)) { if (PT_LO == 14) pt0 = __builtin_amdgcn_s_memrealtime(); REP(14) {
        pg8::PlainSched S; S.init(WSP(bf16_t, WS_YMIX), WSP(bf16_t, WS_WOUT1), NLAT, D, D, D, D, F.G, F.bid, 0);
        pg8::EpiResid E{ARGP().in[0], ARGP().in[2], F.out, WSP(float, WS_XC), WSP(float, WS_MOD) + (size_t)9 * NMOD * D, 1};
        pg8::gemm_phase(F.lds, D, D, D, 1 << 30, S, E);
    } if (PT_PRE && PT_HI == 14) pt1 = __builtin_amdgcn_s_memrealtime(); SEAM(14); if (!PT_PRE && PT_HI == 14) pt1 = __builtin_amdgcn_s_memrealtime(); }
    if (IN(15)) { if (PT_LO == 15) pt0 = __builtin_amdgcn_s_memrealtime(); REP(15) { router_phase(F, ARGP(), 1); } if (PT_PRE && PT_HI == 15) pt1 = __builtin_amdgcn_s_memrealtime(); SEAM(15); if (!PT_PRE && PT_HI == 15) pt1 = __builtin_amdgcn_s_memrealtime(); }
    if (IN(16)) { if (PT_LO == 16) pt0 = __builtin_amdgcn_s_memrealtime(); REP(16) {
        const int nt = moe_prefix(F, 1, PRE);
        MoeSchedT<true> S; S.m = MoeSched{F.G, F.bid, nt, 1, 0, F.ctl + CW_CNT + 64, WSP(int, WS_LIST), (const char*)WSP(bf16_t, WS_H), (const char*)WSP(bf16_t, WS_WM1), PRE};
        EpiMoe1 E{WSP(bf16_t, WS_BIG), WSP(f32x2, WS_TW)};
        pg8::gemm_phase(F.lds, D, D, D, 1 << 30, S, E);
    } if (PT_PRE && PT_HI == 16) pt1 = __builtin_amdgcn_s_memrealtime(); SEAM(16); if (!PT_PRE && PT_HI == 16) pt1 = __builtin_amdgcn_s_memrealtime(); }
    if (IN(17)) { if (PT_LO == 17) pt0 = __builtin_amdgcn_s_memrealtime(); REP(17) {
        const int nt = moe_prefix(F, 1, PRE);
        MoeSchedT<false> S; S.m = MoeSched{F.G, F.bid, nt, 1, 1, F.ctl + CW_CNT + 64, WSP(int, WS_LIST), (const char*)WSP(bf16_t, WS_BIG), (const char*)WSP(bf16_t, WS_WM2), PRE};
        EpiMoe2 E{F.out, WSP(float, WS_XC), WSP(float, WS_MOD) + (size_t)9 * NMOD * D};
        pg8::gemm_phase(F.lds, 512, 512, 256, 4, S, E);
    } if (PT_HI == 17) pt1 = __builtin_amdgcn_s_memrealtime(); }
    if (PT_LO >= 0 && F.bid == 0 && F.tid == 0) { const unsigned long long tend = __builtin_amdgcn_s_memrealtime() + (unsigned long long)PT_AMP * (pt1 - pt0);
        while (__builtin_amdgcn_s_memrealtime() < tend) __builtin_amdgcn_s_sleep(8); }
#undef IN
#undef SEAM
}

extern "C" void kernel_launch(void* const* d_in, const int* in_sizes, int n_in, void* d_out, int out_size, void* d_ws, size_t ws_size, hipStream_t stream) {
    static int grid = 0;
    if (grid == 0) {
        if (n_in != 30 || in_sizes[0] != NLAT * D || out_size != NLAT * D || ws_size < WS_END) { fprintf(stderr, "kernel_launch: unexpected shapes (n_in %d, in0 %d, out %d, ws %zu)\n", n_in, n_in > 0 ? in_sizes[0] : -1, out_size, ws_size); grid = -1; return; }
        int dev = 0, cus = 0, per_cu = 0;
        if (hipGetDevice(&dev) != hipSuccess || hipDeviceGetAttribute(&cus, hipDeviceAttributeMultiprocessorCount, dev) != hipSuccess) { grid = -1; return; }
        if (hipFuncSetAttribute((const void*)fwd, hipFuncAttributeMaxDynamicSharedMemorySize, LDS_BYTES) != hipSuccess) { fprintf(stderr, "kernel_launch: hipFuncSetAttribute failed\n"); grid = -1; return; }
        if (hipOccupancyMaxActiveBlocksPerMultiprocessor(&per_cu, (const void*)fwd, 512, LDS_BYTES) != hipSuccess || per_cu < 1) fprintf(stderr, "kernel_launch: occupancy query reports %d\n", per_cu);
        (void)hipGetLastError();
        grid = cus;
    }
    if (grid < 0) return;
    if (hipMemsetAsync((char*)d_ws + WS_CTL, 0, CTL_ZERO_BYTES, stream) != hipSuccess) return;
    Args a{};
    for (int i = 0; i < 30; ++i) a.in[i] = (const float*)d_in[i];
    a.out = (float*)d_out; a.ws = (unsigned char*)d_ws;
    const int last = MK_LAST_PHASE < NPHASE - 1 ? MK_LAST_PHASE : NPHASE - 1;
#if MK_ONE_LAUNCH
    a.ph_lo = 0; a.ph_hi = last + 1;
    hipLaunchKernelGGL(fwd, dim3(grid), dim3(512), LDS_BYTES, stream, a);
#else
    for (int p = 0; p <= last; ++p) { a.ph_lo = p; a.ph_hi = p + 1; hipLaunchKernelGGL(fwd, dim3(grid), dim3(512), LDS_BYTES, stream, a); }
#endif
    const hipError_t le = hipPeekAtLastError();
    if (le != hipSuccess) fprintf(stderr, "kernel_launch: launch failed: %s\n", hipGetErrorName(le));
}
```

```cpp
#include <hip/hip_runtime.h>
#include <cstdio>
#include <cstdint>

#ifndef MK_ONE_LAUNCH
#define MK_ONE_LAUNCH 1
#endif
#ifndef MK_LAST_PHASE
#define MK_LAST_PHASE 99
#endif

#ifndef PROBE_REP
#define PROBE_REP 0
#endif
#define PT_LO -1
#define PT_HI -1
#define PT_AMP 4
#define PT_PRE 0
#define PROBE_ABL_SET 0
#define PROBE_ABL PROBE_ABL_SET
#define PT_SUB 0

#define GAS __attribute__((address_space(1)))
#define LAS __attribute__((address_space(3)))
typedef unsigned short bf16_t;
typedef short bf16x8 __attribute__((ext_vector_type(8)));
typedef short s16x4 __attribute__((ext_vector_type(4)));
typedef float f32x4 __attribute__((ext_vector_type(4)));
typedef float f32x2 __attribute__((ext_vector_type(2)));
typedef float f32x16 __attribute__((ext_vector_type(16)));
typedef unsigned u32x4 __attribute__((ext_vector_type(4)));
typedef unsigned u32x2 __attribute__((ext_vector_type(2)));

constexpr int D = 1024, NB = 8, SEQ = 4096, CTXL = 256, TPB = SEQ + CTXL;
constexpr int NTOK = NB * TPB, NLAT = NB * SEQ, NCTX = NB * CTXL;
constexpr int NMOD = 6;
constexpr float EPS = 1e-6f;
constexpr int NEXP = 32, NBUCK = 48, DEXP = 256, LCAP = NTOK;
constexpr int PW = 2048;
constexpr int UW = 1024;
constexpr int PC_CQ = 0, PC_QD = 256, PC_CKV = 768, PC_KROPE = 896, PC_KD = 960, PC_VD = 1472;
constexpr float LAM_INIT = 0.35550906759096934f;
constexpr int MOE_MAXT = NTOK / 256 + NBUCK;

constexpr size_t MiB = 1u << 20;
constexpr size_t WS_CTL = 0, CTL_ZERO_BYTES = 576 * 1024;
constexpr size_t WS_MOD = 128 * 1024;
constexpr size_t WS_COS = 3 * MiB, WS_SIN = 3 * MiB + 512 * 1024;
constexpr size_t WS_XC = 4 * MiB;
constexpr size_t WS_LIST = 12 * MiB;
constexpr size_t WS_TW = 19 * MiB;
constexpr size_t WS_WIN0 = 20 * MiB, WS_WOUT0 = 23 * MiB, WS_WIN1 = 25 * MiB, WS_WUQ = 29 * MiB, WS_WUKV = 29 * MiB + 512 * 1024, WS_WOUT1 = 30 * MiB, WS_WPOOL = 32 * MiB;
constexpr size_t WS_WM1 = 33 * MiB;
constexpr size_t WS_WM2 = 97 * MiB;
constexpr size_t WS_H = 129 * MiB;
constexpr size_t WS_BIG = 197 * MiB;
constexpr size_t WS_X = 333 * MiB;
constexpr size_t WS_QM = 401 * MiB;
constexpr size_t WS_KM = 449 * MiB;
constexpr size_t WS_END = 500 * MiB;
constexpr size_t WS_STASH = WS_WM1;
constexpr int CW_BAR = 4096;
constexpr int CW_CNT = 16384;

constexpr int LDS_BYTES = 163840;
constexpr int LDS_CTL = 162816;
constexpr int LDS_GT = 147456;

__device__ __forceinline__ unsigned cvt_pk_bf16(float lo, float hi) { unsigned r; asm volatile("v_cvt_pk_bf16_f32 %0, %1, %2" : "=v"(r) : "v"(lo), "v"(hi)); return r; }
__device__ __forceinline__ float bf2f(unsigned short u) { return __uint_as_float((unsigned)u << 16); }
__device__ __forceinline__ float bflo(unsigned w) { return __uint_as_float(w << 16); }
__device__ __forceinline__ float bfhi(unsigned w) { return __uint_as_float(w & 0xffff0000u); }
__device__ __forceinline__ f32x4 bf4(u32x2 w) { return (f32x4){bflo(w.x), bfhi(w.x), bflo(w.y), bfhi(w.y)}; }
__device__ __forceinline__ unsigned short f2bf(float f) { return (unsigned short)(cvt_pk_bf16(f, 0.f) & 0xffffu); }
__device__ __forceinline__ float wave_sum(float v) {
#pragma unroll
    for (int o = 1; o < 64; o <<= 1) v += __shfl_xor(v, o);
    return v;
}
#define DPPF(v, ctrl) __int_as_float(__builtin_amdgcn_update_dpp(0, __float_as_int(v), (ctrl), 0xF, 0xF, true))
__device__ __forceinline__ float wave_sum_dpp(float v) {
    v += DPPF(v, 0xB1); v += DPPF(v, 0x4E); v += DPPF(v, 0x141); v += DPPF(v, 0x140);
    const float r0 = __int_as_float(__builtin_amdgcn_readlane(__float_as_int(v), 0)), r1 = __int_as_float(__builtin_amdgcn_readlane(__float_as_int(v), 16));
    const float r2 = __int_as_float(__builtin_amdgcn_readlane(__float_as_int(v), 32)), r3 = __int_as_float(__builtin_amdgcn_readlane(__float_as_int(v), 48));
    return (r0 + r1) + (r2 + r3);
}
__device__ __forceinline__ float sigmoidf_(float x) { return 1.f / (1.f + __expf(-x)); }
__device__ __forceinline__ float siluf_(float x) { return x / (1.f + __expf(-x)); }
__device__ __forceinline__ int crow(int r, int hi) { return (r & 3) + 8 * (r >> 2) + 4 * hi; }
#define LDS_WAIT() asm volatile("s_waitcnt lgkmcnt(0)" ::: "memory")
#define VM_WAIT() asm volatile("s_waitcnt vmcnt(0)" ::: "memory")

#define XB_TMO      128
#define XB_XCNT(j)  (256  + 64 * (j))
#define XB_XSUB(j)  (1280 + 64 * (j))
#define XB_XGEN(j)  (2304 + 64 * (j))
#define XB_TOP      3328
#define XB_TOPGEN   3392
#define XCD_BAR_WORDS 3456
#define XB_SPIN_CAP (1u << 18)
__device__ __forceinline__ unsigned xb_ld(unsigned* p)              { return __hip_atomic_load(p, __ATOMIC_RELAXED, __HIP_MEMORY_SCOPE_AGENT); }
__device__ __forceinline__ unsigned xb_add(unsigned* p, unsigned v) { return __hip_atomic_fetch_add(p, v, __ATOMIC_RELAXED, __HIP_MEMORY_SCOPE_AGENT); }
__device__ __forceinline__ unsigned xb_xcc_id() { return (unsigned)__builtin_amdgcn_s_getreg((3 << 11) | 20) & 0xFu; }
#define XB_SPIN(cond, bar) do { unsigned _sp = 0; while (cond) { __builtin_amdgcn_s_sleep(1); \
    if ((++_sp & 255u) == 0u) { if (xb_ld(&(bar)[XB_TMO])) break; if (_sp > XB_SPIN_CAP) { atomicAdd(&(bar)[XB_TMO], 1u); break; } } } } while (0)
struct XcdBarrier { unsigned* bar; unsigned x; volatile LAS unsigned* st; };
__device__ __forceinline__ XcdBarrier xcd_barrier_post(unsigned* bar, volatile LAS unsigned* st) {
    XcdBarrier b; b.bar = bar; b.x = xb_xcc_id(); b.st = st;
    if (threadIdx.x == 0) (void)xb_add(&bar[XB_XCNT(b.x)], 1u);
    return b;
}
__device__ __forceinline__ void xcd_barrier_complete(unsigned* bar, unsigned x, unsigned& nloc, unsigned& nx) {
    const unsigned G = gridDim.x * gridDim.y * gridDim.z;
    unsigned sum, cnt, mine, sp = 0u;
    for (;;) {
        sum = 0u; cnt = 0u; mine = 0u;
#pragma unroll
        for (unsigned j = 0; j < 16; ++j) { const unsigned c = xb_ld(&bar[XB_XCNT(j)]); sum += c; cnt += (c > 0u) ? 1u : 0u; mine = (j == x) ? c : mine; }
        if (sum == G) break;
        __builtin_amdgcn_s_sleep(1);
        if ((++sp & 255u) == 0u) { if (xb_ld(&bar[XB_TMO])) break; if (sp > XB_SPIN_CAP) { atomicAdd(&bar[XB_TMO], 1u); break; } }
    }
    nloc = mine > 0u ? mine : 1u; nx = cnt > 0u ? cnt : 1u;
}
__device__ __forceinline__ void xcd_barrier(const XcdBarrier& b) {
    asm volatile("s_waitcnt vmcnt(0)" ::: "memory");
    __syncthreads();
    if (threadIdx.x == 0) {
        unsigned* bar = b.bar;
        __builtin_amdgcn_s_waitcnt(0);
        unsigned nloc = b.st[0], nx = b.st[1];
        if (nloc == 0u) { xcd_barrier_complete(bar, b.x, nloc, nx); b.st[0] = nloc; b.st[1] = nx; }
        const unsigned old = xb_add(&bar[XB_XSUB(b.x)], 1u);
        const unsigned gen = old / nloc;
        if (old + 1u == (gen + 1u) * nloc) {
            __builtin_amdgcn_fence(__ATOMIC_RELEASE, "agent");
            asm volatile("s_waitcnt vmcnt(0)" ::: "memory");
            const unsigned og = xb_add(&bar[XB_TOP], 1u);
            const unsigned tg = og / nx;
            if (og + 1u == (tg + 1u) * nx) xb_add(&bar[XB_TOPGEN], 1u);
            else XB_SPIN(xb_ld(&bar[XB_TOPGEN]) == tg, bar);
            __builtin_amdgcn_fence(__ATOMIC_ACQUIRE, "agent");
            xb_add(&bar[XB_XGEN(b.x)], 1u);
            asm volatile("s_waitcnt vmcnt(0)" ::: "memory");
        } else {
            XB_SPIN(xb_ld(&bar[XB_XGEN(b.x)]) == gen, bar);
            __builtin_amdgcn_fence(__ATOMIC_ACQUIRE, "agent");
            asm volatile("s_waitcnt vmcnt(0)" ::: "memory");
        }
    }
    __syncthreads();
}

namespace pg8 {
constexpr int BM = 256, BK = 64, HALF = 128, HTB = HALF * BK * 2, STAGE_BYTES = 8 * HTB, NXCD = 8, WGM = 8;
__device__ __forceinline__ int lds_byte(int r, int c) { const int st = (r >> 4) * 2 + (c >> 5), rr = r & 15, cc = c & 31, ob = rr * 64 + cc * 2; return st * 1024 + (ob ^ (((ob >> 9) & 1) << 5)); }
__device__ __forceinline__ void stage_rc(int b, int& R, int& C) { const int st = b / 1024, sb = b % 1024, swz = sb ^ (((sb >> 9) & 1) << 5); R = (st >> 1) * 16 + swz / 64; C = (st & 1) * 32 + (swz % 64) / 2; }
__device__ __forceinline__ int perm32(int rho) { const int n = rho >> 4, i = rho & 15; return 8 * (i >> 2) + 4 * n + (i & 3); }

struct Unit {
    int pm, pn, po;
    const char* A;
    const char* B;
    const char* B2;
    const int* rows;
    int nvalid, aux;
    int half;
};

template <class Epi, class Sched>
__device__ __forceinline__ void gemm_phase(LAS unsigned char* lds, int K, int lda, int ldb, int ksplit, const Sched& S, const Epi& E) {
    asm volatile("" : "+s"(K), "+s"(lda), "+s"(ldb), "+s"(ksplit));
    const int tid = threadIdx.x, wid = __builtin_amdgcn_readfirstlane(tid >> 6), lane = tid & 63, wr = wid >> 2, wc = wid & 3, fr = lane & 15, fq = lane >> 4;
    const int nt = K / BK;
    unsigned voffB[2];
#pragma unroll
    for (int i = 0; i < 2; ++i) { int R, C; stage_rc(tid * 16 + i * 8192, R, C); const int Rb = (R & ~31) + perm32(R & 31); voffB[i] = (unsigned)(Rb * ldb + C) * 2u; }
    const size_t kstep = (size_t)(BK * 2);
    const size_t hstepB = (size_t)HALF * ldb * 2;
    const unsigned ldsw = (unsigned)wid * 1024u;
    const int aoff = lds_byte(wr * 64 + fr, fq * 8), boff = lds_byte(wc * 32 + fr, fq * 8);
#define PG8_SA(b, h) (((b) * 2 + (h)) * HTB)
#define PG8_SB(b, h) ((4 + (b) * 2 + (h)) * HTB)
#define PG8_STAGE(bufoff, gbase, voff) do { _Pragma("unroll") for (int _i = 0; _i < 2; ++_i) \
        __builtin_amdgcn_global_load_lds((const unsigned*)((const char*)(gbase) + (voff)[_i]), (LAS unsigned*)(lds + (bufoff) + ldsw + _i * 8192), 16, 0, 0); } while (0)
#define PG8_LDA(dst, b, h) do { _Pragma("unroll") for (int m = 0; m < 4; ++m) _Pragma("unroll") for (int k = 0; k < 2; ++k) dst[m][k] = *(const LAS bf16x8*)(lds + PG8_SA(b, h) + aoff + m * 2048 + k * 1024); } while (0)
#define PG8_LDB(dst, b, h) do { _Pragma("unroll") for (int n = 0; n < 2; ++n) _Pragma("unroll") for (int k = 0; k < 2; ++k) dst[n][k] = *(const LAS bf16x8*)(lds + PG8_SB(b, h) + boff + n * 2048 + k * 1024); } while (0)
#define PG8_MMA(ai, bj, At, Bt) do { __builtin_amdgcn_s_setprio(1); _Pragma("unroll") for (int m = 0; m < 4; ++m) _Pragma("unroll") for (int n = 0; n < 2; ++n) _Pragma("unroll") for (int k = 0; k < 2; ++k) \
        acc[ai][bj][m][n] = __builtin_amdgcn_mfma_f32_16x16x32_bf16(Bt[n][k], At[m][k], acc[ai][bj][m][n], 0, 0, 0); __builtin_amdgcn_s_setprio(0); } while (0)
#define PG8_WAIT_V(n) asm volatile("s_waitcnt vmcnt(" #n ")" ::: "memory")
#define PG8_WAIT_L(n) asm volatile("s_waitcnt lgkmcnt(" #n ")" ::: "memory")
#define PG8_BAR __builtin_amdgcn_s_barrier()
#define PG8_SCHED __builtin_amdgcn_sched_barrier(0)
#define PG8_BK(u, t) (((t) < ksplit ? (u).B : (u).B2) + (size_t)(t) * kstep)
#define PG8_VOFF(dst, u) do { int _tl = tid; asm volatile("" : "+v"(_tl)); _Pragma("unroll") for (int _h = 0; _h < 2; ++_h) _Pragma("unroll") for (int _i = 0; _i < 2; ++_i) { int _R, _C; stage_rc(_tl * 16 + _i * 8192, _R, _C); int _r = _R + HALF * _h; \
        if constexpr (Sched::GATHER) { const int _rr = _r < (u).nvalid ? _r : 0; _r = (u).rows[_rr]; } dst[_h][_i] = ((u).half == 2 - _h) ? (unsigned)(_tl * 16 + _i * 8192) : (unsigned)(_r * lda + _C) * 2u; } } while (0)
    Unit cur, nxt; int ui = 0;
    if (!S.next(0, cur)) return;
    f32x4 acc[2][2][4][2];
#pragma unroll
    for (int a = 0; a < 2; ++a)
#pragma unroll
        for (int b = 0; b < 2; ++b)
#pragma unroll
            for (int m = 0; m < 4; ++m)
#pragma unroll
                for (int n = 0; n < 2; ++n) acc[a][b][m][n] = (f32x4){0.f, 0.f, 0.f, 0.f};
    bf16x8 At[4][2], B0[2][2], B1[2][2];
    LAS unsigned* VO = (LAS unsigned*)(lds + STAGE_BYTES) + tid;
#define PG8_VO(slot, h, i) VO[(((slot) & 1) * 4 + (h) * 2 + (i)) * 512]
    unsigned vfix[2][2];
    {
        unsigned vc[2][2];
        PG8_VOFF(vc, cur);
#pragma unroll
        for (int h = 0; h < 2; ++h)
#pragma unroll
            for (int i = 0; i < 2; ++i) { vfix[h][i] = vc[h][i]; PG8_VO(0, h, i) = vc[h][i]; }
        const char* cA0 = cur.A;
        const char* b0 = PG8_BK(cur, 0); const char* b1 = PG8_BK(cur, 1);
        PG8_STAGE(PG8_SB(0, 0), b0, voffB); PG8_STAGE(PG8_SB(0, 1), b0 + hstepB, voffB); PG8_STAGE(PG8_SA(0, 0), cA0, vc[0]); PG8_STAGE(PG8_SA(0, 1), cA0, vc[1]);
        if (wr == 1) PG8_BAR;
        PG8_WAIT_V(2); PG8_BAR;
        PG8_STAGE(PG8_SB(1, 0), b1, voffB); PG8_STAGE(PG8_SA(1, 0), cA0 + kstep, vc[0]); PG8_STAGE(PG8_SB(1, 1), b1 + hstepB, voffB);
        PG8_WAIT_V(6); PG8_BAR;
    }
    const char* cA = cur.A;
    for (;;) {
        const bool has_next = S.next(ui + 1, nxt);
        if (!has_next) nxt = cur;
        { unsigned vn[2][2]; PG8_VOFF(vn, nxt);
#pragma unroll
            for (int h = 0; h < 2; ++h)
#pragma unroll
                for (int i = 0; i < 2; ++i) PG8_VO(ui + 1, h, i) = vn[h][i]; }
        const char* nA = nxt.A;
#pragma nounroll
        for (int t = 0; t < nt; t += 2) {
            const bool last = (t == nt - 2);
            const char* a1 = cA + (size_t)(t + 1) * kstep;
            const char* a2 = last ? nA : cA + (size_t)(t + 2) * kstep;
            const char* a3 = a2 + kstep;
            const char* b2 = last ? PG8_BK(nxt, 0) : PG8_BK(cur, t + 2);
            const char* b3 = last ? PG8_BK(nxt, 1) : PG8_BK(cur, t + 3);
            unsigned v1[2], v2[2][2];
            if constexpr (true) { const int s2 = last ? ui + 1 : ui;
                v1[0] = PG8_VO(ui, 1, 0); v1[1] = PG8_VO(ui, 1, 1);
#pragma unroll
                for (int h = 0; h < 2; ++h)
#pragma unroll
                    for (int i = 0; i < 2; ++i) v2[h][i] = PG8_VO(s2, h, i);
            } else { v1[0] = vfix[1][0]; v1[1] = vfix[1][1];
#pragma unroll
                for (int h = 0; h < 2; ++h)
#pragma unroll
                    for (int i = 0; i < 2; ++i) v2[h][i] = vfix[h][i]; }
            PG8_LDB(B0, 0, 0); PG8_LDB(B1, 0, 1); PG8_SCHED; PG8_LDA(At, 0, 0); PG8_STAGE(PG8_SA(1, 1), a1, v1);
            PG8_WAIT_V(8); PG8_WAIT_L(0); PG8_BAR; if (cur.half != 2) { PG8_MMA(0, 0, At, B0); PG8_MMA(0, 1, At, B1); } PG8_BAR; PG8_SCHED;
            PG8_LDA(At, 0, 1); PG8_STAGE(PG8_SB(0, 0), b2, voffB); PG8_STAGE(PG8_SB(0, 1), b2 + hstepB, voffB); PG8_STAGE(PG8_SA(0, 0), a2, v2[0]);
            PG8_WAIT_V(8); PG8_WAIT_L(0); PG8_BAR; if (cur.half != 1) { PG8_MMA(1, 0, At, B0); PG8_MMA(1, 1, At, B1); } PG8_BAR; PG8_SCHED;
            PG8_LDB(B0, 1, 0); PG8_LDB(B1, 1, 1); PG8_SCHED; PG8_LDA(At, 1, 0); PG8_STAGE(PG8_SA(0, 1), a2, v2[1]);
            PG8_WAIT_V(8); PG8_WAIT_L(0); PG8_BAR; if (cur.half != 2) { PG8_MMA(0, 0, At, B0); PG8_MMA(0, 1, At, B1); } PG8_BAR; PG8_SCHED;
            PG8_LDA(At, 1, 1); PG8_STAGE(PG8_SB(1, 0), b3, voffB); PG8_STAGE(PG8_SB(1, 1), b3 + hstepB, voffB); PG8_STAGE(PG8_SA(1, 0), a3, v2[0]);
            PG8_WAIT_V(8); PG8_WAIT_L(0); PG8_BAR; if (cur.half != 1) { PG8_MMA(1, 0, At, B0); PG8_MMA(1, 1, At, B1); } PG8_BAR; PG8_SCHED;
        }
        if (wr == 0) PG8_BAR;
        E(acc, cur, wr, wc, fr, fq);
        if (!has_next) break;
#pragma unroll
        for (int a = 0; a < 2; ++a)
#pragma unroll
            for (int b = 0; b < 2; ++b)
#pragma unroll
                for (int m = 0; m < 4; ++m)
#pragma unroll
                    for (int n = 0; n < 2; ++n) acc[a][b][m][n] = (f32x4){0.f, 0.f, 0.f, 0.f};
        cur = nxt; cA = nA; ++ui;
        if (wr == 1) PG8_BAR;
    }
    PG8_WAIT_V(0);
    PG8_BAR;
#undef PG8_SA
#undef PG8_SB
#undef PG8_STAGE
#undef PG8_LDA
#undef PG8_LDB
#undef PG8_MMA
#undef PG8_WAIT_V
#undef PG8_WAIT_L
#undef PG8_BAR
#undef PG8_SCHED
#undef PG8_BK
#undef PG8_VOFF
#undef PG8_VO
}

struct PlainSched {
    static constexpr bool GATHER = false;
    int nM, nN, nwg, G, c; const char* A; const char* Bt; int lda, ldb, K; int rowmap;
    __device__ __forceinline__ void init(const void* A_, const void* Bt_, int M, int N, int K_, int lda_, int ldb_, int G_, int c_, int rowmap_) {
        A = (const char*)A_; Bt = (const char*)Bt_; nM = M / BM; nN = N / BM; nwg = nM * nN; G = G_; c = c_; lda = lda_; ldb = ldb_; K = K_; rowmap = rowmap_; }
    __device__ __forceinline__ bool next(int i, Unit& u) const {
        const int fullr = nwg / G, R = nwg - fullr * G; const bool split = (R > 0) && (2 * R <= G);
        int L, hf = 0;
        if (i < fullr) L = i * G + c;
        else if (i == fullr && split) { if (c >= 2 * R) return false; L = fullr * G + (c >> 1); hf = 1 + (c & 1); }
        else { L = i * G + c; if (L >= nwg) return false; }
        u.half = hf;
        int wgid = L; { const int q = nwg / NXCD, r = nwg % NXCD, xcd = wgid % NXCD, off = wgid / NXCD; wgid = (xcd < r ? xcd * (q + 1) : r * (q + 1) + (xcd - r) * q) + off; }
        const int nig = WGM * nN, gid = wgid / nig, fm = gid * WGM, gsz = (nM - fm) < WGM ? (nM - fm) : WGM;
        const int pm = fm + ((wgid % nig) % gsz), pn = (wgid % nig) / gsz;
        u.po = pm; u.pn = pn; u.pm = rowmap ? (pm / 16) * 17 + 1 + (pm % 16) : pm;
        u.A = A + (size_t)u.pm * BM * lda * 2; u.B = Bt + (size_t)pn * BM * ldb * 2; u.B2 = u.B; u.rows = nullptr; u.nvalid = BM; u.aux = 0;
        return true;
    }
};

struct EpiStoreBf16 {
    bf16_t* O; int ldc;
    __device__ __forceinline__ void operator()(const f32x4 (&acc)[2][2][4][2], const Unit& u, int wr, int wc, int fr, int fq) const {
        bf16_t* base = O + (size_t)(u.po * BM + wr * 64 + fr) * ldc + u.pn * BM + wc * 32 + 8 * fq;
#pragma unroll
        for (int ai = 0; ai < 2; ++ai)
            if (u.half != 2 - ai)
#pragma unroll
            for (int m = 0; m < 4; ++m) { bf16_t* rowp = base + (size_t)(ai * HALF + m * 16) * ldc;
#pragma unroll
                for (int bj = 0; bj < 2; ++bj) { const f32x4 v0 = acc[ai][bj][m][0], v1 = acc[ai][bj][m][1];
                    u32x4 w; w.x = cvt_pk_bf16(v0[0], v0[1]); w.y = cvt_pk_bf16(v0[2], v0[3]); w.z = cvt_pk_bf16(v1[0], v1[1]); w.w = cvt_pk_bf16(v1[2], v1[3]);
                    *(u32x4*)(rowp + bj * HALF) = w; } }
    }
};
struct EpiGlu {
    bf16_t* O; int ldc;
    __device__ __forceinline__ void operator()(const f32x4 (&acc)[2][2][4][2], const Unit& u, int wr, int wc, int fr, int fq) const {
        if (u.pn < 4) {
            bf16_t* base = O + (size_t)(u.po * BM + wr * 64 + fr) * ldc + u.pn * 128 + wc * 32 + 8 * fq;
#pragma unroll
            for (int ai = 0; ai < 2; ++ai)
            if (u.half != 2 - ai)
#pragma unroll
                for (int m = 0; m < 4; ++m) { float o[8];
#pragma unroll
                    for (int n = 0; n < 2; ++n)
#pragma unroll
                        for (int q = 0; q < 4; ++q) { const float a = acc[ai][0][m][n][q], g = acc[ai][1][m][n][q]; o[4 * n + q] = a * __builtin_amdgcn_rcpf(1.f + __expf(-g)); }
                    u32x4 w; w.x = cvt_pk_bf16(o[0], o[1]); w.y = cvt_pk_bf16(o[2], o[3]); w.z = cvt_pk_bf16(o[4], o[5]); w.w = cvt_pk_bf16(o[6], o[7]);
                    *(u32x4*)(base + (size_t)(ai * HALF + m * 16) * ldc) = w; }
        } else {
            bf16_t* base = O + (size_t)(u.po * BM + wr * 64 + fr) * ldc + 512 + (u.pn - 4) * BM + wc * 32 + 8 * fq;
#pragma unroll
            for (int ai = 0; ai < 2; ++ai)
            if (u.half != 2 - ai)
#pragma unroll
                for (int m = 0; m < 4; ++m) { bf16_t* rowp = base + (size_t)(ai * HALF + m * 16) * ldc;
#pragma unroll
                    for (int bj = 0; bj < 2; ++bj) { const f32x4 v0 = acc[ai][bj][m][0], v1 = acc[ai][bj][m][1];
                        u32x4 w; w.x = cvt_pk_bf16(v0[0], v0[1]); w.y = cvt_pk_bf16(v0[2], v0[3]); w.z = cvt_pk_bf16(v1[0], v1[1]); w.w = cvt_pk_bf16(v1[2], v1[3]);
                        *(u32x4*)(rowp + bj * HALF) = w; } }
        }
    }
};
template <int MODE> struct EpiResid {
    const float* x; const float* ctx; bf16_t* X; const float* modl;
    __device__ __forceinline__ void operator()(const f32x4 (&acc)[2][2][4][2], const Unit& u, int wr, int wc, int fr, int fq) const {
        const float* src = nullptr; bf16_t* dst; int mrow;
        if (MODE == 0) { const int b = u.po / 17, jt = u.po % 17;
            if (jt == 0) { src = ctx + (size_t)b * CTXL * D; mrow = 8; } else { src = x + ((size_t)b * SEQ + (jt - 1) * 256) * D; mrow = b; }
            dst = X + (size_t)u.po * BM * D; }
        else { const int b = u.po / 16; dst = X + ((size_t)b * TPB + CTXL + (u.po % 16) * BM) * D; mrow = b; }
        const float* gate = modl + (size_t)mrow * (NMOD * D) + 2 * D;
        const int col0 = u.pn * BM + wc * 32 + 8 * fq;
        f32x4 gv[2][2];
#pragma unroll
        for (int bj = 0; bj < 2; ++bj)
#pragma unroll
            for (int n = 0; n < 2; ++n) gv[bj][n] = *(const f32x4*)(gate + col0 + bj * HALF + 4 * n);
        if (MODE == 0) {
#pragma unroll
            for (int ai = 0; ai < 2; ++ai)
                if (u.half != 2 - ai)
#pragma unroll
            for (int mp = 0; mp < 2; ++mp) {
                f32x4 sv[2][2][2];
#pragma unroll
                for (int mm = 0; mm < 2; ++mm) { const size_t ro = (size_t)(ai * HALF + wr * 64 + (mp * 2 + mm) * 16 + fr) * D + col0;
#pragma unroll
                    for (int bj = 0; bj < 2; ++bj)
#pragma unroll
                        for (int n = 0; n < 2; ++n) sv[mm][bj][n] = *(const f32x4*)(src + ro + bj * HALF + 4 * n); }
                __builtin_amdgcn_sched_barrier(0);
#pragma unroll
                for (int mm = 0; mm < 2; ++mm) { const int m = mp * 2 + mm; const size_t ro = (size_t)(ai * HALF + wr * 64 + m * 16 + fr) * D + col0;
#pragma unroll
                    for (int bj = 0; bj < 2; ++bj) { const f32x4 r0 = sv[mm][bj][0] + gv[bj][0] * acc[ai][bj][m][0], r1 = sv[mm][bj][1] + gv[bj][1] * acc[ai][bj][m][1];
                        u32x4 w; w.x = cvt_pk_bf16(r0.x, r0.y); w.y = cvt_pk_bf16(r0.z, r0.w); w.z = cvt_pk_bf16(r1.x, r1.y); w.w = cvt_pk_bf16(r1.z, r1.w);
                        *(u32x4*)(dst + ro + bj * HALF) = w; } }
                __builtin_amdgcn_sched_barrier(0);
            }
        } else {
#pragma unroll
            for (int ai = 0; ai < 2; ++ai)
                if (u.half != 2 - ai) {
                u32x4 sb[4][2];
#pragma unroll
                for (int m = 0; m < 4; ++m) { const size_t ro = (size_t)(ai * HALF + wr * 64 + m * 16 + fr) * D + col0;
#pragma unroll
                    for (int bj = 0; bj < 2; ++bj) sb[m][bj] = *(const u32x4*)(dst + ro + bj * HALF); }
                __builtin_amdgcn_sched_barrier(0);
#pragma unroll
                for (int m = 0; m < 4; ++m) { const size_t ro = (size_t)(ai * HALF + wr * 64 + m * 16 + fr) * D + col0;
#pragma unroll
                    for (int bj = 0; bj < 2; ++bj) { const u32x4 w0 = sb[m][bj];
                        const f32x4 r0 = (f32x4){bflo(w0.x), bfhi(w0.x), bflo(w0.y), bfhi(w0.y)} + gv[bj][0] * acc[ai][bj][m][0], r1 = (f32x4){bflo(w0.z), bfhi(w0.z), bflo(w0.w), bfhi(w0.w)} + gv[bj][1] * acc[ai][bj][m][1];
                        u32x4 w; w.x = cvt_pk_bf16(r0.x, r0.y); w.y = cvt_pk_bf16(r0.z, r0.w); w.z = cvt_pk_bf16(r1.x, r1.y); w.w = cvt_pk_bf16(r1.z, r1.w);
                        *(u32x4*)(dst + ro + bj * HALF) = w; } }
                __builtin_amdgcn_sched_barrier(0);
                }
        }
    }
};
}

struct Args { const float* in[30]; float* out; unsigned char* ws; int ph_lo, ph_hi; };
typedef const __attribute__((address_space(4))) Args& CArgsRef;
#define ARGP() (*({ const __attribute__((address_space(4))) Args* _p = (const __attribute__((address_space(4))) Args*)__builtin_amdgcn_kernarg_segment_ptr(); asm volatile("" : "+s"(_p)); _p; }))
struct Frame {
    LAS unsigned char* lds;
    int tid, lane, wave, G, bid;
    float* out; unsigned char* ws;
    unsigned* ctl;
};
#define WSP(T, off) ((T*)(F.ws + (off)))

__device__ __forceinline__ bf16_t* xl_row(const Frame& F, int ta) { return WSP(bf16_t, WS_X) + (size_t)ta * D; }

struct TrItem { const float* src; bf16_t* dst; int N, ldo; int vp = -1; };
__device__ __forceinline__ void tr_load(const TrItem& t, f32x4 (&v)[8], int lane) {
#pragma unroll
    for (int i = 0; i < 8; ++i) { const int kk = 8 * i + (lane >> 3); v[i] = *(const f32x4*)(t.src + (size_t)kk * t.N + 4 * (lane & 7)); }
}
__device__ __forceinline__ void tr_finish(const TrItem& t, const f32x4 (&v)[8], LAS float* scr, int lane) {
#pragma unroll
    for (int i = 0; i < 8; ++i) { const int kk = 8 * i + (lane >> 3); LAS float* p = scr + kk * 33 + 4 * (lane & 7); p[0] = v[i].x; p[1] = v[i].y; p[2] = v[i].z; p[3] = v[i].w; }
    LDS_WAIT(); asm volatile("" ::: "memory");
    const int c = lane & 7;
#pragma unroll
    for (int j = 0; j < 4; ++j) { const int n = (lane >> 3) + 8 * j; const LAS float* s = scr + (8 * c) * 33 + n;
        u32x4 o; o.x = cvt_pk_bf16(s[0 * 33], s[1 * 33]); o.y = cvt_pk_bf16(s[2 * 33], s[3 * 33]); o.z = cvt_pk_bf16(s[4 * 33], s[5 * 33]); o.w = cvt_pk_bf16(s[6 * 33], s[7 * 33]);
        const int nr = t.vp < 0 ? n : (n & 3) * 32 + t.vp * 8 + (n >> 2);
        *(u32x4*)(t.dst + (size_t)nr * t.ldo + 8 * c) = o; }
    LDS_WAIT(); asm volatile("" ::: "memory");
}
__device__ __forceinline__ TrItem tr_generic(const float* W, int K, int N, bf16_t* WT, int item) {
    const int nblk = N / 32, kb = item / nblk, nb = item % nblk;
    return TrItem{W + (size_t)(64 * kb) * N + 32 * nb, WT + (size_t)(32 * nb) * K + 64 * kb, N, K};
}

__device__ __forceinline__ TrItem moe_tr_item(CArgsRef A, unsigned char* ws_, int le, int q) {
    bf16_t* W1 = (bf16_t*)(ws_ + WS_WM1) + (size_t)le * 512 * 1024; bf16_t* W2 = (bf16_t*)(ws_ + WS_WM2) + (size_t)le * 1024 * 256;
    if (q < 256) {
        const int up = q >> 7, item = q & 127, kb = item / 8, nb = item % 8, n0 = 32 * nb;
        const float* W = A.in[up ? 28 : 27] + (size_t)le * 1024 * 256;
        const int drow = (n0 >> 7) * 256 + up * 128 + (n0 & 127);
        return TrItem{W + (size_t)(64 * kb) * 256 + n0, W1 + (size_t)drow * 1024 + 64 * kb, 256, 1024};
    }
    return tr_generic(A.in[29] + (size_t)le * 256 * 1024, 256, 1024, W2, q - 256);
}
__device__ __forceinline__ void moe_fill(Frame& F, CArgsRef A, int le0, int nle, int rank, int nranks) {
    const int lane = F.lane, wave = F.wave;
    LAS float* scr = (LAS float*)(F.lds + wave * 16384);
    const int items = nle * 384, nw = nranks * 8, per = (items + nw - 1) / nw, wv = rank * 8 + wave;
    int it0 = wv * per, it1 = it0 + per; if (it1 > items) it1 = items;
    unsigned char* ws_ = F.ws;
    for (int it = it0; it < it1; it += 4) {
#define MF_ITEM(k) moe_tr_item(A, ws_, le0 + ((it + (k)) < it1 ? (it + (k)) : it) / 384, ((it + (k)) < it1 ? (it + (k)) : it) % 384)
        TrItem t0 = MF_ITEM(0), t1 = MF_ITEM(1), t2 = MF_ITEM(2), t3 = MF_ITEM(3);
#undef MF_ITEM
        f32x4 v0[8], v1[8], v2[8], v3[8];
        tr_load(t0, v0, lane); tr_load(t1, v1, lane); tr_load(t2, v2, lane); tr_load(t3, v3, lane);
        __builtin_amdgcn_sched_barrier(0);
        tr_finish(t0, v0, scr, lane);
        if (it + 1 < it1) tr_finish(t1, v1, scr, lane);
        if (it + 2 < it1) tr_finish(t2, v2, scr, lane);
        if (it + 3 < it1) tr_finish(t3, v3, scr, lane);
    }
}

__device__ __forceinline__ void p0_prologue(Frame& F, CArgsRef A, unsigned long long& pt1) {
    const int tid = F.tid, lane = F.lane, wave = F.wave;
    constexpr int NMODU = 192;
    if (F.bid < NMODU) {
        LAS float* SC = (LAS float*)F.lds;
        LAS float* RED = (LAS float*)(F.lds + 36864);
#define MOD_WLOAD(u_) do { const int l_ = (u_) / 96, cb_ = ((u_) % 96) >> 1, kh_ = (u_) & 1; \
            const float* W_ = A.in[4] + (size_t)l_ * D * (NMOD * D) + (size_t)(kh_ * 512 + 64 * wave) * (NMOD * D) + cb_ * 128 + 2 * lane; \
            _Pragma("unroll") for (int i = 0; i < 64; ++i) w[i] = *(const f32x2*)(W_ + (size_t)i * (NMOD * D)); } while (0)
        f32x2 w[64];
        MOD_WLOAD(F.bid);
        {
            float cv[18];
#pragma unroll
            for (int q = 0; q < 18; ++q) { const int i = tid + 512 * q, r = i >> 10, k = i & 1023; cv[q] = r < 8 ? A.in[1][r * 1024 + k] : A.in[3][k]; }
            __builtin_amdgcn_sched_barrier(0);
#pragma unroll
            for (int q = 0; q < 18; ++q) SC[tid + 512 * q] = siluf_(cv[q]);
        }
        __syncthreads();
        float* MOD = WSP(float, WS_MOD);
        for (int u = F.bid; u < NMODU; u += F.G) {
            const int l = u / 96, cb = (u % 96) >> 1, kh = u & 1, k0 = kh * 512 + 64 * wave;
            __builtin_amdgcn_sched_barrier(0);
            f32x2 a[9];
#pragma unroll
            for (int r = 0; r < 9; ++r) { a[r] = (f32x2){0.f, 0.f};
#pragma unroll
                for (int i4 = 0; i4 < 16; ++i4) { const f32x4 sc4 = *(const LAS f32x4*)(SC + r * 1024 + k0 + 4 * i4);
                    a[r] += w[4 * i4] * sc4.x; a[r] += w[4 * i4 + 1] * sc4.y; a[r] += w[4 * i4 + 2] * sc4.z; a[r] += w[4 * i4 + 3] * sc4.w; } }
#pragma unroll
            for (int r = 0; r < 9; ++r) *(LAS f32x2*)(RED + (wave * 9 + r) * 128 + 2 * lane) = a[r];
            __syncthreads();
            {
                float bs[3];
#pragma unroll
                for (int q = 0; q < 3; ++q) { const int o = tid + 512 * q; bs[q] = (kh == 0 && o < 9 * 128) ? A.in[5][l * (NMOD * D) + cb * 128 + (o & 127)] : 0.f; }
#pragma unroll
                for (int q = 0; q < 3; ++q) { const int o = tid + 512 * q; if (o < 9 * 128) { const int r = o >> 7, cc = o & 127; float sm = 0.f;
#pragma unroll
                    for (int w8 = 0; w8 < 8; ++w8) sm += RED[(w8 * 9 + r) * 128 + cc];
                    atomicAdd(&MOD[((size_t)l * 9 + r) * (NMOD * D) + cb * 128 + cc], sm + bs[q]); } }
            }
            __syncthreads();
            if (u + F.G < NMODU) MOD_WLOAD(u + F.G);
        }
    }
#undef MOD_WLOAD
    if (PT_SUB == 1) pt1 = __builtin_amdgcn_s_memrealtime();
    {
        const float invf[16] = {1.000000000e+00f, 5.623413324e-01f, 3.162277639e-01f, 1.778279394e-01f, 1.000000015e-01f, 5.623413250e-02f, 3.162277490e-02f, 1.778279431e-02f,
                                9.999999776e-03f, 5.623413250e-03f, 3.162277630e-03f, 1.778279431e-03f, 1.000000047e-03f, 5.623413017e-04f, 3.162277571e-04f, 1.778279402e-04f};
        float* COS = WSP(float, WS_COS); float* SIN = WSP(float, WS_SIN);
        for (int i = F.bid * 512 + tid; i < SEQ * 32; i += F.G * 512) {
            const int pos = i >> 5, j = i & 31, f = j & 15; const float p = (float)(j < 16 ? (pos >> 6) : (pos & 63));
            float fr = 1.f;
#pragma unroll
            for (int q = 0; q < 16; ++q) fr = (f == q) ? invf[q] : fr;
            const float angf = p * fr; const double x = (double)angf;
            const double n = __builtin_rint(x * 0.63661977236758134308);
            const double y = (x - n * 1.57079632679489655800e+00) - n * 6.12323399573676603587e-17;
            const double y2 = y * y;
            double sn = y * (1.0 + y2 * (-1.0 / 6 + y2 * (1.0 / 120 + y2 * (-1.0 / 5040 + y2 * (1.0 / 362880 + y2 * (-1.0 / 39916800 + y2 * (1.0 / 6227020800.0)))))));
            double cs = 1.0 + y2 * (-0.5 + y2 * (1.0 / 24 + y2 * (-1.0 / 720 + y2 * (1.0 / 40320 + y2 * (-1.0 / 3628800 + y2 * (1.0 / 479001600.0 + y2 * (-1.0 / 87178291200.0)))))));
            const int q4 = ((int)n) & 3;
            const double c = (q4 == 0) ? cs : (q4 == 1) ? -sn : (q4 == 2) ? -cs : sn;
            const double s = (q4 == 0) ? sn : (q4 == 1) ? cs : (q4 == 2) ? -sn : -cs;
            COS[i] = (float)c; SIN[i] = (float)s;
        }
    }
    if (PT_SUB == 2) pt1 = __builtin_amdgcn_s_memrealtime();
    {
        LAS float* scr = (LAS float*)(F.lds + wave * 16384);
        constexpr int I_IN0 = 16 * 48, I_OUT = 16 * 32, I_IN1 = 16 * 62, I_UQ = 4 * 24, I_UKV = 2 * 32, I_POOL = 4 * 8, I_MOE = 8 * 384;
        constexpr int NIT = I_IN0 + I_OUT + I_IN1 + I_UQ + I_UKV + I_OUT + I_POOL + I_MOE;
        int it0, it1, step;
        if (F.G == 256) {
            const int wv = F.bid * 8 + wave;
            it0 = F.bid < NMODU ? wv * 2 : NMODU * 16 + (wv - NMODU * 8) * 6; it1 = it0 + (F.bid < NMODU ? 2 : 6); if (it1 > NIT) it1 = NIT; if (it0 > NIT) it0 = NIT; step = 1;
            static_assert(NMODU * 16 + (256 - NMODU) * 48 >= NIT, "prologue item split");
        } else { it0 = F.bid * 8 + wave; it1 = NIT; step = F.G * 8; }
        unsigned char* ws_ = F.ws;
        auto item_of = [&](int it) -> TrItem {
            int r = it;
            if (r < I_IN0) {
                const int kb = r / 48, nb = r % 48, n0 = 32 * nb;
                const int drow = n0 < 512 ? (n0 >> 7) * 256 + (n0 & 127) : n0 < 1024 ? ((n0 - 512) >> 7) * 256 + 128 + ((n0 - 512) & 127) : n0;
                return TrItem{A.in[7] + (size_t)(64 * kb) * 1536 + n0, (bf16_t*)(ws_ + WS_WIN0) + (size_t)drow * D + 64 * kb, 1536, D}; }
            r -= I_IN0;
            if (r < I_OUT) return tr_generic(A.in[14], D, D, (bf16_t*)(ws_ + WS_WOUT0), r); r -= I_OUT;
            if (r < I_IN1) { TrItem t = tr_generic(A.in[15], D, 1984, (bf16_t*)(ws_ + WS_WIN1), r); const int kb = r / 62, n0 = 32 * (r % 62);
                if (n0 >= PC_VD) { const int hv = (n0 - PC_VD) >> 7; t.dst = (bf16_t*)(ws_ + WS_WIN1) + (size_t)(PC_VD + hv * 128) * D + 64 * kb; t.vp = ((n0 - PC_VD) & 127) >> 5; }
                return t; } r -= I_IN1;
            if (r < I_UQ) return tr_generic(A.in[17], 256, 768, (bf16_t*)(ws_ + WS_WUQ), r); r -= I_UQ;
            if (r < I_UKV) { TrItem t = tr_generic(A.in[19], 128, 1024, (bf16_t*)(ws_ + WS_WUKV), r); const int kb = r / 32, n0 = 32 * (r % 32);
                if ((n0 & 255) >= 128) { t.dst = (bf16_t*)(ws_ + WS_WUKV) + (size_t)((n0 >> 8) * 256 + 128) * 128 + 64 * kb; t.vp = ((n0 & 255) - 128) >> 5; }
                return t; } r -= I_UKV;
            if (r < I_OUT) return tr_generic(A.in[24], D, D, (bf16_t*)(ws_ + WS_WOUT1), r); r -= I_OUT;
            if (r < I_POOL) { const int g = r / 8; return tr_generic(A.in[12] + (size_t)g * 128 * 128, 128, 128, (bf16_t*)(ws_ + WS_WPOOL) + (size_t)g * 128 * 128, r % 8); } r -= I_POOL;
            return moe_tr_item(A, ws_, 32 + r / 384, r % 384);
        };
        for (int it = it0; it < it1; it += 4 * step) {
            TrItem t0 = item_of(it), t1 = item_of(it + step < it1 ? it + step : it), t2 = item_of(it + 2 * step < it1 ? it + 2 * step : it), t3 = item_of(it + 3 * step < it1 ? it + 3 * step : it);
            f32x4 v0[8], v1[8], v2[8], v3[8];
            tr_load(t0, v0, lane); tr_load(t1, v1, lane); tr_load(t2, v2, lane); tr_load(t3, v3, lane);
            __builtin_amdgcn_sched_barrier(0);
            tr_finish(t0, v0, scr, lane);
            if (it + step < it1) tr_finish(t1, v1, scr, lane);
            if (it + 2 * step < it1) tr_finish(t2, v2, scr, lane);
            if (it + 3 * step < it1) tr_finish(t3, v3, scr, lane);
        }
        { u32x4* z = (u32x4*)(WSP(bf16_t, WS_WIN1) + (size_t)1984 * 1024); const u32x4 zero = {0u, 0u, 0u, 0u};
          for (int i = F.bid * 512 + tid; i < 64 * 1024 / 8; i += F.G * 512) z[i] = zero; }
    }
}

__device__ __forceinline__ void norm_mod_phase(Frame& F, CArgsRef A, int layer) {
    const int gw = F.bid * 8 + F.wave, NGW = F.G * 8, lane = F.lane;
    const float* g = A.in[6] + (size_t)(layer * 2 + 0) * D;
    const float* MODL = WSP(float, WS_MOD) + (size_t)layer * 9 * (NMOD * D);
    bf16_t* H = WSP(bf16_t, WS_H);
    f32x4 gvec[4];
#pragma unroll
    for (int q = 0; q < 4; ++q) gvec[q] = *(const f32x4*)(g + 8 * lane + 512 * (q >> 1) + 4 * (q & 1));
    for (int ta0 = gw; ta0 < NTOK; ta0 += 2 * NGW) {
        const int ta1 = ta0 + NGW; const bool has1 = ta1 < NTOK;
        f32x4 v[2][4], s4[2][4], h4[2][4];
#pragma unroll
        for (int e = 0; e < 2; ++e) { const int ta = e ? (has1 ? ta1 : ta0) : ta0; const int b = ta / TPB, j = ta - b * TPB, mrow = j < CTXL ? 8 : b;
            const float* src = j < CTXL ? A.in[2] + (size_t)(b * CTXL + j) * D : A.in[0] + ((size_t)b * SEQ + (j - CTXL)) * D;
            const u32x4* xb = (const u32x4*)xl_row(F, ta) + lane;
            const float* sh = MODL + (size_t)mrow * (NMOD * D); const float* sc = sh + D;
            if (layer != 0) { const u32x4 w0 = xb[0], w1 = xb[64]; v[e][0] = bf4((u32x2){w0.x, w0.y}); v[e][1] = bf4((u32x2){w0.z, w0.w}); v[e][2] = bf4((u32x2){w1.x, w1.y}); v[e][3] = bf4((u32x2){w1.z, w1.w}); }
#pragma unroll
            for (int q = 0; q < 4; ++q) { const int cq = 8 * lane + 512 * (q >> 1) + 4 * (q & 1); if (layer == 0) v[e][q] = *(const f32x4*)(src + cq); s4[e][q] = *(const f32x4*)(sc + cq); h4[e][q] = *(const f32x4*)(sh + cq); } }
        __builtin_amdgcn_sched_barrier(0);
#pragma unroll
        for (int e = 0; e < 2; ++e) { const int ta = e ? ta1 : ta0; if (e && !has1) break;
            float s = 0.f;
#pragma unroll
            for (int q = 0; q < 4; ++q) s += (v[e][q].x * v[e][q].x + v[e][q].y * v[e][q].y) + (v[e][q].z * v[e][q].z + v[e][q].w * v[e][q].w);
            const float r = 1.f / sqrtf(wave_sum(s) * (1.f / D) + EPS);
            u32x4* o8 = (u32x4*)(H + (size_t)ta * D) + lane;
#pragma unroll
            for (int c = 0; c < 2; ++c) { const f32x4 y = (v[e][2 * c] * r) * gvec[2 * c] * (s4[e][2 * c] + 1.f) + h4[e][2 * c], z = (v[e][2 * c + 1] * r) * gvec[2 * c + 1] * (s4[e][2 * c + 1] + 1.f) + h4[e][2 * c + 1];
                u32x4 w; w.x = cvt_pk_bf16(y.x, y.y); w.y = cvt_pk_bf16(y.z, y.w); w.z = cvt_pk_bf16(z.x, z.y); w.w = cvt_pk_bf16(z.z, z.w); o8[64 * c] = w; } }
    }
}

__device__ __forceinline__ void convpool_phase(Frame& F, CArgsRef A, unsigned long long& pt1) {
    const int tid = F.tid, lane = F.lane, wave = F.wave, r32 = lane & 31, hi = lane >> 5;
    const bf16_t* __restrict__ U = WSP(bf16_t, WS_BIG); bf16_t* __restrict__ Y = (bf16_t*)F.out; const bf16_t* __restrict__ WP = WSP(bf16_t, WS_WPOOL);
    {
        LAS bf16_t* GL = (LAS bf16_t*)F.lds;
        LAS float* CV = (LAS float*)(F.lds + 63488);
        const int c0 = wave * 64 + lane;
        float w0[31];
#pragma unroll
        for (int k = 0; k < 31; ++k) w0[k] = A.in[8][k * 512 + c0];
        __builtin_amdgcn_sched_barrier(0);
        const float dwb = A.in[9][c0];
        f32x2 wp[32];
#pragma unroll
        for (int k = 0; k < 32; ++k) wp[k] = (f32x2){k < 31 ? w0[k < 31 ? k : 0] : 0.f, k >= 1 ? w0[k >= 1 ? k - 1 : 0] : 0.f};
        const f32x4 lg0 = *(const f32x4*)(A.in[10] + 8 * lane), lg1 = *(const f32x4*)(A.in[10] + 8 * lane + 4), lb0 = *(const f32x4*)(A.in[11] + 8 * lane), lb1 = *(const f32x4*)(A.in[11] + 8 * lane + 4);
#define CP_UNIT(u_, b, n, tb, t0, TS) int b, n, tb, t0, TS; if ((u_) < 1024) { b = (u_) >> 7; n = SEQ; tb = b * TPB + CTXL; t0 = ((u_) & 127) * 32; TS = 32; } else { const int uu = (u_) - 1024; b = uu >> 5; n = CTXL; tb = b * TPB; t0 = (uu & 31) * 8; TS = 8; }
#define CPA_LOAD(u_) do { CP_UNIT(u_, b_, n_, tb_, t0_, TS_); const int nG_ = (TS_ + 30) * 64; (void)b_; \
            _Pragma("unroll") for (int q = 0; q < 8; ++q) { const int ch = q * 512 + tid, ri = ch >> 6, c8 = (ch & 63) * 8, pos = t0_ + ri - 15; const bool ok = (ch < nG_) && pos >= 0 && pos < n_; \
                const bf16_t* up = U + (size_t)(tb_ + (ok ? pos : t0_)) * UW + c8; av[q] = *(const u32x4*)up; } } while (0)
        u32x4 av[8];
        if (F.bid < 1280) CPA_LOAD(F.bid);
        for (int u = F.bid; u < 1280; u += F.G) {
            CP_UNIT(u, b, n, tb, t0, TS); (void)b;
            __syncthreads();
            const int nG = (TS + 30) * 64;
#pragma unroll
            for (int q = 0; q < 8; ++q) { const int ch = q * 512 + tid, ri = ch >> 6, c8 = (ch & 63) * 8, pos = t0 + ri - 15; const bool ok = pos >= 0 && pos < n;
                u32x4 o = av[q];
                if (!ok) o = (u32x4){0u, 0u, 0u, 0u};
                if (ch < nG) *(LAS u32x4*)(GL + ri * 512 + c8) = o; }
            __builtin_amdgcn_sched_barrier(0);
            if (u + F.G < 1280) CPA_LOAD(u + F.G);
            __builtin_amdgcn_sched_barrier(0);
            __syncthreads();
#pragma unroll 1
            for (int i0 = 0; i0 < TS; i0 += 8) {
                f32x2 x0[4];
#pragma unroll
                for (int q = 0; q < 4; ++q) x0[q] = (f32x2){dwb, dwb};
#pragma unroll
                for (int r = 0; r < 38; ++r) { const float g0 = bf2f(*(const LAS unsigned short*)(GL + (i0 + r) * 512 + c0));
#pragma unroll
                    for (int q = 0; q < 4; ++q) { const int k = r - 2 * q; if (k >= 0 && k < 32) x0[q] += wp[k] * g0; } }
#pragma unroll
                for (int q = 0; q < 4; ++q) { CV[(i0 + 2 * q) * 512 + c0] = x0[q].x; CV[(i0 + 2 * q + 1) * 512 + c0] = x0[q].y; }
            }
            __syncthreads();
            {
                f32x4 v0[4], v1[4]; float mean[4], rstd[4];
#pragma unroll
                for (int j = 0; j < 4; ++j) { const int tk = (wave + 8 * j) < TS ? (wave + 8 * j) : wave; v0[j] = *(const LAS f32x4*)(CV + tk * 512 + 8 * lane); v1[j] = *(const LAS f32x4*)(CV + tk * 512 + 8 * lane + 4); }
#pragma unroll
                for (int j = 0; j < 4; ++j) mean[j] = wave_sum_dpp((v0[j].x + v0[j].y) + (v0[j].z + v0[j].w) + (v1[j].x + v1[j].y) + (v1[j].z + v1[j].w)) * (1.f / 512.f);
#pragma unroll
                for (int j = 0; j < 4; ++j) { v0[j] = v0[j] - mean[j]; v1[j] = v1[j] - mean[j]; }
#pragma unroll
                for (int j = 0; j < 4; ++j) { const f32x4 d0 = v0[j], d1 = v1[j];
                    rstd[j] = 1.f / sqrtf(wave_sum_dpp((d0.x * d0.x + d0.y * d0.y) + (d0.z * d0.z + d0.w * d0.w) + (d1.x * d1.x + d1.y * d1.y) + (d1.z * d1.z + d1.w * d1.w)) * (1.f / 512.f) + EPS); }
#pragma unroll
                for (int j = 0; j < 4; ++j) { const int tk = wave + 8 * j;
                    if (tk < TS) { const f32x4 y0 = v0[j] * rstd[j] * lg0 + lb0, y1 = v1[j] * rstd[j] * lg1 + lb1;
                        u32x4 o; o.x = cvt_pk_bf16(siluf_(y0.x), siluf_(y0.y)); o.y = cvt_pk_bf16(siluf_(y0.z), siluf_(y0.w)); o.z = cvt_pk_bf16(siluf_(y1.x), siluf_(y1.y)); o.w = cvt_pk_bf16(siluf_(y1.z), siluf_(y1.w));
                        *(u32x4*)(Y + (size_t)(tb + t0 + tk) * D + 8 * lane) = o; } }
            }
        }
    }
    if (PT_SUB == 4) pt1 = __builtin_amdgcn_s_memrealtime();
    {
        LAS bf16_t* UP = (LAS bf16_t*)F.lds;
        LAS bf16_t* PL = (LAS bf16_t*)(F.lds + 49152);
        bf16x8 wfr[2][8]; float pscv[2];
#pragma unroll
        for (int ntile = 0; ntile < 2; ++ntile) { const int gi = wave >> 1, nc = (wave & 1) * 64 + 2 * r32 + ntile; pscv[ntile] = A.in[13][gi * 128 + nc];
#pragma unroll
            for (int ks = 0; ks < 8; ++ks) wfr[ntile][ks] = *(const bf16x8*)(WP + ((size_t)(gi * 128 + nc)) * 128 + ks * 16 + hi * 8); }
        __builtin_amdgcn_sched_barrier(0);
#define CPB_LOAD(u_) do { CP_UNIT(u_, b_, n_, tb_, t0_, TS_); const int nU_ = (TS_ + 16) * 64; (void)b_; \
            _Pragma("unroll") for (int q = 0; q < 6; ++q) { const int ch = q * 512 + tid, ri = ch >> 6, c8 = (ch & 63) * 8, pos = t0_ + ri - 8; const bool ok = (ch < nU_) && pos >= 0 && pos < n_; \
                uv[q] = *(const u32x4*)(U + (size_t)(tb_ + (ok ? pos : t0_)) * UW + 512 + c8); if (!ok) uv[q] = (u32x4){0u, 0u, 0u, 0u}; } } while (0)
        u32x4 uv[6];
        if (F.bid < 1280) CPB_LOAD(F.bid);
        for (int u = F.bid; u < 1280; u += F.G) {
            CP_UNIT(u, b, n, tb, t0, TS); (void)b;
            __syncthreads();
            const int nU = (TS + 16) * 64;
#pragma unroll
            for (int q = 0; q < 6; ++q) { const int ch = q * 512 + tid, ri = ch >> 6, c8 = (ch & 63) * 8; if (ch < nU) *(LAS u32x4*)(UP + ri * 512 + c8) = uv[q]; }
            __builtin_amdgcn_sched_barrier(0);
            if (u + F.G < 1280) CPB_LOAD(u + F.G);
            __builtin_amdgcn_sched_barrier(0);
            __syncthreads();
#pragma unroll
            for (int gi = 0; gi < 4; ++gi) { const int hw = 1 << gi, i = tid >> 4, c8 = gi * 128 + (tid & 15) * 8, pos = t0 + i;
                u32x4 o = {0u, 0u, 0u, 0u};
                if (i < TS) {
                    const int lo = (pos - hw) > 0 ? (pos - hw) : 0, hh = (pos + hw) < n ? (pos + hw) : n;
                    float s[8];
#pragma unroll
                    for (int j = 0; j < 8; ++j) s[j] = 0.f;
#pragma unroll
                    for (int d = -hw; d < hw; ++d) { const u32x4 v = *(const LAS u32x4*)(UP + (i + d + 8) * 512 + c8);
                        s[0] += bflo(v.x); s[1] += bfhi(v.x); s[2] += bflo(v.y); s[3] += bfhi(v.y); s[4] += bflo(v.z); s[5] += bfhi(v.z); s[6] += bflo(v.w); s[7] += bfhi(v.w); }
                    const float ic = 1.f / (float)(hh - lo);
                    const u32x4 v = *(const LAS u32x4*)(UP + (i + 8) * 512 + c8);
                    o.x = cvt_pk_bf16(s[0] * ic - bflo(v.x), s[1] * ic - bfhi(v.x)); o.y = cvt_pk_bf16(s[2] * ic - bflo(v.y), s[3] * ic - bfhi(v.y));
                    o.z = cvt_pk_bf16(s[4] * ic - bflo(v.z), s[5] * ic - bfhi(v.z)); o.w = cvt_pk_bf16(s[6] * ic - bflo(v.w), s[7] * ic - bfhi(v.w)); }
                *(LAS u32x4*)(PL + i * 520 + c8) = o; }
            __syncthreads();
            {
                const int gi = wave >> 1, nh = wave & 1;
                f32x16 acc0 = {}, acc1 = {};
#pragma unroll
                for (int ks = 0; ks < 8; ++ks) { const bf16x8 a = *(const LAS bf16x8*)(PL + r32 * 520 + gi * 128 + ks * 16 + hi * 8);
                    acc0 = __builtin_amdgcn_mfma_f32_32x32x16_bf16(a, wfr[0][ks], acc0, 0, 0, 0); acc1 = __builtin_amdgcn_mfma_f32_32x32x16_bf16(a, wfr[1][ks], acc1, 0, 0, 0); }
#pragma unroll
                for (int r = 0; r < 16; ++r) { const int tk = crow(r, hi); if (tk < TS) *(unsigned*)(Y + (size_t)(tb + t0 + tk) * D + 512 + gi * 128 + nh * 64 + 2 * r32) = cvt_pk_bf16(acc0[r] * pscv[0], acc1[r] * pscv[1]); }
            }
        }
    }
#undef CP_UNIT
#undef CPA_LOAD
#undef CPB_LOAD
    __syncthreads();
}

__device__ __forceinline__ void router_phase(Frame& F, CArgsRef A, int layer, int rb, int rg) {
    const int tid = F.tid, lane = F.lane, wave = F.wave, r32 = lane & 31, hi = lane >> 5;
    LAS float* T = (LAS float*)F.lds;
    LAS bf16_t* TH = (LAS bf16_t*)F.lds;
    LAS bf16_t* TL = TH + 32 * 1032;
    LAS float* LOG = (LAS float*)(F.lds + 133120);
    LAS float* GS = LOG; LAS int* GI = (LAS int*)(LOG + 288); LAS float* G1 = LOG + 576; LAS float* G2 = LOG + 864;
    const f32x4 rb4 = *(const f32x4*)(A.in[26] + 4 * ((tid >> 5) & 7));
    LAS float* VA = (LAS float*)(F.lds + 141568);
    LAS float* VB = VA + 1024;
    const float* g = A.in[6] + (size_t)(layer * 2 + 1) * D;
    const float* MODL = WSP(float, WS_MOD) + (size_t)layer * 9 * (NMOD * D);
    bf16_t* H = WSP(bf16_t, WS_H);
    unsigned* CNT = F.ctl + CW_CNT + layer * 64; int* LIST = WSP(int, WS_LIST); f32x2* TW = WSP(f32x2, WS_TW);
    bf16x8 rwh[8], rwl[8];
    {
        float rwreg[64];
#pragma unroll
        for (int s = 0; s < 64; ++s) rwreg[s] = A.in[25][(size_t)(128 * wave + 16 * (s >> 3) + 8 * hi + (s & 7)) * NEXP + r32];
        __builtin_amdgcn_sched_barrier(0);
#pragma unroll
        for (int ks = 0; ks < 8; ++ks) { u32x4 wh, wl;
#pragma unroll
            for (int p = 0; p < 4; ++p) { const float a = rwreg[8 * ks + 2 * p], b = rwreg[8 * ks + 2 * p + 1]; const unsigned hh = cvt_pk_bf16(a, b);
                wh[p] = hh; wl[p] = cvt_pk_bf16(a - bflo(hh), b - bfhi(hh)); }
            rwh[ks] = *reinterpret_cast<bf16x8*>(&wh); rwl[ks] = *reinterpret_cast<bf16x8*>(&wl); }
    }
    const int ngroups = layer == 0 ? NTOK / 32 : NLAT / 32;
#define RT_TA0(grp_) (layer == 0 ? (grp_) * 32 : ((grp_) >> 7) * TPB + CTXL + ((grp_) & 127) * 32)
#define RT_LOAD(grp_) do { const int ta0_ = RT_TA0(grp_); \
        _Pragma("unroll") for (int q = 0; q < 4; ++q) { const u32x4* xr = (const u32x4*)xl_row(F, ta0_ + 4 * wave + q) + lane; _Pragma("unroll") for (int c = 0; c < 2; ++c) vr[q][c] = xr[64 * c]; } \
        const int b0 = ta0_ / TPB, j0 = ta0_ - b0 * TPB, mrow = j0 < CTXL ? 8 : b0; const float* sh = MODL + (size_t)mrow * (NMOD * D) + 3 * D; const float* sc = sh + D; \
        g2 = *(const f32x2*)(g + 2 * tid); s2 = *(const f32x2*)(sc + 2 * tid); h2 = *(const f32x2*)(sh + 2 * tid); } while (0)
    u32x4 vr[4][2]; f32x2 g2, s2, h2;
    LAS int* LCNT = (LAS int*)(F.lds + 150016);
    LAS int* LBASE = LCNT + 48;
    LAS int* RTA = LCNT + 96;
    LAS int* RBP = RTA + 192;
    if (tid < NBUCK) LCNT[tid] = 0;
    int it = 0;
#define RT_FLUSH() do { __syncthreads(); \
        if (tid < NBUCK) { const int c_ = LCNT[tid]; LBASE[tid] = c_ ? (int)atomicAdd(&CNT[tid], (unsigned)c_) : 0; LCNT[tid] = 0; } \
        __syncthreads(); \
        if (tid < it * 32) { const int bp_ = RBP[tid]; const int bk_ = bp_ >> 16; LIST[(size_t)bk_ * LCAP + LBASE[bk_] + (bp_ & 0xffff)] = RTA[tid]; } \
        __syncthreads(); } while (0)
    if (rb < ngroups) RT_LOAD(rb);
    for (int grp = rb; grp < ngroups; grp += rg) {
        const int ta0 = RT_TA0(grp);
        __syncthreads();
        {
            *(LAS f32x2*)(VA + 2 * tid) = g2 * (s2 + 1.f); *(LAS f32x2*)(VB + 2 * tid) = h2;
            float rr[4];
#pragma unroll
            for (int q = 0; q < 4; ++q) { float s = 0.f;
#pragma unroll
                for (int c = 0; c < 2; ++c) { const f32x4 x4 = bf4((u32x2){vr[q][c].x, vr[q][c].y}), x5 = bf4((u32x2){vr[q][c].z, vr[q][c].w}); s += ((x4.x * x4.x + x4.y * x4.y) + (x4.z * x4.z + x4.w * x4.w)) + ((x5.x * x5.x + x5.y * x5.y) + (x5.z * x5.z + x5.w * x5.w)); }
                rr[q] = 1.f / sqrtf(wave_sum_dpp(s) * (1.f / D) + EPS); }
            __syncthreads();
#pragma unroll
            for (int q = 0; q < 4; ++q) { const int ti = 4 * wave + q, ta = ta0 + ti;
                u32x4* o8 = (u32x4*)(H + (size_t)ta * D) + lane;
#pragma unroll
                for (int c = 0; c < 2; ++c) { const int col = 8 * lane + 512 * c;
                    const f32x4 a4 = *(const LAS f32x4*)(VA + col), b4 = *(const LAS f32x4*)(VB + col), a5 = *(const LAS f32x4*)(VA + col + 4), b5 = *(const LAS f32x4*)(VB + col + 4);
                    const f32x4 y = (bf4((u32x2){vr[q][c].x, vr[q][c].y}) * rr[q]) * a4 + b4, z = (bf4((u32x2){vr[q][c].z, vr[q][c].w}) * rr[q]) * a5 + b5;
                    u32x4 w; w.x = cvt_pk_bf16(y.x, y.y); w.y = cvt_pk_bf16(y.z, y.w); w.z = cvt_pk_bf16(z.x, z.y); w.w = cvt_pk_bf16(z.z, z.w); o8[64 * c] = w;
                    u32x4 wl; wl.x = cvt_pk_bf16(y.x - bflo(w.x), y.y - bfhi(w.x)); wl.y = cvt_pk_bf16(y.z - bflo(w.y), y.w - bfhi(w.y)); wl.z = cvt_pk_bf16(z.x - bflo(w.z), z.y - bfhi(w.z)); wl.w = cvt_pk_bf16(z.z - bflo(w.w), z.w - bfhi(w.w));
                    *(LAS u32x4*)(TH + ti * 1032 + col) = w; *(LAS u32x4*)(TL + ti * 1032 + col) = wl; } }
            __builtin_amdgcn_sched_barrier(0);
            if (grp + rg < ngroups) RT_LOAD(grp + rg);
            __builtin_amdgcn_sched_barrier(0);
        }
        __syncthreads();
        f32x16 acc = {};
#pragma unroll
        for (int ks = 0; ks < 8; ++ks) { const bf16x8 ah = *(const LAS bf16x8*)(TH + r32 * 1032 + 128 * wave + 16 * ks + 8 * hi), al = *(const LAS bf16x8*)(TL + r32 * 1032 + 128 * wave + 16 * ks + 8 * hi);
            acc = __builtin_amdgcn_mfma_f32_32x32x16_bf16(ah, rwh[ks], acc, 0, 0, 0); acc = __builtin_amdgcn_mfma_f32_32x32x16_bf16(ah, rwl[ks], acc, 0, 0, 0); acc = __builtin_amdgcn_mfma_f32_32x32x16_bf16(al, rwh[ks], acc, 0, 0, 0); }
        __syncthreads();
        { LAS float* RED = T + wave * (32 * 33);
#pragma unroll
          for (int r = 0; r < 16; ++r) RED[crow(r, hi) * 33 + r32] = acc[r]; }
        __syncthreads();
        if (tid < 256) { int t3 = tid; asm volatile("" : "+v"(t3)); const int tk = t3 & 31, gq = t3 >> 5;
            float sc[4], bb[4];
#pragma unroll
            for (int q = 0; q < 4; ++q) { float s = 0.f;
#pragma unroll
                for (int w = 0; w < 8; ++w) s += T[w * (32 * 33) + tk * 33 + gq * 4 + q];
                const float sg = __builtin_amdgcn_rcpf(1.f + __expf(-s)); sc[q] = sg; bb[q] = sg + rb4[q]; }
            int i1 = 0; float m1 = bb[0];
#pragma unroll
            for (int q = 1; q < 4; ++q) if (bb[q] > m1) { m1 = bb[q]; i1 = q; }
            int i2 = -1; float m2 = -1e30f;
#pragma unroll
            for (int q = 0; q < 4; ++q) if (q != i1 && bb[q] > m2) { m2 = bb[q]; i2 = q; }
            float s1 = sc[0], s2 = sc[0];
#pragma unroll
            for (int q = 1; q < 4; ++q) { s1 = (i1 == q) ? sc[q] : s1; s2 = (i2 == q) ? sc[q] : s2; }
            GS[tk * 9 + gq] = m1 + m2; GI[tk * 9 + gq] = i1 | (i2 << 4); G1[tk * 9 + gq] = s1; G2[tk * 9 + gq] = s2; }
        __syncthreads();
        if (tid < 32) { int t2 = tid; asm volatile("" : "+v"(t2)); const int ta = ta0 + t2;
            float bestg = GS[t2 * 9]; int bgrp = 0;
#pragma unroll
            for (int gq = 1; gq < 8; ++gq) { const float gsv = GS[t2 * 9 + gq]; if (gsv > bestg) { bestg = gsv; bgrp = gq; } }
            const int bi = GI[t2 * 9 + bgrp], bi1 = bi & 15, bi2 = bi >> 4; const float bs1 = G1[t2 * 9 + bgrp], bs2 = G2[t2 * 9 + bgrp];
            const float inv = 1.f / (bs1 + bs2); const float w1 = bs1 * inv, w2 = bs2 * inv;
            const int lo = bi1 < bi2 ? bi1 : bi2, hh = bi1 < bi2 ? bi2 : bi1;
            const float wlo = bi1 < bi2 ? w1 : w2, whi = bi1 < bi2 ? w2 : w1;
            const int pair = (lo == 0) ? (hh - 1) : (lo == 1 ? (hh + 1) : 5);
            const int bucket = bgrp * 6 + pair;
            const int lp = __hip_atomic_fetch_add(&LCNT[bucket], 1, __ATOMIC_RELAXED, __HIP_MEMORY_SCOPE_WORKGROUP);
            RTA[it * 32 + t2] = ta; RBP[it * 32 + t2] = (bucket << 16) | lp; TW[ta] = (f32x2){wlo, whi}; }
        if (++it == 6) { RT_FLUSH(); it = 0; }
    }
    if (it) RT_FLUSH();
    __syncthreads();
}
#undef RT_FLUSH

#undef RT_TA0
#undef RT_LOAD
struct MoeSched {
    static constexpr bool GATHER_ = true;
    int G, c, ntiles, layer, stage; const unsigned* cnt; const int* list; const char* A; const char* W; LAS int* pre;
};
template <bool G1> struct MoeSchedT {
    static constexpr bool GATHER = G1;
    MoeSched m;
    __device__ __forceinline__ bool next(int i, pg8::Unit& u) const {
        const int nwg = m.ntiles * 4, fullr = nwg / m.G, R = nwg - fullr * m.G; const bool split = (R > 0) && (2 * R <= m.G);
        int L, hf = 0;
        if (i < fullr) L = i * m.G + m.c;
        else if (i == fullr && split) { if (m.c >= 2 * R) return false; L = fullr * m.G + (m.c >> 1); hf = 1 + (m.c & 1); }
        else { L = i * m.G + m.c; if (L >= nwg) return false; }
        u.half = hf;
        const int tile = L >> 2, pn = L & 3;
        int bk = 0;
        for (int q = 1; q < NBUCK; ++q) bk = (m.pre[q] <= tile) ? q : bk;
        const int tin = tile - m.pre[bk], cntb = (int)m.cnt[bk];
        const int grp = bk / 6, pair = bk % 6;
        const int lo = pair < 3 ? 0 : (pair < 5 ? 1 : 2), hh = pair < 3 ? pair + 1 : (pair < 5 ? pair - 1 : 3);
        const int e1 = grp * 4 + lo, e2 = grp * 4 + hh;
        u.pm = tile; u.po = tile; u.pn = pn; u.rows = m.list + (size_t)bk * LCAP + tin * 256; u.nvalid = (cntb - tin * 256) < 256 ? (cntb - tin * 256) : 256; u.aux = pn >> 1;
        if (G1) {
            const int e = (pn < 2) ? e1 : e2;
            u.A = m.A; u.B = m.W + ((size_t)(m.layer * NEXP + e) * 512 + (pn & 1) * 256) * 1024 * 2; u.B2 = u.B;
        } else {
            u.A = m.A + (size_t)tile * 256 * 512 * 2;
            u.B = m.W + ((size_t)(m.layer * NEXP + e1) * 1024 + pn * 256) * 256 * 2;
            u.B2 = m.W + ((size_t)(m.layer * NEXP + e2) * 1024 + pn * 256) * 256 * 2 - (size_t)4 * 128;
        }
        return true;
    }
};
struct EpiMoe1 {
    bf16_t* HE; const f32x2* TW;
    __device__ __forceinline__ void operator()(const f32x4 (&acc)[2][2][4][2], const pg8::Unit& u, int wr, int wc, int fr, int fq) const {
        const int slot = u.aux;
        int tok[8]; f32x2 tw[8];
#pragma unroll
        for (int q = 0; q < 8; ++q) { const int r = (q >> 2) * 128 + wr * 64 + (q & 3) * 16 + fr; tok[q] = u.rows[r < u.nvalid ? r : 0]; }
        __builtin_amdgcn_sched_barrier(0);
#pragma unroll
        for (int q = 0; q < 8; ++q) tw[q] = TW[tok[q]];
        __builtin_amdgcn_sched_barrier(0);
#pragma unroll
        for (int ai = 0; ai < 2; ++ai)
            if (u.half != 2 - ai)
#pragma unroll
            for (int m = 0; m < 4; ++m) { const int r = ai * 128 + wr * 64 + m * 16 + fr; const float w = slot ? tw[ai * 4 + m].y : tw[ai * 4 + m].x;
                float o[8];
#pragma unroll
                for (int n = 0; n < 2; ++n)
#pragma unroll
                    for (int q = 0; q < 4; ++q) { const float gt = acc[ai][0][m][n][q], up = acc[ai][1][m][n][q]; o[4 * n + q] = gt * __builtin_amdgcn_rcpf(1.f + __expf(-gt)) * up * w; }
                u32x4 wv; wv.x = cvt_pk_bf16(o[0], o[1]); wv.y = cvt_pk_bf16(o[2], o[3]); wv.z = cvt_pk_bf16(o[4], o[5]); wv.w = cvt_pk_bf16(o[6], o[7]);
                *(u32x4*)(HE + (size_t)(u.po * 256 + r) * 512 + slot * 256 + (u.pn & 1) * 128 + wc * 32 + 8 * fq) = wv; }
    }
};
template <int LAYER> struct EpiMoe2 {
    float* out; bf16_t* X; const float* modl; LAS float* GT;
    __device__ __forceinline__ void operator()(const f32x4 (&acc)[2][2][4][2], const pg8::Unit& u, int wr, int wc, int fr, int fq) const {
        const int col0 = u.pn * 256 + wc * 32 + 8 * fq, tid = threadIdx.x;
        int tok[8];
#pragma unroll
        for (int q = 0; q < 8; ++q) { const int r = (q >> 2) * 128 + wr * 64 + (q & 3) * 16 + fr; tok[q] = u.rows[r < u.nvalid ? r : 0]; }
        f32x4 gt0 = {0.f, 0.f, 0.f, 0.f}, gt1 = {0.f, 0.f, 0.f, 0.f};
        gt0 = *(const f32x4*)(modl + (size_t)(tid >> 6) * (NMOD * D) + 5 * D + u.pn * 256 + 4 * (tid & 63));
        if (tid < 64) gt1 = *(const f32x4*)(modl + (size_t)8 * (NMOD * D) + 5 * D + u.pn * 256 + 4 * tid);
        __builtin_amdgcn_sched_barrier(0);
        *(LAS f32x4*)(GT + (tid >> 6) * 260 + 4 * (tid & 63)) = gt0; if (tid < 64) *(LAS f32x4*)(GT + 8 * 260 + 4 * tid) = gt1;
        __syncthreads();
#pragma unroll
        for (int ai = 0; ai < 2; ++ai)
            if (u.half != 2 - ai) {
            u32x4 sb[4][2];
#pragma unroll
            for (int m = 0; m < 4; ++m) { const bf16_t* xp = X + (size_t)tok[ai * 4 + m] * D + col0;
#pragma unroll
                for (int bj = 0; bj < 2; ++bj) sb[m][bj] = *(const u32x4*)(xp + bj * 128); }
            __builtin_amdgcn_sched_barrier(0);
#pragma unroll
            for (int m = 0; m < 4; ++m) { const int r = ai * 128 + wr * 64 + m * 16 + fr;
                if (r < u.nvalid) { const int tk = tok[ai * 4 + m]; const int b = tk / TPB, j = tk - b * TPB; const int mrow = j < CTXL ? 8 : b;
                    const LAS float* gp = GT + mrow * 260 + wc * 32 + 8 * fq;
#pragma unroll
                    for (int bj = 0; bj < 2; ++bj) { const u32x4 w = sb[m][bj];
                        const f32x4 g0 = *(const LAS f32x4*)(gp + bj * 128), g1 = *(const LAS f32x4*)(gp + bj * 128 + 4);
                        const f32x4 r0 = (f32x4){bflo(w.x), bfhi(w.x), bflo(w.y), bfhi(w.y)} + g0 * acc[ai][bj][m][0], r1 = (f32x4){bflo(w.z), bfhi(w.z), bflo(w.w), bfhi(w.w)} + g1 * acc[ai][bj][m][1];
                        if (LAYER == 0) { u32x4 o; o.x = cvt_pk_bf16(r0.x, r0.y); o.y = cvt_pk_bf16(r0.z, r0.w); o.z = cvt_pk_bf16(r1.x, r1.y); o.w = cvt_pk_bf16(r1.z, r1.w); *(u32x4*)(X + (size_t)tk * D + col0 + bj * 128) = o; }
                        else { float* op = out + ((size_t)b * SEQ + (j - CTXL)) * D + col0 + bj * 128; *(f32x4*)op = r0; *(f32x4*)(op + 4) = r1; } } } }
            __builtin_amdgcn_sched_barrier(0);
            }
        __syncthreads();
    }
};
__device__ __forceinline__ int moe_prefix(Frame& F, int layer, LAS int* pre) {
    __syncthreads();
    if (F.tid == 0) { int s = 0; const unsigned* cnt = F.ctl + CW_CNT + layer * 64; for (int q = 0; q < NBUCK; ++q) { pre[q] = s; s += ((int)cnt[q] + 255) >> 8; } pre[NBUCK] = s; }
    __syncthreads();
    return pre[NBUCK];
}

__device__ __forceinline__ void p9_phase(Frame& F, CArgsRef A) {
    const int gw = F.bid * 8 + F.wave, NGW = F.G * 8, l = F.lane;
    bf16_t* P = WSP(bf16_t, WS_BIG); const float* COS = WSP(float, WS_COS); const float* SIN = WSP(float, WS_SIN);
    const int kind = l < 8 ? 0 : l < 24 ? 1 : l < 28 ? 2 : l < 30 ? 5 : l < 46 ? 3 : 5;
    float gg[32];
    {
        const float* gp = nullptr;
        if (kind == 0) gp = A.in[16] + 32 * l; else if (kind == 1) gp = A.in[21] + 0 * 64 + (l & 1) * 32; else if (kind == 2) gp = A.in[18] + 32 * (l - 24); else if (kind == 3) gp = A.in[21] + 1 * 64 + (l & 1) * 32;
#pragma unroll
        for (int j = 0; j < 32; ++j) gg[j] = gp ? gp[j] : 1.f;
        __builtin_amdgcn_sched_barrier(0);
    }
    for (int tb0 = gw; tb0 < NTOK; tb0 += 2 * NGW) {
        const int tb1 = tb0 + NGW; const bool has1 = tb1 < NTOK;
        u32x4 wq[2][4]; f32x4 csv[2][8], snv[2][8];
#pragma unroll
        for (int e = 0; e < 2; ++e) { const int ta = e ? (has1 ? tb1 : tb0) : tb0; const bf16_t* rp = P + (size_t)ta * PW + 32 * l;
            const int b_ = ta / TPB, jj_ = ta - b_ * TPB; const int pos_ = jj_ >= CTXL ? jj_ - CTXL : 0;
            typedef const __attribute__((address_space(4))) f32x4 CF4;
            const int pu_ = __builtin_amdgcn_readfirstlane(pos_);
            CF4* cp = (CF4*)(unsigned long long)(COS + (size_t)pu_ * 32); CF4* sp = (CF4*)(unsigned long long)(SIN + (size_t)pu_ * 32);
            const bool need = (kind == 2 || kind == 3) || ((kind == 0 || kind == 1) && jj_ >= CTXL);
            const bool nrope = (kind == 1 || kind == 3) && jj_ >= CTXL;
#pragma unroll
            for (int q = 0; q < 4; ++q) { wq[e][q] = (u32x4){0u, 0u, 0u, 0u}; if (need) wq[e][q] = *(const u32x4*)(rp + 8 * q); }
#pragma unroll
            for (int q = 0; q < 8; ++q) { csv[e][q] = cp[q]; snv[e][q] = sp[q]; } (void)nrope; }
        __builtin_amdgcn_sched_barrier(0);
#pragma unroll
        for (int e = 0; e < 2; ++e) {
            const int ta = e ? tb1 : tb0; if (e && !has1) break;
            const int b = ta / TPB, jj = ta - b * TPB; const bool lat = jj >= CTXL; const int pos = jj - CTXL;
            bf16_t* rowp = P + (size_t)ta * PW + 32 * l;
            float v[32]; float ss = 0.f;
#pragma unroll
            for (int q = 0; q < 4; ++q)
#pragma unroll
                for (int c = 0; c < 4; ++c) { v[8 * q + 2 * c] = bflo(wq[e][q][c]); v[8 * q + 2 * c + 1] = bfhi(wq[e][q][c]); }
#pragma unroll
            for (int j = 0; j < 32; ++j) ss += v[j] * v[j];
            const float s1 = ss + __shfl_xor(ss, 1), s2 = s1 + __shfl_xor(s1, 2), s4 = s2 + __shfl_xor(s2, 4);
            const float tot = kind == 0 ? s4 : kind == 2 ? s2 : s1;
            const float nn = kind == 0 ? 256.f : kind == 2 ? 128.f : 64.f;
            const float r = 1.f / sqrtf(tot / nn + EPS);
            const bool act = (kind == 0 && lat) || (kind == 1 && lat) || kind == 2 || kind == 3;
#pragma unroll
            for (int j = 0; j < 32; ++j) v[j] = v[j] * r * gg[j];
            const bool rope = (kind == 1 || kind == 3) && lat;
            {
#pragma unroll
                for (int j4 = 0; j4 < 8; ++j4) { const f32x4 cs4 = csv[e][j4], sn4 = snv[e][j4];
#pragma unroll
                    for (int c = 0; c < 4; ++c) { const int j = 4 * j4 + c; const float other = __shfl_xor(v[j], 1); const float cs = cs4[c], sn = sn4[c];
                        const float rv = (l & 1) ? (v[j] * cs + other * sn) : (v[j] * cs - other * sn);
                        v[j] = rope ? rv : v[j]; } }
            }
            if (act) {
#pragma unroll
                for (int q = 0; q < 4; ++q) { u32x4 o; o.x = cvt_pk_bf16(v[8 * q], v[8 * q + 1]); o.y = cvt_pk_bf16(v[8 * q + 2], v[8 * q + 3]); o.z = cvt_pk_bf16(v[8 * q + 4], v[8 * q + 5]); o.w = cvt_pk_bf16(v[8 * q + 6], v[8 * q + 7]);
                    *(u32x4*)(rowp + 8 * q) = o; }
            }
        }
    }
}

__device__ __forceinline__ void p11_phase(Frame& F, CArgsRef A) {
    const int gw = F.bid * 8 + F.wave, NGW = F.G * 8, l = F.lane, h = l >> 4, j = l & 15;
    const bf16_t* __restrict__ P = WSP(bf16_t, WS_BIG); bf16_t* __restrict__ QM = WSP(bf16_t, WS_QM); bf16_t* __restrict__ KM = WSP(bf16_t, WS_KM); const bf16_t* __restrict__ KV = WSP(bf16_t, WS_H);
    const float* __restrict__ COS = WSP(float, WS_COS); const float* __restrict__ SIN = WSP(float, WS_SIN);
#define P11_BODY(wa, wb, DST, GP, DOROPE, CSV, SNV) do { \
        float v[12]; \
        _Pragma("unroll") for (int c = 0; c < 4; ++c) { v[2 * c] = bflo(wa[c]); v[2 * c + 1] = bfhi(wa[c]); } \
        v[8] = bflo(wb.x); v[9] = bfhi(wb.x); v[10] = bflo(wb.y); v[11] = bfhi(wb.y); \
        float ss = 0.f; \
        _Pragma("unroll") for (int c = 0; c < 12; ++c) ss += v[c] * v[c]; \
        ss += __shfl_xor(ss, 1); ss += __shfl_xor(ss, 2); ss += __shfl_xor(ss, 4); ss += __shfl_xor(ss, 8); \
        const float r = 1.f / sqrtf(ss * (1.f / 192.f) + EPS); \
        const f32x4 ga = GP##a, gb = GP##b, gc = GP##c; \
        v[0] *= r * ga.x; v[1] *= r * ga.y; v[2] *= r * ga.z; v[3] *= r * ga.w; v[4] *= r * gb.x; v[5] *= r * gb.y; v[6] *= r * gb.z; v[7] *= r * gb.w; \
        v[8] *= r * gc.x; v[9] *= r * gc.y; v[10] *= r * gc.z; v[11] *= r * gc.w; \
        const f32x4 cs = CSV, sn = SNV; \
        _Pragma("unroll") for (int c = 0; c < 4; ++c) { const float other = __shfl_xor(v[8 + c], 8); const float rv = (j < 8) ? (v[8 + c] * cs[c] - other * sn[c]) : (v[8 + c] * cs[c] + other * sn[c]); v[8 + c] = (DOROPE) ? rv : v[8 + c]; } \
        u32x4 oa; oa.x = cvt_pk_bf16(v[0], v[1]); oa.y = cvt_pk_bf16(v[2], v[3]); oa.z = cvt_pk_bf16(v[4], v[5]); oa.w = cvt_pk_bf16(v[6], v[7]); \
        u32x2 ob; ob.x = cvt_pk_bf16(v[8], v[9]); ob.y = cvt_pk_bf16(v[10], v[11]); \
        *(u32x4*)((DST) + 8 * j) = oa; *(u32x2*)((DST) + 128 + 4 * j) = ob; } while (0)
    const f32x4 gqa = *(const f32x4*)(A.in[20] + 8 * j), gqb = *(const f32x4*)(A.in[20] + 8 * j + 4), gqc = *(const f32x4*)(A.in[20] + 128 + 4 * j);
    const f32x4 gka = *(const f32x4*)(A.in[20] + 192 + 8 * j), gkb = *(const f32x4*)(A.in[20] + 192 + 8 * j + 4), gkc = *(const f32x4*)(A.in[20] + 192 + 128 + 4 * j);
    constexpr int NB4 = 4;
    for (int t0 = gw; t0 < NLAT; t0 += NB4 * NGW) {
        u32x4 wa[NB4]; u32x2 wb[NB4]; f32x4 cv[NB4], sv[NB4];
#pragma unroll
        for (int e = 0; e < NB4; ++e) { const int tl = (t0 + e * NGW) < NLAT ? (t0 + e * NGW) : t0; const bf16_t* q = QM + (size_t)tl * 768 + h * 192; wa[e] = *(const u32x4*)(q + 8 * j); wb[e] = *(const u32x2*)(q + 128 + 4 * j);
            const int pos = tl & (SEQ - 1); cv[e] = *(const f32x4*)(COS + (size_t)pos * 32 + 4 * (j & 7)); sv[e] = *(const f32x4*)(SIN + (size_t)pos * 32 + 4 * (j & 7)); }
        __builtin_amdgcn_sched_barrier(0);
#pragma unroll
        for (int e = 0; e < NB4; ++e) { const int tl = t0 + e * NGW; if (tl < NLAT) { bf16_t* q = QM + (size_t)tl * 768 + h * 192;
            P11_BODY(wa[e], wb[e], q, gq, true, cv[e], sv[e]); } }
    }
    for (int t0 = gw; t0 < NTOK; t0 += NB4 * NGW) {
        u32x4 wa[NB4]; u32x2 wb[NB4]; f32x4 cv[NB4], sv[NB4];
#pragma unroll
        for (int e = 0; e < NB4; ++e) { const int ta = (t0 + e * NGW) < NTOK ? (t0 + e * NGW) : t0; wa[e] = *(const u32x4*)(KV + (size_t)ta * 1024 + h * 256 + 8 * j); wb[e] = *(const u32x2*)(P + (size_t)ta * PW + PC_KROPE + 4 * j);
            const int b_ = ta / TPB, jj_ = ta - b_ * TPB; const int pos = jj_ >= CTXL ? jj_ - CTXL : 0; cv[e] = *(const f32x4*)(COS + (size_t)pos * 32 + 4 * (j & 7)); sv[e] = *(const f32x4*)(SIN + (size_t)pos * 32 + 4 * (j & 7)); }
        __builtin_amdgcn_sched_barrier(0);
#pragma unroll
        for (int e = 0; e < NB4; ++e) { const int ta = t0 + e * NGW; if (ta < NTOK) { const int b = ta / TPB, jj = ta - b * TPB; const bool lat = jj >= CTXL;
            bf16_t* k = KM + ((size_t)(b * 4 + h) * TPB + jj) * 192;
            P11_BODY(wa[e], wb[e], k, gk, lat, cv[e], sv[e]); } }
    }
#undef P11_BODY
}

#define SBAR() __builtin_amdgcn_sched_barrier(0)
__device__ __forceinline__ void partialSM(f32x16& p0, f32x16& p1, float& m_reg, float& mn, float& alpha, const float C, const float thr) {
    float pmax = p0[0];
#pragma unroll
    for (int r = 1; r < 16; ++r) pmax = fmaxf(pmax, p0[r]);
#pragma unroll
    for (int r = 0; r < 16; ++r) pmax = fmaxf(pmax, p1[r]);
    { auto rr = __builtin_amdgcn_permlane32_swap(__float_as_uint(pmax), __float_as_uint(pmax), false, false);
      pmax = fmaxf(__uint_as_float(rr[0]), __uint_as_float(rr[1])); }
    if (__builtin_expect(__all(pmax - m_reg <= thr), 1)) { mn = m_reg; alpha = 1.f; }
    else { mn = fmaxf(m_reg, pmax); alpha = __builtin_amdgcn_exp2f((m_reg - mn) * C); m_reg = mn; }
    const float mnC = -mn * C;
#pragma unroll
    for (int r = 0; r < 16; ++r) p0[r] = fmaf(p0[r], C, mnC);
#pragma unroll
    for (int r = 0; r < 16; ++r) p1[r] = fmaf(p1[r], C, mnC);
#pragma unroll
    for (int r = 0; r < 16; ++r) p0[r] = __builtin_amdgcn_exp2f(p0[r]);
}
__device__ __forceinline__ void finishSM(f32x16& p0, f32x16& p1, float alpha, float& l_reg, bf16x8& pa0, bf16x8& pa1, bf16x8& pa2, bf16x8& pa3) {
#pragma unroll
    for (int r = 0; r < 16; ++r) p1[r] = __builtin_amdgcn_exp2f(p1[r]);
    float ps = 0;
#pragma unroll
    for (int r = 0; r < 16; ++r) ps += p0[r];
#pragma unroll
    for (int r = 0; r < 16; ++r) ps += p1[r];
    { auto rr = __builtin_amdgcn_permlane32_swap(__float_as_uint(ps), __float_as_uint(ps), false, false);
      ps = __uint_as_float(rr[0]) + __uint_as_float(rr[1]); }
    l_reg = l_reg * alpha + ps;
#define PK4(P, BASE, OUT) do { unsigned a0 = cvt_pk_bf16(P[BASE + 0], P[BASE + 1]), a1 = cvt_pk_bf16(P[BASE + 2], P[BASE + 3]);   \
    unsigned b0 = cvt_pk_bf16(P[BASE + 4], P[BASE + 5]), b1 = cvt_pk_bf16(P[BASE + 6], P[BASE + 7]);                              \
    auto r0 = __builtin_amdgcn_permlane32_swap(a0, b0, false, false); auto r1 = __builtin_amdgcn_permlane32_swap(a1, b1, false, false); \
    u32x4 w = {r0[0], r1[0], r0[1], r1[1]}; OUT = *reinterpret_cast<bf16x8*>(&w); } while (0)
    PK4(p0, 0, pa0); PK4(p0, 8, pa1); PK4(p1, 0, pa2); PK4(p1, 8, pa3);
#undef PK4
}
__device__ __forceinline__ void partialSM_fs(f32x16& p0, f32x16& p1, const float C, const float nBC) {
#pragma unroll
    for (int r = 0; r < 16; ++r) p0[r] = fmaf(p0[r], C, nBC);
#pragma unroll
    for (int r = 0; r < 16; ++r) p1[r] = fmaf(p1[r], C, nBC);
#pragma unroll
    for (int r = 0; r < 16; ++r) p0[r] = __builtin_amdgcn_exp2f(p0[r]);
}
__device__ __forceinline__ void finishSM_fs(f32x16& p0, f32x16& p1, float& l_reg, bf16x8& pa0, bf16x8& pa1, bf16x8& pa2, bf16x8& pa3) {
#pragma unroll
    for (int r = 0; r < 16; ++r) p1[r] = __builtin_amdgcn_exp2f(p1[r]);
    float ps = 0;
#pragma unroll
    for (int r = 0; r < 16; ++r) ps += p0[r];
#pragma unroll
    for (int r = 0; r < 16; ++r) ps += p1[r];
    l_reg += ps;
#define PK4(P, BASE, OUT) do { unsigned a0 = cvt_pk_bf16(P[BASE + 0], P[BASE + 1]), a1 = cvt_pk_bf16(P[BASE + 2], P[BASE + 3]);   \
    unsigned b0 = cvt_pk_bf16(P[BASE + 4], P[BASE + 5]), b1 = cvt_pk_bf16(P[BASE + 6], P[BASE + 7]);                              \
    auto r0 = __builtin_amdgcn_permlane32_swap(a0, b0, false, false); auto r1 = __builtin_amdgcn_permlane32_swap(a1, b1, false, false); \
    u32x4 w = {r0[0], r1[0], r0[1], r1[1]}; OUT = *reinterpret_cast<bf16x8*>(&w); } while (0)
    PK4(p0, 0, pa0); PK4(p0, 8, pa1); PK4(p1, 0, pa2); PK4(p1, 8, pa3);
#undef PK4
}
__device__ __forceinline__ int v_st(int k, int c) { const int kk = (k & ~0xC) | ((k & 4) << 1) | ((k & 8) >> 1); return ((kk >> 3) * 4 + (c >> 5)) * 512 + ((kk & 7) * 32 + (c & 31)) * 2; }
__device__ __forceinline__ int v_rd_base(int lane) { return ((lane & 3) << 3) | (((lane >> 2) & 3) << 6) | (((lane >> 4) & 1) << 5) | (((lane >> 5) & 1) << 8); }
constexpr int v_rd_off(int d0, int ks, int half) { return d0 * 512 + ks * 4096 + half * 2048; }
template <int OFF> __device__ __forceinline__ s16x4 tr_read(int vb) {
    s16x4 r; asm volatile("ds_read_b64_tr_b16 %0, %1 offset:%2" : "=&v"(r) : "v"(vb), "i"(OFF) : "memory"); return r;
}
template <int D0> __device__ __forceinline__ void pv_one(f32x16& od, int vb, bf16x8 pa0, bf16x8 pa1, bf16x8 pa2, bf16x8 pa3) {
    const s16x4 l0 = tr_read<v_rd_off(D0, 0, 0)>(vb), h0 = tr_read<v_rd_off(D0, 0, 1)>(vb), l1 = tr_read<v_rd_off(D0, 1, 0)>(vb), h1 = tr_read<v_rd_off(D0, 1, 1)>(vb);
    const s16x4 l2 = tr_read<v_rd_off(D0, 2, 0)>(vb), h2 = tr_read<v_rd_off(D0, 2, 1)>(vb), l3 = tr_read<v_rd_off(D0, 3, 0)>(vb), h3 = tr_read<v_rd_off(D0, 3, 1)>(vb);
    asm volatile("s_waitcnt lgkmcnt(0)" ::: "memory"); SBAR();
#define PK(L, H) (bf16x8){L[0], L[1], L[2], L[3], H[0], H[1], H[2], H[3]}
    od = __builtin_amdgcn_mfma_f32_32x32x16_bf16(pa0, PK(l0, h0), od, 0, 0, 0);
    od = __builtin_amdgcn_mfma_f32_32x32x16_bf16(pa1, PK(l1, h1), od, 0, 0, 0);
    od = __builtin_amdgcn_mfma_f32_32x32x16_bf16(pa2, PK(l2, h2), od, 0, 0, 0);
    od = __builtin_amdgcn_mfma_f32_32x32x16_bf16(pa3, PK(l3, h3), od, 0, 0, 0);
#undef PK
}
__device__ __forceinline__ void pv_d0(f32x16* o, int vb, bf16x8 pa0, bf16x8 pa1, bf16x8 pa2, bf16x8 pa3) {
    pv_one<0>(o[0], vb, pa0, pa1, pa2, pa3); pv_one<1>(o[1], vb, pa0, pa1, pa2, pa3); pv_one<2>(o[2], vb, pa0, pa1, pa2, pa3); pv_one<3>(o[3], vb, pa0, pa1, pa2, pa3);
}

#define PV_READS(D0, L0, H0, L1, H1, L2, H2, L3, H3) do { L0 = tr_read<v_rd_off(D0, 0, 0)>(vb); H0 = tr_read<v_rd_off(D0, 0, 1)>(vb); L1 = tr_read<v_rd_off(D0, 1, 0)>(vb); H1 = tr_read<v_rd_off(D0, 1, 1)>(vb); \
    L2 = tr_read<v_rd_off(D0, 2, 0)>(vb); H2 = tr_read<v_rd_off(D0, 2, 1)>(vb); L3 = tr_read<v_rd_off(D0, 3, 0)>(vb); H3 = tr_read<v_rd_off(D0, 3, 1)>(vb); } while (0)
#define PV_PK(L, H) (bf16x8){L[0], L[1], L[2], L[3], H[0], H[1], H[2], H[3]}
#define PV_MMA(OD, L0, H0, L1, H1, L2, H2, L3, H3) do { OD = __builtin_amdgcn_mfma_f32_32x32x16_bf16(pa0, PV_PK(L0, H0), OD, 0, 0, 0); OD = __builtin_amdgcn_mfma_f32_32x32x16_bf16(pa1, PV_PK(L1, H1), OD, 0, 0, 0); \
    OD = __builtin_amdgcn_mfma_f32_32x32x16_bf16(pa2, PV_PK(L2, H2), OD, 0, 0, 0); OD = __builtin_amdgcn_mfma_f32_32x32x16_bf16(pa3, PV_PK(L3, H3), OD, 0, 0, 0); } while (0)
__device__ __forceinline__ void pv_d0_pipe(f32x16* o, int vb, bf16x8 pa0, bf16x8 pa1, bf16x8 pa2, bf16x8 pa3) {
    s16x4 a0, a1, a2, a3, a4, a5, a6, a7, b0, b1, b2, b3, b4, b5, b6, b7;
    PV_READS(0, a0, a1, a2, a3, a4, a5, a6, a7);
    PV_READS(1, b0, b1, b2, b3, b4, b5, b6, b7);
    asm volatile("s_waitcnt lgkmcnt(8)" ::: "memory"); SBAR();
    PV_MMA(o[0], a0, a1, a2, a3, a4, a5, a6, a7); SBAR();
    PV_READS(2, a0, a1, a2, a3, a4, a5, a6, a7);
    asm volatile("s_waitcnt lgkmcnt(8)" ::: "memory"); SBAR();
    PV_MMA(o[1], b0, b1, b2, b3, b4, b5, b6, b7); SBAR();
    PV_READS(3, b0, b1, b2, b3, b4, b5, b6, b7);
    asm volatile("s_waitcnt lgkmcnt(8)" ::: "memory"); SBAR();
    PV_MMA(o[2], a0, a1, a2, a3, a4, a5, a6, a7); SBAR();
    asm volatile("s_waitcnt lgkmcnt(0)" ::: "memory"); SBAR();
    PV_MMA(o[3], b0, b1, b2, b3, b4, b5, b6, b7);
}

template <int DK, int LDQ, int LDK, int LDV, int SDEPTH, int NQL, bool FS, bool PVP, int ABL = 0>
__device__ __forceinline__ void attn_body(const int tid, const bf16_t* __restrict__ Qb, const bf16_t* __restrict__ Kh, const bf16_t* __restrict__ Vh, const int seq, char* lds,
                                          const float C, const float thr, f32x16 (&o)[4], float& l_out) {
    constexpr int RB = DK * 2, SHM_V = 64 * 256, SHM_K = 64 * RB, CPR = DK / 8, NKC = CPR / 8, ND0 = DK / 16, NQR = ND0 - NQL, QTB = NQL * 32;
#define KSWZ(row, colB) ((row) * RB + ((colB) ^ ((((row) >> 1) & 7) << 4)))
    const int wid = tid >> 6, lane = tid & 63, r32 = lane & 31, hi = lane >> 5;
    char* V_lds = lds; char* K_lds = lds + 2 * SHM_V;
    float* ws = (float*)(lds + 2 * SHM_V + 2 * SHM_K) + wid * 64; float* al_l = ws + 32;
    char* Qt = lds + 2 * SHM_V + 2 * SHM_K + 2048 + wid * (32 * (QTB > 0 ? QTB : 1));
    float m_reg = -1e30f, l_reg = 0;
#pragma unroll
    for (int d = 0; d < 4; ++d) o[d] = f32x16{};
    bf16x8 qr[NQR];
    const bf16_t* Qw = Qb + (size_t)(wid * 32 + r32) * LDQ + hi * 8;
#pragma unroll
    for (int d0 = 0; d0 < NQR; ++d0) qr[d0] = *(const bf16x8*)(Qw + d0 * 16);
    if constexpr (NQL > 0) {
        constexpr int CH = QTB / 16;
#pragma unroll
        for (int i = 0; i < (32 * CH) / 64; ++i) { const int c = lane + 64 * i, row = c / CH, cc = c % CH;
            const bf16x8 v = *(const bf16x8*)(Qb + (size_t)(wid * 32 + row) * LDQ + NQR * 16 + cc * 8);
            *(bf16x8*)(Qt + row * QTB + ((cc * 16) ^ (((row) & (CH - 1)) << 4))) = v; }
        asm volatile("s_waitcnt lgkmcnt(0)" ::: "memory");
    }
    const int sr = tid >> 4, sc = (tid & 15) * 8, vst0 = v_st(sr, sc), vst1 = v_st(32 + sr, sc);
    const int vb0 = (int)(uintptr_t)V_lds + v_rd_base(lane);
    int krow[NKC], kcc[NKC];
#pragma unroll
    for (int i = 0; i < NKC; ++i) { const int c = tid + 512 * i; krow[i] = c / CPR; kcc[i] = c % CPR; }
    struct { bf16x8 vs0, vs1, ks[NKC]; } sr_[SDEPTH];
    constexpr int SE = 0, SO = SDEPTH - 1;
#define SLOAD(i, k0) do { sr_[i].vs0 = *(const bf16x8*)(&Vh[(size_t)((k0) + sr) * LDV + sc]); sr_[i].vs1 = *(const bf16x8*)(&Vh[(size_t)((k0) + 32 + sr) * LDV + sc]); \
    _Pragma("unroll") for (int _q = 0; _q < NKC; ++_q) sr_[i].ks[_q] = *(const bf16x8*)(&Kh[(size_t)((k0) + krow[_q]) * LDK + kcc[_q] * 8]); } while (0)
#define SWRITE(b, i) do { *(bf16x8*)(V_lds + (b) * SHM_V + vst0) = sr_[i].vs0; *(bf16x8*)(V_lds + (b) * SHM_V + vst1) = sr_[i].vs1; \
    _Pragma("unroll") for (int _q = 0; _q < NKC; ++_q) *(bf16x8*)(K_lds + (b) * SHM_K + KSWZ(krow[_q], kcc[_q] * 16)) = sr_[i].ks[_q]; } while (0)
#define SWAIT() do { if constexpr (SDEPTH == 2) asm volatile("s_waitcnt vmcnt(%0)" :: "n"(2 + NKC) : "memory"); else asm volatile("s_waitcnt vmcnt(0)" ::: "memory"); } while (0)
#define RESC(a) do { if (__any((a) < 1.f)) { if (hi == 0) al_l[r32] = (a); asm volatile("s_waitcnt lgkmcnt(0)" ::: "memory"); \
    _Pragma("unroll") for (int d = 0; d < 4; ++d) _Pragma("unroll") for (int r = 0; r < 16; ++r) o[d][r] *= al_l[crow(r, hi)]; } } while (0)
#define QFRAG(d0) ((d0) < NQR ? qr[(d0) < NQR ? (d0) : 0] : *(const bf16x8*)(Qt + r32 * QTB + (((((d0) - NQR) * 2 + hi) * 16) ^ ((r32 & ((QTB / 16) - 1)) << 4))))
#define QKT(P0, P1, KB) do { P0 = f32x16{}; P1 = f32x16{}; if constexpr (ABL & 2) { asm volatile("" : "+v"(P0), "+v"(P1)); } else _Pragma("unroll") for (int d0 = 0; d0 < ND0; ++d0) { const int cb = (d0 * 16 + hi * 8) * 2; \
    const bf16x8 b0 = *(const bf16x8*)((KB) + KSWZ(r32, cb)); const bf16x8 b1 = *(const bf16x8*)((KB) + KSWZ(32 + r32, cb)); const bf16x8 qf = QFRAG(d0); \
    P0 = __builtin_amdgcn_mfma_f32_32x32x16_bf16(b0, qf, P0, 0, 0, 0); P1 = __builtin_amdgcn_mfma_f32_32x32x16_bf16(b1, qf, P1, 0, 0, 0); } } while (0)
    f32x16 pA0, pA1, pB0, pB1; float mnA, mnB, alA, alB; bf16x8 pa0, pa1, pa2, pa3; const int NT = seq / 64;
#define PVD(VB) do { if constexpr (!(ABL & 1)) { if constexpr (PVP) pv_d0_pipe(o, VB, pa0, pa1, pa2, pa3); else pv_d0(o, VB, pa0, pa1, pa2, pa3); } else { asm volatile("" : "+v"(pa0), "+v"(pa1), "+v"(pa2), "+v"(pa3)); } } while (0)
    const float nBC = -thr * C;
#define PSM(P0, P1, MN, AL) do { if constexpr (ABL & 4) { asm volatile("" : "+v"(P0), "+v"(P1)); } else if constexpr (FS) partialSM_fs(P0, P1, C, nBC); else partialSM(P0, P1, m_reg, MN, AL, C, thr); } while (0)
#define FSM(P0, P1, AL) do { if constexpr (ABL & 4) { asm volatile("" : "+v"(P0), "+v"(P1)); pa0 = (bf16x8){1,2,3,4,5,6,7,8}; pa1 = pa0; pa2 = pa0; pa3 = pa0; asm volatile("" : "+v"(pa0), "+v"(pa1), "+v"(pa2), "+v"(pa3)); } else if constexpr (FS) finishSM_fs(P0, P1, l_reg, pa0, pa1, pa2, pa3); else finishSM(P0, P1, AL, l_reg, pa0, pa1, pa2, pa3); } while (0)
#define RSC(a) do { if constexpr (!FS) { RESC(a); } } while (0)
#define ABAR() do { if constexpr (!(ABL & 16)) __syncthreads(); } while (0)
    SLOAD(SE, 0); asm volatile("s_waitcnt vmcnt(0)" ::: "memory"); SWRITE(0, SE); __syncthreads();
    QKT(pA0, pA1, K_lds); PSM(pA0, pA1, mnA, alA);
    SLOAD(SO, 64); if constexpr (SDEPTH == 2) { if (2 < NT) SLOAD(SE, 128); }
    SWAIT(); SWRITE(1, SO); __syncthreads();
    for (int j = 1; j + 1 < NT; j += 2) {
        if constexpr (SDEPTH == 1 && !(ABL & 8)) { SBAR(); SLOAD(SO, (j + SDEPTH) * 64); }
        SBAR(); QKT(pB0, pB1, K_lds + SHM_K);
        FSM(pA0, pA1, alA); SBAR();
        if constexpr (SDEPTH != 1 && !(ABL & 8)) SLOAD(SO, (j + SDEPTH) * 64); SBAR();
        PVD(vb0); PSM(pB0, pB1, mnB, alB);
        ABAR(); if constexpr (!(ABL & 8)) { SWAIT(); SWRITE(0, SE); }
        RSC(alB); ABAR();
        if constexpr (SDEPTH == 1 && !(ABL & 8)) { SBAR(); SLOAD(SE, (j + 1 + SDEPTH) * 64); }
        SBAR(); QKT(pA0, pA1, K_lds);
        FSM(pB0, pB1, alB); SBAR();
        if constexpr (SDEPTH != 1 && !(ABL & 8)) { if (j + 3 < NT) SLOAD(SE, (j + 1 + SDEPTH) * 64); } SBAR();
        PVD(vb0 + SHM_V); PSM(pA0, pA1, mnA, alA);
        ABAR(); if constexpr (!(ABL & 8)) { SWAIT(); SWRITE(1, SO); }
        RSC(alA); ABAR();
    }
    SBAR(); QKT(pB0, pB1, K_lds + SHM_K);
    FSM(pA0, pA1, alA); SBAR();
    PVD(vb0); PSM(pB0, pB1, mnB, alB);
    __syncthreads(); RSC(alB);
    FSM(pB0, pB1, alB); SBAR();
    PVD(vb0 + SHM_V);
    if constexpr (FS) { auto rr = __builtin_amdgcn_permlane32_swap(__float_as_uint(l_reg), __float_as_uint(l_reg), false, false); l_reg = __uint_as_float(rr[0]) + __uint_as_float(rr[1]); }
#undef PSM
#undef PVD
#undef FSM
#undef RSC
#undef ABAR
    l_out = l_reg;
#undef SLOAD
#undef SWRITE
#undef SWAIT
#undef RESC
#undef QKT
#undef QFRAG
#undef KSWZ
}

__device__ __forceinline__ void attn_phase(Frame& F, CArgsRef A, unsigned long long& pt1, unsigned long long& pt0) {
    char* lds = (char*)F.lds;
    const bf16_t* P = WSP(bf16_t, WS_BIG); const bf16_t* QM = WSP(bf16_t, WS_QM); const bf16_t* KM = WSP(bf16_t, WS_KM); const bf16_t* KV = WSP(bf16_t, WS_H);
    bf16_t* Y = (bf16_t*)F.out; float* ST = WSP(float, WS_STASH) + (size_t)F.bid * 256 * 128;
    float lam;
    { const int lane = F.lane; const float* dl = A.in[22]; const float a = dl[lane] * dl[64 + lane], b = dl[128 + lane] * dl[192 + lane]; lam = __expf(wave_sum(a)) - __expf(wave_sum(b)) + LAM_INIT; lam = __uint_as_float(__builtin_amdgcn_readfirstlane(__float_as_uint(lam))); }
    constexpr float LOG2E = 1.4426950408889634f;
#ifndef ATT_KINDS
#define ATT_KINDS 3
#endif
#ifndef ATT_PVP_MLA
#define ATT_PVP_MLA 0
#endif
#ifndef ATT_PVP_DIFF
#define ATT_PVP_DIFF 1
#endif
#ifndef ATT_FS
#define ATT_FS 1
#endif
    float bnd_mla, bnd_diff;
    { const int lane = F.lane; const float* gm = A.in[20]; const float* gd = A.in[21];
      float a = fmaxf(fmaxf(fabsf(gm[lane]), fabsf(gm[64 + lane])), fabsf(gm[128 + lane])), b = fmaxf(fmaxf(fabsf(gm[192 + lane]), fabsf(gm[256 + lane])), fabsf(gm[320 + lane]));
      float c = fabsf(gd[lane]), d = fabsf(gd[64 + lane]);
#pragma unroll
      for (int o = 1; o < 64; o <<= 1) { a = fmaxf(a, __shfl_xor(a, o)); b = fmaxf(b, __shfl_xor(b, o)); c = fmaxf(c, __shfl_xor(c, o)); d = fmaxf(d, __shfl_xor(d, o)); }
      bnd_mla = __uint_as_float(__builtin_amdgcn_readfirstlane(__float_as_uint(fminf(0.07216878364870322f * 192.f * a * b * 1.001f, 60.f))));
      bnd_diff = __uint_as_float(__builtin_amdgcn_readfirstlane(__float_as_uint(fminf(0.125f * 64.f * c * d * 1.001f, 60.f)))); }
#ifndef PROBE_ABL
#define PROBE_ABL 0
#endif
    if (PT_SUB == 7 || PT_SUB == 8) {
        int tid = threadIdx.x; asm volatile("" : "+v"(tid));
        const int wid = tid >> 6, lane = tid & 63, r32 = lane & 31, hi = lane >> 5;
        const int u = F.bid, bh = u >> 4, qb = u & 15, b = bh >> 2, h = bh & 3;
        f32x16 o[4]; float l_reg;
        __syncthreads();
        pt0 = __builtin_amdgcn_s_memrealtime();
        if (PT_SUB == 7) { const bf16_t* Pb = P + (size_t)(b * TPB) * PW;
            attn_body<64, PW, PW, PW, 1, 0, ATT_FS != 0, ATT_PVP_DIFF != 0, PROBE_ABL>(tid, Pb + (size_t)(CTXL + qb * 256) * PW + PC_QD + h * 128, Pb + PC_KD + h * 128, Pb + PC_VD + h * 128, TPB, lds, 0.125f * LOG2E, bnd_diff / 0.125f, o, l_reg); }
        else attn_body<192, 768, 192, 1024, 1, 8, ATT_FS != 0, ATT_PVP_MLA != 0, PROBE_ABL>(tid, QM + ((size_t)(b * SEQ + qb * 256)) * 768 + h * 192, KM + (size_t)(b * 4 + h) * TPB * 192, KV + (size_t)(b * TPB) * 1024 + h * 256 + 128, TPB, lds, 0.07216878364870322f * LOG2E, bnd_mla / 0.07216878364870322f, o, l_reg);
        pt1 = __builtin_amdgcn_s_memrealtime();
        float* Sw = ST + (size_t)(wid * 32) * 128;
#pragma unroll
        for (int r = 0; r < 16; ++r)
#pragma unroll
            for (int d0 = 0; d0 < 4; ++d0) Sw[(size_t)crow(r, hi) * 128 + d0 * 32 + r32] = o[d0][r] * l_reg;
        __syncthreads();
    }
    if (ATT_KINDS & 1)
    for (int u = F.bid, rnd = 0; u < 512; u += F.G, ++rnd) {
        int tid = threadIdx.x; asm volatile("" : "+v"(tid));
        const int wid = tid >> 6, lane = tid & 63, r32 = lane & 31, hi = lane >> 5;
        const int ux = (F.G == 256) ? ((((F.bid & 7) * 4 + rnd * 2 + ((F.bid >> 3) >> 4)) << 4) | ((F.bid >> 3) & 15)) : u;
        const int bh = ux >> 4, qb = ux & 15, b = bh >> 2, h = bh & 3;
        f32x16 o[4]; float l_reg;
        __syncthreads();
        attn_body<192, 768, 192, 1024, 1, 8, ATT_FS != 0, ATT_PVP_MLA != 0>(tid, QM + ((size_t)(b * SEQ + qb * 256)) * 768 + h * 192, KM + (size_t)(b * 4 + h) * TPB * 192, KV + (size_t)(b * TPB) * 1024 + h * 256 + 128,
                                       TPB, lds, 0.07216878364870322f * LOG2E, ATT_FS ? bnd_mla / 0.07216878364870322f : 8.f / 0.07216878364870322f, o, l_reg);
        float* li_l = (float*)(lds + 2 * 16384 + 2 * 64 * 384) + wid * 64;
        if (hi == 0) li_l[r32] = l_reg; LDS_WAIT();
        float rli[16];
#pragma unroll
        for (int r = 0; r < 16; ++r) rli[r] = __builtin_amdgcn_rcpf(li_l[crow(r, hi)]);
        bf16_t* Ow = Y + (size_t)(b * SEQ + qb * 256 + wid * 32) * D + h * 128;
#pragma unroll
        for (int r = 0; r < 16; ++r) { u32x2 w; w.x = cvt_pk_bf16(o[0][r] * rli[r], o[1][r] * rli[r]); w.y = cvt_pk_bf16(o[2][r] * rli[r], o[3][r] * rli[r]);
            *(u32x2*)(Ow + (size_t)crow(r, hi) * D + 4 * r32) = w; }
    }
    if (PT_SUB == 3) pt1 = __builtin_amdgcn_s_memrealtime();
    if (ATT_KINDS & 2)
    for (int u = F.bid, rnd = 0; u < 512; u += F.G, ++rnd) {
        int tid = threadIdx.x; asm volatile("" : "+v"(tid));
        const int wid = tid >> 6, lane = tid & 63, r32 = lane & 31, hi = lane >> 5;
        const int ux = (F.G == 256) ? ((((F.bid & 7) * 4 + rnd * 2 + ((F.bid >> 3) >> 4)) << 4) | ((F.bid >> 3) & 15)) : u;
        const int bh = ux >> 4, qb = ux & 15, b = bh >> 2, h = bh & 3;
        const bf16_t* Pb = P + (size_t)(b * TPB) * PW;
        LAS bf16_t* Sw = (LAS bf16_t*)(F.lds + 65536) + wid * (32 * 128);
        float* li_l = (float*)(lds + 2 * 16384 + 2 * 64 * 128) + wid * 64;
        {
            f32x16 o[4]; float l_reg;
            __syncthreads();
            attn_body<64, PW, PW, PW, 1, 0, ATT_FS != 0, ATT_PVP_DIFF != 0>(tid, Pb + (size_t)(CTXL + qb * 256) * PW + PC_QD + h * 128, Pb + PC_KD + h * 128, Pb + PC_VD + h * 128, TPB, lds, 0.125f * LOG2E, ATT_FS ? bnd_diff / 0.125f : 8.f / 0.125f, o, l_reg);
            if (hi == 0) li_l[r32] = l_reg; LDS_WAIT();
            float rli[16];
#pragma unroll
            for (int r = 0; r < 16; ++r) rli[r] = __builtin_amdgcn_rcpf(li_l[crow(r, hi)]);
#pragma unroll
            for (int r = 0; r < 16; ++r)
#pragma unroll
                for (int d0 = 0; d0 < 4; ++d0) Sw[crow(r, hi) * 128 + d0 * 32 + r32] = f2bf(o[d0][r] * rli[r]);
        }
        {
            f32x16 o[4]; float l_reg;
            __syncthreads();
            attn_body<64, PW, PW, PW, 1, 0, ATT_FS != 0, ATT_PVP_DIFF != 0>(tid, Pb + (size_t)(CTXL + qb * 256) * PW + PC_QD + h * 128 + 64, Pb + PC_KD + h * 128 + 64, Pb + PC_VD + h * 128, TPB, lds, 0.125f * LOG2E, ATT_FS ? bnd_diff / 0.125f : 8.f / 0.125f, o, l_reg);
            if (hi == 0) li_l[r32] = l_reg; LDS_WAIT();
            float ss[16];
#pragma unroll
            for (int r = 0; r < 16; ++r) { const float rl = __builtin_amdgcn_rcpf(li_l[crow(r, hi)]); float s = 0.f;
#pragma unroll
                for (int d0 = 0; d0 < 4; ++d0) { const float a1 = bf2f(Sw[crow(r, hi) * 128 + d0 * 32 + r32]); const float v = a1 - lam * (o[d0][r] * rl); o[d0][r] = v; s += v * v; }
                ss[r] = s; }
#pragma unroll
            for (int r = 0; r < 16; ++r) {
#pragma unroll
                for (int sh = 1; sh < 32; sh <<= 1) ss[r] += __shfl_xor(ss[r], sh);
                ss[r] = (1.f / sqrtf(ss[r] * (1.f / 128.f) + EPS)) * (1.f - LAM_INIT); }
            bf16_t* Ow = Y + (size_t)(b * SEQ + qb * 256 + wid * 32) * D + 512 + h * 128;
            const f32x4 gs4 = *(const f32x4*)(A.in[23] + 4 * r32);
#pragma unroll
            for (int r = 0; r < 16; ++r) { u32x2 w; w.x = cvt_pk_bf16(o[0][r] * ss[r] * gs4.x, o[1][r] * ss[r] * gs4.y); w.y = cvt_pk_bf16(o[2][r] * ss[r] * gs4.z, o[3][r] * ss[r] * gs4.w);
                *(u32x2*)(Ow + (size_t)crow(r, hi) * D + 4 * r32) = w; }
        }
    }
    __syncthreads();
}

constexpr int NPHASE = 18;

__global__ void __launch_bounds__(512, 2) fwd(Args args) {
    extern __shared__ __attribute__((aligned(16))) unsigned char lds_raw[];
    Frame F;
    F.lds = (LAS unsigned char*)lds_raw;
    F.tid = threadIdx.x; F.lane = F.tid & 63; F.wave = __builtin_amdgcn_readfirstlane(F.tid >> 6);
    F.G = gridDim.x; F.bid = blockIdx.x;
    F.out = args.out; F.ws = args.ws; F.ctl = (unsigned*)(args.ws + WS_CTL);
    volatile LAS unsigned* MISC = (volatile LAS unsigned*)(F.lds + LDS_CTL);
    LAS int* PRE = (LAS int*)(F.lds + LDS_CTL + 64);
    if (F.tid < 4) MISC[F.tid] = 0u;
    __syncthreads();
    XcdBarrier bar; bar.bar = F.ctl + CW_BAR; bar.x = 0; bar.st = nullptr;
#if MK_ONE_LAUNCH
    bar = xcd_barrier_post(F.ctl + CW_BAR, MISC);
#define GRID_BAR() xcd_barrier(bar)
#else
#define GRID_BAR() do {} while (0)
#endif
    const int lo = args.ph_lo, hi = args.ph_hi;
    unsigned long long pt0 = 0, pt1 = 0;
#ifndef PH_MASK
#define PH_MASK 0x3ffff
#endif
#define IN(k) (((PH_MASK >> (k)) & 1) && lo <= (k) && (k) < hi)
#define SEAM(k) do { if (IN((k) + 1)) GRID_BAR(); } while (0)
#define REP(k) for (int _rep = 0; _rep <= ((PROBE_REP >> (k)) & 1); ++_rep, (void)((_rep <= ((PROBE_REP >> (k)) & 1)) ? (GRID_BAR(), 0) : 0))

    if (IN(0)) { if (PT_LO == 0) pt0 = __builtin_amdgcn_s_memrealtime(); REP(0) { p0_prologue(F, ARGP(), pt1); } if (!PT_SUB && PT_PRE && PT_HI == 0) pt1 = __builtin_amdgcn_s_memrealtime(); SEAM(0); if (!PT_SUB && !PT_PRE && PT_HI == 0) pt1 = __builtin_amdgcn_s_memrealtime(); }
    if (IN(1)) { if (PT_LO == 1) pt0 = __builtin_amdgcn_s_memrealtime(); REP(1) { norm_mod_phase(F, ARGP(), 0); } if (PT_PRE && PT_HI == 1) pt1 = __builtin_amdgcn_s_memrealtime(); SEAM(1); if (!PT_PRE && PT_HI == 1) pt1 = __builtin_amdgcn_s_memrealtime(); }
    if (IN(2)) { if (PT_LO == 2) pt0 = __builtin_amdgcn_s_memrealtime(); REP(2) {
        pg8::PlainSched S; S.init(WSP(bf16_t, WS_H), WSP(bf16_t, WS_WIN0), NTOK, 1536, D, D, D, F.G, F.bid, 0);
        pg8::EpiGlu E{WSP(bf16_t, WS_BIG), UW};
        pg8::gemm_phase(F.lds, D, D, D, 1 << 30, S, E);
        { int nextra = (136 * 6) % F.G; if (nextra > 0 && 2 * nextra <= F.G) nextra *= 2; if (nextra == 0) moe_fill(F, ARGP(), 0, 16, F.bid, F.G); else if (F.bid >= nextra) moe_fill(F, ARGP(), 0, 16, F.bid - nextra, F.G - nextra); }
    } if (PT_PRE && PT_HI == 2) pt1 = __builtin_amdgcn_s_memrealtime(); SEAM(2); if (!PT_PRE && PT_HI == 2) pt1 = __builtin_amdgcn_s_memrealtime(); }
    if (IN(3)) { if (PT_LO == 3) pt0 = __builtin_amdgcn_s_memrealtime(); REP(3) { convpool_phase(F, ARGP(), pt1); } if (!PT_SUB && PT_PRE && PT_HI == 3) pt1 = __builtin_amdgcn_s_memrealtime(); SEAM(3); if (!PT_SUB && !PT_PRE && PT_HI == 3) pt1 = __builtin_amdgcn_s_memrealtime(); }
    if (IN(4)) { if (PT_LO == 4) pt0 = __builtin_amdgcn_s_memrealtime(); REP(4) {
        pg8::PlainSched S; S.init((bf16_t*)F.out, WSP(bf16_t, WS_WOUT0), NTOK, D, D, D, D, F.G, F.bid, 0);
        pg8::EpiResid<0> E{ARGP().in[0], ARGP().in[2], WSP(bf16_t, WS_X), WSP(float, WS_MOD)};
        pg8::gemm_phase(F.lds, D, D, D, 1 << 30, S, E);
        { int nextra = (136 * 4) % F.G; if (nextra > 0 && 2 * nextra <= F.G) nextra *= 2; if (nextra == 0) moe_fill(F, ARGP(), 16, 16, F.bid, F.G); else if (F.bid >= nextra) moe_fill(F, ARGP(), 16, 16, F.bid - nextra, F.G - nextra); }
    } if (PT_PRE && PT_HI == 4) pt1 = __builtin_amdgcn_s_memrealtime(); SEAM(4); if (!PT_PRE && PT_HI == 4) pt1 = __builtin_amdgcn_s_memrealtime(); }
    if (IN(5)) { if (PT_LO == 5) pt0 = __builtin_amdgcn_s_memrealtime(); REP(5) {
        const bool ded = F.G == 256;
        if (!ded || F.bid < 218) router_phase(F, ARGP(), 0, F.bid, ded ? 218 : F.G);
        if (!ded || F.bid >= 218) moe_fill(F, ARGP(), 40, 8, ded ? F.bid - 218 : F.bid, ded ? 38 : F.G); } if (PT_PRE && PT_HI == 5) pt1 = __builtin_amdgcn_s_memrealtime(); SEAM(5); if (!PT_PRE && PT_HI == 5) pt1 = __builtin_amdgcn_s_memrealtime(); }
    if (IN(6)) { if (PT_LO == 6) pt0 = __builtin_amdgcn_s_memrealtime(); REP(6) {
        const int nt = moe_prefix(F, 0, PRE);
        MoeSchedT<true> S; S.m = MoeSched{F.G, F.bid, nt, 0, 0, F.ctl + CW_CNT, WSP(int, WS_LIST), (const char*)WSP(bf16_t, WS_H), (const char*)WSP(bf16_t, WS_WM1), PRE};
        EpiMoe1 E{WSP(bf16_t, WS_BIG), WSP(f32x2, WS_TW)};
        pg8::gemm_phase(F.lds, D, D, D, 1 << 30, S, E);
    } if (PT_PRE && PT_HI == 6) pt1 = __builtin_amdgcn_s_memrealtime(); SEAM(6); if (!PT_PRE && PT_HI == 6) pt1 = __builtin_amdgcn_s_memrealtime(); }
    if (IN(7)) { if (PT_LO == 7) pt0 = __builtin_amdgcn_s_memrealtime(); REP(7) {
        const int nt = moe_prefix(F, 0, PRE);
        MoeSchedT<false> S; S.m = MoeSched{F.G, F.bid, nt, 0, 1, F.ctl + CW_CNT, WSP(int, WS_LIST), (const char*)WSP(bf16_t, WS_BIG), (const char*)WSP(bf16_t, WS_WM2), PRE};
        EpiMoe2<0> E{F.out, WSP(bf16_t, WS_X), WSP(float, WS_MOD), (LAS float*)(F.lds + LDS_GT)};
        pg8::gemm_phase(F.lds, 512, 512, 256, 4, S, E);
    } if (PT_PRE && PT_HI == 7) pt1 = __builtin_amdgcn_s_memrealtime(); SEAM(7); if (!PT_PRE && PT_HI == 7) pt1 = __builtin_amdgcn_s_memrealtime(); }
    if (IN(8)) { if (PT_LO == 8) pt0 = __builtin_amdgcn_s_memrealtime(); REP(8) { norm_mod_phase(F, ARGP(), 1); } if (PT_PRE && PT_HI == 8) pt1 = __builtin_amdgcn_s_memrealtime(); SEAM(8); if (!PT_PRE && PT_HI == 8) pt1 = __builtin_amdgcn_s_memrealtime(); }
    if (IN(9)) { if (PT_LO == 9) pt0 = __builtin_amdgcn_s_memrealtime(); REP(9) {
        pg8::PlainSched S; S.init(WSP(bf16_t, WS_H), WSP(bf16_t, WS_WIN1), NTOK, PW, D, D, D, F.G, F.bid, 0);
        pg8::EpiStoreBf16 E{WSP(bf16_t, WS_BIG), PW};
        pg8::gemm_phase(F.lds, D, D, D, 1 << 30, S, E);
        { int nextra = (136 * 8) % F.G; if (nextra > 0 && 2 * nextra <= F.G) nextra *= 2; if (nextra == 0) moe_fill(F, ARGP(), 48, 16, F.bid, F.G); else if (F.bid >= nextra) moe_fill(F, ARGP(), 48, 16, F.bid - nextra, F.G - nextra); }
    } if (PT_PRE && PT_HI == 9) pt1 = __builtin_amdgcn_s_memrealtime(); SEAM(9); if (!PT_PRE && PT_HI == 9) pt1 = __builtin_amdgcn_s_memrealtime(); }
    if (IN(10)) { if (PT_LO == 10) pt0 = __builtin_amdgcn_s_memrealtime(); REP(10) { p9_phase(F, ARGP()); } if (PT_PRE && PT_HI == 10) pt1 = __builtin_amdgcn_s_memrealtime(); SEAM(10); if (!PT_PRE && PT_HI == 10) pt1 = __builtin_amdgcn_s_memrealtime(); }
    if (IN(11)) { if (PT_LO == 11) pt0 = __builtin_amdgcn_s_memrealtime(); REP(11) {
        { pg8::PlainSched S; S.init(WSP(bf16_t, WS_BIG) + PC_CQ, WSP(bf16_t, WS_WUQ), NLAT, 768, 256, PW, 256, F.G, F.bid, 1);
          pg8::EpiStoreBf16 E{WSP(bf16_t, WS_QM), 768};
          pg8::gemm_phase(F.lds, 256, PW, 256, 1 << 30, S, E); }
        { pg8::PlainSched S; S.init(WSP(bf16_t, WS_BIG) + PC_CKV, WSP(bf16_t, WS_WUKV), NTOK, 1024, 128, PW, 128, F.G, F.bid, 0);
          pg8::EpiStoreBf16 E{WSP(bf16_t, WS_H), 1024};
          pg8::gemm_phase(F.lds, 128, PW, 128, 1 << 30, S, E); }

    } if (PT_PRE && PT_HI == 11) pt1 = __builtin_amdgcn_s_memrealtime(); SEAM(11); if (!PT_PRE && PT_HI == 11) pt1 = __builtin_amdgcn_s_memrealtime(); }
    if (IN(12)) { if (PT_LO == 12) pt0 = __builtin_amdgcn_s_memrealtime(); REP(12) { p11_phase(F, ARGP()); } if (PT_PRE && PT_HI == 12) pt1 = __builtin_amdgcn_s_memrealtime(); SEAM(12); if (!PT_PRE && PT_HI == 12) pt1 = __builtin_amdgcn_s_memrealtime(); }
    if (IN(13)) { if (PT_LO == 13 && PT_SUB != 7 && PT_SUB != 8) pt0 = __builtin_amdgcn_s_memrealtime(); REP(13) { attn_phase(F, ARGP(), pt1, pt0); } if (!PT_SUB && PT_PRE && PT_HI == 13) pt1 = __builtin_amdgcn_s_memrealtime(); SEAM(13); if (!PT_SUB && !PT_PRE && PT_HI == 13) pt1 = __builtin_amdgcn_s_memrealtime(); }
    if (IN(14)) { if (PT_LO == 14) pt0 = __builtin_amdgcn_s_memrealtime(); REP(14) {
        pg8::PlainSched S; S.init((bf16_t*)F.out, WSP(bf16_t, WS_WOUT1), NLAT, D, D, D, D, F.G, F.bid, 0);
        pg8::EpiResid<1> E{ARGP().in[0], ARGP().in[2], WSP(bf16_t, WS_X), WSP(float, WS_MOD) + (size_t)9 * NMOD * D};
        pg8::gemm_phase(F.lds, D, D, D, 1 << 30, S, E);
    } if (PT_PRE && PT_HI == 14) pt1 = __builtin_amdgcn_s_memrealtime(); SEAM(14); if (!PT_PRE && PT_HI == 14) pt1 = __builtin_amdgcn_s_memrealtime(); }
    if (IN(15)) { if (PT_LO == 15) pt0 = __builtin_amdgcn_s_memrealtime(); REP(15) { router_phase(F, ARGP(), 1, F.bid, F.G); } if (PT_PRE && PT_HI == 15) pt1 = __builtin_amdgcn_s_memrealtime(); SEAM(15); if (!PT_PRE && PT_HI == 15) pt1 = __builtin_amdgcn_s_memrealtime(); }
    if (IN(16)) { if (PT_LO == 16) pt0 = __builtin_amdgcn_s_memrealtime(); REP(16) {
        const int nt = moe_prefix(F, 1, PRE);
        MoeSchedT<true> S; S.m = MoeSched{F.G, F.bid, nt, 1, 0, F.ctl + CW_CNT + 64, WSP(int, WS_LIST), (const char*)WSP(bf16_t, WS_H), (const char*)WSP(bf16_t, WS_WM1), PRE};
        EpiMoe1 E{WSP(bf16_t, WS_BIG), WSP(f32x2, WS_TW)};
        pg8::gemm_phase(F.lds, D, D, D, 1 << 30, S, E);
    } if (PT_PRE && PT_HI == 16) pt1 = __builtin_amdgcn_s_memrealtime(); SEAM(16); if (!PT_PRE && PT_HI == 16) pt1 = __builtin_amdgcn_s_memrealtime(); }
    if (IN(17)) { if (PT_LO == 17) pt0 = __builtin_amdgcn_s_memrealtime(); REP(17) {
        const int nt = moe_prefix(F, 1, PRE);
        MoeSchedT<false> S; S.m = MoeSched{F.G, F.bid, nt, 1, 1, F.ctl + CW_CNT + 64, WSP(int, WS_LIST), (const char*)WSP(bf16_t, WS_BIG), (const char*)WSP(bf16_t, WS_WM2), PRE};
        EpiMoe2<1> E{F.out, WSP(bf16_t, WS_X), WSP(float, WS_MOD) + (size_t)9 * NMOD * D, (LAS float*)(F.lds + LDS_GT)};
        pg8::gemm_phase(F.lds, 512, 512, 256, 4, S, E);
    } if (PT_HI == 17) pt1 = __builtin_amdgcn_s_memrealtime(); }
    if (PT_LO >= 0 && F.bid == 0 && F.tid == 0) { const unsigned long long tend = __builtin_amdgcn_s_memrealtime() + (unsigned long long)PT_AMP * (pt1 - pt0);
        while (__builtin_amdgcn_s_memrealtime() < tend) __builtin_amdgcn_s_sleep(8); }
#undef IN
#undef SEAM
}

extern "C" void kernel_launch(void* const* d_in, const int* in_sizes, int n_in, void* d_out, int out_size, void* d_ws, size_t ws_size, hipStream_t stream) {
    static int grid = 0;
    if (grid == 0) {
        if (n_in != 30 || in_sizes[0] != NLAT * D || out_size != NLAT * D || ws_size < WS_END) { fprintf(stderr, "kernel_launch: unexpected shapes (n_in %d, in0 %d, out %d, ws %zu)\n", n_in, n_in > 0 ? in_sizes[0] : -1, out_size, ws_size); grid = -1; return; }
        int dev = 0, cus = 0, per_cu = 0;
        if (hipGetDevice(&dev) != hipSuccess || hipDeviceGetAttribute(&cus, hipDeviceAttributeMultiprocessorCount, dev) != hipSuccess) { grid = -1; return; }
        if (hipFuncSetAttribute((const void*)fwd, hipFuncAttributeMaxDynamicSharedMemorySize, LDS_BYTES) != hipSuccess) { fprintf(stderr, "kernel_launch: hipFuncSetAttribute failed\n"); grid = -1; return; }
        if (hipOccupancyMaxActiveBlocksPerMultiprocessor(&per_cu, (const void*)fwd, 512, LDS_BYTES) != hipSuccess || per_cu < 1) fprintf(stderr, "kernel_launch: occupancy query reports %d\n", per_cu);
        (void)hipGetLastError();
        grid = cus;
    }
    if (grid < 0) return;
    if (hipMemsetAsync((char*)d_ws + WS_CTL, 0, CTL_ZERO_BYTES, stream) != hipSuccess) return;
    Args a{};
    for (int i = 0; i < 30; ++i) a.in[i] = (const float*)d_in[i];
    a.out = (float*)d_out; a.ws = (unsigned char*)d_ws;
    const int last = MK_LAST_PHASE < NPHASE - 1 ? MK_LAST_PHASE : NPHASE - 1;
#if MK_ONE_LAUNCH
    a.ph_lo = 0; a.ph_hi = last + 1;
    hipLaunchKernelGGL(fwd, dim3(grid), dim3(512), LDS_BYTES, stream, a);
#else
    for (int p = 0; p <= last; ++p) { a.ph_lo = p; a.ph_hi = p + 1; hipLaunchKernelGGL(fwd, dim3(grid), dim3(512), LDS_BYTES, stream, a); }
#endif
    const hipError_t le = hipPeekAtLastError();
    if (le != hipSuccess) fprintf(stderr, "kernel_launch: launch failed: %s\n", hipGetErrorName(le));
}
```
